# Optimizing an MI355X kernel written in HIP

```python
import math
import jax
import jax.numpy as jnp
from jax import lax
import numpy as np

D_MODEL = 1024
BATCH = 8
SEQ = 8192
DEPTH = 4

GRID_W = 64
CTX_LEN = 256
N_MIXERS = 2

N_HEADS = 16
N_KV_HEADS = 4
HEAD_DIM = 64
GROUP = N_HEADS // N_KV_HEADS
Q_DIM = N_HEADS * HEAD_DIM
KV_DIM = N_KV_HEADS * HEAD_DIM
QKV_DIM = Q_DIM + 2 * KV_DIM
WINDOW = 128
Q_BLOCK = 128
ROPE_THETA = 10000.0

HY_ORDER = 2
HY_SHORT = 3
HY_FILTER_ORDER = 64
HY_BANDS = 16
HY_EMB = 1 + 2 * HY_BANDS
HY_TARGET = 1e-2
HY_FAST_DECAY = 0.3
HY_SLOW_DECAY = 1.5

N_EXPERTS = 32
TOP_K = 4
D_EXPERT = D_MODEL
SWIGLU_LIMIT = 7.0
SWIGLU_ALPHA = 1.702
MOE_BLOCK = 256

NORM_EPS = 1e-6

kernel_name = "hybrid_swa_hyena_moe_prefix_dit"


def rmsnorm(x, g):
    xf = x.astype(jnp.float32)
    y = xf * lax.rsqrt(jnp.mean(xf * xf, axis=-1, keepdims=True) + NORM_EPS)
    return (y * g.astype(jnp.float32)).astype(x.dtype)


def modulate(x, g, shift, scale):
    return rmsnorm(x, g) * (1 + scale) + shift


def axial_rope(x):
    n = x.shape[1]
    rows = n // GRID_W
    row = jnp.repeat(jnp.arange(rows), GRID_W).astype(jnp.float32)
    col = jnp.tile(jnp.arange(GRID_W), rows).astype(jnp.float32)
    half = HEAD_DIM // 2
    n_freq = half // 2
    inv = ROPE_THETA ** (-jnp.arange(n_freq, dtype=jnp.float32) / n_freq)
    ang = jnp.concatenate([row[:, None] * inv, col[:, None] * inv], axis=-1)
    cos = jnp.cos(ang)[None, :, None, :]
    sin = jnp.sin(ang)[None, :, None, :]
    xf = x.astype(jnp.float32)
    x1, x2 = xf[..., :half], xf[..., half:]
    return jnp.concatenate([x1 * cos - x2 * sin, x1 * sin + x2 * cos], axis=-1).astype(x.dtype)


def sink_softmax(s, sinks_f):
    sink = jnp.broadcast_to(sinks_f[None, :, :, None, None], s.shape[:-1] + (1,))
    return jax.nn.softmax(jnp.concatenate([s, sink], axis=-1), axis=-1)[..., :-1]


def attention_mixer(h, hc, w_qkv, b_qkv, w_o, b_o, sinks, ctx_out):
    B, N, _ = h.shape
    C = hc.shape[1]
    scale = HEAD_DIM ** -0.5
    sinks_f = sinks.astype(jnp.float32).reshape(N_KV_HEADS, GROUP)

    qkv = h @ w_qkv + b_qkv
    q = axial_rope(qkv[..., :Q_DIM].reshape(B, N, N_HEADS, HEAD_DIM))
    k = axial_rope(qkv[..., Q_DIM:Q_DIM + KV_DIM].reshape(B, N, N_KV_HEADS, HEAD_DIM))
    v = qkv[..., Q_DIM + KV_DIM:].reshape(B, N, N_KV_HEADS, HEAD_DIM)

    kv_c = hc @ w_qkv[:, Q_DIM:] + b_qkv[Q_DIM:]
    kc = kv_c[..., :KV_DIM].reshape(B, C, N_KV_HEADS, HEAD_DIM)
    vc = kv_c[..., KV_DIM:].reshape(B, C, N_KV_HEADS, HEAD_DIM)

    nb = N // Q_BLOCK
    qb = q.reshape(B, nb, Q_BLOCK, N_KV_HEADS, GROUP, HEAD_DIM)
    pad = ((0, 0), (Q_BLOCK, Q_BLOCK), (0, 0), (0, 0))
    kp = jnp.pad(k, pad)
    vp = jnp.pad(v, pad)

    def block(bi):
        qi = lax.dynamic_index_in_dim(qb, bi, axis=1, keepdims=False)
        kw = lax.dynamic_slice_in_dim(kp, bi * Q_BLOCK, 3 * Q_BLOCK, axis=1)
        vw = lax.dynamic_slice_in_dim(vp, bi * Q_BLOCK, 3 * Q_BLOCK, axis=1)
        qpos = bi * Q_BLOCK + jnp.arange(Q_BLOCK)
        kpos = (bi - 1) * Q_BLOCK + jnp.arange(3 * Q_BLOCK)
        valid = (jnp.abs(qpos[:, None] - kpos[None, :]) <= WINDOW) & (kpos >= 0)[None, :] & (kpos < N)[None, :]
        s_loc = jnp.einsum("bqkgd,bskd->bkgqs", qi, kw).astype(jnp.float32) * scale
        s_loc = jnp.where(valid, s_loc, -jnp.inf)
        s_ctx = jnp.einsum("bqkgd,bckd->bkgqc", qi, kc).astype(jnp.float32) * scale
        p = sink_softmax(jnp.concatenate([s_loc, s_ctx], axis=-1), sinks_f).astype(v.dtype)
        return (jnp.einsum("bkgqs,bskd->bqkgd", p[..., :3 * Q_BLOCK], vw)
                + jnp.einsum("bkgqc,bckd->bqkgd", p[..., 3 * Q_BLOCK:], vc))

    o = lax.map(block, jnp.arange(nb))
    o = jnp.moveaxis(o, 0, 1).reshape(B, N, Q_DIM)
    y = o @ w_o + b_o

    yc = None
    if ctx_out:
        qc = (hc @ w_qkv[:, :Q_DIM] + b_qkv[:Q_DIM]).reshape(B, C, N_KV_HEADS, GROUP, HEAD_DIM)
        s = jnp.einsum("bqkgd,bckd->bkgqc", qc, kc).astype(jnp.float32) * scale
        p = sink_softmax(s, sinks_f).astype(vc.dtype)
        oc = jnp.einsum("bkgqc,bckd->bqkgd", p, vc).reshape(B, C, Q_DIM)
        yc = oc @ w_o + b_o
    return y, yc


def short_conv(u, w, b):
    L = u.shape[1]
    r = HY_SHORT // 2
    up = jnp.pad(u, ((0, 0), (r, r), (0, 0)))
    out = b
    for s in range(HY_SHORT):
        out = out + up[:, s:s + L] * w[s]
    return out


def hyena_filter_spectrum(L, w1, b1, w2, b2, w3, b3, freq, w_out):
    f32 = jnp.float32
    t = jnp.linspace(0.0, 1.0, L, dtype=f32)[:, None]
    w = 2.0 * math.pi * jnp.arange(L, dtype=f32)[:, None] / L
    bands = jnp.linspace(1e-4, HY_BANDS - 1, HY_BANDS, dtype=f32)[None, :]
    z = jnp.concatenate([t, jnp.cos(bands * w), -jnp.sin(bands * w)], axis=-1)
    fr = freq.astype(f32)
    a = jnp.sin(fr * (z @ w1.astype(f32) + b1.astype(f32)))
    a = jnp.sin(fr * (a @ w2.astype(f32) + b2.astype(f32)))
    a = jnp.sin(fr * (a @ w3.astype(f32) + b3.astype(f32)))
    hf = (a @ w_out.astype(f32)).reshape(L, 2, HY_ORDER, D_MODEL)
    deltas = jnp.linspace(math.log(HY_TARGET) / HY_SLOW_DECAY, math.log(HY_TARGET) / HY_FAST_DECAY,
                          D_MODEL, dtype=f32)
    hf = hf * jnp.exp(-t * jnp.abs(deltas))[:, None, None, :]
    fwd, bwd = hf[:, 0], hf[:, 1]
    g = jnp.concatenate([fwd, jnp.zeros((1, HY_ORDER, D_MODEL), f32), bwd[:0:-1]], axis=0)
    g = g / jnp.sum(jnp.abs(g), axis=0, keepdims=True)
    return jnp.fft.rfft(g, axis=0)


def hyena_mixer(h, w_in, b_in, conv_w, conv_b, bias_d, w_o, b_o, filt):
    L = h.shape[1]
    spec = hyena_filter_spectrum(L, *filt)
    u = short_conv(h @ w_in + b_in, conv_w, conv_b)
    x1, x2, v = jnp.split(u, 3, axis=-1)
    z = v
    for o, gate in enumerate((x1, x2)):
        zf = z.astype(jnp.float32)
        conv = jnp.fft.irfft(jnp.fft.rfft(zf, n=2 * L, axis=1) * spec[None, :, o], n=2 * L, axis=1)[:, :L]
        z = gate * (conv + zf * bias_d[o].astype(jnp.float32)).astype(h.dtype)
    return z @ w_o + b_o


def moe_ffn(h, router_w, router_b, w_gu, b_gu, w_down, b_down):
    T, D = h.shape
    logits = (h @ router_w + router_b).astype(jnp.float32)
    top_v, top_i = lax.top_k(logits, TOP_K)
    gates = jax.nn.softmax(top_v, axis=-1)
    n_assign = T * TOP_K
    flat_e = top_i.reshape(-1)
    flat_tok = jnp.repeat(jnp.arange(T, dtype=jnp.int32), TOP_K)
    flat_g = gates.reshape(-1)
    order = jnp.argsort(flat_e)
    sorted_e = flat_e[order]
    counts = jnp.bincount(flat_e, length=N_EXPERTS)
    padded = (counts + MOE_BLOCK - 1) // MOE_BLOCK * MOE_BLOCK
    pad_end = jnp.cumsum(padded)
    pad_start = pad_end - padded
    start = jnp.cumsum(counts) - counts
    dest = pad_start[sorted_e] + jnp.arange(n_assign) - start[sorted_e]
    n_blocks = -(-n_assign // MOE_BLOCK) + N_EXPERTS
    n_rows = n_blocks * MOE_BLOCK
    row_tok = jnp.full((n_rows,), T, jnp.int32).at[dest].set(flat_tok[order])
    row_gate = jnp.zeros((n_rows,), jnp.float32).at[dest].set(flat_g[order])
    block_e = jnp.minimum(jnp.searchsorted(pad_end, jnp.arange(n_blocks) * MOE_BLOCK, side="right"),
                          N_EXPERTS - 1)
    h_pad = jnp.concatenate([h, jnp.zeros((1, D), h.dtype)], axis=0)
    xs = h_pad[row_tok].reshape(n_blocks, MOE_BLOCK, D)

    def expert_block(args):
        xb, e = args
        gu = xb @ w_gu[e] + b_gu[e]
        g = jnp.minimum(gu[..., :D_EXPERT], SWIGLU_LIMIT)
        up = jnp.clip(gu[..., D_EXPERT:], -SWIGLU_LIMIT, SWIGLU_LIMIT)
        act = g * jax.nn.sigmoid(SWIGLU_ALPHA * g) * (up + 1)
        return act @ w_down[e] + b_down[e]

    ys = lax.map(expert_block, (xs, block_e))
    out = jnp.zeros((T + 1, D), jnp.float32).at[row_tok].add(
        ys.reshape(n_rows, D).astype(jnp.float32) * row_gate[:, None])
    return out[:T].astype(h.dtype)


def setup_inputs(seed: int = 0) -> dict:
    key = jax.random.key(seed)
    ks = iter(jax.random.split(key, 48))
    f32 = jnp.float32
    D = D_MODEL
    n_attn = (DEPTH + N_MIXERS - 1) // N_MIXERS
    n_hy = DEPTH // N_MIXERS

    def nrm(shape, s):
        return jax.random.normal(next(ks), shape, f32) * s

    def gain(shape):
        return 1.0 + nrm(shape, 0.05)

    return {
        "x": nrm((BATCH, SEQ, D), 1.0),
        "c": nrm((BATCH, D), 1.0),
        "ctx": nrm((BATCH, CTX_LEN, D), 1.0),
        "c_ctx": nrm((D,), 1.0),
        "ada_w": nrm((DEPTH, D, 6 * D), 0.5 * D ** -0.5),
        "ada_b": nrm((DEPTH, 6 * D), 0.02),
        "norm_mix": gain((DEPTH, D)),
        "norm_ffn": gain((DEPTH, D)),
        "attn_w_qkv": nrm((n_attn, D, QKV_DIM), D ** -0.5),
        "attn_b_qkv": nrm((n_attn, QKV_DIM), 0.02),
        "attn_w_o": nrm((n_attn, Q_DIM, D), Q_DIM ** -0.5),
        "attn_b_o": nrm((n_attn, D), 0.02),
        "attn_sinks": nrm((n_attn, N_HEADS), 0.5),
        "hy_w_in": nrm((n_hy, D, 3 * D), D ** -0.5),
        "hy_b_in": nrm((n_hy, 3 * D), 0.02),
        "hy_conv_w": nrm((n_hy, HY_SHORT, 3 * D), HY_SHORT ** -0.5),
        "hy_conv_b": nrm((n_hy, 3 * D), 0.02),
        "hy_f_w1": nrm((n_hy, HY_EMB, HY_FILTER_ORDER), HY_EMB ** -0.5),
        "hy_f_b1": nrm((n_hy, HY_FILTER_ORDER), 0.1),
        "hy_f_w2": nrm((n_hy, HY_FILTER_ORDER, HY_FILTER_ORDER), HY_FILTER_ORDER ** -0.5),
        "hy_f_b2": nrm((n_hy, HY_FILTER_ORDER), 0.1),
        "hy_f_w3": nrm((n_hy, HY_FILTER_ORDER, HY_FILTER_ORDER), HY_FILTER_ORDER ** -0.5),
        "hy_f_b3": nrm((n_hy, HY_FILTER_ORDER), 0.1),
        "hy_f_freq": gain((n_hy, HY_FILTER_ORDER)),
        "hy_f_wout": nrm((n_hy, HY_FILTER_ORDER, 2 * HY_ORDER * D), HY_FILTER_ORDER ** -0.5),
        "hy_bias_d": nrm((n_hy, HY_ORDER, D), 0.5),
        "hy_w_o": nrm((n_hy, D, D), D ** -0.5),
        "hy_b_o": nrm((n_hy, D), 0.02),
        "moe_router_w": nrm((DEPTH, D, N_EXPERTS), D ** -0.5),
        "moe_router_b": nrm((DEPTH, N_EXPERTS), 0.01),
        "moe_w_gu": nrm((DEPTH, N_EXPERTS, D, 2 * D_EXPERT), D ** -0.5),
        "moe_b_gu": nrm((DEPTH, N_EXPERTS, 2 * D_EXPERT), 0.02),
        "moe_w_down": nrm((DEPTH, N_EXPERTS, D_EXPERT, D), D_EXPERT ** -0.5),
        "moe_b_down": nrm((DEPTH, N_EXPERTS, D), 0.02),
        "final_norm": gain((D,)),
    }


def reference(x, c, ctx, c_ctx, ada_w, ada_b, norm_mix, norm_ffn,
              attn_w_qkv, attn_b_qkv, attn_w_o, attn_b_o, attn_sinks,
              hy_w_in, hy_b_in, hy_conv_w, hy_conv_b, hy_f_w1, hy_f_b1, hy_f_w2, hy_f_b2,
              hy_f_w3, hy_f_b3, hy_f_freq, hy_f_wout, hy_bias_d, hy_w_o, hy_b_o,
              moe_router_w, moe_router_b, moe_w_gu, moe_b_gu, moe_w_down, moe_b_down,
              final_norm):
    B, N, D = x.shape
    s_c = jax.nn.silu(c)
    s_cc = jax.nn.silu(c_ctx)
    for i in range(DEPTH):
        kind = i % N_MIXERS
        j = i // N_MIXERS
        update_ctx = any(l % N_MIXERS == 0 for l in range(i + 1, DEPTH))
        need_ctx = update_ctx or kind == 0
        sh1, sc1, g1, sh2, sc2, g2 = jnp.split((s_c @ ada_w[i] + ada_b[i])[:, None, :], 6, axis=-1)
        h = modulate(x, norm_mix[i], sh1, sc1)
        hc = None
        if need_ctx:
            csh1, csc1, cg1, csh2, csc2, cg2 = jnp.split(s_cc @ ada_w[i] + ada_b[i], 6, axis=-1)
            hc = modulate(ctx, norm_mix[i], csh1, csc1)
        if kind == 0:
            y, yc = attention_mixer(h, hc, attn_w_qkv[j], attn_b_qkv[j], attn_w_o[j], attn_b_o[j],
                                    attn_sinks[j], update_ctx)
        else:
            filt = (hy_f_w1[j], hy_f_b1[j], hy_f_w2[j], hy_f_b2[j], hy_f_w3[j], hy_f_b3[j],
                    hy_f_freq[j], hy_f_wout[j])
            y = hyena_mixer(h, hy_w_in[j], hy_b_in[j], hy_conv_w[j], hy_conv_b[j], hy_bias_d[j],
                            hy_w_o[j], hy_b_o[j], filt)
            yc = None
            if update_ctx:
                yc = hyena_mixer(hc, hy_w_in[j], hy_b_in[j], hy_conv_w[j], hy_conv_b[j], hy_bias_d[j],
                                 hy_w_o[j], hy_b_o[j], filt)
        x = x + g1 * y
        if update_ctx:
            ctx = ctx + cg1 * yc
            tok = jnp.concatenate([modulate(x, norm_ffn[i], sh2, sc2).reshape(-1, D),
                                   modulate(ctx, norm_ffn[i], csh2, csc2).reshape(-1, D)], axis=0)
            f = moe_ffn(tok, moe_router_w[i], moe_router_b[i], moe_w_gu[i], moe_b_gu[i],
                        moe_w_down[i], moe_b_down[i])
            x = x + g2 * f[:B * N].reshape(x.shape)
            ctx = ctx + cg2 * f[B * N:].reshape(ctx.shape)
        else:
            f = moe_ffn(modulate(x, norm_ffn[i], sh2, sc2).reshape(-1, D), moe_router_w[i], moe_router_b[i],
                        moe_w_gu[i], moe_b_gu[i], moe_w_down[i], moe_b_down[i])
            x = x + g2 * f.reshape(x.shape)
    return rmsnorm(x, final_norm)
```

```cpp
#include <hip/hip_runtime.h>
#include <cstdio>
#include <cstdint>
#include <cmath>
#define MK_ONE_LAUNCH 1
namespace pg8 {
#define PG8_LAS __attribute__((address_space(3)))
typedef unsigned short bf16_t;
typedef short bf16x8 __attribute__((ext_vector_type(8)));
typedef float f32x4 __attribute__((ext_vector_type(4)));
typedef unsigned u32x4 __attribute__((ext_vector_type(4)));
constexpr int BM = 256, BK = 64, HALF = 128, HTB = HALF * BK * 2  , STAGE_BYTES = 8 * HTB, NXCD = 8, WGM = 8;

__host__ __device__ __forceinline__ int lds_byte(int r, int c) { const int st = (r >> 4) * 2 + (c >> 5), rr = r & 15, cc = c & 31, ob = rr * 64 + cc * 2; return st * 1024 + (ob ^ (((ob >> 9) & 1) << 5)); }
__host__ __device__ __forceinline__ void stage_rc(int b, int& R, int& C) { const int st = b / 1024, sb = b % 1024, swz = sb ^ (((sb >> 9) & 1) << 5); R = (st >> 1) * 16 + swz / 64; C = (st & 1) * 32 + (swz % 64) / 2; }
__host__ __device__ __forceinline__ int perm32(int rho) { const int n = rho >> 4, i = rho & 15; return 8 * (i >> 2) + 4 * n + (i & 3); }

struct Unit { int pm, pn, pb; };
struct Gemm { const bf16_t* A; const bf16_t* Bt; int M, N, K; const int* rows; };
struct StaticOrder {
    int nM, nN, nwg, G, c;
    __host__ __device__ void init(int M, int N, int G_, int c_) { nM = M / BM; nN = N / BM; nwg = nM * nN; G = G_; c = c_; }
    __host__ __device__ bool next(int i, Unit& u) const {
        const long L = (long)i * G + c; if (L >= nwg) return false;
        int wgid = (int)L; { const int q = nwg / NXCD, r = nwg % NXCD, xcd = wgid % NXCD, off = wgid / NXCD; wgid = (xcd < r ? xcd * (q + 1) : r * (q + 1) + (xcd - r) * q) + off; }
        const int nig = WGM * nN, gid = wgid / nig, fm = gid * WGM, gsz = (nM - fm) < WGM ? (nM - fm) : WGM;
        u.pm = fm + ((wgid % nig) % gsz); u.pn = (wgid % nig) / gsz; u.pb = u.pn; return true;
    }
    __device__ __forceinline__ void a_ready(const Unit&) const {}
    __device__ __forceinline__ void done(const Unit&) const {}
};
__device__ __forceinline__ unsigned cvt_pk_bf16(float lo, float hi) { unsigned r; asm volatile("v_cvt_pk_bf16_f32 %0, %1, %2" : "=v"(r) : "v"(lo), "v"(hi)); return r; }
typedef float f32x2 __attribute__((ext_vector_type(2)));
template <class Epi, class Sched, bool ALIGN_EPI = false, bool SP2 = false>
__device__ __forceinline__ void gemm_phase(PG8_LAS unsigned char* lds, const Gemm g, const Sched& S, const Epi& E) {
    int tid_ = threadIdx.x; asm volatile("" : "+v"(tid_));
    const int tid = tid_, wid = __builtin_amdgcn_readfirstlane(tid >> 6), lane = tid & 63, wr = wid >> 2, wc = wid & 3, fr = lane & 15, fq = lane >> 4;
    const int K = g.K, nt = K / BK;
    unsigned roffA[4], voffB[2];
#pragma unroll
    for (int i = 0; i < 2; ++i) { int R, C; stage_rc(tid * 16 + i * 8192, R, C); const int Rb = Epi::PERM ? ((R & ~31) + perm32(R & 31)) : R;
        roffA[i] = (unsigned)(R * K + C) * 2u; roffA[2 + i] = (unsigned)((R + HALF) * K + C) * 2u; voffB[i] = (unsigned)(Rb * K + C) * 2u; }
    const size_t kstep = (size_t)(BK * 2);
    const size_t hstep = (size_t)HALF * K * 2;
    const size_t tstep = 2 * hstep;
    const unsigned ldsw = (unsigned)wid * 1024u;
    const int aoff = lds_byte(wr * 64 + fr, fq * 8), boff = lds_byte(wc * 32 + fr, fq * 8);
#define PG8_SA(b, h) (((b) * 2 + (h)) * HTB)
#define PG8_SB(b, h) ((4 + (b) * 2 + (h)) * HTB)
#define PG8_STAGE(bufoff, gbase, voff) do { _Pragma("unroll") for (int _i = 0; _i < 2; ++_i) \
        __builtin_amdgcn_global_load_lds((const unsigned*)((const char*)(gbase) + (voff)[_i]), (PG8_LAS unsigned*)(lds + (bufoff) + ldsw + _i * 8192), 16, 0, 0); } while (0)
#define PG8_STAGEA(bufoff, gbase, h) do { _Pragma("unroll") for (int _i = 0; _i < 2; ++_i) \
        __builtin_amdgcn_global_load_lds((const unsigned*)((const char*)(gbase) + roffA[2 * (h) + _i]), (PG8_LAS unsigned*)(lds + (bufoff) + ldsw + _i * 8192), 16, 0, 0); } while (0)
#define PG8_LDA(dst, b, h) do { _Pragma("unroll") for (int m = 0; m < 4; ++m) _Pragma("unroll") for (int k = 0; k < 2; ++k) dst[m][k] = *(const PG8_LAS bf16x8*)(lds + PG8_SA(b, h) + aoff + m * 2048 + k * 1024); } while (0)
#define PG8_LDB(dst, b, h) do { _Pragma("unroll") for (int n = 0; n < 2; ++n) _Pragma("unroll") for (int k = 0; k < 2; ++k) dst[n][k] = *(const PG8_LAS bf16x8*)(lds + PG8_SB(b, h) + boff + n * 2048 + k * 1024); } while (0)
#define PG8_MMA(ai, bj, At, Bt) do { __builtin_amdgcn_s_setprio(1); _Pragma("unroll") for (int m = 0; m < 4; ++m) _Pragma("unroll") for (int n = 0; n < 2; ++n) _Pragma("unroll") for (int k = 0; k < 2; ++k) \
        acc[ai][bj][m][n] = __builtin_amdgcn_mfma_f32_16x16x32_bf16(Bt[n][k], At[m][k], acc[ai][bj][m][n], 0, 0, 0); __builtin_amdgcn_s_setprio(0); } while (0)
#define PG8_WAIT_V(n) asm volatile("s_waitcnt vmcnt(" #n ")" ::: "memory")
#define PG8_WAIT_L(n) asm volatile("s_waitcnt lgkmcnt(" #n ")" ::: "memory")
#define PG8_BAR __builtin_amdgcn_s_barrier()
#define PG8_SCHED __builtin_amdgcn_sched_barrier(0)
    Unit cur, nxt; int ui = 0;
    if (!S.next(0, cur)) return;
    f32x4 acc[2][2][4][2];
#pragma unroll
    for (int a = 0; a < 2; ++a)
#pragma unroll
        for (int b = 0; b < 2; ++b)
#pragma unroll
            for (int m = 0; m < 4; ++m)
#pragma unroll
                for (int n = 0; n < 2; ++n) acc[a][b][m][n] = (f32x4){0.f, 0.f, 0.f, 0.f};
    bf16x8 At[4][2], B0[2][2], B1[2][2];
    const __attribute__((address_space(1))) int* const rows = (const __attribute__((address_space(1))) int*)g.rows; const int r0g = (wid >> 1) * 16 + (lane >> 2); const unsigned cb2g = roffA[0] - (unsigned)(r0g * K) * 2u;
#define PG8_ROWS(dst, pm_) do { _Pragma("unroll") for (int _j = 0; _j < 4; ++_j) dst[_j] = (unsigned)rows[(size_t)(pm_) * BM + r0g + 64 * _j] * (unsigned)(K * 2) + cb2g; } while (0)
    if (rows) { unsigned t4[4]; PG8_ROWS(t4, cur.pm); roffA[0] = t4[0]; roffA[1] = t4[1]; roffA[2] = t4[2]; roffA[3] = t4[3]; }
    const char* cA = rows ? (const char*)g.A : (const char*)g.A + (size_t)cur.pm * tstep; const char* cB = (const char*)g.Bt + (size_t)cur.pb * tstep;
    S.a_ready(cur);
    if constexpr (SP2) {
        PG8_STAGE(PG8_SB(0, 0), cB, voffB); PG8_STAGE(PG8_SB(0, 1), cB + hstep, voffB); PG8_STAGEA(PG8_SA(0, 0), cA, 0); PG8_STAGEA(PG8_SA(0, 1), cA, 1);
        if (wr == 1) PG8_BAR;
        PG8_WAIT_V(2); PG8_BAR;
        PG8_STAGE(PG8_SB(1, 0), cB + kstep, voffB); PG8_STAGEA(PG8_SA(1, 0), cA + kstep, 0); PG8_STAGE(PG8_SB(1, 1), cB + hstep + kstep, voffB);
        PG8_WAIT_V(6); PG8_BAR;
    } else {
        PG8_STAGE(PG8_SB(0, 0), cB, voffB); PG8_STAGEA(PG8_SA(0, 0), cA, 0); PG8_STAGE(PG8_SB(0, 1), cB + hstep, voffB); PG8_STAGEA(PG8_SA(0, 1), cA, 1);
        if (wr == 1) PG8_BAR;
        PG8_WAIT_V(4); PG8_BAR;
        PG8_STAGE(PG8_SB(1, 0), cB + kstep, voffB); PG8_STAGEA(PG8_SA(1, 0), cA + kstep, 0); PG8_STAGE(PG8_SB(1, 1), cB + hstep + kstep, voffB);
        PG8_WAIT_V(6); PG8_BAR;
    }
    unsigned nr4[4] = {0u, 0u, 0u, 0u};
    for (;;) {
        const bool has_next = S.next(ui + 1, nxt);
        const char* nA = (has_next && !rows) ? (const char*)g.A + (size_t)nxt.pm * tstep : cA; const char* nB = has_next ? (const char*)g.Bt + (size_t)nxt.pb * tstep : cB;
        for (int t = 0; t < nt; t += 2) {
            const bool last = (t == nt - 2);
            const char* a1 = cA + (size_t)(t + 1) * kstep;
            const char* a2 = last ? nA : cA + (size_t)(t + 2) * kstep; const char* b2 = last ? nB : cB + (size_t)(t + 2) * kstep;
            const char* a3 = a2 + kstep; const char* b3 = b2 + kstep;
            if (last && has_next) S.a_ready(nxt);
            const bool swap_rows = rows != nullptr && last && has_next;
            if (rows != nullptr && has_next && t == nt - 4) {
                const __attribute__((address_space(1))) int* rp = rows + (size_t)nxt.pm * BM + r0g;
                asm volatile("global_load_dword %0, %4, off\n\tglobal_load_dword %1, %4, off offset:256\n\tglobal_load_dword %2, %4, off offset:512\n\tglobal_load_dword %3, %4, off offset:768"
                             : "=&v"(nr4[0]), "=&v"(nr4[1]), "=&v"(nr4[2]), "=&v"(nr4[3]) : "v"(rp) : "memory"); }
            if constexpr (SP2) {
            PG8_LDB(B0, 0, 0); PG8_LDB(B1, 0, 1); PG8_SCHED; PG8_LDA(At, 0, 0); PG8_STAGEA(PG8_SA(1, 1), a1, 1);
            if (swap_rows) {
#pragma unroll
                for (int _j = 0; _j < 4; ++_j) roffA[_j] = nr4[_j] * (unsigned)(K * 2) + cb2g; }
            PG8_WAIT_V(8); PG8_WAIT_L(0); PG8_BAR; PG8_MMA(0, 0, At, B0); PG8_MMA(0, 1, At, B1); PG8_BAR; PG8_SCHED;
            PG8_LDA(At, 0, 1); PG8_STAGE(PG8_SB(0, 0), b2, voffB); PG8_STAGE(PG8_SB(0, 1), b2 + hstep, voffB); PG8_STAGEA(PG8_SA(0, 0), a2, 0);
            PG8_WAIT_V(8); PG8_WAIT_L(0); PG8_BAR; PG8_MMA(1, 0, At, B0); PG8_MMA(1, 1, At, B1); PG8_BAR; PG8_SCHED;
            PG8_LDB(B0, 1, 0); PG8_LDB(B1, 1, 1); PG8_SCHED; PG8_LDA(At, 1, 0); PG8_STAGEA(PG8_SA(0, 1), a2, 1);
            PG8_WAIT_V(8); PG8_WAIT_L(0); PG8_BAR; PG8_MMA(0, 0, At, B0); PG8_MMA(0, 1, At, B1); PG8_BAR; PG8_SCHED;
            PG8_LDA(At, 1, 1); PG8_STAGE(PG8_SB(1, 0), b3, voffB); PG8_STAGE(PG8_SB(1, 1), b3 + hstep, voffB); PG8_STAGEA(PG8_SA(1, 0), a3, 0);
            PG8_WAIT_V(8); PG8_WAIT_L(0); PG8_BAR; PG8_MMA(1, 0, At, B0); PG8_MMA(1, 1, At, B1); PG8_BAR; PG8_SCHED;
            } else {
            PG8_LDB(B0, 0, 0); PG8_SCHED; PG8_LDA(At, 0, 0); PG8_STAGEA(PG8_SA(1, 1), a1, 1);
            if (swap_rows) {
#pragma unroll
                for (int _j = 0; _j < 4; ++_j) roffA[_j] = nr4[_j] * (unsigned)(K * 2) + cb2g; }
            PG8_WAIT_L(8); PG8_BAR; PG8_WAIT_L(0); PG8_MMA(0, 0, At, B0); PG8_BAR; PG8_SCHED;
            PG8_LDB(B1, 0, 1); PG8_STAGE(PG8_SB(0, 0), b2, voffB);
            PG8_BAR; PG8_WAIT_L(0); PG8_MMA(0, 1, At, B1); PG8_BAR;
            PG8_LDA(At, 0, 1); PG8_STAGEA(PG8_SA(0, 0), a2, 0);
            PG8_BAR; PG8_WAIT_L(0); PG8_MMA(1, 0, At, B0); PG8_BAR; PG8_SCHED;
            PG8_STAGE(PG8_SB(0, 1), b2 + hstep, voffB);
            PG8_WAIT_V(6); PG8_BAR; PG8_MMA(1, 1, At, B1); PG8_BAR;
            PG8_LDB(B0, 1, 0); PG8_SCHED; PG8_LDA(At, 1, 0); PG8_STAGEA(PG8_SA(0, 1), a2, 1);
            PG8_WAIT_L(8); PG8_BAR; PG8_WAIT_L(0); PG8_MMA(0, 0, At, B0); PG8_BAR; PG8_SCHED;
            PG8_LDB(B1, 1, 1); PG8_STAGE(PG8_SB(1, 0), b3, voffB);
            PG8_BAR; PG8_WAIT_L(0); PG8_MMA(0, 1, At, B1); PG8_BAR;
            PG8_LDA(At, 1, 1); PG8_STAGEA(PG8_SA(1, 0), a3, 0);
            PG8_BAR; PG8_WAIT_L(0); PG8_MMA(1, 0, At, B0); PG8_BAR; PG8_SCHED;
            PG8_STAGE(PG8_SB(1, 1), b3 + hstep, voffB);
            PG8_WAIT_V(6); PG8_BAR; PG8_MMA(1, 1, At, B1); PG8_BAR;
            }
        }
        if constexpr (ALIGN_EPI) { if (wr == 0) PG8_BAR; }
        if constexpr (!Epi::AFTER_DRAIN) { E(acc, cur, wr, wc, fr, fq); S.done(cur); }
        if (!has_next) break;
#pragma unroll
        for (int a = 0; a < 2; ++a)
#pragma unroll
            for (int b = 0; b < 2; ++b)
#pragma unroll
                for (int m = 0; m < 4; ++m)
#pragma unroll
                    for (int n = 0; n < 2; ++n) acc[a][b][m][n] = (f32x4){0.f, 0.f, 0.f, 0.f};
        cur = nxt; cA = nA; cB = nB; ++ui;
        if constexpr (ALIGN_EPI) { if (wr == 1) PG8_BAR; }
    }
    PG8_WAIT_V(0);
    if constexpr (!ALIGN_EPI) { if (wr == 0) PG8_BAR; }
    PG8_BAR;
    if constexpr (Epi::AFTER_DRAIN) { E.fused(acc, cur, wr, wc, fr, fq, lds, wid, lane); S.done(cur); }
#undef PG8_SA
#undef PG8_SB
#undef PG8_STAGE
#undef PG8_STAGEA
#undef PG8_ROWS
#undef PG8_LDA
#undef PG8_LDB
#undef PG8_MMA
#undef PG8_WAIT_V
#undef PG8_WAIT_L
#undef PG8_BAR
#undef PG8_SCHED
}
}
constexpr int NWAVES = 8;
constexpr int D = 1024, NBATCH = 8, SEQ = 8192, CTXL = 256, DEPTH = 4;
constexpr int TL = NBATCH * SEQ;
constexpr int TC = NBATCH * CTXL;
constexpr int TT = TL + TC;
constexpr int QKD = 1536, NE = 32;
constexpr int MAXBLK = 1088, MAXROWS = MAXBLK * 256;
constexpr float NORM_EPS = 1e-6f;
constexpr int N_IN = 35;
enum { I_X = 0, I_C, I_CTX, I_CCTX, I_ADAW, I_ADAB, I_NMIX, I_NFFN, I_AWQKV, I_ABQKV, I_AWO, I_ABO, I_ASINK, I_HWIN, I_HBIN, I_HCW, I_HCB,
       I_FW1, I_FB1, I_FW2, I_FB2, I_FW3, I_FB3, I_FFREQ, I_FWOUT, I_HBD, I_HWO, I_HBO, I_RW, I_RB, I_WGU, I_BGU, I_WDN, I_BDN, I_FNORM };

constexpr size_t MiB = 1u << 20;
constexpr size_t WS_CTL = 0, CTL_ZERO_BYTES = 1 * MiB;
constexpr size_t WS_MOD = 1 * MiB;
constexpr size_t WS_ROPE = 2 * MiB;
constexpr size_t WS_A3L = 4 * MiB;
constexpr size_t WS_A3C = 8 * MiB;
constexpr size_t WS_WQK = 9 * MiB;
constexpr size_t WS_WAO = 15 * MiB;
constexpr size_t WS_WHIN = 19 * MiB;
constexpr size_t WS_WHO = 31 * MiB;
constexpr size_t WS_WGU = 35 * MiB;
constexpr size_t WS_WDN = 547 * MiB;
constexpr size_t WS_XC = 803 * MiB;
constexpr size_t WS_H = 811 * MiB;
constexpr size_t WS_POS = 943 * MiB;
constexpr size_t WS_GATE = 945 * MiB;
constexpr size_t WS_DEST = 947 * MiB;
constexpr size_t WS_BIG = 949 * MiB;
constexpr size_t WS_QK = WS_BIG, WS_UT = WS_BIG, WS_YS = WS_BIG;
constexpr size_t WS_O = WS_BIG + 396 * MiB;
constexpr size_t WS_B2 = WS_BIG + 544 * MiB;
constexpr size_t WS_ZT = WS_B2, WS_G = WS_B2 + 132 * MiB, WS_TP = WS_B2 + 388 * MiB  , WS_ACT = WS_B2;
constexpr size_t WS_XB = WS_B2 + 544 * MiB;
constexpr size_t WS_RSRC = WS_XB + 132 * MiB;
constexpr size_t WS_END = WS_RSRC + 2 * MiB;
static_assert(WS_O + (size_t)TT * D * 2 <= WS_B2 && (size_t)MAXROWS * D * 2 <= 544 * MiB && (size_t)3072 * TT * 2 <= 396 * MiB, "ws map");
static_assert(WS_QK + (size_t)TT * QKD * 2 <= WS_O, "ws map 2");
constexpr int CW_BAR = 4096;
constexpr int CW_ECNT = 16384;

constexpr int RING_OFF = 0, RING_BYTES = 131072;
constexpr int LDSCTL_OFF = RING_BYTES, MISC_OFF = LDSCTL_OFF + 320, USER_OFF = RING_BYTES + 512;
constexpr int LDS_BYTES = 147456;

#define GAS __attribute__((address_space(1)))
#define LAS __attribute__((address_space(3)))
#define KAS __attribute__((address_space(4)))
typedef unsigned short bf16;
typedef unsigned v4u __attribute__((ext_vector_type(4)));
typedef unsigned v2u __attribute__((ext_vector_type(2)));
typedef int v4i __attribute__((ext_vector_type(4)));
typedef float f32x4 __attribute__((ext_vector_type(4)));
typedef float f32x16 __attribute__((ext_vector_type(16)));
typedef short bf16x8 __attribute__((ext_vector_type(8)));
typedef GAS unsigned gu32;
#define RLX_AGENT __ATOMIC_RELAXED, __HIP_MEMORY_SCOPE_AGENT
#define LDS_WAIT() asm volatile("s_waitcnt lgkmcnt(0)" ::: "memory")
#define VM_WAIT() asm volatile("s_waitcnt vmcnt(0)" ::: "memory")
__device__ __forceinline__ unsigned f2bf(float f) { unsigned u = __builtin_bit_cast(unsigned, f); return (u + 0x7fffu + ((u >> 16) & 1u)) >> 16; }
__device__ __forceinline__ unsigned pk2(float lo, float hi) { return f2bf(lo) | (f2bf(hi) << 16); }
__device__ __forceinline__ float bf2f(unsigned short b) { return __builtin_bit_cast(float, ((unsigned)b) << 16); }
__device__ __forceinline__ float bflo(unsigned w) { return __builtin_bit_cast(float, w << 16); }
__device__ __forceinline__ float bfhi(unsigned w) { return __builtin_bit_cast(float, w & 0xffff0000u); }
#define XB_TMO      128
#define XB_XCNT(j)  (256  + 64 * (j))
#define XB_XSUB(j)  (1280 + 64 * (j))
#define XB_XGEN(j)  (2304 + 64 * (j))
#define XB_TOP      3328
#define XB_TOPGEN   3392
#define XCD_BAR_WORDS 3456
#define XB_SPIN_CAP (1u << 21)

__device__ __forceinline__ unsigned xb_ld(unsigned* p)              { return __hip_atomic_load(p, __ATOMIC_RELAXED, __HIP_MEMORY_SCOPE_AGENT); }
__device__ __forceinline__ unsigned xb_add(unsigned* p, unsigned v) { return __hip_atomic_fetch_add(p, v, __ATOMIC_RELAXED, __HIP_MEMORY_SCOPE_AGENT); }
__device__ __forceinline__ unsigned xb_xcc_id() { return (unsigned)__builtin_amdgcn_s_getreg((3 << 11) | 20) & 0xFu; }
#define XB_SPIN(cond, bar) do { unsigned _sp = 0; while (cond) { __builtin_amdgcn_s_sleep(1); \
    if ((++_sp & 255u) == 0u) { if (xb_ld(&(bar)[XB_TMO])) break; if (_sp > XB_SPIN_CAP) { atomicAdd(&(bar)[XB_TMO], 1u); break; } } } } while (0)

struct XcdBarrier {
    unsigned* bar; unsigned x;
    volatile LAS unsigned* st;
};

__device__ __forceinline__ XcdBarrier xcd_barrier_post(unsigned* bar, volatile LAS unsigned* st) {
    XcdBarrier b; b.bar = bar; b.x = xb_xcc_id(); b.st = st;
    if (threadIdx.x == 0) (void)xb_add(&bar[XB_XCNT(b.x)], 1u);
    return b;
}
__device__ __forceinline__ void xcd_barrier_complete(unsigned* bar, unsigned x, unsigned& nloc, unsigned& nx) {
    const unsigned G = gridDim.x * gridDim.y * gridDim.z;
    unsigned sum, cnt, mine, sp = 0u;
    for (;;) {
        sum = 0u; cnt = 0u; mine = 0u;
#pragma unroll
        for (unsigned j = 0; j < 16; ++j) { const unsigned c = xb_ld(&bar[XB_XCNT(j)]); sum += c; cnt += (c > 0u) ? 1u : 0u; mine = (j == x) ? c : mine; }
        if (sum == G) break;
        __builtin_amdgcn_s_sleep(1);
        if ((++sp & 255u) == 0u) { if (xb_ld(&bar[XB_TMO])) break; if (sp > XB_SPIN_CAP) { atomicAdd(&bar[XB_TMO], 1u); break; } }
    }
    nloc = mine > 0u ? mine : 1u; nx = cnt > 0u ? cnt : 1u;
}

__device__ __forceinline__ void xcd_barrier(const XcdBarrier& b) {
    asm volatile("s_waitcnt vmcnt(0)" ::: "memory");
    __syncthreads();
    if (threadIdx.x == 0) {
        unsigned* bar = b.bar;
        __builtin_amdgcn_s_waitcnt(0);
        unsigned nloc = b.st[0], nx = b.st[1];
        if (nloc == 0u) { xcd_barrier_complete(bar, b.x, nloc, nx); b.st[0] = nloc; b.st[1] = nx; }
        const unsigned old = xb_add(&bar[XB_XSUB(b.x)], 1u);
        const unsigned gen = old / nloc;
        if (old + 1u == (gen + 1u) * nloc) {
            __builtin_amdgcn_fence(__ATOMIC_RELEASE, "agent");
            asm volatile("s_waitcnt vmcnt(0)" ::: "memory");
            const unsigned og = xb_add(&bar[XB_TOP], 1u);
            const unsigned tg = og / nx;
            if (og + 1u == (tg + 1u) * nx) xb_add(&bar[XB_TOPGEN], 1u);
            else XB_SPIN(xb_ld(&bar[XB_TOPGEN]) == tg, bar);
            __builtin_amdgcn_fence(__ATOMIC_ACQUIRE, "agent");
            xb_add(&bar[XB_XGEN(b.x)], 1u);
            asm volatile("s_waitcnt vmcnt(0)" ::: "memory");
        } else {
            XB_SPIN(xb_ld(&bar[XB_XGEN(b.x)]) == gen, bar);
            __builtin_amdgcn_fence(__ATOMIC_ACQUIRE, "agent");
            asm volatile("s_waitcnt vmcnt(0)" ::: "memory");
        }
    }
    __syncthreads();
}
#ifndef FFT_HOST_TEST
#define FFT_DEV __device__ __forceinline__
#define FFT_LAUNDER(t) asm volatile("" : "+v"(t))
#else
#define FFT_DEV inline
#define FFT_LAUNDER(t) (void)0
#endif
#ifndef FFT_HOST_TEST
#define FFT_FENCE() do { asm volatile("" ::: "memory"); __builtin_amdgcn_sched_barrier(0); } while (0)
#else
#define FFT_FENCE() (void)0
#endif
typedef float cf2 __attribute__((ext_vector_type(2)));
typedef float cf4 __attribute__((ext_vector_type(4)));
constexpr int FFT_N = 16384, FFT_THREADS = 512;
FFT_DEV void fft_cs(float frac, float& c, float& s) {
#ifndef FFT_HOST_TEST
    c = __builtin_amdgcn_cosf(frac); s = __builtin_amdgcn_sinf(frac);
#else
    c = (float)cos(6.283185307179586 * (double)frac); s = (float)sin(6.283185307179586 * (double)frac);
#endif
}
FFT_DEV cf2 cmulf(cf2 a, float c, float s) { cf2 r; r.x = a.x * c - a.y * s; r.y = a.x * s + a.y * c; return r; }
FFT_DEV int fft_swz(int e) { return e ^ (((e >> 5) & 7) << 1); }
FFT_DEV cf2 cmul2(cf2 a, cf2 b) { const cf2 axx = {a.x, a.x}, ayy = {a.y, a.y}, bs = {-b.y, b.x}; return ayy * bs + axx * b; }
FFT_DEV cf2 cmulc(cf2 a, cf2 b) { const cf2 axx = {a.x, a.x}, ayy = {a.y, a.y}, bs = {b.y, b.x}, bn = {b.x, -b.y}; return ayy * bs + axx * bn; }
FFT_DEV cf2 tw32(int j) {
    constexpr float C[9] = {1.0f, 0.98078528040323044913f, 0.92387953251128675613f, 0.83146961230254523708f, 0.70710678118654752440f, 0.55557023301960222474f, 0.38268343236508977173f, 0.19509032201612826785f, 0.0f};
    const int q = (j >> 3) & 3, r = j & 7; float c, sn;
    if (q == 0) { c = C[r]; sn = C[8 - r]; } else if (q == 1) { c = -C[8 - r]; sn = C[r]; } else if (q == 2) { c = -C[r]; sn = -C[8 - r]; } else { c = C[8 - r]; sn = -C[r]; }
    cf2 w; w.x = c; w.y = -sn; return w;
}
template <bool TW> FFT_DEV void bfly_fwd_w(cf2& a0, cf2& a1, cf2& a2, cf2& a3, cf2 w1, cf2 w2, cf2 w3) {
    const cf2 t0 = a0 + a2, t1 = a0 - a2, t2 = a1 + a3, t3 = a1 - a3;
    cf2 y0 = t0 + t2, y2 = t0 - t2, y1, y3;
    y1.x = t1.x + t3.y; y1.y = t1.y - t3.x;
    y3.x = t1.x - t3.y; y3.y = t1.y + t3.x;
    if (TW) { y1 = cmul2(y1, w1); y2 = cmul2(y2, w2); y3 = cmul2(y3, w3); }
    a0 = y0; a1 = y1; a2 = y2; a3 = y3;
}
template <bool TW> FFT_DEV void bfly_inv_w(cf2& a0, cf2& a1, cf2& a2, cf2& a3, cf2 w1, cf2 w2, cf2 w3) {
    if (TW) { a1 = cmulc(a1, w1); a2 = cmulc(a2, w2); a3 = cmulc(a3, w3); }
    const cf2 t0 = a0 + a2, t1 = a0 - a2, t2 = a1 + a3, t3 = a1 - a3;
    cf2 y0 = t0 + t2, y2 = t0 - t2, y1, y3;
    y1.x = t1.x - t3.y; y1.y = t1.y + t3.x;
    y3.x = t1.x + t3.y; y3.y = t1.y - t3.x;
    a0 = y0; a1 = y1; a2 = y2; a3 = y3;
}
FFT_DEV cf2 fft_w(float frac) { float c, sn; fft_cs(frac, c, sn); cf2 w; w.x = c; w.y = -sn; return w; }
template <bool TW> FFT_DEV void bfly_fwd(cf2& a0, cf2& a1, cf2& a2, cf2& a3, float f) {
    const cf2 t0 = a0 + a2, t1 = a0 - a2, t2 = a1 + a3, t3 = a1 - a3;
    cf2 y0 = t0 + t2, y2 = t0 - t2, y1, y3;
    y1.x = t1.x + t3.y; y1.y = t1.y - t3.x;
    y3.x = t1.x - t3.y; y3.y = t1.y + t3.x;
    if (TW) { float c1, s1, c2, s2, c3, s3; fft_cs(f, c1, s1); fft_cs(2.0f * f, c2, s2); fft_cs(3.0f * f, c3, s3);
        y1 = cmulf(y1, c1, -s1); y2 = cmulf(y2, c2, -s2); y3 = cmulf(y3, c3, -s3); }
    a0 = y0; a1 = y1; a2 = y2; a3 = y3;
}
template <bool TW> FFT_DEV void bfly_inv(cf2& a0, cf2& a1, cf2& a2, cf2& a3, float f) {
    if (TW) { float c1, s1, c2, s2, c3, s3; fft_cs(f, c1, s1); fft_cs(2.0f * f, c2, s2); fft_cs(3.0f * f, c3, s3);
        a1 = cmulf(a1, c1, s1); a2 = cmulf(a2, c2, s2); a3 = cmulf(a3, c3, s3); }
    const cf2 t0 = a0 + a2, t1 = a0 - a2, t2 = a1 + a3, t3 = a1 - a3;
    cf2 y0 = t0 + t2, y2 = t0 - t2, y1, y3;
    y1.x = t1.x - t3.y; y1.y = t1.y + t3.x;
    y3.x = t1.x + t3.y; y3.y = t1.y - t3.x;
    a0 = y0; a1 = y1; a2 = y2; a3 = y3;
}
template <class PT> FFT_DEV void fft_fwd_first(PT X, const float (&za)[16], const float (&zb)[16], int tid) {
    FFT_LAUNDER(tid);
    const cf2 wt1 = fft_w((float)tid * (1.0f / 16384.0f)), wt2 = cmul2(wt1, wt1), wt3 = cmul2(wt2, wt1);
#pragma unroll
    for (int q = 0; q < 8; ++q) {
        const int k = tid + FFT_THREADS * q;
        cf2 a0, a1, a2, a3; a0.x = za[q]; a0.y = zb[q]; a1.x = za[q + 8]; a1.y = zb[q + 8]; a2.x = 0.f; a2.y = 0.f; a3 = a2;
        bfly_fwd_w<true>(a0, a1, a2, a3, cmul2(wt1, tw32(q)), cmul2(wt2, tw32(2 * q)), cmul2(wt3, tw32(3 * q)));
        const int sk = fft_swz(k);
        X[sk] = a0; X[sk + 4096] = a1; X[sk + 8192] = a2; X[sk + 12288] = a3;
        FFT_FENCE();
    }
}
template <class PT, class SP> FFT_DEV void fft_fwd_first_full(PT X, SP src, float scale, int tid) {
    FFT_LAUNDER(tid);
    const cf2 wt1 = fft_w((float)tid * (1.0f / 16384.0f)), wt2 = cmul2(wt1, wt1), wt3 = cmul2(wt2, wt1);
#pragma unroll
    for (int q = 0; q < 8; ++q) {
        const int k = tid + FFT_THREADS * q;
        cf2 a0, a1, a2, a3; a0.x = src[k] * scale; a0.y = 0.f; a1.x = src[k + 4096] * scale; a1.y = 0.f; a2.x = src[k + 8192] * scale; a2.y = 0.f; a3.x = src[k + 12288] * scale; a3.y = 0.f;
        bfly_fwd_w<true>(a0, a1, a2, a3, cmul2(wt1, tw32(q)), cmul2(wt2, tw32(2 * q)), cmul2(wt3, tw32(3 * q)));
        const int sk = fft_swz(k);
        X[sk] = a0; X[sk + 4096] = a1; X[sk + 8192] = a2; X[sk + 12288] = a3;
        if (q & 1) FFT_FENCE();
    }
}
template <int S2> FFT_DEV int fft_dbl_idx(int base, int i) {
    if (S2 == 256) return fft_swz(base) + S2 * i;
    if (S2 == 16) return (base ^ ((i >> 1) << 1)) + S2 * i;
    return fft_swz(base + S2 * i);
}
template <int P, class PT> FFT_DEV void fft_fwd_double(PT X, int tid) {
    FFT_LAUNDER(tid);
    constexpr int LS2 = 2 * (5 - P), S2 = 1 << LS2, NCUR = 1 << (2 * (7 - P));
#pragma unroll 1
    for (int q = 0; q < 2; ++q) {
        const int g = tid + FFT_THREADS * q, blk = g >> LS2, k = g & (S2 - 1), base = blk * NCUR + k;
        cf2 s[16];
#pragma unroll
        for (int i = 0; i < 16; ++i) s[i] = X[fft_dbl_idx<S2>(base, i)];
        const cf2 w1 = fft_w((float)k * (1.0f / (float)NCUR)), w2 = cmul2(w1, w1), w3 = cmul2(w2, w1), v1 = cmul2(w2, w2), v2 = cmul2(v1, v1), v3 = cmul2(v2, v1);
#pragma unroll
        for (int i0 = 0; i0 < 4; ++i0) bfly_fwd_w<true>(s[i0], s[i0 + 4], s[i0 + 8], s[i0 + 12], cmul2(w1, tw32(2 * i0)), cmul2(w2, tw32(4 * i0)), cmul2(w3, tw32(6 * i0)));
#pragma unroll
        for (int m = 0; m < 4; ++m) bfly_fwd_w<true>(s[4 * m], s[4 * m + 1], s[4 * m + 2], s[4 * m + 3], v1, v2, v3);
#pragma unroll
        for (int i = 0; i < 16; ++i) X[fft_dbl_idx<S2>(base, i)] = s[i];
    }
}
template <int P, class PT> FFT_DEV void fft_inv_double(PT X, int tid) {
    FFT_LAUNDER(tid);
    constexpr int LS2 = 2 * (5 - P), S2 = 1 << LS2, NCUR = 1 << (2 * (7 - P));
#pragma unroll 1
    for (int q = 0; q < 2; ++q) {
        const int g = tid + FFT_THREADS * q, blk = g >> LS2, k = g & (S2 - 1), base = blk * NCUR + k;
        cf2 s[16];
#pragma unroll
        for (int i = 0; i < 16; ++i) s[i] = X[fft_dbl_idx<S2>(base, i)];
        const cf2 w1 = fft_w((float)k * (1.0f / (float)NCUR)), w2 = cmul2(w1, w1), w3 = cmul2(w2, w1), v1 = cmul2(w2, w2), v2 = cmul2(v1, v1), v3 = cmul2(v2, v1);
#pragma unroll
        for (int m = 0; m < 4; ++m) bfly_inv_w<true>(s[4 * m], s[4 * m + 1], s[4 * m + 2], s[4 * m + 3], v1, v2, v3);
#pragma unroll
        for (int i0 = 0; i0 < 4; ++i0) bfly_inv_w<true>(s[i0], s[i0 + 4], s[i0 + 8], s[i0 + 12], cmul2(w1, tw32(2 * i0)), cmul2(w2, tw32(4 * i0)), cmul2(w3, tw32(6 * i0)));
#pragma unroll
        for (int i = 0; i < 16; ++i) X[fft_dbl_idx<S2>(base, i)] = s[i];
    }
}
template <class PT> FFT_DEV void fft_load_group(PT X, int g, cf2 (&s)[16]) {
    const int m2 = ((g >> 1) & 7) << 1;
#pragma unroll
    for (int c = 0; c < 8; ++c) { const int e = 16 * g + ((2 * c) ^ m2); s[2 * c] = X[e]; s[2 * c + 1] = X[e + 1]; }
}
template <class PT> FFT_DEV void fft_store_group(PT X, int g, const cf2 (&s)[16]) {
    const int m2 = ((g >> 1) & 7) << 1;
#pragma unroll
    for (int c = 0; c < 8; ++c) { const int e = 16 * g + ((2 * c) ^ m2); X[e] = s[2 * c]; X[e + 1] = s[2 * c + 1]; }
}
FFT_DEV void fft_last2_fwd(cf2 (&s)[16]) {
#pragma unroll
    for (int i0 = 0; i0 < 4; ++i0) bfly_fwd_w<true>(s[i0], s[i0 + 4], s[i0 + 8], s[i0 + 12], tw32(2 * i0), tw32(4 * i0), tw32(6 * i0));
#pragma unroll
    for (int m = 0; m < 4; ++m) bfly_fwd_w<false>(s[4 * m], s[4 * m + 1], s[4 * m + 2], s[4 * m + 3], tw32(0), tw32(0), tw32(0));
}
FFT_DEV void fft_last2_inv(cf2 (&s)[16]) {
#pragma unroll
    for (int m = 0; m < 4; ++m) bfly_inv_w<false>(s[4 * m], s[4 * m + 1], s[4 * m + 2], s[4 * m + 3], tw32(0), tw32(0), tw32(0));
#pragma unroll
    for (int i0 = 0; i0 < 4; ++i0) bfly_inv_w<true>(s[i0], s[i0 + 4], s[i0 + 8], s[i0 + 12], tw32(2 * i0), tw32(4 * i0), tw32(6 * i0));
}
template <class PT, class GP> FFT_DEV void fft_mid_store(PT X, GP G, float scale, float add, int tid) {
    FFT_LAUNDER(tid);
#pragma unroll 1
    for (int q = 0; q < 2; ++q) { const int g = tid + FFT_THREADS * q; cf2 s[16]; fft_load_group(X, g, s); fft_last2_fwd(s);
#pragma unroll
        for (int c = 0; c < 8; ++c) { cf4 w; w.x = (s[2 * c].x + add) * scale; w.y = s[2 * c].y * scale; w.z = (s[2 * c + 1].x + add) * scale; w.w = s[2 * c + 1].y * scale; G[c * 1024 + g] = w; } }
}
template <class PT, class GP> FFT_DEV void fft_mid_mul(PT X, GP G, int tid) {
    FFT_LAUNDER(tid);
#pragma unroll 1
    for (int q = 0; q < 2; ++q) { const int g = tid + FFT_THREADS * q; cf2 s[16]; cf4 w[4];
#pragma unroll
        for (int c = 0; c < 4; ++c) w[c] = G[c * 1024 + g];
        fft_load_group(X, g, s); fft_last2_fwd(s);
#pragma unroll
        for (int h = 0; h < 2; ++h) {
#pragma unroll
            for (int c4 = 0; c4 < 4; ++c4) { const int c = 4 * h + c4; const cf4 wc = w[c4]; if (h == 0) w[c4] = G[(c + 4) * 1024 + g];
                cf2 a = s[2 * c], b = s[2 * c + 1], r; r.x = a.x * wc.x - a.y * wc.y; r.y = a.x * wc.y + a.y * wc.x; s[2 * c] = r;
                r.x = b.x * wc.z - b.y * wc.w; r.y = b.x * wc.w + b.y * wc.z; s[2 * c + 1] = r; } }
        fft_last2_inv(s); fft_store_group(X, g, s); }
}
template <class PT> FFT_DEV void fft_inv_last(PT X, float (&za)[16], float (&zb)[16], int tid) {
    FFT_LAUNDER(tid);
    const cf2 wt1 = fft_w((float)tid * (1.0f / 16384.0f)), wt2 = cmul2(wt1, wt1), wt3 = cmul2(wt2, wt1);
#pragma unroll
    for (int q = 0; q < 8; ++q) {
        const int k = tid + FFT_THREADS * q;
        const int sk = fft_swz(k);
        cf2 a0 = X[sk], a1 = X[sk + 4096], a2 = X[sk + 8192], a3 = X[sk + 12288];
        bfly_inv_w<true>(a0, a1, a2, a3, cmul2(wt1, tw32(q)), cmul2(wt2, tw32(2 * q)), cmul2(wt3, tw32(3 * q)));
        za[q] = a0.x; zb[q] = a0.y; za[q + 8] = a1.x; zb[q + 8] = a1.y;
        FFT_FENCE();
    }
}
template <int Q0, class PT> FFT_DEV void fft_inv_last_part(PT X, float (&za)[8], float (&zb)[8], int tid) {
    FFT_LAUNDER(tid);
    const cf2 wt1 = fft_w((float)tid * (1.0f / 16384.0f)), wt2 = cmul2(wt1, wt1), wt3 = cmul2(wt2, wt1);
#pragma unroll
    for (int q = Q0; q < Q0 + 4; ++q) {
        const int k = tid + FFT_THREADS * q;
        const int sk = fft_swz(k);
        cf2 a0 = X[sk], a1 = X[sk + 4096], a2 = X[sk + 8192], a3 = X[sk + 12288];
        bfly_inv_w<true>(a0, a1, a2, a3, cmul2(wt1, tw32(q)), cmul2(wt2, tw32(2 * q)), cmul2(wt3, tw32(3 * q)));
        za[q - Q0] = a0.x; zb[q - Q0] = a0.y; za[4 + q - Q0] = a1.x; zb[4 + q - Q0] = a1.y;
    }
}
namespace pg8 {
enum { EPI_QK = 0, EPI_T = 1, EPI_RES = 2, EPI_SWIGLU = 3, EPI_DOWN = 4 };
struct EpiAny {
    static constexpr bool PERM = true, AFTER_DRAIN = false;
    int mode, ldc;
    bf16_t* O;
    float* f0; float* f1;
    const float* p0; const float* p1; const float* p2; const float* p3;
    __device__ __forceinline__ void epi_qk(const f32x4 (&acc)[2][2][4][2], const Unit& u, int wr, int wc, int fr, int fq) const {
        const int row0 = u.pm * BM + wr * 64 + fr;
        const bool latent = u.pm < 256;
#pragma unroll
        for (int bj = 0; bj < 2; ++bj) {
            const int cs = u.pn * BM + bj * HALF + wc * 32 + 8 * fq;
            const int hb = cs & ~63, jj = (cs & 63) >> 3;
            const bool isv = u.pn >= 5;
            const f32x4 b0 = *(const f32x4*)(p0 + (isv ? cs : hb + 4 * jj)), b1 = *(const f32x4*)(p0 + (isv ? cs + 4 : hb + 32 + 4 * jj));
#pragma unroll
            for (int ai = 0; ai < 2; ++ai)
#pragma unroll
                for (int m = 0; m < 4; ++m) {
                    const int row = row0 + ai * HALF + m * 16;
                    f32x4 x1 = acc[ai][bj][m][0] + b0, x2 = acc[ai][bj][m][1] + b1;
                    if (latent && !isv) {
                        const float* rp = p1 + ((size_t)(row & 8191) * 32 + 4 * jj) * 2;
                        const f32x4 cs0 = *(const f32x4*)rp, cs1 = *(const f32x4*)(rp + 4);
                        const f32x4 c = (f32x4){cs0[0], cs0[2], cs1[0], cs1[2]}, s = (f32x4){cs0[1], cs0[3], cs1[1], cs1[3]};
                        const f32x4 o1 = x1 * c - x2 * s, o2 = x1 * s + x2 * c; x1 = o1; x2 = o2;
                    }
                    u32x4 w; w.x = cvt_pk_bf16(x1[0], x1[1]); w.y = cvt_pk_bf16(x1[2], x1[3]); w.z = cvt_pk_bf16(x2[0], x2[1]); w.w = cvt_pk_bf16(x2[2], x2[3]);
                    *(u32x4*)(O + (size_t)row * 1536 + cs) = w;
                }
        }
    }
    __device__ __forceinline__ void epi_t(const f32x4 (&acc)[2][2][4][2], const Unit& u, int wr, int wc, int fr, int fq) const {
        const int row0 = u.pm * BM + wr * 64 + fr, col0 = u.pn * BM + wc * 32 + 8 * fq;
#pragma unroll
        for (int ai = 0; ai < 2; ++ai)
#pragma unroll
            for (int m = 0; m < 4; ++m) { const int row = row0 + ai * HALF + m * 16; const float bv = p0[row]; bf16_t* rowp = O + (size_t)row * ldc + col0;
#pragma unroll
                for (int bj = 0; bj < 2; ++bj) { const f32x4 v0 = acc[ai][bj][m][0] + bv, v1 = acc[ai][bj][m][1] + bv;
                    u32x4 w; w.x = cvt_pk_bf16(v0[0], v0[1]); w.y = cvt_pk_bf16(v0[2], v0[3]); w.z = cvt_pk_bf16(v1[0], v1[1]); w.w = cvt_pk_bf16(v1[2], v1[3]);
                    *(u32x4*)(rowp + bj * HALF) = w; } }
    }
    __device__ __forceinline__ void epi_res(const f32x4 (&acc)[2][2][4][2], const Unit& u, int wr, int wc, int fr, int fq) const {
        const bool latent = u.pm < 256;
        const int row0 = u.pm * BM + wr * 64 + fr, col0 = u.pn * BM + wc * 32 + 8 * fq;
        const float* gp = p3 + (size_t)(latent ? (u.pm >> 5) : 8) * 6144 + col0; const float* bp = p2 + col0;
        const float* srcf = p0 ? (latent ? p0 : p1 - (size_t)TL * 1024) : nullptr;
#pragma unroll
        for (int bj = 0; bj < 2; ++bj) { const f32x4 b0 = *(const f32x4*)(bp + bj * HALF), b1 = *(const f32x4*)(bp + bj * HALF + 4), g0 = *(const f32x4*)(gp + bj * HALF), g1 = *(const f32x4*)(gp + bj * HALF + 4);
#pragma unroll
            for (int ai = 0; ai < 2; ++ai)
#pragma unroll
                for (int m = 0; m < 4; ++m) { const size_t off = (size_t)(row0 + ai * HALF + m * 16) * 1024 + col0 + bj * HALF;
                    f32x4 x0, x1;
                    if (srcf) { x0 = *(const f32x4*)(srcf + off); x1 = *(const f32x4*)(srcf + off + 4); }
                    else { const u32x4 r = *(const u32x4*)(O + off); x0 = (f32x4){__builtin_bit_cast(float, r.x << 16), __builtin_bit_cast(float, r.x & 0xffff0000u), __builtin_bit_cast(float, r.y << 16), __builtin_bit_cast(float, r.y & 0xffff0000u)};
                        x1 = (f32x4){__builtin_bit_cast(float, r.z << 16), __builtin_bit_cast(float, r.z & 0xffff0000u), __builtin_bit_cast(float, r.w << 16), __builtin_bit_cast(float, r.w & 0xffff0000u)}; }
                    const f32x4 v0 = x0 + g0 * (acc[ai][bj][m][0] + b0), v1 = x1 + g1 * (acc[ai][bj][m][1] + b1);
                    u32x4 w; w.x = cvt_pk_bf16(v0[0], v0[1]); w.y = cvt_pk_bf16(v0[2], v0[3]); w.z = cvt_pk_bf16(v1[0], v1[1]); w.w = cvt_pk_bf16(v1[2], v1[3]);
                    *(u32x4*)(O + off) = w; } }
    }
    __device__ __forceinline__ void epi_swiglu(const f32x4 (&acc)[2][2][4][2], const Unit& u, int wr, int wc, int fr, int fq) const {
        const int e = (u.pb >> 3) & 31;
        const int row0 = u.pm * BM + wr * 64 + fr, col0 = u.pn * HALF + wc * 32 + 8 * fq;
        const float* bp = p0 + (size_t)e * 2048 + col0;
        const f32x4 bg0 = *(const f32x4*)bp, bg1 = *(const f32x4*)(bp + 4), bu0 = *(const f32x4*)(bp + 1024), bu1 = *(const f32x4*)(bp + 1028);
#pragma unroll
        for (int ai = 0; ai < 2; ++ai)
#pragma unroll
            for (int m = 0; m < 4; ++m) {
                f32x4 a[2];
#pragma unroll
                for (int n = 0; n < 2; ++n) {
                    f32x4 g = acc[ai][0][m][n] + (n ? bg1 : bg0), up = acc[ai][1][m][n] + (n ? bu1 : bu0);
#pragma unroll
                    for (int t = 0; t < 4; ++t) { const float gg = fminf(g[t], 7.0f), uu = fminf(fmaxf(up[t], -7.0f), 7.0f);
                        const float sg = __builtin_amdgcn_rcpf(1.0f + __builtin_amdgcn_exp2f(-2.4554669595930157f * gg)); a[n][t] = gg * sg * (uu + 1.0f); }
                }
                u32x4 w; w.x = cvt_pk_bf16(a[0][0], a[0][1]); w.y = cvt_pk_bf16(a[0][2], a[0][3]); w.z = cvt_pk_bf16(a[1][0], a[1][1]); w.w = cvt_pk_bf16(a[1][2], a[1][3]);
                *(u32x4*)(O + (size_t)(row0 + ai * HALF + m * 16) * 1024 + col0) = w;
            }
    }
    __device__ __forceinline__ void epi_down(const f32x4 (&acc)[2][2][4][2], const Unit& u, int wr, int wc, int fr, int fq) const {
        const int e = (u.pb >> 2) & 31;
        const int row0 = u.pm * BM + wr * 64 + fr, col0 = u.pn * BM + wc * 32 + 8 * fq;
        const float* bp = p0 + (size_t)e * 1024 + col0;
#pragma unroll
        for (int bj = 0; bj < 2; ++bj) { const f32x4 b0 = *(const f32x4*)(bp + bj * HALF), b1 = *(const f32x4*)(bp + bj * HALF + 4);
#pragma unroll
            for (int ai = 0; ai < 2; ++ai)
#pragma unroll
                for (int m = 0; m < 4; ++m) { const f32x4 v0 = acc[ai][bj][m][0] + b0, v1 = acc[ai][bj][m][1] + b1;
                    u32x4 w; w.x = cvt_pk_bf16(v0[0], v0[1]); w.y = cvt_pk_bf16(v0[2], v0[3]); w.z = cvt_pk_bf16(v1[0], v1[1]); w.w = cvt_pk_bf16(v1[2], v1[3]);
                    *(u32x4*)(O + (size_t)(row0 + ai * HALF + m * 16) * 1024 + col0 + bj * HALF) = w; } }
    }
    __device__ __forceinline__ void operator()(const f32x4 (&acc)[2][2][4][2], const Unit& u, int wr, int wc, int fr, int fq) const {
        if (mode == EPI_QK) epi_qk(acc, u, wr, wc, fr, fq);
        else if (mode == EPI_T) epi_t(acc, u, wr, wc, fr, fq);
        else if (mode == EPI_RES) epi_res(acc, u, wr, wc, fr, fq);
        else if (mode == EPI_SWIGLU) epi_swiglu(acc, u, wr, wc, fr, fq);
        else epi_down(acc, u, wr, wc, fr, fq);
    }
};
struct AnyOrder {
    int moe; StaticOrder so;
    const PG8_LAS int* rb2e; int nblk, lg, wbase;
    __device__ __forceinline__ bool next(int i, Unit& u) const {
        if (!moe) return so.next(i, u);
        const int x = so.c & 7, j = so.c >> 3, per = (so.G >> 3) >> lg;
        const int rb = (i * 8 + x) * per + (j >> lg); if (rb >= nblk) return false;
        const int e = rb2e[rb];
        u.pm = rb; u.pn = j & ((1 << lg) - 1); u.pb = ((wbase + e) << lg) + u.pn; return true;
    }
    __device__ __forceinline__ void a_ready(const Unit&) const {}
    __device__ __forceinline__ void done(const Unit&) const {}
};
}
struct Frame {
    LAS unsigned char* lds;
    volatile LAS unsigned* MISC;
    gu32* ctl;
    int tid, lane, wave;
    int vcu, G;
    const float* const KAS* in;
    float* out; unsigned char* ws;
};
__device__ __forceinline__ float wave_sum(float v) {
#pragma unroll
    for (int o = 1; o < 64; o <<= 1) v += __shfl_xor(v, o);
    return v;
}
__device__ __forceinline__ void block_sum2(Frame& F, LAS float* red, float& a, float& b) {
    a = wave_sum(a); b = wave_sum(b);
    __syncthreads();
    if (F.lane == 0) { red[F.wave * 2] = a; red[F.wave * 2 + 1] = b; }
    __syncthreads();
    float sa = 0.f, sb = 0.f;
#pragma unroll
    for (int w = 0; w < NWAVES; ++w) { sa += red[2 * w]; sb += red[2 * w + 1]; }
    a = sa; b = sb;
}

template <int MODE>
__device__ __forceinline__ void tr_item(const float* W, int N, bf16* WT, bf16* WT2, LAS float* scr, int item, int lane) {
    const int nblk = N / 32, kb = item / nblk, nb = item % nblk, k0 = 64 * kb, n0 = 32 * nb;
#pragma unroll 8
    for (int i = 0; i < 32; ++i) { const int kk = 2 * i + (lane >> 5); scr[kk * 33 + (lane & 31)] = W[(size_t)(k0 + kk) * N + n0 + (lane & 31)]; }
    LDS_WAIT(); asm volatile("" ::: "memory");
    const int c = lane & 7;
#pragma unroll
    for (int j = 0; j < 4; ++j) { const int n = (lane >> 3) + 8 * j; const LAS float* s = scr + (8 * c) * 33 + n;
        const int ns = n0 + n; int d = ns; bf16* dst = WT;
        if (MODE == 1) { const int n2 = ns & 1023; d = 256 * (n2 >> 7) + (n2 & 127) + (ns >= 1024 ? 128 : 0); }
        if (MODE == 2) { if (ns < 1280) { const int hb = ns & ~63, dd = ns & 63, d2 = dd & 31; d = hb + 8 * (d2 >> 2) + (d2 & 3) + (dd >= 32 ? 4 : 0); } }
        v4u o; o.x = pk2(s[0 * 33], s[1 * 33]); o.y = pk2(s[2 * 33], s[3 * 33]); o.z = pk2(s[4 * 33], s[5 * 33]); o.w = pk2(s[6 * 33], s[7 * 33]);
        *(GAS v4u*)(dst + (size_t)d * 1024 + k0 + 8 * c) = o; }
    LDS_WAIT(); asm volatile("" ::: "memory");
}
__device__ __forceinline__ float silu_f(float v) { return v / (1.0f + expf(-v)); }
__device__ __forceinline__ void p0_prologue(Frame& F) {
    const int tid = F.tid, lane = F.lane;
    if (blockIdx.x < 48) {
        LAS float* sv = (LAS float*)F.lds;
        for (int i = tid; i < 1024 * 9; i += NWAVES * 64) { const int r = i >> 10, k = i & 1023; const float v = (r < 8) ? F.in[I_C][r * 1024 + k] : F.in[I_CCTX][k]; sv[k * 12 + r] = silu_f(v); }
        __syncthreads();
        const int ng = blockIdx.x * 512 + tid, l = ng / 6144, n = ng % 6144;
        const float* wp = F.in[I_ADAW] + (size_t)l * 1024 * 6144 + n;
        float acc[9];
#pragma unroll
        for (int r = 0; r < 9; ++r) acc[r] = 0.f;
#pragma unroll 4
        for (int k = 0; k < 1024; ++k) { const float w = wp[(size_t)k * 6144];
            const f32x4 s0 = *(const LAS f32x4*)(sv + k * 12), s1 = *(const LAS f32x4*)(sv + k * 12 + 4); const float s8 = sv[k * 12 + 8];
            acc[0] += s0[0] * w; acc[1] += s0[1] * w; acc[2] += s0[2] * w; acc[3] += s0[3] * w; acc[4] += s1[0] * w; acc[5] += s1[1] * w; acc[6] += s1[2] * w; acc[7] += s1[3] * w; acc[8] += s8 * w; }
        const float bb = F.in[I_ADAB][l * 6144 + n];
        float* mo = (float*)(F.ws + WS_MOD) + (size_t)l * 9 * 6144 + n;
#pragma unroll
        for (int r = 0; r < 9; ++r) mo[(size_t)r * 6144] = acc[r] + bb;
        __syncthreads();
    }
    if (blockIdx.x >= 48 && blockIdx.x < 112) {
        float* rt = (float*)(F.ws + WS_ROPE);
        for (int e = (blockIdx.x - 48) * 512 + tid; e < 8192 * 32; e += 64 * 512) { const int pos = e >> 5, i = e & 31;
            const float inv = expf(-(float)(i & 15) * (1.0f / 16.0f) * 9.210340371976184f);
            const float ang = (float)((i < 16) ? (pos >> 6) : (pos & 63)) * inv; float sn, cs; sincosf(ang, &sn, &cs);
            rt[2 * e] = cs; rt[2 * e + 1] = sn; }
    }
    const int gw = F.vcu * NWAVES + F.wave, NGW = F.G * NWAVES;
    for (int task = gw; task < 2 * (8192 + 256); task += NGW) {
        const int j = task / 8448, tt = task % 8448; const bool lat = tt < 8192; const int t = lat ? tt : tt - 8192, L = lat ? 8192 : 256;
        float* dst = lat ? (float*)(F.ws + WS_A3L) + ((size_t)j * 8192 + t) * 64 : (float*)(F.ws + WS_A3C) + ((size_t)j * 256 + t) * 64;
        const float tl = (float)t / (float)(L - 1), w = 6.283185307179586f * (float)t / (float)L;
        float z = 0.f;
        if (lane == 0) z = tl;
        else if (lane <= 32) { const int mI = (lane - 1) & 15; const float band = 1e-4f + (float)mI * ((15.0f - 1e-4f) / 15.0f); z = (lane <= 16) ? cosf(band * w) : -sinf(band * w); }
        const float fr = F.in[I_FFREQ][j * 64 + lane];
        const float* w1 = F.in[I_FW1] + (size_t)j * 33 * 64; const float* w2 = F.in[I_FW2] + (size_t)j * 64 * 64; const float* w3 = F.in[I_FW3] + (size_t)j * 64 * 64;
        float a = F.in[I_FB1][j * 64 + lane];
        for (int i = 0; i < 33; ++i) a += __shfl(z, i) * w1[i * 64 + lane];
        a = sinf(fr * a);
        float a2 = F.in[I_FB2][j * 64 + lane];
        for (int k = 0; k < 64; ++k) a2 += __shfl(a, k) * w2[k * 64 + lane];
        a2 = sinf(fr * a2);
        float a3 = F.in[I_FB3][j * 64 + lane];
        for (int k = 0; k < 64; ++k) a3 += __shfl(a2, k) * w3[k * 64 + lane];
        if (lat) ((float*)(F.ws + WS_A3L))[((size_t)j * 64 + lane) * 8192 + t] = sinf(fr * a3);
        else dst[lane] = sinf(fr * a3);
    }
    LAS float* scr = (LAS float*)(F.lds + RING_OFF + F.wave * 16384);
    constexpr int NI_GU = 128 * 1024, NI_DN = 128 * 512, NI_QKV = 2 * 768, NI_AO = 2 * 512, NI_HIN = 2 * 1536, NI_HO = 2 * 512;
    constexpr int NITEMS = NI_GU + NI_DN + NI_QKV + NI_AO + NI_HIN + NI_HO;
    for (int it = gw; it < NITEMS; it += NGW) {
        int r = it;
        if (r < NI_GU) { const int mat = r >> 10; tr_item<1>(F.in[I_WGU] + (size_t)mat * 1024 * 2048, 2048, (bf16*)(F.ws + WS_WGU) + (size_t)mat * 2048 * 1024, nullptr, scr, r & 1023, lane); continue; } r -= NI_GU;
        if (r < NI_DN) { const int mat = r >> 9; tr_item<0>(F.in[I_WDN] + (size_t)mat * 1024 * 1024, 1024, (bf16*)(F.ws + WS_WDN) + (size_t)mat * 1024 * 1024, nullptr, scr, r & 511, lane); continue; } r -= NI_DN;
        if (r < NI_QKV) { const int mat = r / 768; tr_item<2>(F.in[I_AWQKV] + (size_t)mat * 1024 * 1536, 1536, (bf16*)(F.ws + WS_WQK) + (size_t)mat * 1536 * 1024, nullptr, scr, r % 768, lane); continue; } r -= NI_QKV;
        if (r < NI_AO) { const int mat = r >> 9; tr_item<0>(F.in[I_AWO] + (size_t)mat * 1024 * 1024, 1024, (bf16*)(F.ws + WS_WAO) + (size_t)mat * 1024 * 1024, nullptr, scr, r & 511, lane); continue; } r -= NI_AO;
        if (r < NI_HIN) { const int mat = r / 1536; tr_item<0>(F.in[I_HWIN] + (size_t)mat * 1024 * 3072, 3072, (bf16*)(F.ws + WS_WHIN) + (size_t)mat * 3072 * 1024, nullptr, scr, r % 1536, lane); continue; } r -= NI_HIN;
        { const int mat = r >> 9; tr_item<0>(F.in[I_HWO] + (size_t)mat * 1024 * 1024, 1024, (bf16*)(F.ws + WS_WHO) + (size_t)mat * 1024 * 1024, nullptr, scr, r & 511, lane); }
    }
}

__device__ __forceinline__ void row8_unpack(const v4u w, f32x4& a, f32x4& b) { a = (f32x4){bflo(w.x), bfhi(w.x), bflo(w.y), bfhi(w.y)}; b = (f32x4){bflo(w.z), bfhi(w.z), bflo(w.w), bfhi(w.w)}; }
__device__ __forceinline__ v4u row8_pack(const f32x4 a, const f32x4 b) { v4u w; w.x = pk2(a.x, a.y); w.y = pk2(a.z, a.w); w.z = pk2(b.x, b.y); w.w = pk2(b.z, b.w); return w; }
#define ROW8_F32(ptr, jj, hf, lane) (((const f32x4*)(ptr))[128 * (jj) + 2 * (lane) + (hf)])
__device__ __forceinline__ void norm_mod_store(Frame& F, const f32x4 (&v)[4], const float* gain, const float* shift, const float* scale, bf16* orow) {
    float s2 = 0.f;
#pragma unroll
    for (int j = 0; j < 4; ++j) s2 += (v[j].x * v[j].x + v[j].y * v[j].y) + (v[j].z * v[j].z + v[j].w * v[j].w);
    const float rstd = 1.0f / sqrtf(wave_sum(s2) * (1.0f / D) + NORM_EPS);
#pragma unroll
    for (int jj = 0; jj < 2; ++jj) { f32x4 h[2];
#pragma unroll
        for (int hf = 0; hf < 2; ++hf) h[hf] = v[2 * jj + hf] * rstd * ROW8_F32(gain, jj, hf, F.lane) * (ROW8_F32(scale, jj, hf, F.lane) + 1.0f) + ROW8_F32(shift, jj, hf, F.lane);
        ((GAS v4u*)orow)[64 * jj + F.lane] = row8_pack(h[0], h[1]); }
}
__device__ __forceinline__ int mod_row(int row) { return row < TL ? (row >> 13) : 8; }
__device__ __forceinline__ int rows_of_layer(int l) { return l >= 2 ? TL : TT; }
__device__ __forceinline__ void norm0_phase(Frame& F) {
    const int gw = F.vcu * NWAVES + F.wave, NGW = F.G * NWAVES;
    const float* mod = (const float*)(F.ws + WS_MOD);
    for (int row = gw; row < TT; row += NGW) {
        const float* xr = row < TL ? F.in[I_X] + (size_t)row * D : F.in[I_CTX] + (size_t)(row - TL) * D;
        f32x4 v[4];
#pragma unroll
        for (int j = 0; j < 4; ++j) v[j] = ((const GAS f32x4*)xr)[128 * (j >> 1) + 2 * F.lane + (j & 1)];
        const float* mr = mod + (size_t)mod_row(row) * 6144;
        norm_mod_store(F, v, F.in[I_NMIX], mr, mr + 1024, (bf16*)(F.ws + WS_H) + (size_t)row * D);
    }
}

__device__ __forceinline__ void attn_phase(Frame& F, int j, int nunits) {
    const bf16* QK = (const bf16*)(F.ws + WS_QK); bf16* O = (bf16*)(F.ws + WS_O);
    const float* sinks = F.in[I_ASINK] + j * 16;
    LAS bf16* Ks0 = (LAS bf16*)(F.lds);
    const int w = F.wave, lane = F.lane, r = lane & 31, h = lane >> 5, tid = F.tid;
    for (int u = F.vcu; u < nunits; u += F.G) {
        int b, kvh, q0; const bool isctx = u >= 4096;
        if (!isctx) { b = u >> 9; kvh = (u >> 7) & 3; q0 = (u & 127) * 64; } else { const int u2 = u - 4096; b = u2 >> 4; kvh = (u2 >> 2) & 3; q0 = (u2 & 3) * 64; }
        const int head = kvh * 4 + (w >> 1), qrow = q0 + 32 * (w & 1) + r;
        const size_t tokq = isctx ? (size_t)TL + b * CTXL + qrow : (size_t)b * SEQ + qrow;
        const bf16* qp = QK + tokq * QKD + head * 64 + 8 * h;
        bf16x8 bq[4];
#pragma unroll
        for (int s = 0; s < 4; ++s) bq[s] = *(const bf16x8*)(qp + 16 * s);
        float m = sinks[head] * 1.4426950408889634f, l = (h == 0) ? 1.0f : 0.0f;
        f32x16 o0, o1;
#pragma unroll
        for (int i = 0; i < 16; ++i) { o0[i] = 0.f; o1[i] = 0.f; }
        const int nloc = isctx ? 0 : 5, ntile = nloc + 4;
        const int srow = tid >> 3, sch = tid & 7;
#define ATT_VALID(j) (!((j) < nloc && (q0 - 128 + 64 * (j) < 0 || q0 - 128 + 64 * (j) >= SEQ)))
#define ATT_LOAD(j) do { const size_t kt_ = ((j) < nloc) ? (size_t)b * SEQ + (q0 - 128 + 64 * (j)) : (size_t)TL + b * CTXL + 64 * ((j) - nloc); \
            kv = *(const GAS v4u*)(QK + (kt_ + srow) * QKD + 1024 + kvh * 64 + sch * 8); vv = *(const GAS v4u*)(QK + (kt_ + lane) * QKD + 1280 + kvh * 64 + w * 8); } while (0)
#define ATT_WRITE(bufi) do { LAS bf16* ks_ = Ks0 + (bufi) * 9216; LAS bf16* vs_ = ks_ + 4608; *(LAS v4u*)(ks_ + srow * 72 + sch * 8) = kv;     \
            LAS bf16* vd = vs_ + (w * 8) * 72 + lane; \
            vd[0] = (bf16)(vv.x & 0xffffu); vd[72] = (bf16)(vv.x >> 16); vd[144] = (bf16)(vv.y & 0xffffu); vd[216] = (bf16)(vv.y >> 16); \
            vd[288] = (bf16)(vv.z & 0xffffu); vd[360] = (bf16)(vv.z >> 16); vd[432] = (bf16)(vv.w & 0xffffu); vd[504] = (bf16)(vv.w >> 16); } while (0)
        int jt = 0; while (!ATT_VALID(jt)) ++jt;
        int jn = jt + 1; while (jn < ntile && !ATT_VALID(jn)) ++jn;
        v4u kv, vv;
        ATT_LOAD(jt);
        ATT_WRITE(0);
        if (jn < ntile) ATT_LOAD(jn);
        __syncthreads();
        int cur = 0;
        while (jt < ntile) {
            const bool local = jt < nloc; const int kp0 = q0 - 128 + 64 * jt;
            const LAS bf16* Ks = Ks0 + cur * 9216; const LAS bf16* Vs = Ks + 4608;
            int jn2 = jn + 1; while (jn2 < ntile && !ATT_VALID(jn2)) ++jn2;
            if (jn < ntile) { ATT_WRITE(cur ^ 1); if (jn2 < ntile) ATT_LOAD(jn2); }
            f32x16 st0, st1;
#pragma unroll
            for (int i = 0; i < 16; ++i) { st0[i] = 0.f; st1[i] = 0.f; }
#pragma unroll
            for (int s = 0; s < 4; ++s) {
                const bf16x8 a0 = *(const LAS bf16x8*)(Ks + r * 72 + 16 * s + 8 * h), a1 = *(const LAS bf16x8*)(Ks + (32 + r) * 72 + 16 * s + 8 * h);
                st0 = __builtin_amdgcn_mfma_f32_32x32x16_bf16(a0, bq[s], st0, 0, 0, 0);
                st1 = __builtin_amdgcn_mfma_f32_32x32x16_bf16(a1, bq[s], st1, 0, 0, 0);
            }
            float mx = -1e30f;
            const bool edge = local && (jt == 0 || jt == 4);
#pragma unroll
            for (int i = 0; i < 16; ++i) {
                const int key = (i & 3) + 8 * (i >> 2) + 4 * h;
                float v0 = st0[i] * 0.18033688011112042f, v1 = st1[i] * 0.18033688011112042f;
                if (edge) { const int d0 = qrow - (kp0 + key), d1 = d0 - 32; if (d0 > 128 || d0 < -128) v0 = -1e30f; if (d1 > 128 || d1 < -128) v1 = -1e30f; }
                st0[i] = v0; st1[i] = v1; mx = fmaxf(mx, fmaxf(v0, v1));
            }
            mx = fmaxf(mx, __shfl_xor(mx, 32));
            const float mn = fmaxf(m, mx), alpha = __builtin_amdgcn_exp2f(m - mn); m = mn;
            float ls = 0.f;
#pragma unroll
            for (int i = 0; i < 16; ++i) { st0[i] = __builtin_amdgcn_exp2f(st0[i] - mn); st1[i] = __builtin_amdgcn_exp2f(st1[i] - mn); ls += st0[i] + st1[i]; }
            l = l * alpha + ls;
#pragma unroll
            for (int i = 0; i < 16; ++i) { o0[i] *= alpha; o1[i] *= alpha; }
#pragma unroll
            for (int sp = 0; sp < 4; ++sp) {
                unsigned pw[4];
#pragma unroll
                for (int e = 0; e < 4; ++e) { const int i0 = 8 * (sp & 1) + 2 * e; pw[e] = (sp < 2) ? pg8::cvt_pk_bf16(st0[i0], st0[i0 + 1]) : pg8::cvt_pk_bf16(st1[i0], st1[i0 + 1]); }
                const bf16x8 pf = __builtin_bit_cast(bf16x8, (v4u){pw[0], pw[1], pw[2], pw[3]});
#pragma unroll
                for (int dt = 0; dt < 2; ++dt) {
                    const LAS bf16* vp = Vs + (32 * dt + r) * 72 + 16 * sp + 4 * h;
                    const v2u va = *(const LAS v2u*)vp, vb = *(const LAS v2u*)(vp + 8);
                    const bf16x8 vf = __builtin_bit_cast(bf16x8, (v4u){va.x, va.y, vb.x, vb.y});
                    if (dt == 0) o0 = __builtin_amdgcn_mfma_f32_32x32x16_bf16(vf, pf, o0, 0, 0, 0); else o1 = __builtin_amdgcn_mfma_f32_32x32x16_bf16(vf, pf, o1, 0, 0, 0);
                }
            }
            __syncthreads();
            jt = jn; jn = jn2; cur ^= 1;
        }
#undef ATT_VALID
#undef ATT_LOAD
#undef ATT_WRITE
        const float lt = l + __shfl_xor(l, 32), inv = 1.0f / lt;
        bf16* op = O + tokq * D + head * 64 + 4 * h;
#pragma unroll
        for (int g = 0; g < 4; ++g) {
            v2u w0, w1; w0.x = pg8::cvt_pk_bf16(o0[4 * g] * inv, o0[4 * g + 1] * inv); w0.y = pg8::cvt_pk_bf16(o0[4 * g + 2] * inv, o0[4 * g + 3] * inv);
            w1.x = pg8::cvt_pk_bf16(o1[4 * g] * inv, o1[4 * g + 1] * inv); w1.y = pg8::cvt_pk_bf16(o1[4 * g + 2] * inv, o1[4 * g + 3] * inv);
            *(GAS v2u*)(op + 8 * g) = w0; *(GAS v2u*)(op + 32 + 8 * g) = w1;
        }
    }
}
__device__ __forceinline__ float sconv3(const bf16* p, int n, int L, float w0, float w1, float w2, float cb) {
    const float a = (n > 0) ? bf2f(p[n - 1]) : 0.f, b = bf2f(p[n]), c = (n < L - 1) ? bf2f(p[n + 1]) : 0.f;
    return cb + w0 * a + w1 * b + w2 * c;
}
struct HyRaw { v4u raw[4]; unsigned short lf[4], rt[4]; };
__device__ __forceinline__ void hy_stage_load(const bf16* p, HyRaw& R, int tid) {
#pragma unroll
    for (int ch = 0; ch < 2; ++ch)
#pragma unroll
        for (int b = 0; b < 2; ++b) {
            const int n0 = 8 * tid + 4096 * ch; const bf16* pb = p + (size_t)b * SEQ;
            R.raw[2 * ch + b] = *(const GAS v4u*)(pb + n0);
            R.lf[2 * ch + b] = n0 > 0 ? pb[n0 - 1] : (unsigned short)0; R.rt[2 * ch + b] = n0 + 8 < SEQ ? pb[n0 + 8] : (unsigned short)0;
        }
}
__device__ __forceinline__ void hy_stage_write(const HyRaw& R, float w0, float w1, float w2, float cb, LAS float* S, int tid) {
#pragma unroll
    for (int ch = 0; ch < 2; ++ch)
#pragma unroll
        for (int b = 0; b < 2; ++b) {
            const int n0 = 8 * tid + 4096 * ch; const v4u raw = R.raw[2 * ch + b];
            float x[10]; x[0] = bf2f(R.lf[2 * ch + b]); x[1] = bflo(raw.x); x[2] = bfhi(raw.x); x[3] = bflo(raw.y); x[4] = bfhi(raw.y); x[5] = bflo(raw.z); x[6] = bfhi(raw.z); x[7] = bflo(raw.w); x[8] = bfhi(raw.w); x[9] = bf2f(R.rt[2 * ch + b]);
            f32x4 lo, hi;
#pragma unroll
            for (int e = 0; e < 4; ++e) { lo[e] = cb + w0 * x[e] + w1 * x[e + 1] + w2 * x[e + 2]; hi[e] = cb + w0 * x[e + 4] + w1 * x[e + 5] + w2 * x[e + 6]; }
            *(LAS f32x4*)(S + b * 8192 + n0) = lo; *(LAS f32x4*)(S + b * 8192 + n0 + 4) = hi;
        }
}
__device__ __forceinline__ void hyena_phase(Frame& F, int j, bool with_ctx) {
    LAS cf2* X = (LAS cf2*)F.lds;
    LAS float* U = (LAS float*)(F.lds + USER_OFF);
    LAS float* red = (LAS float*)(F.lds + USER_OFF + 1024);
    const int tid0 = F.tid;
    const bf16* Ut = (const bf16*)(F.ws + WS_UT); bf16* Zt = (bf16*)(F.ws + WS_ZT);
    const float* a3t = (const float*)(F.ws + WS_A3L) + (size_t)j * 64 * 8192; const float* a3c = (const float*)(F.ws + WS_A3C) + (size_t)j * 256 * 64;
    const float* wout = F.in[I_FWOUT] + (size_t)j * 64 * 4096; const float* convw = F.in[I_HCW] + (size_t)j * 3 * 3072; const float* convb = F.in[I_HCB] + (size_t)j * 3072;
    const float* biasd = F.in[I_HBD] + (size_t)j * 2 * 1024;
    for (int c = F.vcu; c < 1024; c += F.G) {
        int tid = tid0; asm volatile("" : "+v"(tid));
        __syncthreads();
        if (tid < 256) { const int k = tid >> 2, q = tid & 3; U[tid] = wout[(size_t)k * 4096 + q * 1024 + c]; }
        __syncthreads();
        const float absd = 3.0701134573253945f + (15.350567286626973f - 3.0701134573253945f) * (float)c * (1.0f / 1023.0f);
        float* tp = (float*)(F.ws + WS_TP) + (size_t)c * 2 * FFT_N;
        float* Gc = (float*)(F.ws + WS_G) + (size_t)c * 2 * FFT_N * 2;
        float sum0 = 0.f, sum1 = 0.f;
#pragma unroll 1
        for (int i = 0; i < 4; ++i) {
            const int t0 = 4 * (tid + 512 * i);
            f32x4 acc0 = (f32x4){0.f, 0.f, 0.f, 0.f}, acc1 = acc0, acc2 = acc0, acc3 = acc0;
#pragma unroll 8
            for (int k = 0; k < 64; ++k) { const f32x4 a = *(const GAS f32x4*)(a3t + (size_t)k * 8192 + t0); const f32x4 w = *(const LAS f32x4*)(U + 4 * k);
                acc0 += a * w.x; acc1 += a * w.y; acc2 += a * w.z; acc3 += a * w.w; }
            f32x4 dec;
#pragma unroll
            for (int e = 0; e < 4; ++e) dec[e] = expf(-((float)(t0 + e) * (1.0f / 8191.0f)) * absd);
            acc0 *= dec; acc1 *= dec; acc2 *= dec; acc3 *= dec;
            *(GAS f32x4*)(tp + t0) = acc0; *(GAS f32x4*)(tp + FFT_N + t0) = acc1;
#pragma unroll
            for (int e = 0; e < 4; ++e) { const int t = t0 + e; sum0 += fabsf(acc0[e]); sum1 += fabsf(acc1[e]);
                if (t > 0) { tp[FFT_N - t] = acc2[e]; tp[2 * FFT_N - t] = acc3[e]; sum0 += fabsf(acc2[e]); sum1 += fabsf(acc3[e]); } }
        }
        if (tid == 0) { tp[FFT_N / 2] = 0.f; tp[FFT_N + FFT_N / 2] = 0.f; }
        VM_WAIT();
        block_sum2(F, red, sum0, sum1);
#pragma unroll 1
#ifndef PROBE_HY_SPEC
#define PROBE_HY_SPEC 2
#endif
        for (int o4 = 0; o4 < PROBE_HY_SPEC; ++o4) { const int o = o4 & 1;
            fft_fwd_first_full(X, (const GAS float*)(tp + (size_t)o * FFT_N), 1.0f / (o == 0 ? sum0 : sum1), tid); __syncthreads();
            fft_fwd_double<1>(X, tid); __syncthreads();
            fft_fwd_double<3>(X, tid); __syncthreads();
            fft_mid_store(X, (GAS cf4*)(Gc + (size_t)o * FFT_N * 2), 1.0f / (float)FFT_N, biasd[o * 1024 + c], tid); __syncthreads();
        }
        VM_WAIT();
        __syncthreads();
        const float cwv0 = convw[2048 + c], cwv1 = convw[3072 + 2048 + c], cwv2 = convw[6144 + 2048 + c], cbv = convb[2048 + c];
        const float cwa0 = convw[c], cwa1 = convw[3072 + c], cwa2 = convw[6144 + c], cba = convb[c];
        const float cwb0 = convw[1024 + c], cwb1 = convw[3072 + 1024 + c], cwb2 = convw[6144 + 1024 + c], cbb = convb[1024 + c];
        const float d0 = biasd[c], d1 = biasd[1024 + c];
#ifndef PROBE_HY_PAIRS
#define PROBE_HY_PAIRS 4
#endif
        HyRaw rv, rg;
        hy_stage_load(Ut + (size_t)(2048 + c) * TT, rv, tid);
#pragma unroll 1
        for (int pr8 = 0; pr8 < PROBE_HY_PAIRS; ++pr8) { const int pr = pr8 & 3;
            const size_t tb0 = (size_t)(2 * pr) * SEQ;
            LAS float* S = (LAS float*)F.lds;
            float z0[16], z1[16];
            __syncthreads();
            hy_stage_write(rv, cwv0, cwv1, cwv2, cbv, S, tid); __syncthreads();
#pragma unroll
            for (int i = 0; i < 16; ++i) { z0[i] = S[tid + 512 * i]; z1[i] = S[8192 + tid + 512 * i]; }
#pragma unroll 1
            for (int o = 0; o < 2; ++o) {
                __syncthreads();
                fft_fwd_first(X, z0, z1, tid);
                hy_stage_load(Ut + (size_t)(o == 0 ? c : 1024 + c) * TT + tb0, rg, tid);
                if (o == 1) hy_stage_load(Ut + (size_t)(2048 + c) * TT + (size_t)(2 * ((pr8 + 1) & 3)) * SEQ, rv, tid);
                __syncthreads();
                fft_fwd_double<1>(X, tid); __syncthreads();
                fft_fwd_double<3>(X, tid); __syncthreads();
                fft_mid_mul(X, (const GAS cf4*)(Gc + (size_t)o * FFT_N * 2), tid); __syncthreads();
                fft_inv_double<3>(X, tid); __syncthreads();
                fft_inv_double<1>(X, tid); __syncthreads();
                fft_inv_last(X, z0, z1, tid); __syncthreads();
                hy_stage_write(rg, o == 0 ? cwa0 : cwb0, o == 0 ? cwa1 : cwb1, o == 0 ? cwa2 : cwb2, o == 0 ? cba : cbb, S, tid); __syncthreads();
#pragma unroll
                for (int i = 0; i < 16; ++i) { z0[i] *= S[tid + 512 * i]; z1[i] *= S[8192 + tid + 512 * i]; }
            }
            __syncthreads();
#pragma unroll
            for (int i = 0; i < 16; ++i) { S[tid + 512 * i] = z0[i]; S[8192 + tid + 512 * i] = z1[i]; }
            __syncthreads();
#pragma unroll
            for (int ch = 0; ch < 2; ++ch)
#pragma unroll
                for (int b = 0; b < 2; ++b) { const int n0 = 8 * tid + 4096 * ch; const f32x4 lo = *(const LAS f32x4*)(S + b * 8192 + n0), hi = *(const LAS f32x4*)(S + b * 8192 + n0 + 4);
                    v4u w; w.x = pk2(lo.x, lo.y); w.y = pk2(lo.z, lo.w); w.z = pk2(hi.x, hi.y); w.w = pk2(hi.z, hi.w);
                    *(GAS v4u*)(Zt + (size_t)c * TT + tb0 + (size_t)b * SEQ + n0) = w; }
        }
        if (!with_ctx) continue;
        asm volatile("" : "+v"(tid));
        __syncthreads();
        LAS float* tap0 = (LAS float*)F.lds; LAS float* tap1 = tap0 + 512; LAS float* vb = tap0 + 1024; LAS float* zb = tap0 + 1024 + 2048;
        {
            float f0 = 0.f, f1 = 0.f, b0 = 0.f, b1 = 0.f, s0 = 0.f, s1 = 0.f;
            if (tid < 256) { const int t = tid; const GAS f32x4* ar = (const GAS f32x4*)(a3c + (size_t)t * 64); f32x4 acc = (f32x4){0.f, 0.f, 0.f, 0.f};
#pragma unroll 4
                for (int k4 = 0; k4 < 16; ++k4) { const f32x4 a = ar[k4];
                    acc += a[0] * *(const LAS f32x4*)(U + 16 * k4) + a[1] * *(const LAS f32x4*)(U + 16 * k4 + 4) + a[2] * *(const LAS f32x4*)(U + 16 * k4 + 8) + a[3] * *(const LAS f32x4*)(U + 16 * k4 + 12); }
                const float dec = expf(-((float)t * (1.0f / 255.0f)) * absd);
                f0 = acc[0] * dec; f1 = acc[1] * dec; b0 = acc[2] * dec; b1 = acc[3] * dec;
                s0 = fabsf(f0) + (t > 0 ? fabsf(b0) : 0.f); s1 = fabsf(f1) + (t > 0 ? fabsf(b1) : 0.f); }
            block_sum2(F, red, s0, s1);
            if (tid < 256) { const float i0 = 1.0f / s0, i1 = 1.0f / s1; tap0[256 + tid] = f0 * i0; tap1[256 + tid] = f1 * i1; if (tid > 0) { tap0[256 - tid] = b0 * i0; tap1[256 - tid] = b1 * i1; } else { tap0[0] = 0.f; tap1[0] = 0.f; } }
        }
        const int cb_ = tid >> 6, n0 = (tid & 63) * 4;
        const size_t tcx = (size_t)TL + (size_t)cb_ * CTXL;
        float vloc[4], zloc[4];
        { const bf16* pv = Ut + (size_t)(2048 + c) * TT + tcx;
#pragma unroll
          for (int e = 0; e < 4; ++e) { vloc[e] = sconv3(pv, n0 + e, CTXL, cwv0, cwv1, cwv2, cbv); vb[cb_ * 256 + n0 + e] = vloc[e]; } }
        __syncthreads();
        { const bf16* pa = Ut + (size_t)c * TT + tcx; float acc[4] = {0.f, 0.f, 0.f, 0.f};
          for (int mI = 0; mI < 256; ++mI) { const float vv = vb[cb_ * 256 + mI];
#pragma unroll
              for (int e = 0; e < 4; ++e) acc[e] += tap0[256 + n0 + e - mI] * vv; }
#pragma unroll
          for (int e = 0; e < 4; ++e) { zloc[e] = sconv3(pa, n0 + e, CTXL, cwa0, cwa1, cwa2, cba) * (acc[e] + vloc[e] * d0); zb[cb_ * 256 + n0 + e] = zloc[e]; } }
        __syncthreads();
        { const bf16* pb = Ut + (size_t)(1024 + c) * TT + tcx; float acc[4] = {0.f, 0.f, 0.f, 0.f};
          for (int mI = 0; mI < 256; ++mI) { const float vv = zb[cb_ * 256 + mI];
#pragma unroll
              for (int e = 0; e < 4; ++e) acc[e] += tap1[256 + n0 + e - mI] * vv; }
#pragma unroll
          for (int e = 0; e < 4; ++e) { const float ov = sconv3(pb, n0 + e, CTXL, cwb0, cwb1, cwb2, cbb) * (acc[e] + zloc[e] * d1); Zt[(size_t)c * TT + tcx + n0 + e] = (bf16)f2bf(ov); } }
    }
}
__device__ __forceinline__ void transpose_phase(Frame& F, int ncols) {
    const bf16* Zt = (const bf16*)(F.ws + WS_ZT); bf16* Z = (bf16*)(F.ws + WS_O);
    LAS bf16* T = (LAS bf16*)(F.lds + F.wave * 16384);
    const int gw = F.vcu * NWAVES + F.wave, NGW = F.G * NWAVES, lane = F.lane;
    for (int item = gw; item < 16 * (ncols / 64); item += NGW) {
        const int ct = item & 15, tt = item >> 4;
#pragma unroll
        for (int i = 0; i < 8; ++i) { const int cr = (lane >> 3) + 8 * i, ch = lane & 7;
            const v4u v = *(const GAS v4u*)(Zt + (size_t)(ct * 64 + cr) * TT + (size_t)tt * 64 + ch * 8); *(LAS v4u*)(T + cr * 72 + ch * 8) = v; }
        LDS_WAIT(); asm volatile("" ::: "memory");
#pragma unroll
        for (int i = 0; i < 8; ++i) { const int tok = (lane >> 3) + 8 * i, cc = (lane & 7) * 8;
            unsigned short e[8];
#pragma unroll
            for (int q = 0; q < 8; ++q) e[q] = T[(cc + q) * 72 + tok];
            v4u o; o.x = e[0] | ((unsigned)e[1] << 16); o.y = e[2] | ((unsigned)e[3] << 16); o.z = e[4] | ((unsigned)e[5] << 16); o.w = e[6] | ((unsigned)e[7] << 16);
            *(GAS v4u*)(Z + (size_t)(tt * 64 + tok) * D + ct * 64 + cc) = o; }
        LDS_WAIT(); asm volatile("" ::: "memory");
    }
}

__device__ __forceinline__ void router_phase(Frame& F, int l) {
    const int nrows = rows_of_layer(l);
    constexpr int RR = 6;
    LAS bf16* Whi = (LAS bf16*)F.lds; LAS bf16* Wlo = Whi + 32 * 1024;
    LAS int* cnt = (LAS int*)(F.lds + USER_OFF); LAS int* base = cnt + 32; LAS int* rec = cnt + 64;
    const int tid = F.tid, lane = F.lane, wave = F.wave;
    const float* rw = F.in[I_RW] + (size_t)l * 1024 * 32;
    __syncthreads();
    for (int i = tid; i < 1024 * 32; i += NWAVES * 64) { const int k = i >> 5, e = i & 31; const float w = rw[i]; const unsigned hi = f2bf(w), lo = f2bf(w - bflo(hi));
        const int idx = e * 1024 + ((((k >> 3) ^ (e & 15)) << 3) | (k & 7)); Whi[idx] = (bf16)hi; Wlo[idx] = (bf16)lo; }
    if (tid < 32) cnt[tid] = 0;
    __syncthreads();
    const float* mod = (const float*)(F.ws + WS_MOD) + (size_t)l * 9 * 6144;
    const float* gain = F.in[I_NFFN] + (size_t)l * D;
    const int gw = F.vcu * NWAVES + wave, NGW = F.G * NWAVES;
    bf16* H = (bf16*)(F.ws + WS_H);
    for (int row0 = gw; row0 < nrows; row0 += RR * NGW) {
        f32x4 v[RR][4]; float s2[RR];
#pragma unroll
        for (int r = 0; r < RR; ++r) { const int row = row0 + r * NGW < nrows ? row0 + r * NGW : row0;
            const GAS v4u* xr = (const GAS v4u*)((const bf16*)(F.ws + WS_XB) + (size_t)row * D) + lane;
#pragma unroll
            for (int jj = 0; jj < 2; ++jj) row8_unpack(xr[64 * jj], v[r][2 * jj], v[r][2 * jj + 1]); }
#pragma unroll
        for (int r = 0; r < RR; ++r) { s2[r] = 0.f;
#pragma unroll
            for (int jj = 0; jj < 4; ++jj) s2[r] += (v[r][jj].x * v[r][jj].x + v[r][jj].y * v[r][jj].y) + (v[r][jj].z * v[r][jj].z + v[r][jj].w * v[r][jj].w); }
#pragma unroll
        for (int o = 1; o < 64; o <<= 1) {
#pragma unroll
            for (int r = 0; r < RR; ++r) s2[r] += __shfl_xor(s2[r], o); }
#pragma unroll
        for (int r = 0; r < RR; ++r) { const int row = row0 + r * NGW < nrows ? row0 + r * NGW : row0;
            const float rstd = 1.0f / sqrtf(s2[r] * (1.0f / D) + NORM_EPS);
            const float* mr = mod + (size_t)mod_row(row) * 6144;
#pragma unroll
            for (int jj = 0; jj < 2; ++jj) { f32x4 hq[2];
#pragma unroll
                for (int hf = 0; hf < 2; ++hf) hq[hf] = v[r][2 * jj + hf] * rstd * ROW8_F32(gain, jj, hf, lane) * (ROW8_F32(mr + 4 * 1024, jj, hf, lane) + 1.0f) + ROW8_F32(mr + 3 * 1024, jj, hf, lane);
                ((GAS v4u*)(H + (size_t)row * D))[64 * jj + lane] = row8_pack(hq[0], hq[1]); } }
    }
    VM_WAIT();
    asm volatile("" ::: "memory");
    const int r32 = lane & 31, hh2 = lane >> 5;
    const float rb = F.in[I_RB][l * 32 + r32];
    const int nmine = (nrows - gw + NGW - 1) / NGW;
    for (int tile = 0; tile * 32 < nmine; ++tile) {
        const int irow = 32 * tile + r32; const size_t arow = (size_t)gw + (size_t)NGW * (irow < nmine ? irow : 0);
        const bf16* ap = H + arow * D + 8 * hh2;
        const LAS bf16* bh = Whi + r32 * 1024; const LAS bf16* bl = Wlo + r32 * 1024;
        f32x16 acc;
#pragma unroll
        for (int i = 0; i < 16; ++i) acc[i] = 0.f;
#pragma unroll 8
        for (int s = 0; s < 64; ++s) {
            const bf16x8 a = *(const GAS bf16x8*)(ap + 16 * s);
            const int cb = ((2 * s + hh2) ^ (r32 & 15)) << 3;
            const bf16x8 b1 = *(const LAS bf16x8*)(bh + cb), b2 = *(const LAS bf16x8*)(bl + cb);
            acc = __builtin_amdgcn_mfma_f32_32x32x16_bf16(a, b1, acc, 0, 0, 0);
            acc = __builtin_amdgcn_mfma_f32_32x32x16_bf16(a, b2, acc, 0, 0, 0);
        }
#pragma unroll 2
        for (int i = 0; i < 16; ++i) {
            const float mine = acc[i] + rb; int rank = 0;
#pragma unroll 8
            for (int e2 = 0; e2 < 32; ++e2) { const float sv = __shfl(mine, (lane & 32) | e2); rank += (sv > mine || (sv == mine && e2 < r32)) ? 1 : 0; }
            const int rr = (i & 3) + 8 * (i >> 2);
#pragma unroll
            for (int hsel = 0; hsel < 2; ++hsel) {
                const int it = 32 * tile + rr + 4 * hsel;
                float tv[4]; int te[4];
#pragma unroll
                for (int k = 0; k < 4; ++k) { const unsigned long long mk = __ballot(rank == k) & (hsel ? 0xffffffff00000000ull : 0x00000000ffffffffull); const int src = __ffsll((long long)mk) - 1;
                    te[k] = src & 31; tv[k] = __builtin_bit_cast(float, __builtin_amdgcn_readlane(__builtin_bit_cast(int, mine), src)); }
                if (it < nmine) {
                    const size_t row = (size_t)gw + (size_t)NGW * it;
                    const float e1 = __expf(tv[1] - tv[0]), e2 = __expf(tv[2] - tv[0]), e3 = __expf(tv[3] - tv[0]), isum = 1.0f / (1.0f + e1 + e2 + e3);
                    if (lane == 0) *(GAS f32x4*)((float*)(F.ws + WS_GATE) + row * 4) = (f32x4){isum, e1 * isum, e2 * isum, e3 * isum};
                    if (lane < 4) { const int tel = lane == 0 ? te[0] : lane == 1 ? te[1] : lane == 2 ? te[2] : te[3];
                        const int rk = __hip_atomic_fetch_add(cnt + tel, 1, __ATOMIC_RELAXED, __HIP_MEMORY_SCOPE_WORKGROUP); rec[(wave * 64 + it) * 4 + lane] = tel | (rk << 8); }
                }
            }
        }
    }
    __syncthreads();
    if (tid < 32) base[tid] = (int)__hip_atomic_fetch_add((unsigned*)(F.ctl + CW_ECNT + l * 32 + tid), (unsigned)cnt[tid], RLX_AGENT);
    __syncthreads();
    for (int it = 0; it < nmine; ++it) {
        if (lane < 4) { const int rc = rec[(wave * 64 + it) * 4 + lane], e = rc & 255; ((int*)(F.ws + WS_POS))[((size_t)gw + (size_t)NGW * it) * 4 + lane] = e | ((base[e] + (rc >> 8)) << 8); }
    }
}
__device__ __forceinline__ void load_blkstart(Frame& F, int l, LAS int* blkstart) {
    __syncthreads();
    if (F.tid == 0) { int s = 0; for (int e = 0; e < 32; ++e) { blkstart[e] = s; const unsigned c = __hip_atomic_load((unsigned*)(F.ctl + CW_ECNT + l * 32 + e), RLX_AGENT); s += (int)((c + 255u) >> 8); } blkstart[32] = s; }
    __syncthreads();
    for (int rb = F.tid; rb < MAXBLK; rb += NWAVES * 64) { int e = 0;
#pragma unroll 1
        for (int q = 1; q < 32; ++q) e += (blkstart[q] <= rb) ? 1 : 0;
        blkstart[64 + rb] = e; }
    __syncthreads();
}
__device__ __forceinline__ void index_phase(Frame& F, int l) {
    const int nrows = rows_of_layer(l);
    LAS int* blkstart = (LAS int*)(F.lds + USER_OFF + 8192);
    load_blkstart(F, l, blkstart);
    const int* POS = (const int*)(F.ws + WS_POS); int* DEST = (int*)(F.ws + WS_DEST); int* RSRC = (int*)(F.ws + WS_RSRC);
    const int gt = F.vcu * (NWAVES * 64) + F.tid, NT = F.G * NWAVES * 64;
    for (int a = gt; a < nrows * 4; a += NT) { const int pk = POS[a], e = pk & 255, rk = pk >> 8, d = blkstart[e] * 256 + rk; DEST[a] = d; RSRC[d] = a >> 2; }
    if (blockIdx.x < 32) { const int e = blockIdx.x; const int cnt = (int)__hip_atomic_load((unsigned*)(F.ctl + CW_ECNT + l * 32 + e), RLX_AGENT), end = (blkstart[e + 1] - blkstart[e]) * 256;
        for (int p2 = cnt + F.tid; p2 < end; p2 += NWAVES * 64) RSRC[blkstart[e] * 256 + p2] = 0; }
}
__device__ __forceinline__ void combine_phase(Frame& F, int l, bool dry = false) {
    constexpr int RR = 3;
    const int gw = F.vcu * NWAVES + F.wave, NGW = F.G * NWAVES, lane = F.lane;
    const bf16* YS = (const bf16*)(F.ws + WS_YS); const int* POS = (const int*)(F.ws + WS_DEST); const float* GT = (const float*)(F.ws + WS_GATE);
    const float* mod = (const float*)(F.ws + WS_MOD);
    const int nrows = rows_of_layer(l);
    for (int row0 = gw; row0 < nrows; row0 += RR * NGW) {
        v4i ps[RR]; f32x4 gt[RR]; f32x4 v[RR][4]; int rows[RR];
#pragma unroll
        for (int r = 0; r < RR; ++r) { rows[r] = row0 + r * NGW < nrows ? row0 + r * NGW : row0; ps[r] = *(const GAS v4i*)(POS + (size_t)rows[r] * 4); gt[r] = *(const GAS f32x4*)(GT + (size_t)rows[r] * 4); }
#pragma unroll
        for (int r = 0; r < RR; ++r) { const int row = rows[r];
            const GAS v4u* xr = (const GAS v4u*)((const bf16*)(F.ws + WS_XB) + (size_t)row * D) + lane;
            const float* g2 = mod + ((size_t)l * 9 + mod_row(row)) * 6144 + 5 * 1024;
#pragma unroll
            for (int jj = 0; jj < 2; ++jj) {
                f32x4 y0 = (f32x4){0.f, 0.f, 0.f, 0.f}, y1 = y0;
#pragma unroll
                for (int k = 0; k < 4; ++k) { f32x4 a, b; row8_unpack(*(const GAS v4u*)(YS + (size_t)ps[r][k] * D + 512 * jj + 8 * lane), a, b); y0 += gt[r][k] * a; y1 += gt[r][k] * b; }
                f32x4 xa, xb2; row8_unpack(xr[64 * jj], xa, xb2);
                v[r][2 * jj] = xa + ROW8_F32(g2, jj, 0, lane) * y0; v[r][2 * jj + 1] = xb2 + ROW8_F32(g2, jj, 1, lane) * y1;
            } }
#pragma unroll
        for (int r = 0; r < RR; ++r) { const int row = rows[r];
            if (r > 0 && row0 + r * NGW >= nrows) continue;
            bf16* xw = (bf16*)(F.ws + (dry ? WS_ACT : WS_XB)) + (size_t)row * D; bf16* hw = (bf16*)(F.ws + (dry ? WS_ACT + 270 * MiB : WS_H)) + (size_t)row * D;
            if (l < DEPTH - 1) {
#pragma unroll
                for (int jj = 0; jj < 2; ++jj) ((GAS v4u*)xw)[64 * jj + lane] = row8_pack(v[r][2 * jj], v[r][2 * jj + 1]);
                const float* mr = mod + ((size_t)(l + 1) * 9 + mod_row(row)) * 6144;
                norm_mod_store(F, v[r], F.in[I_NMIX] + (size_t)(l + 1) * D, mr, mr + 1024, hw);
            } else {
                float s2 = 0.f;
#pragma unroll
                for (int jj = 0; jj < 4; ++jj) s2 += (v[r][jj].x * v[r][jj].x + v[r][jj].y * v[r][jj].y) + (v[r][jj].z * v[r][jj].z + v[r][jj].w * v[r][jj].w);
                const float rstd = 1.0f / sqrtf(wave_sum(s2) * (1.0f / D) + NORM_EPS);
#pragma unroll
                for (int q = 0; q < 4; ++q) ((GAS f32x4*)(dry ? (float*)(F.ws + WS_ACT) + (size_t)row * D : F.out + (size_t)row * D))[128 * (q >> 1) + 2 * lane + (q & 1)] = v[r][q] * rstd * ROW8_F32(F.in[I_FNORM], q >> 1, q & 1, lane);
            }
        }
    }
}
constexpr int N_PHASES = 1 + 10 * DEPTH;
#ifndef PG8_SP2
#define PG8_SP2 true
#endif
#ifndef PG8_ALIGN_EPI
#define PG8_ALIGN_EPI true
#endif
__host__ __device__ inline bool phase_exists(int ph) { if (ph == 0) return true; const int l = (ph - 1) / 10, k = (ph - 1) % 10; return !((k == 0 && l != 0) || (k == 3 && (l & 1) == 0)); }
struct Args { const float* in[N_IN]; float* out; unsigned char* ws; int ph_lo, ph_hi, use_bar, pad; };
__global__ void __launch_bounds__(NWAVES * 64, 2) fwd_kernel(Args args) {
    extern __shared__ __attribute__((aligned(16))) unsigned char lds[];
    Frame F;
    F.lds = (LAS unsigned char*)lds;
    F.MISC = (volatile LAS unsigned*)(F.lds + MISC_OFF);
    F.tid = threadIdx.x; F.lane = F.tid & 63; F.wave = __builtin_amdgcn_readfirstlane(F.tid >> 6);
    F.G = gridDim.x; { const int bx = blockIdx.x; F.vcu = (F.G % 8 == 0) ? (bx % 8) * (F.G / 8) + bx / 8 : bx; }
    const KAS Args* ap = (const KAS Args*)__builtin_amdgcn_kernarg_segment_ptr();
    F.in = ap->in; F.out = ap->out; F.ws = ap->ws;
    F.ctl = (gu32*)(F.ws + WS_CTL);
    const int use_bar = ap->use_bar;
    for (int u = F.tid; u < (USER_OFF - LDSCTL_OFF) / 4; u += NWAVES * 64) ((LAS unsigned*)(F.lds + LDSCTL_OFF))[u] = 0u;
    __syncthreads();
    XcdBarrier bar; bar.bar = (unsigned*)(F.ctl + CW_BAR); bar.x = 0; bar.st = nullptr;
    if (use_bar) bar = xcd_barrier_post((unsigned*)(F.ctl + CW_BAR), F.MISC + 8);
    const int hi = ap->ph_hi;
    LAS int* blkstart = (LAS int*)(F.lds + USER_OFF + 8192);
#ifndef PROBE_REP_MASK
#define PROBE_REP_MASK 0
#define PROBE_REP_KIND 2
#endif
    int rep_done = 0;
#pragma unroll 1
    for (int ph = ap->ph_lo; ph < hi; ++ph) {
        if (!phase_exists(ph)) continue;
        { int t_ = threadIdx.x; asm volatile("" : "+v"(t_)); F.tid = t_; F.lane = t_ & 63; F.wave = __builtin_amdgcn_readfirstlane(t_ >> 6);
          unsigned char* w_ = ap->ws; asm volatile("" : "+s"(w_)); F.ws = w_; float* o_ = ap->out; asm volatile("" : "+s"(o_)); F.out = o_;
          int v_ = F.vcu; asm volatile("" : "+s"(v_)); F.vcu = v_; }
        const int l = ph == 0 ? 0 : (ph - 1) / 10, k = ph == 0 ? -1 : (ph - 1) % 10, kind = l & 1, j = l >> 1;
        if (k == -1) {
#ifndef NO_P0
            p0_prologue(F);
#endif
        }
        else if (k == 0) norm0_phase(F);
        else if (k == 2) {
#ifndef NO_ATTN
            if (kind == 0) attn_phase(F, j, l == 0 ? 4096 + 128 : 4096);
#endif
#ifndef NO_HY
            if (kind == 1) hyena_phase(F, j, l == 1);
#endif
        }
#ifndef NO_TR
        else if (k == 3) transpose_phase(F, rows_of_layer(l));
#endif
#ifndef NO_ROUTER
        else if (k == 5) router_phase(F, l);
#endif
#ifndef NO_GATHER
        else if (k == 6) index_phase(F, l);
#endif
#ifndef NO_COMB
        else if (k == 9) combine_phase(F, l, ((PROBE_REP_MASK >> 10) & 1) != 0 && !rep_done);
#endif
        else if (k == 1 || k == 4 || k == 7 || k == 8) {
            pg8::Gemm g; pg8::AnyOrder S; pg8::EpiAny E;
            S.moe = 0; S.rb2e = blkstart + 64; S.nblk = 0; S.lg = 0; S.wbase = l * 32;
            E.ldc = TT; E.O = nullptr; E.f0 = nullptr; E.f1 = nullptr; E.p0 = nullptr; E.p1 = nullptr; E.p2 = nullptr; E.p3 = nullptr;
            if (k == 1 && kind == 0) {
                g = pg8::Gemm{(const bf16*)(F.ws + WS_H), (const bf16*)(F.ws + WS_WQK) + (size_t)j * QKD * 1024, TT, QKD, D}; S.so.init(TT, QKD, F.G, (int)blockIdx.x);
                E.mode = pg8::EPI_QK; E.O = (bf16*)(F.ws + WS_QK); E.p0 = F.in[I_ABQKV] + (size_t)j * 1536; E.p1 = (const float*)(F.ws + WS_ROPE);
            } else if (k == 1) {
                g = pg8::Gemm{(const bf16*)(F.ws + WS_WHIN) + (size_t)j * 3072 * 1024, (const bf16*)(F.ws + WS_H), 3072, rows_of_layer(l), D}; S.so.init(3072, rows_of_layer(l), F.G, (int)blockIdx.x);
                E.mode = pg8::EPI_T; E.O = (bf16*)(F.ws + WS_UT); E.p0 = F.in[I_HBIN] + (size_t)j * 3072;
            } else if (k == 4) {
                g = pg8::Gemm{(const bf16*)(F.ws + WS_O), kind == 0 ? (const bf16*)(F.ws + WS_WAO) + (size_t)j * 1024 * 1024 : (const bf16*)(F.ws + WS_WHO) + (size_t)j * 1024 * 1024, rows_of_layer(l), D, D};
                S.so.init(rows_of_layer(l), D, F.G, (int)blockIdx.x);
                E.mode = pg8::EPI_RES; E.p0 = l == 0 ? F.in[I_X] : nullptr; E.p1 = l == 0 ? F.in[I_CTX] : nullptr; E.O = (bf16*)(F.ws + WS_XB);
                E.p2 = kind == 0 ? F.in[I_ABO] + (size_t)j * 1024 : F.in[I_HBO] + (size_t)j * 1024; E.p3 = (const float*)(F.ws + WS_MOD) + (size_t)l * 9 * 6144 + 2 * 1024;
            } else {
                load_blkstart(F, l, blkstart);
                S.moe = 1; S.nblk = blkstart[32]; S.so.G = F.G; S.so.c = (int)blockIdx.x; S.so.nM = 0; S.so.nN = 0; S.so.nwg = 0;
                if (k == 7) { g = pg8::Gemm{(const bf16*)(F.ws + WS_H), (const bf16*)(F.ws + WS_WGU), MAXROWS, 2048, D, (const int*)(F.ws + WS_RSRC)}; S.lg = 3; E.mode = pg8::EPI_SWIGLU; E.O = (bf16*)(F.ws + WS_ACT); E.p0 = F.in[I_BGU] + (size_t)l * 32 * 2048; }
                else { g = pg8::Gemm{(const bf16*)(F.ws + WS_ACT), (const bf16*)(F.ws + WS_WDN), MAXROWS, 1024, D}; S.lg = 2; E.mode = pg8::EPI_DOWN; E.O = (bf16*)(F.ws + WS_YS); E.p0 = F.in[I_BDN] + (size_t)l * 32 * 1024; }
            }
#ifndef NO_G1
            pg8::gemm_phase<pg8::EpiAny, pg8::AnyOrder, PG8_ALIGN_EPI, PG8_SP2>(F.lds + RING_OFF, g, S, E);
#endif
        }
        if (use_bar && ph != N_PHASES - 1) xcd_barrier(bar);
#ifdef PROBE_DOUBLE_BAR
        if (use_bar && ph != N_PHASES - 1) xcd_barrier(bar);
#endif
        if (PROBE_REP_MASK != 0) { if (((PROBE_REP_MASK >> (k + 1)) & 1) && (PROBE_REP_KIND == 2 || kind == PROBE_REP_KIND) && !rep_done) { rep_done = 1; --ph;
                if (k == 5) { if (blockIdx.x == 0 && F.tid < 32) __hip_atomic_store((unsigned*)(F.ctl + CW_ECNT + l * 32 + F.tid), 0u, RLX_AGENT); xcd_barrier(bar); }
            } else rep_done = 0; }
    }
}

extern "C" void kernel_launch(void* const* d_in, const int* in_sizes, int n_in, void* d_out, int out_size, void* d_ws, size_t ws_size, hipStream_t stream) {
    static int grid = 0;
    if (grid == 0) {
        if (n_in != N_IN || out_size != TL * D || ws_size < WS_END) { fprintf(stderr, "kernel_launch: unexpected shapes (n_in %d, out %d, ws %zu < %zu)\n", n_in, out_size, ws_size, (size_t)WS_END); grid = -1; return; }
        if (hipFuncSetAttribute((const void*)fwd_kernel, hipFuncAttributeMaxDynamicSharedMemorySize, LDS_BYTES) != hipSuccess) { fprintf(stderr, "kernel_launch: hipFuncSetAttribute failed\n"); grid = -1; return; }
        int per_cu = 0;
        if (hipOccupancyMaxActiveBlocksPerMultiprocessor(&per_cu, (const void*)fwd_kernel, NWAVES * 64, LDS_BYTES) != hipSuccess || per_cu < 1) fprintf(stderr, "kernel_launch: occupancy query says %d\n", per_cu);
        (void)hipGetLastError();
        grid = 256;
    }
    if (grid < 0) return;
    if (hipMemsetAsync((char*)d_ws + WS_CTL, 0, CTL_ZERO_BYTES, stream) != hipSuccess) return;
    Args a{};
    for (int i = 0; i < N_IN; ++i) a.in[i] = (const float*)d_in[i];
    a.out = (float*)d_out; a.ws = (unsigned char*)d_ws; a.pad = 0;
#if MK_ONE_LAUNCH
    a.ph_lo = 0; a.ph_hi = N_PHASES; a.use_bar = 1;
    hipLaunchKernelGGL(fwd_kernel, dim3(grid), dim3(NWAVES * 64), LDS_BYTES, stream, a);
#else
    for (int ph = 0; ph < N_PHASES; ++ph) {
        if (!phase_exists(ph)) continue;
        a.ph_lo = ph; a.ph_hi = ph + 1; a.use_bar = 0;
        hipLaunchKernelGGL(fwd_kernel, dim3(grid), dim3(NWAVES * 64), LDS_BYTES, stream, a);
    }
#endif
}
```

```cpp
#include <hip/hip_runtime.h>
#include <cstdio>
#include <cstdint>
#include <cmath>
#define MK_ONE_LAUNCH 1
namespace pg8 {
#define PG8_LAS __attribute__((address_space(3)))
typedef unsigned short bf16_t;
typedef short bf16x8 __attribute__((ext_vector_type(8)));
typedef float f32x4 __attribute__((ext_vector_type(4)));
typedef unsigned u32x4 __attribute__((ext_vector_type(4)));
constexpr int BM = 256, BK = 64, HALF = 128, HTB = HALF * BK * 2  , STAGE_BYTES = 8 * HTB, NXCD = 8, WGM = 8;

__host__ __device__ __forceinline__ int lds_byte(int r, int c) { const int st = (r >> 4) * 2 + (c >> 5), rr = r & 15, cc = c & 31, ob = rr * 64 + cc * 2; return st * 1024 + (ob ^ (((ob >> 9) & 1) << 5)); }
__host__ __device__ __forceinline__ void stage_rc(int b, int& R, int& C) { const int st = b / 1024, sb = b % 1024, swz = sb ^ (((sb >> 9) & 1) << 5); R = (st >> 1) * 16 + swz / 64; C = (st & 1) * 32 + (swz % 64) / 2; }
__host__ __device__ __forceinline__ int perm32(int rho) { const int n = rho >> 4, i = rho & 15; return 8 * (i >> 2) + 4 * n + (i & 3); }

struct Unit { int pm, pn, pb; };
struct Gemm { const bf16_t* A; const bf16_t* Bt; int M, N, K; const int* rows; };
struct StaticOrder {
    int nM, nN, nwg, G, c;
    __host__ __device__ void init(int M, int N, int G_, int c_) { nM = M / BM; nN = N / BM; nwg = nM * nN; G = G_; c = c_; }
    __host__ __device__ bool next(int i, Unit& u) const {
        const long L = (long)i * G + c; if (L >= nwg) return false;
        int wgid = (int)L; { const int q = nwg / NXCD, r = nwg % NXCD, xcd = wgid % NXCD, off = wgid / NXCD; wgid = (xcd < r ? xcd * (q + 1) : r * (q + 1) + (xcd - r) * q) + off; }
        const int nig = WGM * nN, gid = wgid / nig, fm = gid * WGM, gsz = (nM - fm) < WGM ? (nM - fm) : WGM;
        u.pm = fm + ((wgid % nig) % gsz); u.pn = (wgid % nig) / gsz; u.pb = u.pn; return true;
    }
    __device__ __forceinline__ void a_ready(const Unit&) const {}
    __device__ __forceinline__ void done(const Unit&) const {}
};
__device__ __forceinline__ unsigned cvt_pk_bf16(float lo, float hi) { unsigned r; asm volatile("v_cvt_pk_bf16_f32 %0, %1, %2" : "=v"(r) : "v"(lo), "v"(hi)); return r; }
typedef float f32x2 __attribute__((ext_vector_type(2)));
#define PG8_STR2(x) #x
#define PG8_STR(x) PG8_STR2(x)
template <class Epi, class Sched, bool ALIGN_EPI = false, bool SP2 = false>
__device__ __forceinline__ void gemm_phase(PG8_LAS unsigned char* lds, const Gemm g, const Sched& S, const Epi& E) {
    int tid_ = threadIdx.x; asm volatile("" : "+v"(tid_));
    const int tid = tid_, wid = __builtin_amdgcn_readfirstlane(tid >> 6), lane = tid & 63, wr = wid >> 2, wc = wid & 3, fr = lane & 15, fq = lane >> 4;
    const int K = g.K, nt = K / BK;
    unsigned roffA[4], voffB[2];
#pragma unroll
    for (int i = 0; i < 2; ++i) { int R, C; stage_rc(tid * 16 + i * 8192, R, C); const int Rb = Epi::PERM ? ((R & ~31) + perm32(R & 31)) : R;
        roffA[i] = (unsigned)(R * K + C) * 2u; roffA[2 + i] = (unsigned)((R + HALF) * K + C) * 2u; voffB[i] = (unsigned)(Rb * K + C) * 2u; }
    const size_t kstep = (size_t)(BK * 2);
    const size_t hstep = (size_t)HALF * K * 2;
    const size_t tstep = 2 * hstep;
    const unsigned ldsw = (unsigned)wid * 1024u;
    const int aoff = lds_byte(wr * 64 + fr, fq * 8), boff = lds_byte(wc * 32 + fr, fq * 8);
#define PG8_SA(b, h) (((b) * 2 + (h)) * HTB)
#define PG8_SB(b, h) ((4 + (b) * 2 + (h)) * HTB)
#define PG8_STAGE(bufoff, gbase, voff) do { _Pragma("unroll") for (int _i = 0; _i < 2; ++_i) \
        __builtin_amdgcn_global_load_lds((const unsigned*)((const char*)(gbase) + (voff)[_i]), (PG8_LAS unsigned*)(lds + (bufoff) + ldsw + _i * 8192), 16, 0, 0); } while (0)
#define PG8_STAGEA(bufoff, gbase, h) do { _Pragma("unroll") for (int _i = 0; _i < 2; ++_i) \
        __builtin_amdgcn_global_load_lds((const unsigned*)((const char*)(gbase) + roffA[2 * (h) + _i]), (PG8_LAS unsigned*)(lds + (bufoff) + ldsw + _i * 8192), 16, 0, 0); } while (0)
#define PG8_LDA(dst, b, h) do { _Pragma("unroll") for (int m = 0; m < 4; ++m) _Pragma("unroll") for (int k = 0; k < 2; ++k) dst[m][k] = *(const PG8_LAS bf16x8*)(lds + PG8_SA(b, h) + aoff + m * 2048 + k * 1024); } while (0)
#define PG8_LDB(dst, b, h) do { _Pragma("unroll") for (int n = 0; n < 2; ++n) _Pragma("unroll") for (int k = 0; k < 2; ++k) dst[n][k] = *(const PG8_LAS bf16x8*)(lds + PG8_SB(b, h) + boff + n * 2048 + k * 1024); } while (0)
#define PG8_MMA(ai, bj, At, Bt) do { __builtin_amdgcn_s_setprio(1); _Pragma("unroll") for (int m = 0; m < 4; ++m) _Pragma("unroll") for (int n = 0; n < 2; ++n) _Pragma("unroll") for (int k = 0; k < 2; ++k) \
        acc[ai][bj][m][n] = __builtin_amdgcn_mfma_f32_16x16x32_bf16(Bt[n][k], At[m][k], acc[ai][bj][m][n], 0, 0, 0); __builtin_amdgcn_s_setprio(0); } while (0)
#define PG8_WAIT_V(n) asm volatile("s_waitcnt vmcnt(" #n ")" ::: "memory")
#define PG8_WAIT_L(n) asm volatile("s_waitcnt lgkmcnt(" #n ")" ::: "memory")
#define PG8_BAR __builtin_amdgcn_s_barrier()
#define PG8_SCHED __builtin_amdgcn_sched_barrier(0)
    Unit cur, nxt; int ui = 0;
    if (!S.next(0, cur)) return;
    f32x4 acc[2][2][4][2];
#define PG8_ACC_INIT() do { if (E.mode >= 3) { const PG8_LAS float* bs_ = E.bslot + wid * 64 + 8 * fq; \
            const f32x4 b00_ = *(const PG8_LAS f32x4*)bs_, b01_ = *(const PG8_LAS f32x4*)(bs_ + 4), b10_ = *(const PG8_LAS f32x4*)(bs_ + 32), b11_ = *(const PG8_LAS f32x4*)(bs_ + 36); \
            _Pragma("unroll") for (int a = 0; a < 2; ++a) _Pragma("unroll") for (int m = 0; m < 4; ++m) { acc[a][0][m][0] = b00_; acc[a][0][m][1] = b01_; acc[a][1][m][0] = b10_; acc[a][1][m][1] = b11_; } \
        } else { _Pragma("unroll") for (int a = 0; a < 2; ++a) _Pragma("unroll") for (int b = 0; b < 2; ++b) _Pragma("unroll") for (int m = 0; m < 4; ++m) _Pragma("unroll") for (int n = 0; n < 2; ++n) acc[a][b][m][n] = (f32x4){0.f, 0.f, 0.f, 0.f}; } } while (0)
    if (E.mode >= 3) { __builtin_amdgcn_global_load_lds((const unsigned*)E.bias_src(cur, wc, lane), (PG8_LAS unsigned*)(E.bslot + wid * 64), 4, 0, 0); PG8_WAIT_V(0); }
    PG8_ACC_INIT();
    bf16x8 At[4][2], B0[2][2], B1[2][2];
    const __attribute__((address_space(1))) int* const rows = (const __attribute__((address_space(1))) int*)g.rows; const int r0g = (wid >> 1) * 16 + (lane >> 2); const unsigned cb2g = roffA[0] - (unsigned)(r0g * K) * 2u;
#define PG8_ROWS(dst, pm_) do { _Pragma("unroll") for (int _j = 0; _j < 4; ++_j) dst[_j] = (unsigned)rows[(size_t)(pm_) * BM + r0g + 64 * _j] * (unsigned)(K * 2) + cb2g; } while (0)
    if (rows) { unsigned t4[4]; PG8_ROWS(t4, cur.pm); roffA[0] = t4[0]; roffA[1] = t4[1]; roffA[2] = t4[2]; roffA[3] = t4[3]; }
    const char* cA = rows ? (const char*)g.A : (const char*)g.A + (size_t)cur.pm * tstep; const char* cB = (const char*)g.Bt + (size_t)cur.pb * tstep;
    S.a_ready(cur);
    if constexpr (SP2) {
        PG8_STAGE(PG8_SB(0, 0), cB, voffB); PG8_STAGE(PG8_SB(0, 1), cB + hstep, voffB); PG8_STAGEA(PG8_SA(0, 0), cA, 0); PG8_STAGEA(PG8_SA(0, 1), cA, 1);
        if (wr == 1) PG8_BAR;
        PG8_WAIT_V(2); PG8_BAR;
        PG8_STAGE(PG8_SB(1, 0), cB + kstep, voffB); PG8_STAGEA(PG8_SA(1, 0), cA + kstep, 0); PG8_STAGE(PG8_SB(1, 1), cB + hstep + kstep, voffB);
        PG8_WAIT_V(6); PG8_BAR;
    } else {
        PG8_STAGE(PG8_SB(0, 0), cB, voffB); PG8_STAGEA(PG8_SA(0, 0), cA, 0); PG8_STAGE(PG8_SB(0, 1), cB + hstep, voffB); PG8_STAGEA(PG8_SA(0, 1), cA, 1);
        if (wr == 1) PG8_BAR;
        PG8_WAIT_V(4); PG8_BAR;
        PG8_STAGE(PG8_SB(1, 0), cB + kstep, voffB); PG8_STAGEA(PG8_SA(1, 0), cA + kstep, 0); PG8_STAGE(PG8_SB(1, 1), cB + hstep + kstep, voffB);
        PG8_WAIT_V(6); PG8_BAR;
    }
    unsigned nr4[4] = {0u, 0u, 0u, 0u};
    for (;;) {
        const bool has_next = S.next(ui + 1, nxt);
        const char* nA = (has_next && !rows) ? (const char*)g.A + (size_t)nxt.pm * tstep : cA; const char* nB = has_next ? (const char*)g.Bt + (size_t)nxt.pb * tstep : cB;
#ifdef PG8_LOOP_ALIGN
        asm volatile(".p2align " PG8_STR(PG8_LOOP_ALIGN));
#endif
        for (int t = 0; t < nt; t += 2) {
            const bool last = (t == nt - 2);
            const char* a1 = cA + (size_t)(t + 1) * kstep;
            const char* a2 = last ? nA : cA + (size_t)(t + 2) * kstep; const char* b2 = last ? nB : cB + (size_t)(t + 2) * kstep;
            const char* a3 = a2 + kstep; const char* b3 = b2 + kstep;
            if (last && has_next) S.a_ready(nxt);
            const bool swap_rows = rows != nullptr && last && has_next;
            if (E.mode >= 3 && has_next && t == nt - 4)
                __builtin_amdgcn_global_load_lds((const unsigned*)E.bias_src(nxt, wc, lane), (PG8_LAS unsigned*)(E.bslot + wid * 64), 4, 0, 0);
            if (rows != nullptr && has_next && t == nt - 4) {
                int tl2_ = tid; asm volatile("" : "+v"(tl2_));
                const __attribute__((address_space(1))) int* rp = rows + (size_t)nxt.pm * BM + ((tl2_ >> 7) * 16 + ((tl2_ & 63) >> 2));
                asm volatile("global_load_dword %0, %4, off\n\tglobal_load_dword %1, %4, off offset:256\n\tglobal_load_dword %2, %4, off offset:512\n\tglobal_load_dword %3, %4, off offset:768"
                             : "=&v"(nr4[0]), "=&v"(nr4[1]), "=&v"(nr4[2]), "=&v"(nr4[3]) : "v"(rp) : "memory"); }
            if constexpr (SP2) {
            PG8_LDB(B0, 0, 0); PG8_LDB(B1, 0, 1); PG8_SCHED; PG8_LDA(At, 0, 0); PG8_STAGEA(PG8_SA(1, 1), a1, 1);
            if (swap_rows) { int tl_ = tid; asm volatile("" : "+v"(tl_)); int R_, C_; stage_rc(tl_ * 16, R_, C_); const unsigned cbs_ = (unsigned)C_ * 2u;
#pragma unroll
                for (int _j = 0; _j < 4; ++_j) roffA[_j] = nr4[_j] * (unsigned)(K * 2) + cbs_; }
            PG8_WAIT_V(8); PG8_WAIT_L(0); PG8_BAR; PG8_MMA(0, 0, At, B0); PG8_MMA(0, 1, At, B1); PG8_BAR; PG8_SCHED;
            PG8_LDA(At, 0, 1); PG8_STAGE(PG8_SB(0, 0), b2, voffB); PG8_STAGE(PG8_SB(0, 1), b2 + hstep, voffB); PG8_STAGEA(PG8_SA(0, 0), a2, 0);
            PG8_WAIT_V(8); PG8_WAIT_L(0); PG8_BAR; PG8_MMA(1, 0, At, B0); PG8_MMA(1, 1, At, B1); PG8_BAR; PG8_SCHED;
            PG8_LDB(B0, 1, 0); PG8_LDB(B1, 1, 1); PG8_SCHED; PG8_LDA(At, 1, 0); PG8_STAGEA(PG8_SA(0, 1), a2, 1);
            PG8_WAIT_V(8); PG8_WAIT_L(0); PG8_BAR; PG8_MMA(0, 0, At, B0); PG8_MMA(0, 1, At, B1); PG8_BAR; PG8_SCHED;
            PG8_LDA(At, 1, 1); PG8_STAGE(PG8_SB(1, 0), b3, voffB); PG8_STAGE(PG8_SB(1, 1), b3 + hstep, voffB); PG8_STAGEA(PG8_SA(1, 0), a3, 0);
            PG8_WAIT_V(8); PG8_WAIT_L(0); PG8_BAR; PG8_MMA(1, 0, At, B0); PG8_MMA(1, 1, At, B1); PG8_BAR; PG8_SCHED;
            } else {
            PG8_LDB(B0, 0, 0); PG8_SCHED; PG8_LDA(At, 0, 0); PG8_STAGEA(PG8_SA(1, 1), a1, 1);
            if (swap_rows) { int tl_ = tid; asm volatile("" : "+v"(tl_)); int R_, C_; stage_rc(tl_ * 16, R_, C_); const unsigned cbs_ = (unsigned)C_ * 2u;
#pragma unroll
                for (int _j = 0; _j < 4; ++_j) roffA[_j] = nr4[_j] * (unsigned)(K * 2) + cbs_; }
            PG8_WAIT_L(8); PG8_BAR; PG8_WAIT_L(0); PG8_MMA(0, 0, At, B0); PG8_BAR; PG8_SCHED;
            PG8_LDB(B1, 0, 1); PG8_STAGE(PG8_SB(0, 0), b2, voffB);
            PG8_BAR; PG8_WAIT_L(0); PG8_MMA(0, 1, At, B1); PG8_BAR;
            PG8_LDA(At, 0, 1); PG8_STAGEA(PG8_SA(0, 0), a2, 0);
            PG8_BAR; PG8_WAIT_L(0); PG8_MMA(1, 0, At, B0); PG8_BAR; PG8_SCHED;
            PG8_STAGE(PG8_SB(0, 1), b2 + hstep, voffB);
            PG8_WAIT_V(6); PG8_BAR; PG8_MMA(1, 1, At, B1); PG8_BAR;
            PG8_LDB(B0, 1, 0); PG8_SCHED; PG8_LDA(At, 1, 0); PG8_STAGEA(PG8_SA(0, 1), a2, 1);
            PG8_WAIT_L(8); PG8_BAR; PG8_WAIT_L(0); PG8_MMA(0, 0, At, B0); PG8_BAR; PG8_SCHED;
            PG8_LDB(B1, 1, 1); PG8_STAGE(PG8_SB(1, 0), b3, voffB);
            PG8_BAR; PG8_WAIT_L(0); PG8_MMA(0, 1, At, B1); PG8_BAR;
            PG8_LDA(At, 1, 1); PG8_STAGEA(PG8_SA(1, 0), a3, 0);
            PG8_BAR; PG8_WAIT_L(0); PG8_MMA(1, 0, At, B0); PG8_BAR; PG8_SCHED;
            PG8_STAGE(PG8_SB(1, 1), b3 + hstep, voffB);
            PG8_WAIT_V(6); PG8_BAR; PG8_MMA(1, 1, At, B1); PG8_BAR;
            }
        }
        if constexpr (ALIGN_EPI) { if (wr == 0) PG8_BAR; }
        if constexpr (!Epi::AFTER_DRAIN) { E(acc, cur, wr, wc, fr, fq); S.done(cur); }
        if (!has_next) break;
        PG8_ACC_INIT();
        cur = nxt; cA = nA; cB = nB; ++ui;
        if constexpr (ALIGN_EPI) { if (wr == 1) PG8_BAR; }
    }
    PG8_WAIT_V(0);
    if constexpr (!ALIGN_EPI) { if (wr == 0) PG8_BAR; }
    PG8_BAR;
    if constexpr (Epi::AFTER_DRAIN) { E.fused(acc, cur, wr, wc, fr, fq, lds, wid, lane); S.done(cur); }
#undef PG8_ACC_INIT
#undef PG8_SA
#undef PG8_SB
#undef PG8_STAGE
#undef PG8_STAGEA
#undef PG8_ROWS
#undef PG8_LDA
#undef PG8_LDB
#undef PG8_MMA
#undef PG8_WAIT_V
#undef PG8_WAIT_L
#undef PG8_BAR
#undef PG8_SCHED
}
}
constexpr int NWAVES = 8;
constexpr int D = 1024, NBATCH = 8, SEQ = 8192, CTXL = 256, DEPTH = 4;
constexpr int TL = NBATCH * SEQ;
constexpr int TC = NBATCH * CTXL;
constexpr int TT = TL + TC;
constexpr int QKD = 1536, NE = 32;
constexpr int MAXBLK = 1088, MAXROWS = MAXBLK * 256;
#define SCONST_F32(hex) ([]() __attribute__((always_inline)) { float k_; asm("s_mov_b32 %0, " #hex : "=s"(k_)); return k_; }())
#define NORM_EPS SCONST_F32(0x358637bd)
constexpr int N_IN = 35;
enum { I_X = 0, I_C, I_CTX, I_CCTX, I_ADAW, I_ADAB, I_NMIX, I_NFFN, I_AWQKV, I_ABQKV, I_AWO, I_ABO, I_ASINK, I_HWIN, I_HBIN, I_HCW, I_HCB,
       I_FW1, I_FB1, I_FW2, I_FB2, I_FW3, I_FB3, I_FFREQ, I_FWOUT, I_HBD, I_HWO, I_HBO, I_RW, I_RB, I_WGU, I_BGU, I_WDN, I_BDN, I_FNORM };

constexpr size_t MiB = 1u << 20;
constexpr size_t WS_CTL = 0, CTL_ZERO_BYTES = 1 * MiB;
constexpr size_t WS_MOD = 1 * MiB;
constexpr size_t WS_ROPE = 2 * MiB;
constexpr size_t WS_A3L = 4 * MiB;
constexpr size_t WS_A3C = 8 * MiB;
constexpr size_t WS_WQK = 9 * MiB;
constexpr size_t WS_WAO = 15 * MiB;
constexpr size_t WS_WHIN = 19 * MiB;
constexpr size_t WS_WHO = 31 * MiB;
constexpr size_t WS_WGU = 35 * MiB;
constexpr size_t WS_WDN = 547 * MiB;
constexpr size_t WS_XC = 803 * MiB;
constexpr size_t WS_H = 811 * MiB;
constexpr size_t WS_POS = 943 * MiB;
constexpr size_t WS_GATE = 945 * MiB;
constexpr size_t WS_DEST = 947 * MiB;
constexpr size_t WS_BIG = 949 * MiB;
constexpr size_t WS_QK = WS_BIG, WS_UT = WS_BIG, WS_YS = WS_BIG;
constexpr size_t WS_O = WS_BIG + 396 * MiB;
constexpr size_t WS_B2 = WS_BIG + 544 * MiB;
constexpr size_t WS_ZT = WS_B2, WS_G = WS_B2 + 132 * MiB, WS_TP = WS_B2 + 388 * MiB  , WS_ACT = WS_B2;
constexpr size_t WS_XB = WS_B2 + 544 * MiB;
constexpr size_t WS_RSRC = WS_XB + 132 * MiB;
constexpr size_t WS_END = WS_RSRC + 2 * MiB;
static_assert(WS_O + (size_t)TT * D * 2 <= WS_B2 && (size_t)MAXROWS * D * 2 <= 544 * MiB && (size_t)3072 * TT * 2 <= 396 * MiB, "ws map");
static_assert(WS_QK + (size_t)TT * QKD * 2 <= WS_O, "ws map 2");
constexpr int CW_BAR = 4096;
constexpr int CW_ECNT = 16384;

constexpr int RING_OFF = 0, RING_BYTES = 131072;
constexpr int LDSCTL_OFF = RING_BYTES, MISC_OFF = LDSCTL_OFF + 320, USER_OFF = RING_BYTES + 512;
constexpr int LDS_BYTES = 147456;

#define GAS __attribute__((address_space(1)))
#define LAS __attribute__((address_space(3)))
#define KAS __attribute__((address_space(4)))
typedef unsigned short bf16;
typedef unsigned v4u __attribute__((ext_vector_type(4)));
typedef unsigned v2u __attribute__((ext_vector_type(2)));
typedef int v4i __attribute__((ext_vector_type(4)));
typedef float f32x4 __attribute__((ext_vector_type(4)));
typedef float f32x16 __attribute__((ext_vector_type(16)));
typedef short bf16x8 __attribute__((ext_vector_type(8)));
typedef GAS unsigned gu32;
#define RLX_AGENT __ATOMIC_RELAXED, __HIP_MEMORY_SCOPE_AGENT
#define LDS_WAIT() asm volatile("s_waitcnt lgkmcnt(0)" ::: "memory")
#define VM_WAIT() asm volatile("s_waitcnt vmcnt(0)" ::: "memory")
__device__ __forceinline__ unsigned f2bf(float f) { unsigned u = __builtin_bit_cast(unsigned, f); return (u + 0x7fffu + ((u >> 16) & 1u)) >> 16; }
__device__ __forceinline__ unsigned pk2(float lo, float hi) { return f2bf(lo) | (f2bf(hi) << 16); }
__device__ __forceinline__ float bf2f(unsigned short b) { return __builtin_bit_cast(float, ((unsigned)b) << 16); }
__device__ __forceinline__ float bflo(unsigned w) { return __builtin_bit_cast(float, w << 16); }
__device__ __forceinline__ float bfhi(unsigned w) { return __builtin_bit_cast(float, w & 0xffff0000u); }
#define XB_TMO      128
#define XB_XCNT(j)  (256  + 64 * (j))
#define XB_XSUB(j)  (1280 + 64 * (j))
#define XB_XGEN(j)  (2304 + 64 * (j))
#define XB_TOP      3328
#define XB_TOPGEN   3392
#define XCD_BAR_WORDS 3456
#define XB_SPIN_CAP (1u << 21)

__device__ __forceinline__ unsigned xb_ld(unsigned* p)              { return __hip_atomic_load(p, __ATOMIC_RELAXED, __HIP_MEMORY_SCOPE_AGENT); }
__device__ __forceinline__ unsigned xb_add(unsigned* p, unsigned v) { return __hip_atomic_fetch_add(p, v, __ATOMIC_RELAXED, __HIP_MEMORY_SCOPE_AGENT); }
__device__ __forceinline__ unsigned xb_xcc_id() { return (unsigned)__builtin_amdgcn_s_getreg((3 << 11) | 20) & 0xFu; }
#define XB_SPIN(cond, bar) do { unsigned _sp = 0; while (cond) { __builtin_amdgcn_s_sleep(1); \
    if ((++_sp & 255u) == 0u) { if (xb_ld(&(bar)[XB_TMO])) break; if (_sp > XB_SPIN_CAP) { atomicAdd(&(bar)[XB_TMO], 1u); break; } } } } while (0)

struct XcdBarrier {
    unsigned* bar; unsigned x;
    volatile LAS unsigned* st;
};

__device__ __forceinline__ XcdBarrier xcd_barrier_post(unsigned* bar, volatile LAS unsigned* st) {
    XcdBarrier b; b.bar = bar; b.x = xb_xcc_id(); b.st = st;
    if (threadIdx.x == 0) (void)xb_add(&bar[XB_XCNT(b.x)], 1u);
    return b;
}
__device__ __forceinline__ void xcd_barrier_complete(unsigned* bar, unsigned x, unsigned& nloc, unsigned& nx) {
    const unsigned G = gridDim.x * gridDim.y * gridDim.z;
    unsigned sum, cnt, mine, sp = 0u;
    for (;;) {
        sum = 0u; cnt = 0u; mine = 0u;
#pragma unroll
        for (unsigned j = 0; j < 16; ++j) { const unsigned c = xb_ld(&bar[XB_XCNT(j)]); sum += c; cnt += (c > 0u) ? 1u : 0u; mine = (j == x) ? c : mine; }
        if (sum == G) break;
        __builtin_amdgcn_s_sleep(1);
        if ((++sp & 255u) == 0u) { if (xb_ld(&bar[XB_TMO])) break; if (sp > XB_SPIN_CAP) { atomicAdd(&bar[XB_TMO], 1u); break; } }
    }
    nloc = mine > 0u ? mine : 1u; nx = cnt > 0u ? cnt : 1u;
}

__device__ __forceinline__ void xcd_barrier(const XcdBarrier& b) {
    asm volatile("s_waitcnt vmcnt(0)" ::: "memory");
    __syncthreads();
    if (threadIdx.x == 0) {
        unsigned* bar = b.bar;
        __builtin_amdgcn_s_waitcnt(0);
        unsigned nloc = b.st[0], nx = b.st[1];
        if (nloc == 0u) { xcd_barrier_complete(bar, b.x, nloc, nx); b.st[0] = nloc; b.st[1] = nx; }
        const unsigned old = xb_add(&bar[XB_XSUB(b.x)], 1u);
        const unsigned gen = old / nloc;
        if (old + 1u == (gen + 1u) * nloc) {
            __builtin_amdgcn_fence(__ATOMIC_RELEASE, "agent");
            asm volatile("s_waitcnt vmcnt(0)" ::: "memory");
            const unsigned og = xb_add(&bar[XB_TOP], 1u);
            const unsigned tg = og / nx;
            if (og + 1u == (tg + 1u) * nx) xb_add(&bar[XB_TOPGEN], 1u);
            else XB_SPIN(xb_ld(&bar[XB_TOPGEN]) == tg, bar);
            __builtin_amdgcn_fence(__ATOMIC_ACQUIRE, "agent");
            xb_add(&bar[XB_XGEN(b.x)], 1u);
            asm volatile("s_waitcnt vmcnt(0)" ::: "memory");
        } else {
            XB_SPIN(xb_ld(&bar[XB_XGEN(b.x)]) == gen, bar);
            __builtin_amdgcn_fence(__ATOMIC_ACQUIRE, "agent");
            asm volatile("s_waitcnt vmcnt(0)" ::: "memory");
        }
    }
    __syncthreads();
}
#ifndef FFT_HOST_TEST
#define FFT_DEV __device__ __forceinline__
#define FFT_LAUNDER(t) asm volatile("" : "+v"(t))
#else
#define FFT_DEV inline
#define FFT_LAUNDER(t) (void)0
#endif
#ifndef FFT_HOST_TEST
#define FFT_FENCE() do { asm volatile("" ::: "memory"); __builtin_amdgcn_sched_barrier(0); } while (0)
#else
#define FFT_FENCE() (void)0
#endif
typedef float cf2 __attribute__((ext_vector_type(2)));
typedef float cf4 __attribute__((ext_vector_type(4)));
constexpr int FFT_N = 16384, FFT_THREADS = 512;
FFT_DEV void fft_cs(float frac, float& c, float& s) {
#ifndef FFT_HOST_TEST
    c = __builtin_amdgcn_cosf(frac); s = __builtin_amdgcn_sinf(frac);
#else
    c = (float)cos(6.283185307179586 * (double)frac); s = (float)sin(6.283185307179586 * (double)frac);
#endif
}
FFT_DEV cf2 cmulf(cf2 a, float c, float s) { cf2 r; r.x = a.x * c - a.y * s; r.y = a.x * s + a.y * c; return r; }
FFT_DEV int fft_swz(int e) { return e ^ (((e >> 5) & 7) << 1); }
FFT_DEV cf2 cmul2(cf2 a, cf2 b) { const cf2 axx = {a.x, a.x}, ayy = {a.y, a.y}, bs = {-b.y, b.x}; return ayy * bs + axx * b; }
FFT_DEV cf2 cmulc(cf2 a, cf2 b) { const cf2 axx = {a.x, a.x}, ayy = {a.y, a.y}, bs = {b.y, b.x}, bn = {b.x, -b.y}; return ayy * bs + axx * bn; }
FFT_DEV cf2 tw32(int j) {
    constexpr float C[9] = {1.0f, 0.98078528040323044913f, 0.92387953251128675613f, 0.83146961230254523708f, 0.70710678118654752440f, 0.55557023301960222474f, 0.38268343236508977173f, 0.19509032201612826785f, 0.0f};
    const int q = (j >> 3) & 3, r = j & 7; float c, sn;
    if (q == 0) { c = C[r]; sn = C[8 - r]; } else if (q == 1) { c = -C[8 - r]; sn = C[r]; } else if (q == 2) { c = -C[r]; sn = -C[8 - r]; } else { c = C[8 - r]; sn = -C[r]; }
    cf2 w; w.x = c; w.y = -sn; return w;
}
template <bool TW> FFT_DEV void bfly_fwd_w(cf2& a0, cf2& a1, cf2& a2, cf2& a3, cf2 w1, cf2 w2, cf2 w3) {
    const cf2 t0 = a0 + a2, t1 = a0 - a2, t2 = a1 + a3, t3 = a1 - a3;
    cf2 y0 = t0 + t2, y2 = t0 - t2, y1, y3;
    y1.x = t1.x + t3.y; y1.y = t1.y - t3.x;
    y3.x = t1.x - t3.y; y3.y = t1.y + t3.x;
    if (TW) { y1 = cmul2(y1, w1); y2 = cmul2(y2, w2); y3 = cmul2(y3, w3); }
    a0 = y0; a1 = y1; a2 = y2; a3 = y3;
}
template <bool TW> FFT_DEV void bfly_inv_w(cf2& a0, cf2& a1, cf2& a2, cf2& a3, cf2 w1, cf2 w2, cf2 w3) {
    if (TW) { a1 = cmulc(a1, w1); a2 = cmulc(a2, w2); a3 = cmulc(a3, w3); }
    const cf2 t0 = a0 + a2, t1 = a0 - a2, t2 = a1 + a3, t3 = a1 - a3;
    cf2 y0 = t0 + t2, y2 = t0 - t2, y1, y3;
    y1.x = t1.x - t3.y; y1.y = t1.y + t3.x;
    y3.x = t1.x + t3.y; y3.y = t1.y - t3.x;
    a0 = y0; a1 = y1; a2 = y2; a3 = y3;
}
FFT_DEV cf2 fft_w(float frac) { float c, sn; fft_cs(frac, c, sn); cf2 w; w.x = c; w.y = -sn; return w; }
template <bool TW> FFT_DEV void bfly_fwd(cf2& a0, cf2& a1, cf2& a2, cf2& a3, float f) {
    const cf2 t0 = a0 + a2, t1 = a0 - a2, t2 = a1 + a3, t3 = a1 - a3;
    cf2 y0 = t0 + t2, y2 = t0 - t2, y1, y3;
    y1.x = t1.x + t3.y; y1.y = t1.y - t3.x;
    y3.x = t1.x - t3.y; y3.y = t1.y + t3.x;
    if (TW) { float c1, s1, c2, s2, c3, s3; fft_cs(f, c1, s1); fft_cs(2.0f * f, c2, s2); fft_cs(3.0f * f, c3, s3);
        y1 = cmulf(y1, c1, -s1); y2 = cmulf(y2, c2, -s2); y3 = cmulf(y3, c3, -s3); }
    a0 = y0; a1 = y1; a2 = y2; a3 = y3;
}
template <bool TW> FFT_DEV void bfly_inv(cf2& a0, cf2& a1, cf2& a2, cf2& a3, float f) {
    if (TW) { float c1, s1, c2, s2, c3, s3; fft_cs(f, c1, s1); fft_cs(2.0f * f, c2, s2); fft_cs(3.0f * f, c3, s3);
        a1 = cmulf(a1, c1, s1); a2 = cmulf(a2, c2, s2); a3 = cmulf(a3, c3, s3); }
    const cf2 t0 = a0 + a2, t1 = a0 - a2, t2 = a1 + a3, t3 = a1 - a3;
    cf2 y0 = t0 + t2, y2 = t0 - t2, y1, y3;
    y1.x = t1.x - t3.y; y1.y = t1.y + t3.x;
    y3.x = t1.x + t3.y; y3.y = t1.y - t3.x;
    a0 = y0; a1 = y1; a2 = y2; a3 = y3;
}
template <class PT> FFT_DEV void fft_fwd_first(PT X, const float (&za)[16], const float (&zb)[16], int tid) {
    FFT_LAUNDER(tid);
    const cf2 wt1 = fft_w((float)tid * (1.0f / 16384.0f)), wt2 = cmul2(wt1, wt1), wt3 = cmul2(wt2, wt1);
#pragma unroll
    for (int q = 0; q < 8; ++q) {
        const int k = tid + FFT_THREADS * q;
        cf2 a0, a1, a2, a3; a0.x = za[q]; a0.y = zb[q]; a1.x = za[q + 8]; a1.y = zb[q + 8]; a2.x = 0.f; a2.y = 0.f; a3 = a2;
        bfly_fwd_w<true>(a0, a1, a2, a3, cmul2(wt1, tw32(q)), cmul2(wt2, tw32(2 * q)), cmul2(wt3, tw32(3 * q)));
        const int sk = fft_swz(k);
        X[sk] = a0; X[sk + 4096] = a1; X[sk + 8192] = a2; X[sk + 12288] = a3;
        FFT_FENCE();
    }
}
template <class PT, class SP> FFT_DEV void fft_fwd_first_full(PT X, SP src, float scale, int tid) {
    FFT_LAUNDER(tid);
    const cf2 wt1 = fft_w((float)tid * (1.0f / 16384.0f)), wt2 = cmul2(wt1, wt1), wt3 = cmul2(wt2, wt1);
#pragma unroll
    for (int q = 0; q < 8; ++q) {
        const int k = tid + FFT_THREADS * q;
        cf2 a0, a1, a2, a3; a0.x = src[k] * scale; a0.y = 0.f; a1.x = src[k + 4096] * scale; a1.y = 0.f; a2.x = src[k + 8192] * scale; a2.y = 0.f; a3.x = src[k + 12288] * scale; a3.y = 0.f;
        bfly_fwd_w<true>(a0, a1, a2, a3, cmul2(wt1, tw32(q)), cmul2(wt2, tw32(2 * q)), cmul2(wt3, tw32(3 * q)));
        const int sk = fft_swz(k);
        X[sk] = a0; X[sk + 4096] = a1; X[sk + 8192] = a2; X[sk + 12288] = a3;
        if (q & 1) FFT_FENCE();
    }
}
template <class PT, class SP> FFT_DEV void fft_fwd_first_taps(PT X, SP src, float scale, int tid) {
    FFT_LAUNDER(tid);
    const cf2 wt1 = fft_w((float)tid * (1.0f / 16384.0f)), wt2 = cmul2(wt1, wt1), wt3 = cmul2(wt2, wt1);
#pragma unroll
    for (int q = 0; q < 8; ++q) {
        const int k = tid + FFT_THREADS * q;
        cf2 a0, a1, a2, a3; a0.x = src[k] * scale; a0.y = 0.f; a1.x = src[k + 4096] * scale; a1.y = 0.f; a2.x = k == 0 ? 0.f : src[16384 - (k == 0 ? 1 : k)] * scale; a2.y = 0.f; a3.x = src[12288 - k] * scale; a3.y = 0.f;
        bfly_fwd_w<true>(a0, a1, a2, a3, cmul2(wt1, tw32(q)), cmul2(wt2, tw32(2 * q)), cmul2(wt3, tw32(3 * q)));
        const int sk = fft_swz(k);
        X[sk] = a0; X[sk + 4096] = a1; X[sk + 8192] = a2; X[sk + 12288] = a3;
        if (q & 1) FFT_FENCE();
    }
}
template <int S2> FFT_DEV int fft_dbl_idx(int base, int i) {
    if (S2 == 256) return fft_swz(base) + S2 * i;
    if (S2 == 16) return (base ^ ((i >> 1) << 1)) + S2 * i;
    return fft_swz(base + S2 * i);
}
template <int P, class PT> FFT_DEV void fft_fwd_double(PT X, int tid) {
    FFT_LAUNDER(tid);
    constexpr int LS2 = 2 * (5 - P), S2 = 1 << LS2, NCUR = 1 << (2 * (7 - P));
#pragma unroll 1
    for (int q = 0; q < 2; ++q) {
        const int g = tid + FFT_THREADS * q, blk = g >> LS2, k = g & (S2 - 1), base = blk * NCUR + k;
        cf2 s[16];
#pragma unroll
        for (int i = 0; i < 16; ++i) s[i] = X[fft_dbl_idx<S2>(base, i)];
        const cf2 w1 = fft_w((float)k * (1.0f / (float)NCUR)), w2 = cmul2(w1, w1), w3 = cmul2(w2, w1), v1 = cmul2(w2, w2), v2 = cmul2(v1, v1), v3 = cmul2(v2, v1);
#pragma unroll
        for (int i0 = 0; i0 < 4; ++i0) bfly_fwd_w<true>(s[i0], s[i0 + 4], s[i0 + 8], s[i0 + 12], cmul2(w1, tw32(2 * i0)), cmul2(w2, tw32(4 * i0)), cmul2(w3, tw32(6 * i0)));
#pragma unroll
        for (int m = 0; m < 4; ++m) bfly_fwd_w<true>(s[4 * m], s[4 * m + 1], s[4 * m + 2], s[4 * m + 3], v1, v2, v3);
#pragma unroll
        for (int i = 0; i < 16; ++i) X[fft_dbl_idx<S2>(base, i)] = s[i];
    }
}
template <int P, class PT> FFT_DEV void fft_inv_double(PT X, int tid) {
    FFT_LAUNDER(tid);
    constexpr int LS2 = 2 * (5 - P), S2 = 1 << LS2, NCUR = 1 << (2 * (7 - P));
#pragma unroll 1
    for (int q = 0; q < 2; ++q) {
        const int g = tid + FFT_THREADS * q, blk = g >> LS2, k = g & (S2 - 1), base = blk * NCUR + k;
        cf2 s[16];
#pragma unroll
        for (int i = 0; i < 16; ++i) s[i] = X[fft_dbl_idx<S2>(base, i)];
        const cf2 w1 = fft_w((float)k * (1.0f / (float)NCUR)), w2 = cmul2(w1, w1), w3 = cmul2(w2, w1), v1 = cmul2(w2, w2), v2 = cmul2(v1, v1), v3 = cmul2(v2, v1);
#pragma unroll
        for (int m = 0; m < 4; ++m) bfly_inv_w<true>(s[4 * m], s[4 * m + 1], s[4 * m + 2], s[4 * m + 3], v1, v2, v3);
#pragma unroll
        for (int i0 = 0; i0 < 4; ++i0) bfly_inv_w<true>(s[i0], s[i0 + 4], s[i0 + 8], s[i0 + 12], cmul2(w1, tw32(2 * i0)), cmul2(w2, tw32(4 * i0)), cmul2(w3, tw32(6 * i0)));
#pragma unroll
        for (int i = 0; i < 16; ++i) X[fft_dbl_idx<S2>(base, i)] = s[i];
    }
}
template <class PT> FFT_DEV void fft_load_group(PT X, int g, cf2 (&s)[16]) {
    const int m2 = ((g >> 1) & 7) << 1;
#pragma unroll
    for (int c = 0; c < 8; ++c) { const int e = 16 * g + ((2 * c) ^ m2); s[2 * c] = X[e]; s[2 * c + 1] = X[e + 1]; }
}
template <class PT> FFT_DEV void fft_store_group(PT X, int g, const cf2 (&s)[16]) {
    const int m2 = ((g >> 1) & 7) << 1;
#pragma unroll
    for (int c = 0; c < 8; ++c) { const int e = 16 * g + ((2 * c) ^ m2); X[e] = s[2 * c]; X[e + 1] = s[2 * c + 1]; }
}
FFT_DEV void fft_last2_fwd(cf2 (&s)[16]) {
#pragma unroll
    for (int i0 = 0; i0 < 4; ++i0) bfly_fwd_w<true>(s[i0], s[i0 + 4], s[i0 + 8], s[i0 + 12], tw32(2 * i0), tw32(4 * i0), tw32(6 * i0));
#pragma unroll
    for (int m = 0; m < 4; ++m) bfly_fwd_w<false>(s[4 * m], s[4 * m + 1], s[4 * m + 2], s[4 * m + 3], tw32(0), tw32(0), tw32(0));
}
FFT_DEV void fft_last2_inv(cf2 (&s)[16]) {
#pragma unroll
    for (int m = 0; m < 4; ++m) bfly_inv_w<false>(s[4 * m], s[4 * m + 1], s[4 * m + 2], s[4 * m + 3], tw32(0), tw32(0), tw32(0));
#pragma unroll
    for (int i0 = 0; i0 < 4; ++i0) bfly_inv_w<true>(s[i0], s[i0 + 4], s[i0 + 8], s[i0 + 12], tw32(2 * i0), tw32(4 * i0), tw32(6 * i0));
}
template <class PT, class GP> FFT_DEV void fft_mid_store(PT X, GP G, float scale, float add, int tid) {
    FFT_LAUNDER(tid);
#pragma unroll 1
    for (int q = 0; q < 2; ++q) { const int g = tid + FFT_THREADS * q; cf2 s[16]; fft_load_group(X, g, s); fft_last2_fwd(s);
#pragma unroll
        for (int c = 0; c < 8; ++c) { cf4 w; w.x = (s[2 * c].x + add) * scale; w.y = s[2 * c].y * scale; w.z = (s[2 * c + 1].x + add) * scale; w.w = s[2 * c + 1].y * scale; G[c * 1024 + g] = w; } }
}
template <class PT, class GP> FFT_DEV void fft_mid_mul(PT X, GP G, int tid) {
    FFT_LAUNDER(tid);
#pragma unroll 1
    for (int q = 0; q < 2; ++q) { const int g = tid + FFT_THREADS * q; cf2 s[16]; cf4 w[4];
#pragma unroll
        for (int c = 0; c < 4; ++c) w[c] = G[c * 1024 + g];
        fft_load_group(X, g, s); fft_last2_fwd(s);
#pragma unroll
        for (int h = 0; h < 2; ++h) {
#pragma unroll
            for (int c4 = 0; c4 < 4; ++c4) { const int c = 4 * h + c4; const cf4 wc = w[c4]; if (h == 0) w[c4] = G[(c + 4) * 1024 + g];
                cf2 a = s[2 * c], b = s[2 * c + 1], r; r.x = a.x * wc.x - a.y * wc.y; r.y = a.x * wc.y + a.y * wc.x; s[2 * c] = r;
                r.x = b.x * wc.z - b.y * wc.w; r.y = b.x * wc.w + b.y * wc.z; s[2 * c + 1] = r; } }
        fft_last2_inv(s); fft_store_group(X, g, s); }
}
template <class PT> FFT_DEV void fft_inv_last(PT X, float (&za)[16], float (&zb)[16], int tid) {
    FFT_LAUNDER(tid);
    const cf2 wt1 = fft_w((float)tid * (1.0f / 16384.0f)), wt2 = cmul2(wt1, wt1), wt3 = cmul2(wt2, wt1);
#pragma unroll
    for (int q = 0; q < 8; ++q) {
        const int k = tid + FFT_THREADS * q;
        const int sk = fft_swz(k);
        cf2 a0 = X[sk], a1 = X[sk + 4096], a2 = X[sk + 8192], a3 = X[sk + 12288];
        bfly_inv_w<true>(a0, a1, a2, a3, cmul2(wt1, tw32(q)), cmul2(wt2, tw32(2 * q)), cmul2(wt3, tw32(3 * q)));
        za[q] = a0.x; zb[q] = a0.y; za[q + 8] = a1.x; zb[q + 8] = a1.y;
        FFT_FENCE();
    }
}
template <int Q0, class PT> FFT_DEV void fft_inv_last_part(PT X, float (&za)[8], float (&zb)[8], int tid) {
    FFT_LAUNDER(tid);
    const cf2 wt1 = fft_w((float)tid * (1.0f / 16384.0f)), wt2 = cmul2(wt1, wt1), wt3 = cmul2(wt2, wt1);
#pragma unroll
    for (int q = Q0; q < Q0 + 4; ++q) {
        const int k = tid + FFT_THREADS * q;
        const int sk = fft_swz(k);
        cf2 a0 = X[sk], a1 = X[sk + 4096], a2 = X[sk + 8192], a3 = X[sk + 12288];
        bfly_inv_w<true>(a0, a1, a2, a3, cmul2(wt1, tw32(q)), cmul2(wt2, tw32(2 * q)), cmul2(wt3, tw32(3 * q)));
        za[q - Q0] = a0.x; zb[q - Q0] = a0.y; za[4 + q - Q0] = a1.x; zb[4 + q - Q0] = a1.y;
    }
}
namespace pg8 {
enum { EPI_QK = 0, EPI_T = 1, EPI_RES = 2, EPI_SWIGLU = 3, EPI_DOWN = 4 };
struct EpiAny {
    static constexpr bool PERM = true, AFTER_DRAIN = false;
    int mode, ldc;
    bf16_t* O;
    float* f0; float* f1;
    const float* p0; const float* p1; const float* p2; const float* p3;
    PG8_LAS float* bslot;
    __device__ __forceinline__ void epi_qk(const f32x4 (&acc)[2][2][4][2], const Unit& u, int wr, int wc, int fr, int fq) const {
        const int row0 = u.pm * BM + wr * 64 + fr;
        const bool latent = u.pm < 256;
#pragma unroll
        for (int bj = 0; bj < 2; ++bj) {
            const int cs = u.pn * BM + bj * HALF + wc * 32 + 8 * fq;
            const int hb = cs & ~63, jj = (cs & 63) >> 3;
            const bool isv = u.pn >= 5;
            const f32x4 b0 = *(const f32x4*)(p0 + (isv ? cs : hb + 4 * jj)), b1 = *(const f32x4*)(p0 + (isv ? cs + 4 : hb + 32 + 4 * jj));
            float frq[4];
#pragma unroll
            for (int t = 0; t < 4; ++t) frq[t] = __builtin_amdgcn_exp2f(-(float)((4 * jj + t) & 15) * 0.8304820237218406f) * 0.15915494309189535f;
#pragma unroll
            for (int ai = 0; ai < 2; ++ai)
#pragma unroll
                for (int m = 0; m < 4; ++m) {
                    const int row = row0 + ai * HALF + m * 16;
                    f32x4 x1 = acc[ai][bj][m][0] + b0, x2 = acc[ai][bj][m][1] + b1;
                    if (latent && !isv) {
                        const int pos = row & 8191; const float coord = (float)(jj < 4 ? pos >> 6 : pos & 63);
#pragma unroll
                        for (int t = 0; t < 4; ++t) { const float rev = coord * frq[t];
                            const float c = __builtin_amdgcn_cosf(rev), sn = __builtin_amdgcn_sinf(rev), a1 = x1[t], a2 = x2[t]; x1[t] = a1 * c - a2 * sn; x2[t] = a1 * sn + a2 * c; }
                    }
                    if (u.pn < 4) { x1 *= 0.18033688011112042f; x2 *= 0.18033688011112042f; }
                    u32x4 w; w.x = cvt_pk_bf16(x1[0], x1[1]); w.y = cvt_pk_bf16(x1[2], x1[3]); w.z = cvt_pk_bf16(x2[0], x2[1]); w.w = cvt_pk_bf16(x2[2], x2[3]);
                    *(u32x4*)(O + (size_t)row * 1536 + cs) = w;
                }
        }
    }
    __device__ __forceinline__ void epi_t(const f32x4 (&acc)[2][2][4][2], const Unit& u, int wr, int wc, int fr, int fq) const {
        const int row0 = u.pm * BM + wr * 64 + fr, col0 = u.pn * BM + wc * 32 + 8 * fq;
        float bvs[8];
#pragma unroll
        for (int q = 0; q < 8; ++q) bvs[q] = p0[row0 + (q >> 2) * HALF + (q & 3) * 16];
#pragma unroll
        for (int ai = 0; ai < 2; ++ai)
#pragma unroll
            for (int m = 0; m < 4; ++m) { const int row = row0 + ai * HALF + m * 16; const float bv = bvs[ai * 4 + m]; bf16_t* rowp = O + (size_t)row * ldc + col0;
#pragma unroll
                for (int bj = 0; bj < 2; ++bj) { const f32x4 v0 = acc[ai][bj][m][0] + bv, v1 = acc[ai][bj][m][1] + bv;
                    u32x4 w; w.x = cvt_pk_bf16(v0[0], v0[1]); w.y = cvt_pk_bf16(v0[2], v0[3]); w.z = cvt_pk_bf16(v1[0], v1[1]); w.w = cvt_pk_bf16(v1[2], v1[3]);
                    *(u32x4*)(rowp + bj * HALF) = w; } }
    }
    __device__ __forceinline__ void epi_res(const f32x4 (&acc)[2][2][4][2], const Unit& u, int wr, int wc, int fr, int fq) const {
        const bool latent = u.pm < 256;
        const int row0 = u.pm * BM + wr * 64 + fr, col0 = u.pn * BM + wc * 32 + 8 * fq;
        const float* gp = p3 + (size_t)(latent ? (u.pm >> 5) : 8) * 6144 + col0; const float* bp = p2 + col0;
        const float* srcf = p0 ? (latent ? p0 : p1 - (size_t)TL * 1024) : nullptr;
#pragma unroll
        for (int bj = 0; bj < 2; ++bj) { const f32x4 b0 = *(const f32x4*)(bp + bj * HALF), b1 = *(const f32x4*)(bp + bj * HALF + 4), g0 = *(const f32x4*)(gp + bj * HALF), g1 = *(const f32x4*)(gp + bj * HALF + 4);
#pragma unroll
            for (int ai = 0; ai < 2; ++ai)
#pragma unroll
                for (int m = 0; m < 4; ++m) { const size_t off = (size_t)(row0 + ai * HALF + m * 16) * 1024 + col0 + bj * HALF;
                    f32x4 x0, x1;
                    if (srcf) { x0 = *(const f32x4*)(srcf + off); x1 = *(const f32x4*)(srcf + off + 4); }
                    else { const u32x4 r = *(const u32x4*)(O + off); x0 = (f32x4){__builtin_bit_cast(float, r.x << 16), __builtin_bit_cast(float, r.x & 0xffff0000u), __builtin_bit_cast(float, r.y << 16), __builtin_bit_cast(float, r.y & 0xffff0000u)};
                        x1 = (f32x4){__builtin_bit_cast(float, r.z << 16), __builtin_bit_cast(float, r.z & 0xffff0000u), __builtin_bit_cast(float, r.w << 16), __builtin_bit_cast(float, r.w & 0xffff0000u)}; }
                    const f32x4 v0 = x0 + g0 * (acc[ai][bj][m][0] + b0), v1 = x1 + g1 * (acc[ai][bj][m][1] + b1);
                    u32x4 w; w.x = cvt_pk_bf16(v0[0], v0[1]); w.y = cvt_pk_bf16(v0[2], v0[3]); w.z = cvt_pk_bf16(v1[0], v1[1]); w.w = cvt_pk_bf16(v1[2], v1[3]);
                    *(u32x4*)(O + off) = w; } }
    }
    __device__ __forceinline__ const float* bias_src(const Unit& u, int wc, int lane) const {
        if (mode == EPI_SWIGLU) return p0 + (size_t)((u.pb >> 3) & 31) * 2048 + (lane >> 5) * 1024 + u.pn * HALF + wc * 32 + (lane & 31);
        return p0 + (size_t)((u.pb >> 2) & 31) * 1024 + u.pn * BM + (lane >> 5) * HALF + wc * 32 + (lane & 31);
    }
    __device__ __forceinline__ void epi_swiglu(const f32x4 (&acc)[2][2][4][2], const Unit& u, int wr, int wc, int fr, int fq) const {
        const int e = (u.pb >> 3) & 31;
        const int row0 = u.pm * BM + wr * 64 + fr, col0 = u.pn * HALF + wc * 32 + 8 * fq;
        (void)e;
#pragma unroll
        for (int ai = 0; ai < 2; ++ai)
#pragma unroll
            for (int m = 0; m < 4; ++m) {
                f32x4 a[2];
#pragma unroll
                for (int n = 0; n < 2; ++n) {
                    f32x4 g = acc[ai][0][m][n], up = acc[ai][1][m][n];
#pragma unroll
                    for (int t = 0; t < 4; ++t) { const float gg = fminf(g[t], 7.0f), uu = fminf(fmaxf(up[t], -7.0f), 7.0f);
                        const float sg = __builtin_amdgcn_rcpf(1.0f + __builtin_amdgcn_exp2f(-2.4554669595930157f * gg)); a[n][t] = gg * sg * (uu + 1.0f); }
                }
                u32x4 w; w.x = cvt_pk_bf16(a[0][0], a[0][1]); w.y = cvt_pk_bf16(a[0][2], a[0][3]); w.z = cvt_pk_bf16(a[1][0], a[1][1]); w.w = cvt_pk_bf16(a[1][2], a[1][3]);
                *(u32x4*)(O + (size_t)(row0 + ai * HALF + m * 16) * 1024 + col0) = w;
            }
    }
    __device__ __forceinline__ void epi_down(const f32x4 (&acc)[2][2][4][2], const Unit& u, int wr, int wc, int fr, int fq) const {
        const int e = (u.pb >> 2) & 31;
        const int row0 = u.pm * BM + wr * 64 + fr, col0 = u.pn * BM + wc * 32 + 8 * fq;
        (void)e;
#pragma unroll
        for (int bj = 0; bj < 2; ++bj) {
#pragma unroll
            for (int ai = 0; ai < 2; ++ai)
#pragma unroll
                for (int m = 0; m < 4; ++m) { const f32x4 v0 = acc[ai][bj][m][0], v1 = acc[ai][bj][m][1];
                    u32x4 w; w.x = cvt_pk_bf16(v0[0], v0[1]); w.y = cvt_pk_bf16(v0[2], v0[3]); w.z = cvt_pk_bf16(v1[0], v1[1]); w.w = cvt_pk_bf16(v1[2], v1[3]);
                    *(u32x4*)(O + (size_t)(row0 + ai * HALF + m * 16) * 1024 + col0 + bj * HALF) = w; } }
    }
    __device__ __forceinline__ void operator()(const f32x4 (&acc)[2][2][4][2], const Unit& u, int wr, int wc, int fr, int fq) const {
        if (mode == EPI_QK) epi_qk(acc, u, wr, wc, fr, fq);
        else if (mode == EPI_T) epi_t(acc, u, wr, wc, fr, fq);
        else if (mode == EPI_RES) epi_res(acc, u, wr, wc, fr, fq);
        else if (mode == EPI_SWIGLU) epi_swiglu(acc, u, wr, wc, fr, fq);
        else epi_down(acc, u, wr, wc, fr, fq);
    }
};
struct AnyOrder {
    int moe; StaticOrder so;
    const PG8_LAS int* rb2e; int nblk, lg, wbase;
    __device__ __forceinline__ bool next(int i, Unit& u) const {
        if (!moe) return so.next(i, u);
        const int x = so.c & 7, j = so.c >> 3, per = (so.G >> 3) >> lg;
        const int rb = (i * 8 + x) * per + (j >> lg); if (rb >= nblk) return false;
        const int e = rb2e[rb];
        u.pm = rb; u.pn = j & ((1 << lg) - 1); u.pb = ((wbase + e) << lg) + u.pn; return true;
    }
    __device__ __forceinline__ void a_ready(const Unit&) const {}
    __device__ __forceinline__ void done(const Unit&) const {}
};
}
struct Frame {
    LAS unsigned char* lds;
    volatile LAS unsigned* MISC;
    gu32* ctl;
    int tid, lane, wave;
    int vcu, G, bx;
    const float* const KAS* in;
    float* out; unsigned char* ws;
};
__device__ __forceinline__ float wave_sum(float v) {
#pragma unroll
    for (int o = 1; o < 64; o <<= 1) v += __shfl_xor(v, o);
    return v;
}
__device__ __forceinline__ void block_sum2(Frame& F, LAS float* red, float& a, float& b) {
    a = wave_sum(a); b = wave_sum(b);
    __syncthreads();
    if (F.lane == 0) { red[F.wave * 2] = a; red[F.wave * 2 + 1] = b; }
    __syncthreads();
    float sa = 0.f, sb = 0.f;
#pragma unroll
    for (int w = 0; w < NWAVES; ++w) { sa += red[2 * w]; sb += red[2 * w + 1]; }
    a = sa; b = sb;
}

template <int MODE>
__device__ __forceinline__ void tr_item(const float* W, int N, bf16* WT, bf16* WT2, LAS float* scr, int item, int lane) {
    const int nblk = N / 32, kb = item / nblk, nb = item % nblk, k0 = 64 * kb, n0 = 32 * nb;
#pragma unroll 8
    for (int i = 0; i < 32; ++i) { const int kk = 2 * i + (lane >> 5); scr[kk * 33 + (lane & 31)] = W[(size_t)(k0 + kk) * N + n0 + (lane & 31)]; }
    LDS_WAIT(); asm volatile("" ::: "memory");
    const int c = lane & 7;
#pragma unroll
    for (int j = 0; j < 4; ++j) { const int n = (lane >> 3) + 8 * j; const LAS float* s = scr + (8 * c) * 33 + n;
        const int ns = n0 + n; int d = ns; bf16* dst = WT;
        if (MODE == 1) { const int n2 = ns & 1023; d = 256 * (n2 >> 7) + (n2 & 127) + (ns >= 1024 ? 128 : 0); }
        if (MODE == 2) { if (ns < 1280) { const int hb = ns & ~63, dd = ns & 63, d2 = dd & 31; d = hb + 8 * (d2 >> 2) + (d2 & 3) + (dd >= 32 ? 4 : 0); } }
        v4u o; o.x = pk2(s[0 * 33], s[1 * 33]); o.y = pk2(s[2 * 33], s[3 * 33]); o.z = pk2(s[4 * 33], s[5 * 33]); o.w = pk2(s[6 * 33], s[7 * 33]);
        *(GAS v4u*)(dst + (size_t)d * 1024 + k0 + 8 * c) = o; }
    LDS_WAIT(); asm volatile("" ::: "memory");
}
__device__ __forceinline__ float silu_f(float v) { return v / (1.0f + expf(-v)); }
__device__ __forceinline__ void p0_prologue(Frame& F) {
    const int tid = F.tid, lane = F.lane;
    if (F.bx < 192) {
        LAS float* sv = (LAS float*)F.lds;
        LAS float* part = sv + 1024 * 12;
        for (int i = tid; i < 1024 * 9; i += NWAVES * 64) { const int r = i >> 10, k = i & 1023; const float v = (r < 8) ? F.in[I_C][r * 1024 + k] : F.in[I_CCTX][k]; sv[k * 12 + r] = silu_f(v); }
        __syncthreads();
        const int l = F.bx / 48, n0 = (F.bx % 48) * 128, kb = 128 * F.wave;
        const float* wp = F.in[I_ADAW] + ((size_t)l * 1024 + kb) * 6144 + n0 + 2 * lane;
        float acc0[9], acc1[9];
#pragma unroll
        for (int r = 0; r < 9; ++r) { acc0[r] = 0.f; acc1[r] = 0.f; }
#pragma unroll 1
        for (int k0 = 0; k0 < 128; k0 += 16) { float wx[16], wy[16];
#pragma unroll
            for (int u = 0; u < 16; ++u) { const GAS float* q = (const GAS float*)(wp + (size_t)(k0 + u) * 6144); wx[u] = q[0]; wy[u] = q[1]; }
#pragma unroll
            for (int u = 0; u < 16; ++u) { const LAS float* sk = sv + (kb + k0 + u) * 12;
                const f32x4 s0 = *(const LAS f32x4*)sk, s1 = *(const LAS f32x4*)(sk + 4); const float s8 = sk[8];
#pragma unroll
                for (int r = 0; r < 4; ++r) { acc0[r] += s0[r] * wx[u]; acc1[r] += s0[r] * wy[u]; acc0[4 + r] += s1[r] * wx[u]; acc1[4 + r] += s1[r] * wy[u]; }
                acc0[8] += s8 * wx[u]; acc1[8] += s8 * wy[u]; } }
#pragma unroll
        for (int r = 0; r < 9; ++r) { part[(F.wave * 9 + r) * 128 + 2 * lane] = acc0[r]; part[(F.wave * 9 + r) * 128 + 2 * lane + 1] = acc1[r]; }
        __syncthreads();
        for (int i = tid; i < 9 * 128; i += NWAVES * 64) { const int r = i >> 7, cix = i & 127; float t = F.in[I_ADAB][l * 6144 + n0 + cix];
#pragma unroll
            for (int w = 0; w < NWAVES; ++w) t += part[(w * 9 + r) * 128 + cix];
            ((float*)(F.ws + WS_MOD))[((size_t)l * 9 + r) * 6144 + n0 + cix] = t; }
        __syncthreads();
    }
    const int gw = F.vcu * NWAVES + F.wave, NGW = F.G * NWAVES;
    for (int task = gw; task < 2 * (8192 + 256); task += NGW) {
        const int j = task / 8448, tt = task % 8448; const bool lat = tt < 8192; const int t = lat ? tt : tt - 8192, L = lat ? 8192 : 256;
        float* dst = lat ? (float*)(F.ws + WS_A3L) + ((size_t)j * 8192 + t) * 64 : (float*)(F.ws + WS_A3C) + ((size_t)j * 256 + t) * 64;
        const float tl = (float)t / (float)(L - 1), w = 6.283185307179586f * (float)t / (float)L;
        float z = 0.f;
        if (lane == 0) z = tl;
        else if (lane <= 32) { const int mI = (lane - 1) & 15; const float band = 1e-4f + (float)mI * ((15.0f - 1e-4f) / 15.0f); z = (lane <= 16) ? __cosf(band * w) : -__sinf(band * w); }
        const float fr = F.in[I_FFREQ][j * 64 + lane];
        const float* w1 = F.in[I_FW1] + (size_t)j * 33 * 64; const float* w2 = F.in[I_FW2] + (size_t)j * 64 * 64; const float* w3 = F.in[I_FW3] + (size_t)j * 64 * 64;
        float a = F.in[I_FB1][j * 64 + lane];
        for (int i = 0; i < 33; ++i) a += __shfl(z, i) * w1[i * 64 + lane];
        a = __sinf(fr * a);
        float a2 = F.in[I_FB2][j * 64 + lane];
        for (int k = 0; k < 64; ++k) a2 += __shfl(a, k) * w2[k * 64 + lane];
        a2 = __sinf(fr * a2);
        float a3 = F.in[I_FB3][j * 64 + lane];
        for (int k = 0; k < 64; ++k) a3 += __shfl(a2, k) * w3[k * 64 + lane];
        if (lat) ((bf16*)(F.ws + WS_A3L))[(size_t)j * 8192 * 64 + ((((size_t)(t >> 5) * 4 + (lane >> 4)) * 64 + (t & 31) + 32 * ((lane >> 3) & 1)) << 3) + (lane & 7)] = (bf16)f2bf(__sinf(fr * a3));
        else dst[lane] = __sinf(fr * a3);
    }
    LAS float* scr = (LAS float*)(F.lds + RING_OFF + F.wave * 16384);
    constexpr int NI_GU = 128 * 1024, NI_DN = 128 * 512, NI_QKV = 2 * 768, NI_AO = 2 * 512, NI_HIN = 2 * 1536, NI_HO = 2 * 512;
    constexpr int NITEMS = NI_GU + NI_DN + NI_QKV + NI_AO + NI_HIN + NI_HO;
    for (int it = gw; it < NITEMS; it += NGW) {
        int r = it;
        if (r < NI_GU) { const int mat = r >> 10; tr_item<1>(F.in[I_WGU] + (size_t)mat * 1024 * 2048, 2048, (bf16*)(F.ws + WS_WGU) + (size_t)mat * 2048 * 1024, nullptr, scr, r & 1023, lane); continue; } r -= NI_GU;
        if (r < NI_DN) { const int mat = r >> 9; tr_item<0>(F.in[I_WDN] + (size_t)mat * 1024 * 1024, 1024, (bf16*)(F.ws + WS_WDN) + (size_t)mat * 1024 * 1024, nullptr, scr, r & 511, lane); continue; } r -= NI_DN;
        if (r < NI_QKV) { const int mat = r / 768; tr_item<2>(F.in[I_AWQKV] + (size_t)mat * 1024 * 1536, 1536, (bf16*)(F.ws + WS_WQK) + (size_t)mat * 1536 * 1024, nullptr, scr, r % 768, lane); continue; } r -= NI_QKV;
        if (r < NI_AO) { const int mat = r >> 9; tr_item<0>(F.in[I_AWO] + (size_t)mat * 1024 * 1024, 1024, (bf16*)(F.ws + WS_WAO) + (size_t)mat * 1024 * 1024, nullptr, scr, r & 511, lane); continue; } r -= NI_AO;
        if (r < NI_HIN) { const int mat = r / 1536; tr_item<0>(F.in[I_HWIN] + (size_t)mat * 1024 * 3072, 3072, (bf16*)(F.ws + WS_WHIN) + (size_t)mat * 3072 * 1024, nullptr, scr, r % 1536, lane); continue; } r -= NI_HIN;
        { const int mat = r >> 9; tr_item<0>(F.in[I_HWO] + (size_t)mat * 1024 * 1024, 1024, (bf16*)(F.ws + WS_WHO) + (size_t)mat * 1024 * 1024, nullptr, scr, r & 511, lane); }
    }
}

__device__ __forceinline__ void row8_unpack(const v4u w, f32x4& a, f32x4& b) { a = (f32x4){bflo(w.x), bfhi(w.x), bflo(w.y), bfhi(w.y)}; b = (f32x4){bflo(w.z), bfhi(w.z), bflo(w.w), bfhi(w.w)}; }
__device__ __forceinline__ v4u row8_pack(const f32x4 a, const f32x4 b) { v4u w; w.x = pk2(a.x, a.y); w.y = pk2(a.z, a.w); w.z = pk2(b.x, b.y); w.w = pk2(b.z, b.w); return w; }
#define ROW8_F32(ptr, jj, hf, lane) (((const f32x4*)(ptr))[128 * (jj) + 2 * (lane) + (hf)])
__device__ __forceinline__ void norm_mod_store(Frame& F, const f32x4 (&v)[4], const float* gain, const float* shift, const float* scale, bf16* orow) {
    float s2 = 0.f;
#pragma unroll
    for (int j = 0; j < 4; ++j) s2 += (v[j].x * v[j].x + v[j].y * v[j].y) + (v[j].z * v[j].z + v[j].w * v[j].w);
    const float rstd = 1.0f / sqrtf(wave_sum(s2) * (1.0f / D) + NORM_EPS);
#pragma unroll
    for (int jj = 0; jj < 2; ++jj) { f32x4 h[2];
#pragma unroll
        for (int hf = 0; hf < 2; ++hf) h[hf] = v[2 * jj + hf] * rstd * ROW8_F32(gain, jj, hf, F.lane) * (ROW8_F32(scale, jj, hf, F.lane) + 1.0f) + ROW8_F32(shift, jj, hf, F.lane);
        ((GAS v4u*)orow)[64 * jj + F.lane] = row8_pack(h[0], h[1]); }
}
__device__ __forceinline__ int mod_row(int row) { return row < TL ? (row >> 13) : 8; }
__device__ __forceinline__ int rows_of_layer(int l) { return l >= 2 ? TL : TT; }
__device__ __forceinline__ void norm0_phase(Frame& F) {
    const int gw = F.vcu * NWAVES + F.wave, NGW = F.G * NWAVES;
    const float* mod = (const float*)(F.ws + WS_MOD);
    for (int row = gw; row < TT; row += NGW) {
        const float* xr = row < TL ? F.in[I_X] + (size_t)row * D : F.in[I_CTX] + (size_t)(row - TL) * D;
        f32x4 v[4];
#pragma unroll
        for (int j = 0; j < 4; ++j) v[j] = ((const GAS f32x4*)xr)[128 * (j >> 1) + 2 * F.lane + (j & 1)];
        const float* mr = mod + (size_t)mod_row(row) * 6144;
        norm_mod_store(F, v, F.in[I_NMIX], mr, mr + 1024, (bf16*)(F.ws + WS_H) + (size_t)row * D);
    }
}

__device__ __forceinline__ void attn_phase(Frame& F, int j, int nunits) {
    const bf16* QK = (const bf16*)(F.ws + WS_QK); bf16* O = (bf16*)(F.ws + WS_O);
    const float* sinks = F.in[I_ASINK] + j * 16;
    LAS bf16* Ks0 = (LAS bf16*)(F.lds);
    const int w = F.wave, lane = F.lane, r = lane & 31, h = lane >> 5, tid = F.tid;
    float snk[4];
#pragma unroll
    for (int i = 0; i < 4; ++i) snk[i] = sinks[4 * i + (w >> 1)];
    for (int u = F.vcu; u < nunits; u += F.G) {
        int b, kvh, q0; const bool isctx = u >= 4096;
        if (!isctx) { b = u >> 9; kvh = (u >> 7) & 3; q0 = (u & 127) * 64; } else { const int u2 = u - 4096; b = u2 >> 4; kvh = (u2 >> 2) & 3; q0 = (u2 & 3) * 64; }
        const int head = kvh * 4 + (w >> 1), qrow = q0 + 32 * (w & 1) + r;
        const size_t tokq = isctx ? (size_t)TL + b * CTXL + qrow : (size_t)b * SEQ + qrow;
        const bf16* qp = QK + tokq * QKD + head * 64 + 8 * h;
        v4u bqv[4];
#pragma unroll
        for (int s = 0; s < 4; ++s) asm volatile("global_load_dwordx4 %0, %1, off" : "=&v"(bqv[s]) : "v"((const GAS v4u*)(qp + 16 * s)) : "memory");
        float m = (kvh == 0 ? snk[0] : kvh == 1 ? snk[1] : kvh == 2 ? snk[2] : snk[3]) * 1.4426950408889634f, l = 1.0f;
        f32x16 o0, o1;
#pragma unroll
        for (int i = 0; i < 16; ++i) { o0[i] = 0.f; o1[i] = 0.f; }
        const int jl0 = isctx ? 0 : (q0 >= 128 ? 0 : (128 - q0) >> 6), jl1 = isctx ? 0 : (q0 + 192 <= SEQ ? 5 : (SEQ + 128 - q0) >> 6), nl = jl1 - jl0, ntile = nl + 4;
        const int srow = tid >> 3, sch = tid & 7;
#define ATT_KEY0(i) ((i) < nl ? (size_t)b * SEQ + (q0 - 128 + 64 * (jl0 + (i))) : (size_t)TL + b * CTXL + 64 * ((i) - nl))
#define ATT_LOAD(kv, vv, i) do { const size_t kt_ = ATT_KEY0(i); const GAS v4u* pk_ = (const GAS v4u*)(QK + (kt_ + srow) * QKD + 1024 + kvh * 64 + sch * 8); const GAS v4u* pv_ = (const GAS v4u*)(QK + (kt_ + lane) * QKD + 1280 + kvh * 64 + w * 8); \
            asm volatile("global_load_dwordx4 %0, %2, off\n\tglobal_load_dwordx4 %1, %3, off" : "=&v"(kv), "=&v"(vv) : "v"(pk_), "v"(pv_) : "memory"); } while (0)
#define ATT_WAIT2() asm volatile("s_waitcnt vmcnt(2)" ::: "memory")
#define ATT_WRITE(kv, vv, bufi) do { LAS bf16* ks_ = Ks0 + (bufi) * 9216; LAS bf16* vs_ = ks_ + 4608; *(LAS v4u*)(ks_ + srow * 72 + sch * 8) = kv;     \
            LAS bf16* vd = vs_ + (w * 8) * 72 + lane; \
            vd[0] = (bf16)(vv.x & 0xffffu); vd[72] = (bf16)(vv.x >> 16); vd[144] = (bf16)(vv.y & 0xffffu); vd[216] = (bf16)(vv.y >> 16); \
            vd[288] = (bf16)(vv.z & 0xffffu); vd[360] = (bf16)(vv.z >> 16); vd[432] = (bf16)(vv.w & 0xffffu); vd[504] = (bf16)(vv.w >> 16); } while (0)
        v4u kvA, vvA, kvB, vvB;
        ATT_LOAD(kvA, vvA, 0);
        ATT_LOAD(kvB, vvB, 1);
        ATT_WAIT2();
        asm volatile("" : "+v"(bqv[0]), "+v"(bqv[1]), "+v"(bqv[2]), "+v"(bqv[3]));
        ATT_WRITE(kvA, vvA, 0);
        ATT_LOAD(kvA, vvA, 2);
        __syncthreads();
        auto tile_step = [&](const int it, v4u& kvN, v4u& vvN) __attribute__((always_inline)) {
            const int cur = it & 1;
            const bool local = it < nl; const int kp0 = q0 - 128 + 64 * (jl0 + it);
            const LAS bf16* Ks = Ks0 + cur * 9216; const LAS bf16* Vs = Ks + 4608;
            if (it + 1 < ntile) { ATT_WAIT2(); ATT_WRITE(kvN, vvN, cur ^ 1); }
            { const int i3 = it + 3 < ntile ? it + 3 : ntile - 1; ATT_LOAD(kvN, vvN, i3); }
            f32x16 st0, st1;
#pragma unroll
            for (int i = 0; i < 16; ++i) { st0[i] = 0.f; st1[i] = 0.f; }
#pragma unroll
            for (int s = 0; s < 4; ++s) {
                const bf16x8 a0 = *(const LAS bf16x8*)(Ks + r * 72 + 16 * s + 8 * h), a1 = *(const LAS bf16x8*)(Ks + (32 + r) * 72 + 16 * s + 8 * h);
                st0 = __builtin_amdgcn_mfma_f32_32x32x16_bf16(a0, __builtin_bit_cast(bf16x8, bqv[s]), st0, 0, 0, 0);
                st1 = __builtin_amdgcn_mfma_f32_32x32x16_bf16(a1, __builtin_bit_cast(bf16x8, bqv[s]), st1, 0, 0, 0);
            }
            const bool edge = local && (jl0 + it == 0 || jl0 + it == 4);
            if (edge) {
                const int dq = qrow - kp0 - 4 * h;
#pragma unroll
                for (int i = 0; i < 16; ++i) { const int d0 = dq - ((i & 3) + 8 * (i >> 2)), d1 = d0 - 32;
                    st0[i] = ((unsigned)(d0 + 128) > 256u) ? -1e30f : st0[i]; st1[i] = ((unsigned)(d1 + 128) > 256u) ? -1e30f : st1[i]; }
            }
            float mx = fmaxf(st0[0], st1[0]);
#pragma unroll
            for (int i = 1; i < 16; ++i) mx = __builtin_fmaxf(__builtin_fmaxf(mx, st0[i]), st1[i]);
            mx = fmaxf(mx, __shfl_xor(mx, 32));
            const float mn = fmaxf(m, mx), alpha = __builtin_amdgcn_exp2f(m - mn); m = mn;
#pragma unroll
            for (int i = 0; i < 16; ++i) { st0[i] = __builtin_amdgcn_exp2f(st0[i] - mn); st1[i] = __builtin_amdgcn_exp2f(st1[i] - mn); }
            f32x16 lsum;
#pragma unroll
            for (int i = 0; i < 16; ++i) lsum[i] = 0.f;
            if (!__all(alpha == 1.0f)) {
#pragma unroll
                for (int i = 0; i < 16; ++i) { o0[i] *= alpha; o1[i] *= alpha; } }
#pragma unroll
            for (int sp = 0; sp < 4; ++sp) {
                unsigned pw[4];
#pragma unroll
                for (int e = 0; e < 4; ++e) { const int i0 = 8 * (sp & 1) + 2 * e; pw[e] = (sp < 2) ? pg8::cvt_pk_bf16(st0[i0], st0[i0 + 1]) : pg8::cvt_pk_bf16(st1[i0], st1[i0 + 1]); }
                const bf16x8 pf = __builtin_bit_cast(bf16x8, (v4u){pw[0], pw[1], pw[2], pw[3]});
                lsum = __builtin_amdgcn_mfma_f32_32x32x16_bf16(__builtin_bit_cast(bf16x8, (v4u){0x3f803f80u, 0x3f803f80u, 0x3f803f80u, 0x3f803f80u}), pf, lsum, 0, 0, 0);
#pragma unroll
                for (int dt = 0; dt < 2; ++dt) {
                    const LAS bf16* vp = Vs + (32 * dt + r) * 72 + 16 * sp + 4 * h;
                    const v2u va = *(const LAS v2u*)vp, vb = *(const LAS v2u*)(vp + 8);
                    const bf16x8 vf = __builtin_bit_cast(bf16x8, (v4u){va.x, va.y, vb.x, vb.y});
                    if (dt == 0) o0 = __builtin_amdgcn_mfma_f32_32x32x16_bf16(vf, pf, o0, 0, 0, 0); else o1 = __builtin_amdgcn_mfma_f32_32x32x16_bf16(vf, pf, o1, 0, 0, 0);
                }
            }
            l = l * alpha + lsum[0];
            __syncthreads();
        };
#pragma unroll 1
        for (int it = 0;; it += 2) {
            tile_step(it, kvB, vvB);
            if (it + 1 >= ntile) break;
            tile_step(it + 1, kvA, vvA);
            if (it + 2 >= ntile) break;
        }
#undef ATT_KEY0
#undef ATT_WAIT2
#undef ATT_LOAD
#undef ATT_WRITE
        const float inv = 1.0f / l;
        bf16* op = O + tokq * D + head * 64 + 4 * h;
#pragma unroll
        for (int g = 0; g < 4; ++g) {
            v2u w0, w1; w0.x = pg8::cvt_pk_bf16(o0[4 * g] * inv, o0[4 * g + 1] * inv); w0.y = pg8::cvt_pk_bf16(o0[4 * g + 2] * inv, o0[4 * g + 3] * inv);
            w1.x = pg8::cvt_pk_bf16(o1[4 * g] * inv, o1[4 * g + 1] * inv); w1.y = pg8::cvt_pk_bf16(o1[4 * g + 2] * inv, o1[4 * g + 3] * inv);
            *(GAS v2u*)(op + 8 * g) = w0; *(GAS v2u*)(op + 32 + 8 * g) = w1;
        }
    }
}
__device__ __forceinline__ float sconv3(const bf16* p, int n, int L, float w0, float w1, float w2, float cb) {
    const float a = (n > 0) ? bf2f(p[n - 1]) : 0.f, b = bf2f(p[n]), c = (n < L - 1) ? bf2f(p[n + 1]) : 0.f;
    return cb + w0 * a + w1 * b + w2 * c;
}
struct HyRaw { v4u raw[4]; unsigned short lf[4], rt[4]; };
__device__ __forceinline__ void hy_stage_load(const bf16* p, HyRaw& R, int tid) {
#pragma unroll
    for (int ch = 0; ch < 2; ++ch)
#pragma unroll
        for (int b = 0; b < 2; ++b) {
            const int n0 = 8 * tid + 4096 * ch; const bf16* pb = p + (size_t)b * SEQ;
            R.raw[2 * ch + b] = *(const GAS v4u*)(pb + n0);
            R.lf[2 * ch + b] = n0 > 0 ? pb[n0 - 1] : (unsigned short)0; R.rt[2 * ch + b] = n0 + 8 < SEQ ? pb[n0 + 8] : (unsigned short)0;
        }
}
__device__ __forceinline__ void hy_stage_write(const HyRaw& R, float w0, float w1, float w2, float cb, LAS float* S, int tid) {
#pragma unroll
    for (int ch = 0; ch < 2; ++ch)
#pragma unroll
        for (int b = 0; b < 2; ++b) {
            const int n0 = 8 * tid + 4096 * ch; const v4u raw = R.raw[2 * ch + b];
            float x[10]; x[0] = bf2f(R.lf[2 * ch + b]); x[1] = bflo(raw.x); x[2] = bfhi(raw.x); x[3] = bflo(raw.y); x[4] = bfhi(raw.y); x[5] = bflo(raw.z); x[6] = bfhi(raw.z); x[7] = bflo(raw.w); x[8] = bfhi(raw.w); x[9] = bf2f(R.rt[2 * ch + b]);
            f32x4 lo, hi;
#pragma unroll
            for (int e = 0; e < 4; ++e) { lo[e] = cb + w0 * x[e] + w1 * x[e + 1] + w2 * x[e + 2]; hi[e] = cb + w0 * x[e + 4] + w1 * x[e + 5] + w2 * x[e + 6]; }
            *(LAS f32x4*)(S + b * 8192 + n0) = lo; *(LAS f32x4*)(S + b * 8192 + n0 + 4) = hi;
        }
}
__device__ __forceinline__ void hyena_phase(Frame& F, int j, bool with_ctx) {
    LAS cf2* X = (LAS cf2*)F.lds;
    LAS float* red = (LAS float*)(F.lds + USER_OFF + 1024);
    const int tid0 = F.tid;
    const bf16* Ut = (const bf16*)(F.ws + WS_UT); bf16* Zt = (bf16*)(F.ws + WS_ZT);
    const bf16* a3b = (const bf16*)(F.ws + WS_A3L) + (size_t)j * 8192 * 64; const float* a3c = (const float*)(F.ws + WS_A3C) + (size_t)j * 256 * 64;
    const float* wout = F.in[I_FWOUT] + (size_t)j * 64 * 4096; const float* convw = F.in[I_HCW] + (size_t)j * 3 * 3072; const float* convb = F.in[I_HCB] + (size_t)j * 3072;
    const float* biasd = F.in[I_HBD] + (size_t)j * 2 * 1024;
    LAS float* U4 = (LAS float*)(F.lds + USER_OFF + 2048);
    LAS float* nrm = (LAS float*)(F.lds + USER_OFF + 1536);
    LAS float* red8 = (LAS float*)(F.lds + USER_OFF + 1280);
#ifndef PROBE_HY_TAPS
#define PROBE_HY_TAPS 1
#endif
#pragma unroll 1
    for (int cc0 = 0; cc0 < 4; ++cc0) { const int c = F.vcu + 256 * cc0;
        if (cc0 == 0)
    {
        int tid = tid0; asm volatile("" : "+v"(tid));
        __syncthreads();
        for (int i = tid; i < 1024; i += NWAVES * 64) { const int cc = i >> 8, k = (i >> 2) & 63, q = i & 3; U4[i] = wout[(size_t)k * 4096 + q * 1024 + F.vcu + 256 * cc]; }
        __syncthreads();
        const int n = tid & 31, h = (tid >> 5) & 1, wv = tid >> 6, q = n & 3, cc = (n >> 2) & 3, sb = n >> 4, c = F.vcu + 256 * cc;
        bf16x8 bw[4];
#pragma unroll
        for (int f4 = 0; f4 < 4; ++f4) { unsigned pw[4];
#pragma unroll
            for (int e = 0; e < 4; ++e) { const int k0 = 16 * f4 + 8 * h + 2 * e; pw[e] = pk2(U4[cc * 256 + 4 * k0 + q], U4[cc * 256 + 4 * (k0 + 1) + q]); }
            bw[f4] = __builtin_bit_cast(bf16x8, (v4u){pw[0], pw[1], pw[2], pw[3]}); }
        const bf16x8 zero8 = __builtin_bit_cast(bf16x8, (v4u){0u, 0u, 0u, 0u});
        const float na = -(SCONST_F32(0x40447cbd) + (15.350567286626973f - 3.0701134573253945f) * (float)c * (1.0f / 1023.0f)) * (1.0f / 8191.0f);
        const float r1 = expf(na), r2 = expf(2.0f * na), r3 = expf(3.0f * na);
        float sm = 0.f;
        float* tq = (float*)(F.ws + WS_TP) + (size_t)c * 2 * FFT_N + (size_t)(q & 1) * FFT_N + (q >> 1) * 8192;
#pragma unroll 1
        for (int i = 0; i < 16; ++i) {
            const int T0 = 64 * (wv + 8 * i);
            const bf16* ap = a3b + (size_t)T0 * 64 + 8 * (tid & 63);
            f32x16 acc;
#pragma unroll
            for (int e = 0; e < 16; ++e) acc[e] = 0.f;
#pragma unroll
            for (int s8 = 0; s8 < 2; ++s8)
#pragma unroll
                for (int f4 = 0; f4 < 4; ++f4)
                    acc = __builtin_amdgcn_mfma_f32_32x32x16_bf16(*(const GAS bf16x8*)(ap + (s8 * 4 + f4) * 512), sb == s8 ? bw[f4] : zero8, acc, 0, 0, 0);
#pragma unroll
            for (int g = 0; g < 4; ++g) { const int t = T0 + 32 * sb + 8 * g + 4 * h; const float d0 = expf(na * (float)t);
                f32x4 val = (f32x4){acc[4 * g] * d0, acc[4 * g + 1] * (d0 * r1), acc[4 * g + 2] * (d0 * r2), acc[4 * g + 3] * (d0 * r3)};
                sm += ((q >= 2 && t == 0) ? 0.f : fabsf(val.x)) + fabsf(val.y) + fabsf(val.z) + fabsf(val.w);
                *(GAS f32x4*)(tq + t) = val; }
        }
        sm += __shfl_xor(sm, 2); sm += __shfl_xor(sm, 16); sm += __shfl_xor(sm, 32);
        if ((tid & 50) == 0) red8[wv * 8 + 2 * cc + (q & 1)] = sm;
        __syncthreads();
        if (tid < 8) { float t8 = 0.f;
#pragma unroll
            for (int w = 0; w < NWAVES; ++w) t8 += red8[w * 8 + tid]; nrm[tid] = t8; }
        VM_WAIT();
        __syncthreads();
    }
        int tid = tid0; asm volatile("" : "+v"(tid));
        float* tp = (float*)(F.ws + WS_TP) + (size_t)c * 2 * FFT_N;
        float* Gc = (float*)(F.ws + WS_G) + (size_t)c * 2 * FFT_N * 2;
        __syncthreads();
        const float sum0 = nrm[2 * cc0], sum1 = nrm[2 * cc0 + 1];
        LAS float* U = U4 + cc0 * 256;
        const float absd = SCONST_F32(0x40447cbd) + (15.350567286626973f - 3.0701134573253945f) * (float)c * (1.0f / 1023.0f);
#pragma unroll 1
#ifndef PROBE_HY_SPEC
#define PROBE_HY_SPEC 2
#endif
        for (int o4 = 0; o4 < PROBE_HY_SPEC; ++o4) { const int o = o4 & 1;
            fft_fwd_first_taps(X, (const GAS float*)(tp + (size_t)o * FFT_N), 1.0f / (o == 0 ? sum0 : sum1), tid); __syncthreads();
            fft_fwd_double<1>(X, tid); __syncthreads();
            fft_fwd_double<3>(X, tid); __syncthreads();
            fft_mid_store(X, (GAS cf4*)(Gc + (size_t)o * FFT_N * 2), 1.0f / (float)FFT_N, biasd[o * 1024 + c], tid); __syncthreads();
        }
        VM_WAIT();
        __syncthreads();
        const KAS float* convw_k = (const KAS float*)convw; const KAS float* convb_k = (const KAS float*)convb; const KAS float* biasd_k = (const KAS float*)biasd;
        const float cwv0 = convw_k[2048 + c], cwv1 = convw_k[3072 + 2048 + c], cwv2 = convw_k[6144 + 2048 + c], cbv = convb_k[2048 + c];
        const float cwa0 = convw_k[c], cwa1 = convw_k[3072 + c], cwa2 = convw_k[6144 + c], cba = convb_k[c];
        const float cwb0 = convw_k[1024 + c], cwb1 = convw_k[3072 + 1024 + c], cwb2 = convw_k[6144 + 1024 + c], cbb = convb_k[1024 + c];
        const float d0 = biasd_k[c], d1 = biasd_k[1024 + c];
#ifndef PROBE_HY_PAIRS
#define PROBE_HY_PAIRS 4
#endif
        HyRaw rv, rg;
        hy_stage_load(Ut + (size_t)(2048 + c) * TT, rv, tid);
#pragma unroll 1
        for (int pr8 = 0; pr8 < PROBE_HY_PAIRS; ++pr8) { const int pr = pr8 & 3;
            const size_t tb0 = (size_t)(2 * pr) * SEQ;
            LAS float* S = (LAS float*)F.lds;
            float z0[16], z1[16];
            __syncthreads();
            hy_stage_write(rv, cwv0, cwv1, cwv2, cbv, S, tid); __syncthreads();
#pragma unroll
            for (int i = 0; i < 16; ++i) { z0[i] = S[tid + 512 * i]; z1[i] = S[8192 + tid + 512 * i]; }
#pragma unroll 1
            for (int o = 0; o < 2; ++o) {
                __syncthreads();
                fft_fwd_first(X, z0, z1, tid);
                hy_stage_load(Ut + (size_t)(o == 0 ? c : 1024 + c) * TT + tb0, rg, tid);
                if (o == 1) hy_stage_load(Ut + (size_t)(2048 + c) * TT + (size_t)(2 * ((pr8 + 1) & 3)) * SEQ, rv, tid);
                __syncthreads();
                fft_fwd_double<1>(X, tid); __syncthreads();
                fft_fwd_double<3>(X, tid); __syncthreads();
                fft_mid_mul(X, (const GAS cf4*)(Gc + (size_t)o * FFT_N * 2), tid); __syncthreads();
                fft_inv_double<3>(X, tid); __syncthreads();
                fft_inv_double<1>(X, tid); __syncthreads();
                fft_inv_last(X, z0, z1, tid); __syncthreads();
                hy_stage_write(rg, o == 0 ? cwa0 : cwb0, o == 0 ? cwa1 : cwb1, o == 0 ? cwa2 : cwb2, o == 0 ? cba : cbb, S, tid); __syncthreads();
#pragma unroll
                for (int i = 0; i < 16; ++i) { z0[i] *= S[tid + 512 * i]; z1[i] *= S[8192 + tid + 512 * i]; }
            }
            __syncthreads();
#pragma unroll
            for (int i = 0; i < 16; ++i) { S[tid + 512 * i] = z0[i]; S[8192 + tid + 512 * i] = z1[i]; }
            __syncthreads();
#pragma unroll
            for (int ch = 0; ch < 2; ++ch)
#pragma unroll
                for (int b = 0; b < 2; ++b) { const int n0 = 8 * tid + 4096 * ch; const f32x4 lo = *(const LAS f32x4*)(S + b * 8192 + n0), hi = *(const LAS f32x4*)(S + b * 8192 + n0 + 4);
                    v4u w; w.x = pk2(lo.x, lo.y); w.y = pk2(lo.z, lo.w); w.z = pk2(hi.x, hi.y); w.w = pk2(hi.z, hi.w);
                    *(GAS v4u*)(Zt + (size_t)c * TT + tb0 + (size_t)b * SEQ + n0) = w; }
        }
        if (!with_ctx) continue;
        asm volatile("" : "+v"(tid));
        __syncthreads();
        LAS float* tap0 = (LAS float*)F.lds; LAS float* tap1 = tap0 + 512; LAS float* vb = tap0 + 1024; LAS float* zb = tap0 + 1024 + 2048;
        {
            float f0 = 0.f, f1 = 0.f, b0 = 0.f, b1 = 0.f, s0 = 0.f, s1 = 0.f;
            if (tid < 256) { const int t = tid; const GAS f32x4* ar = (const GAS f32x4*)(a3c + (size_t)t * 64); f32x4 acc = (f32x4){0.f, 0.f, 0.f, 0.f};
#pragma unroll 4
                for (int k4 = 0; k4 < 16; ++k4) { const f32x4 a = ar[k4];
                    acc += a[0] * *(const LAS f32x4*)(U + 16 * k4) + a[1] * *(const LAS f32x4*)(U + 16 * k4 + 4) + a[2] * *(const LAS f32x4*)(U + 16 * k4 + 8) + a[3] * *(const LAS f32x4*)(U + 16 * k4 + 12); }
                const float dec = expf(-((float)t * (1.0f / 255.0f)) * absd);
                f0 = acc[0] * dec; f1 = acc[1] * dec; b0 = acc[2] * dec; b1 = acc[3] * dec;
                s0 = fabsf(f0) + (t > 0 ? fabsf(b0) : 0.f); s1 = fabsf(f1) + (t > 0 ? fabsf(b1) : 0.f); }
            block_sum2(F, red, s0, s1);
            if (tid < 256) { const float i0 = 1.0f / s0, i1 = 1.0f / s1; tap0[256 + tid] = f0 * i0; tap1[256 + tid] = f1 * i1; if (tid > 0) { tap0[256 - tid] = b0 * i0; tap1[256 - tid] = b1 * i1; } else { tap0[0] = 0.f; tap1[0] = 0.f; } }
        }
        const int cb_ = tid >> 6, n0 = (tid & 63) * 4;
        const size_t tcx = (size_t)TL + (size_t)cb_ * CTXL;
        float vloc[4], zloc[4];
        { const bf16* pv = Ut + (size_t)(2048 + c) * TT + tcx;
#pragma unroll
          for (int e = 0; e < 4; ++e) { vloc[e] = sconv3(pv, n0 + e, CTXL, cwv0, cwv1, cwv2, cbv); vb[cb_ * 256 + n0 + e] = vloc[e]; } }
        __syncthreads();
        { const bf16* pa = Ut + (size_t)c * TT + tcx; float acc[4] = {0.f, 0.f, 0.f, 0.f};
          for (int mI = 0; mI < 256; ++mI) { const float vv = vb[cb_ * 256 + mI];
#pragma unroll
              for (int e = 0; e < 4; ++e) acc[e] += tap0[256 + n0 + e - mI] * vv; }
#pragma unroll
          for (int e = 0; e < 4; ++e) { zloc[e] = sconv3(pa, n0 + e, CTXL, cwa0, cwa1, cwa2, cba) * (acc[e] + vloc[e] * d0); zb[cb_ * 256 + n0 + e] = zloc[e]; } }
        __syncthreads();
        { const bf16* pb = Ut + (size_t)(1024 + c) * TT + tcx; float acc[4] = {0.f, 0.f, 0.f, 0.f};
          for (int mI = 0; mI < 256; ++mI) { const float vv = zb[cb_ * 256 + mI];
#pragma unroll
              for (int e = 0; e < 4; ++e) acc[e] += tap1[256 + n0 + e - mI] * vv; }
#pragma unroll
          for (int e = 0; e < 4; ++e) { const float ov = sconv3(pb, n0 + e, CTXL, cwb0, cwb1, cwb2, cbb) * (acc[e] + zloc[e] * d1); Zt[(size_t)c * TT + tcx + n0 + e] = (bf16)f2bf(ov); } }
    }
}
__device__ __forceinline__ void transpose_phase(Frame& F, int ncols) {
    const bf16* Zt = (const bf16*)(F.ws + WS_ZT); bf16* Z = (bf16*)(F.ws + WS_O);
    LAS bf16* T = (LAS bf16*)(F.lds + F.wave * 16384);
    const int gw = F.vcu * NWAVES + F.wave, NGW = F.G * NWAVES, lane = F.lane;
    for (int item = gw; item < 16 * (ncols / 64); item += NGW) {
        const int ct = item & 15, tt = item >> 4;
#pragma unroll
        for (int i = 0; i < 8; ++i) { const int cr = (lane >> 3) + 8 * i, ch = lane & 7;
            const v4u v = *(const GAS v4u*)(Zt + (size_t)(ct * 64 + cr) * TT + (size_t)tt * 64 + ch * 8); *(LAS v4u*)(T + cr * 72 + ch * 8) = v; }
        LDS_WAIT(); asm volatile("" ::: "memory");
#pragma unroll
        for (int i = 0; i < 8; ++i) { const int tok = (lane >> 3) + 8 * i, cc = (lane & 7) * 8;
            unsigned short e[8];
#pragma unroll
            for (int q = 0; q < 8; ++q) e[q] = T[(cc + q) * 72 + tok];
            v4u o; o.x = e[0] | ((unsigned)e[1] << 16); o.y = e[2] | ((unsigned)e[3] << 16); o.z = e[4] | ((unsigned)e[5] << 16); o.w = e[6] | ((unsigned)e[7] << 16);
            *(GAS v4u*)(Z + (size_t)(tt * 64 + tok) * D + ct * 64 + cc) = o; }
        LDS_WAIT(); asm volatile("" ::: "memory");
    }
}

__device__ __forceinline__ void router_phase(Frame& F, int l) {
    const int nrows = rows_of_layer(l);
    constexpr int RR = 6;
    LAS bf16* Whi = (LAS bf16*)F.lds; LAS bf16* Wlo = Whi + 32 * 1024;
    LAS int* cnt = (LAS int*)(F.lds + USER_OFF); LAS int* base = cnt + 32; LAS int* rec = cnt + 64;
    const int tid = F.tid, lane = F.lane, wave = F.wave;
    const float* rw = F.in[I_RW] + (size_t)l * 1024 * 32;
    __syncthreads();
#pragma unroll 1
    for (int i0 = tid; i0 < 1024 * 32; i0 += 16 * NWAVES * 64) { float wv[16];
#pragma unroll
        for (int u = 0; u < 16; ++u) wv[u] = rw[i0 + u * NWAVES * 64];
#pragma unroll
        for (int u = 0; u < 16; ++u) { const int i = i0 + u * NWAVES * 64, k = i >> 5, e = i & 31; const float w = wv[u]; const unsigned hi = f2bf(w), lo = f2bf(w - bflo(hi));
            const int idx = e * 1024 + ((((k >> 3) ^ (e & 15)) << 3) | (k & 7)); Whi[idx] = (bf16)hi; Wlo[idx] = (bf16)lo; } }
    if (tid < 32) cnt[tid] = 0;
    __syncthreads();
    const float* mod = (const float*)(F.ws + WS_MOD) + (size_t)l * 9 * 6144;
    const float* gain = F.in[I_NFFN] + (size_t)l * D;
    const int gw = F.vcu * NWAVES + wave, NGW = F.G * NWAVES;
    bf16* H = (bf16*)(F.ws + WS_H);
#ifndef PROBE_RT_NORM
#define PROBE_RT_NORM 1
#endif
#pragma unroll 1
    for (int rep = 0; rep < PROBE_RT_NORM; ++rep)
    for (int row0 = gw; row0 < nrows; row0 += RR * NGW) {
        f32x4 v[RR][4]; float s2[RR];
#pragma unroll
        for (int r = 0; r < RR; ++r) { const int row = row0 + r * NGW < nrows ? row0 + r * NGW : row0;
            const GAS v4u* xr = (const GAS v4u*)((const bf16*)(F.ws + WS_XB) + (size_t)row * D) + lane;
#pragma unroll
            for (int jj = 0; jj < 2; ++jj) row8_unpack(xr[64 * jj], v[r][2 * jj], v[r][2 * jj + 1]); }
#pragma unroll
        for (int r = 0; r < RR; ++r) { s2[r] = 0.f;
#pragma unroll
            for (int jj = 0; jj < 4; ++jj) s2[r] += (v[r][jj].x * v[r][jj].x + v[r][jj].y * v[r][jj].y) + (v[r][jj].z * v[r][jj].z + v[r][jj].w * v[r][jj].w); }
#pragma unroll
        for (int o = 1; o < 64; o <<= 1) {
#pragma unroll
            for (int r = 0; r < RR; ++r) s2[r] += __shfl_xor(s2[r], o); }
#pragma unroll
        for (int r = 0; r < RR; ++r) { const int row = row0 + r * NGW < nrows ? row0 + r * NGW : row0;
            const float rstd = 1.0f / sqrtf(s2[r] * (1.0f / D) + NORM_EPS);
            const float* mr = mod + (size_t)mod_row(row) * 6144;
#pragma unroll
            for (int jj = 0; jj < 2; ++jj) { f32x4 hq[2];
#pragma unroll
                for (int hf = 0; hf < 2; ++hf) hq[hf] = v[r][2 * jj + hf] * rstd * ROW8_F32(gain, jj, hf, lane) * (ROW8_F32(mr + 4 * 1024, jj, hf, lane) + 1.0f) + ROW8_F32(mr + 3 * 1024, jj, hf, lane);
                ((GAS v4u*)(H + (size_t)row * D))[64 * jj + lane] = row8_pack(hq[0], hq[1]); } }
    }
    VM_WAIT();
    asm volatile("" ::: "memory");
    const int r32 = lane & 31, hh2 = lane >> 5;
    const float rb = F.in[I_RB][l * 32 + r32];
    const int nmine = (nrows - gw + NGW - 1) / NGW;
    for (int tile = 0; tile * 32 < nmine; ++tile) {
        const int irow = 32 * tile + r32; const size_t arow = (size_t)gw + (size_t)NGW * (irow < nmine ? irow : 0);
        const bf16* ap = H + arow * D + 8 * hh2;
        const LAS bf16* bh = Whi + r32 * 1024; const LAS bf16* bl = Wlo + r32 * 1024;
        f32x16 acc;
#pragma unroll
        for (int i = 0; i < 16; ++i) acc[i] = 0.f;
#pragma unroll 1
        for (int s0 = 0; s0 < 64; s0 += 32) {
            bf16x8 a[32];
#pragma unroll
            for (int u = 0; u < 32; ++u) a[u] = *(const GAS bf16x8*)(ap + 16 * (s0 + u));
            __builtin_amdgcn_sched_barrier(0);
#pragma unroll
            for (int u = 0; u < 32; ++u) {
                const int cb = ((2 * (s0 + u) + hh2) ^ (r32 & 15)) << 3;
                const bf16x8 b1 = *(const LAS bf16x8*)(bh + cb), b2 = *(const LAS bf16x8*)(bl + cb);
                acc = __builtin_amdgcn_mfma_f32_32x32x16_bf16(a[u], b1, acc, 0, 0, 0);
                acc = __builtin_amdgcn_mfma_f32_32x32x16_bf16(a[u], b2, acc, 0, 0, 0);
            }
            __builtin_amdgcn_sched_barrier(0);
        }
#pragma unroll 2
        for (int i = 0; i < 16; ++i) {
            const float mine = acc[i] + rb; int rank = 0;
#pragma unroll 8
            for (int e2 = 0; e2 < 32; ++e2) { const float sv = __shfl(mine, (lane & 32) | e2); rank += (sv > mine || (sv == mine && e2 < r32)) ? 1 : 0; }
            const int rr = (i & 3) + 8 * (i >> 2);
#pragma unroll
            for (int hsel = 0; hsel < 2; ++hsel) {
                const int it = 32 * tile + rr + 4 * hsel;
                float tv[4]; int te[4];
#pragma unroll
                for (int k = 0; k < 4; ++k) { const unsigned long long mk = __ballot(rank == k) & (hsel ? 0xffffffff00000000ull : 0x00000000ffffffffull); const int src = __ffsll((long long)mk) - 1;
                    te[k] = src & 31; tv[k] = __builtin_bit_cast(float, __builtin_amdgcn_readlane(__builtin_bit_cast(int, mine), src)); }
                if (it < nmine) {
                    const size_t row = (size_t)gw + (size_t)NGW * it;
                    const float e1 = __expf(tv[1] - tv[0]), e2 = __expf(tv[2] - tv[0]), e3 = __expf(tv[3] - tv[0]), isum = 1.0f / (1.0f + e1 + e2 + e3);
                    if (lane == 0) *(GAS f32x4*)((float*)(F.ws + WS_GATE) + row * 4) = (f32x4){isum, e1 * isum, e2 * isum, e3 * isum};
                    if (lane < 4) { const int tel = lane == 0 ? te[0] : lane == 1 ? te[1] : lane == 2 ? te[2] : te[3];
                        const int rk = __hip_atomic_fetch_add(cnt + tel, 1, __ATOMIC_RELAXED, __HIP_MEMORY_SCOPE_WORKGROUP); rec[(wave * 64 + it) * 4 + lane] = tel | (rk << 8); }
                }
            }
        }
    }
    __syncthreads();
    if (tid < 32) base[tid] = (int)__hip_atomic_fetch_add((unsigned*)(F.ctl + CW_ECNT + l * 32 + tid), (unsigned)cnt[tid], RLX_AGENT);
    __syncthreads();
    for (int it = 0; it < nmine; ++it) {
        if (lane < 4) { const int rc = rec[(wave * 64 + it) * 4 + lane], e = rc & 255; ((int*)(F.ws + WS_POS))[((size_t)gw + (size_t)NGW * it) * 4 + lane] = e | ((base[e] + (rc >> 8)) << 8); }
    }
}
__device__ __forceinline__ void load_blkstart(Frame& F, int l, LAS int* blkstart) {
    __syncthreads();
    if (F.tid < 32) {
        const unsigned c = __hip_atomic_load((unsigned*)(F.ctl + CW_ECNT + l * 32 + F.tid), RLX_AGENT); const int nb = (int)((c + 255u) >> 8); int s = nb;
#pragma unroll
        for (int o = 1; o < 32; o <<= 1) { const int t = __shfl_up(s, o); if (F.tid >= o) s += t; }
        blkstart[F.tid] = s - nb; if (F.tid == 31) blkstart[32] = s; }
    __syncthreads();
    for (int rb = F.tid; rb < MAXBLK; rb += NWAVES * 64) { int e = 0;
#pragma unroll 1
        for (int q = 1; q < 32; ++q) e += (blkstart[q] <= rb) ? 1 : 0;
        blkstart[64 + rb] = e; }
    __syncthreads();
}
__device__ __forceinline__ void index_phase(Frame& F, int l) {
    const int nrows = rows_of_layer(l);
    LAS int* blkstart = (LAS int*)(F.lds + USER_OFF + 8192);
    load_blkstart(F, l, blkstart);
    const int* POS = (const int*)(F.ws + WS_POS); int* DEST = (int*)(F.ws + WS_DEST); int* RSRC = (int*)(F.ws + WS_RSRC);
    const int gt = F.vcu * (NWAVES * 64) + F.tid, NT = F.G * NWAVES * 64;
    for (int a = gt; a < nrows * 4; a += NT) { const int pk = POS[a], e = pk & 255, rk = pk >> 8, d = blkstart[e] * 256 + rk; DEST[a] = d; RSRC[d] = a >> 2; }
    if (F.bx < 32) { const int e = F.bx; const int cnt = (int)__hip_atomic_load((unsigned*)(F.ctl + CW_ECNT + l * 32 + e), RLX_AGENT), end = (blkstart[e + 1] - blkstart[e]) * 256;
        for (int p2 = cnt + F.tid; p2 < end; p2 += NWAVES * 64) RSRC[blkstart[e] * 256 + p2] = 0; }
}
__device__ __forceinline__ void combine_phase(Frame& F, int l, bool dry = false) {
    constexpr int RR = 3;
    const int gw = F.vcu * NWAVES + F.wave, NGW = F.G * NWAVES, lane = F.lane;
    const bf16* YS = (const bf16*)(F.ws + WS_YS); const int* POS = (const int*)(F.ws + WS_DEST); const float* GT = (const float*)(F.ws + WS_GATE);
    const float* mod = (const float*)(F.ws + WS_MOD);
    const int nrows = rows_of_layer(l);
    for (int row0 = gw; row0 < nrows; row0 += RR * NGW) {
        v4i ps[RR]; f32x4 gt[RR]; f32x4 v[RR][4]; int rows[RR];
#pragma unroll
        for (int r = 0; r < RR; ++r) { rows[r] = row0 + r * NGW < nrows ? row0 + r * NGW : row0; ps[r] = *(const GAS v4i*)(POS + (size_t)rows[r] * 4); gt[r] = *(const GAS f32x4*)(GT + (size_t)rows[r] * 4); }
#pragma unroll
        for (int r = 0; r < RR; ++r) { const int row = rows[r];
            const GAS v4u* xr = (const GAS v4u*)((const bf16*)(F.ws + WS_XB) + (size_t)row * D) + lane;
            const float* g2 = mod + ((size_t)l * 9 + mod_row(row)) * 6144 + 5 * 1024;
#pragma unroll
            for (int jj = 0; jj < 2; ++jj) {
                f32x4 y0 = (f32x4){0.f, 0.f, 0.f, 0.f}, y1 = y0;
#pragma unroll
                for (int k = 0; k < 4; ++k) { f32x4 a, b; row8_unpack(*(const GAS v4u*)(YS + (size_t)ps[r][k] * D + 512 * jj + 8 * lane), a, b); y0 += gt[r][k] * a; y1 += gt[r][k] * b; }
                f32x4 xa, xb2; row8_unpack(xr[64 * jj], xa, xb2);
                v[r][2 * jj] = xa + ROW8_F32(g2, jj, 0, lane) * y0; v[r][2 * jj + 1] = xb2 + ROW8_F32(g2, jj, 1, lane) * y1;
            } }
#pragma unroll
        for (int r = 0; r < RR; ++r) { const int row = rows[r];
            if (r > 0 && row0 + r * NGW >= nrows) continue;
            bf16* xw = (bf16*)(F.ws + (dry ? WS_ACT : WS_XB)) + (size_t)row * D; bf16* hw = (bf16*)(F.ws + (dry ? WS_ACT + 270 * MiB : WS_H)) + (size_t)row * D;
            if (l < DEPTH - 1) {
#pragma unroll
                for (int jj = 0; jj < 2; ++jj) ((GAS v4u*)xw)[64 * jj + lane] = row8_pack(v[r][2 * jj], v[r][2 * jj + 1]);
                const float* mr = mod + ((size_t)(l + 1) * 9 + mod_row(row)) * 6144;
                norm_mod_store(F, v[r], F.in[I_NMIX] + (size_t)(l + 1) * D, mr, mr + 1024, hw);
            } else {
                float s2 = 0.f;
#pragma unroll
                for (int jj = 0; jj < 4; ++jj) s2 += (v[r][jj].x * v[r][jj].x + v[r][jj].y * v[r][jj].y) + (v[r][jj].z * v[r][jj].z + v[r][jj].w * v[r][jj].w);
                const float rstd = 1.0f / sqrtf(wave_sum(s2) * (1.0f / D) + NORM_EPS);
#pragma unroll
                for (int q = 0; q < 4; ++q) ((GAS f32x4*)(dry ? (float*)(F.ws + WS_ACT) + (size_t)row * D : F.out + (size_t)row * D))[128 * (q >> 1) + 2 * lane + (q & 1)] = v[r][q] * rstd * ROW8_F32(F.in[I_FNORM], q >> 1, q & 1, lane);
            }
        }
    }
}
constexpr int N_PHASES = 1 + 10 * DEPTH;
#ifndef PG8_SP2
#define PG8_SP2 true
#endif
#ifndef PG8_ALIGN_EPI
#define PG8_ALIGN_EPI true
#endif
__host__ __device__ inline bool phase_exists(int ph) { if (ph == 0) return true; const int l = (ph - 1) / 10, k = (ph - 1) % 10; return !((k == 0 && l != 0) || (k == 3 && (l & 1) == 0)); }
struct Args { const float* in[N_IN]; float* out; unsigned char* ws; int ph_lo, ph_hi, use_bar, pad; };
__global__ void __launch_bounds__(NWAVES * 64, 2) fwd_kernel(Args args) {
    extern __shared__ __attribute__((aligned(16))) unsigned char lds[];
    Frame F;
    F.lds = (LAS unsigned char*)lds;
    F.MISC = (volatile LAS unsigned*)(F.lds + MISC_OFF);
    F.tid = threadIdx.x; F.lane = F.tid & 63; F.wave = __builtin_amdgcn_readfirstlane(F.tid >> 6);
    F.G = gridDim.x; { const int bx = blockIdx.x; F.vcu = (F.G % 8 == 0) ? (bx % 8) * (F.G / 8) + bx / 8 : bx; }
    const KAS Args* ap = (const KAS Args*)__builtin_amdgcn_kernarg_segment_ptr();
    F.in = ap->in; F.out = ap->out; F.ws = ap->ws;
    F.ctl = (gu32*)(F.ws + WS_CTL);
    const int use_bar = ap->use_bar;
    for (int u = F.tid; u < (USER_OFF - LDSCTL_OFF) / 4; u += NWAVES * 64) ((LAS unsigned*)(F.lds + LDSCTL_OFF))[u] = 0u;
    __syncthreads();
    XcdBarrier bar; bar.bar = (unsigned*)(F.ctl + CW_BAR); bar.x = 0; bar.st = nullptr;
    if (use_bar) bar = xcd_barrier_post((unsigned*)(F.ctl + CW_BAR), F.MISC + 8);
    const int hi = ap->ph_hi;
    LAS int* blkstart = (LAS int*)(F.lds + USER_OFF + 8192);
#ifndef PROBE_REP_MASK
#define PROBE_REP_MASK 0
#define PROBE_REP_KIND 2
#endif
    int rep_done = 0;
#pragma unroll 1
    for (int ph = ap->ph_lo; ph < hi; ++ph) {
        if (!phase_exists(ph)) continue;
        { int t_ = threadIdx.x; asm volatile("" : "+v"(t_)); F.tid = t_; F.lane = t_ & 63; F.wave = __builtin_amdgcn_readfirstlane(t_ >> 6);
          const KAS Args* a_ = ap; asm volatile("" : "+s"(a_)); F.in = a_->in;
          unsigned char* w_ = a_->ws; asm volatile("" : "+s"(w_)); F.ws = w_; float* o_ = a_->out; asm volatile("" : "+s"(o_)); F.out = o_;
          int v_ = F.vcu; asm volatile("" : "+s"(v_)); F.vcu = v_; int g_ = (int)gridDim.x; asm volatile("" : "+s"(g_)); F.G = g_; int b_ = (int)blockIdx.x; asm volatile("" : "+s"(b_)); F.bx = b_; }
        const int l = ph == 0 ? 0 : (ph - 1) / 10, k = ph == 0 ? -1 : (ph - 1) % 10, kind = l & 1, j = l >> 1;
        if (k == -1) {
#ifndef NO_P0
            p0_prologue(F);
#endif
        }
        else if (k == 0) norm0_phase(F);
        else if (k == 2) {
#ifndef NO_ATTN
            if (kind == 0) attn_phase(F, j, l == 0 ? 4096 + 128 : 4096);
#endif
#ifndef NO_HY
            if (kind == 1) hyena_phase(F, j, l == 1);
#endif
        }
#ifndef NO_TR
        else if (k == 3) transpose_phase(F, rows_of_layer(l));
#endif
#ifndef NO_ROUTER
        else if (k == 5) router_phase(F, l);
#endif
#ifndef NO_GATHER
        else if (k == 6) index_phase(F, l);
#endif
#ifndef NO_COMB
        else if (k == 9) combine_phase(F, l, ((PROBE_REP_MASK >> 10) & 1) != 0 && !rep_done);
#endif
        else if (k == 1 || k == 4 || k == 7 || k == 8) {
            pg8::Gemm g; pg8::AnyOrder S; pg8::EpiAny E;
            S.moe = 0; S.rb2e = blkstart + 64; S.nblk = 0; S.lg = 0; S.wbase = l * 32;
            E.bslot = (PG8_LAS float*)(F.lds + USER_OFF); E.ldc = TT; E.O = nullptr; E.f0 = nullptr; E.f1 = nullptr; E.p0 = nullptr; E.p1 = nullptr; E.p2 = nullptr; E.p3 = nullptr;
            if (k == 1 && kind == 0) {
                g = pg8::Gemm{(const bf16*)(F.ws + WS_H), (const bf16*)(F.ws + WS_WQK) + (size_t)j * QKD * 1024, TT, QKD, D}; S.so.init(TT, QKD, F.G, F.bx);
                E.mode = pg8::EPI_QK; E.O = (bf16*)(F.ws + WS_QK); E.p0 = F.in[I_ABQKV] + (size_t)j * 1536;
            } else if (k == 1) {
                g = pg8::Gemm{(const bf16*)(F.ws + WS_WHIN) + (size_t)j * 3072 * 1024, (const bf16*)(F.ws + WS_H), 3072, rows_of_layer(l), D}; S.so.init(3072, rows_of_layer(l), F.G, F.bx);
                E.mode = pg8::EPI_T; E.O = (bf16*)(F.ws + WS_UT); E.p0 = F.in[I_HBIN] + (size_t)j * 3072;
            } else if (k == 4) {
                g = pg8::Gemm{(const bf16*)(F.ws + WS_O), kind == 0 ? (const bf16*)(F.ws + WS_WAO) + (size_t)j * 1024 * 1024 : (const bf16*)(F.ws + WS_WHO) + (size_t)j * 1024 * 1024, rows_of_layer(l), D, D};
                S.so.init(rows_of_layer(l), D, F.G, F.bx);
                E.mode = pg8::EPI_RES; E.p0 = l == 0 ? F.in[I_X] : nullptr; E.p1 = l == 0 ? F.in[I_CTX] : nullptr; E.O = (bf16*)(F.ws + WS_XB);
                E.p2 = kind == 0 ? F.in[I_ABO] + (size_t)j * 1024 : F.in[I_HBO] + (size_t)j * 1024; E.p3 = (const float*)(F.ws + WS_MOD) + (size_t)l * 9 * 6144 + 2 * 1024;
            } else {
                load_blkstart(F, l, blkstart);
                S.moe = 1; S.nblk = blkstart[32]; S.so.G = F.G; S.so.c = F.bx; S.so.nM = 0; S.so.nN = 0; S.so.nwg = 0;
                if (k == 7) { g = pg8::Gemm{(const bf16*)(F.ws + WS_H), (const bf16*)(F.ws + WS_WGU), MAXROWS, 2048, D, (const int*)(F.ws + WS_RSRC)}; S.lg = 3; E.mode = pg8::EPI_SWIGLU; E.O = (bf16*)(F.ws + WS_ACT); E.p0 = F.in[I_BGU] + (size_t)l * 32 * 2048; }
                else { g = pg8::Gemm{(const bf16*)(F.ws + WS_ACT), (const bf16*)(F.ws + WS_WDN), MAXROWS, 1024, D}; S.lg = 2; E.mode = pg8::EPI_DOWN; E.O = (bf16*)(F.ws + WS_YS); E.p0 = F.in[I_BDN] + (size_t)l * 32 * 1024; }
            }
#ifndef NO_G1
            pg8::gemm_phase<pg8::EpiAny, pg8::AnyOrder, PG8_ALIGN_EPI, PG8_SP2>(F.lds + RING_OFF, g, S, E);
#endif
        }
        if (use_bar && ph != N_PHASES - 1) xcd_barrier(bar);
#ifdef PROBE_DOUBLE_BAR
        if (use_bar && ph != N_PHASES - 1) xcd_barrier(bar);
#endif
        if (PROBE_REP_MASK != 0) { if (((PROBE_REP_MASK >> (k + 1)) & 1) && (PROBE_REP_KIND == 2 || kind == PROBE_REP_KIND) && !rep_done) { rep_done = 1; --ph;
                if (k == 5) { if (F.bx == 0 && F.tid < 32) __hip_atomic_store((unsigned*)(F.ctl + CW_ECNT + l * 32 + F.tid), 0u, RLX_AGENT); xcd_barrier(bar); }
            } else rep_done = 0; }
    }
}

extern "C" void kernel_launch(void* const* d_in, const int* in_sizes, int n_in, void* d_out, int out_size, void* d_ws, size_t ws_size, hipStream_t stream) {
    static int grid = 0;
    if (grid == 0) {
        if (n_in != N_IN || out_size != TL * D || ws_size < WS_END) { fprintf(stderr, "kernel_launch: unexpected shapes (n_in %d, out %d, ws %zu < %zu)\n", n_in, out_size, ws_size, (size_t)WS_END); grid = -1; return; }
        if (hipFuncSetAttribute((const void*)fwd_kernel, hipFuncAttributeMaxDynamicSharedMemorySize, LDS_BYTES) != hipSuccess) { fprintf(stderr, "kernel_launch: hipFuncSetAttribute failed\n"); grid = -1; return; }
        int per_cu = 0;
        if (hipOccupancyMaxActiveBlocksPerMultiprocessor(&per_cu, (const void*)fwd_kernel, NWAVES * 64, LDS_BYTES) != hipSuccess || per_cu < 1) fprintf(stderr, "kernel_launch: occupancy query says %d\n", per_cu);
        (void)hipGetLastError();
        grid = 256;
    }
    if (grid < 0) return;
    if (hipMemsetAsync((char*)d_ws + WS_CTL, 0, CTL_ZERO_BYTES, stream) != hipSuccess) return;
    Args a{};
    for (int i = 0; i < N_IN; ++i) a.in[i] = (const float*)d_in[i];
    a.out = (float*)d_out; a.ws = (unsigned char*)d_ws; a.pad = 0;
#if MK_ONE_LAUNCH
    a.ph_lo = 0; a.ph_hi = N_PHASES; a.use_bar = 1;
    hipLaunchKernelGGL(fwd_kernel, dim3(grid), dim3(NWAVES * 64), LDS_BYTES, stream, a);
#else
    for (int ph = 0; ph < N_PHASES; ++ph) {
        if (!phase_exists(ph)) continue;
        a.ph_lo = ph; a.ph_hi = ph + 1; a.use_bar = 0;
        hipLaunchKernelGGL(fwd_kernel, dim3(grid), dim3(NWAVES * 64), LDS_BYTES, stream, a);
    }
#endif
}
```

```cpp
#include <hip/hip_runtime.h>
#include <cstdio>
#include <cstdint>
#include <cmath>
#define MK_ONE_LAUNCH 1
namespace pg8 {
#define PG8_LAS __attribute__((address_space(3)))
typedef unsigned short bf16_t;
typedef short bf16x8 __attribute__((ext_vector_type(8)));
typedef float f32x4 __attribute__((ext_vector_type(4)));
typedef unsigned u32x4 __attribute__((ext_vector_type(4)));
constexpr int BM = 256, BK = 64, HALF = 128, HTB = HALF * BK * 2  , STAGE_BYTES = 8 * HTB, NXCD = 8, WGM = 8;

__host__ __device__ __forceinline__ int lds_byte(int r, int c) { const int st = (r >> 4) * 2 + (c >> 5), rr = r & 15, cc = c & 31, ob = rr * 64 + cc * 2; return st * 1024 + (ob ^ (((ob >> 9) & 1) << 5)); }
__host__ __device__ __forceinline__ void stage_rc(int b, int& R, int& C) { const int st = b / 1024, sb = b % 1024, swz = sb ^ (((sb >> 9) & 1) << 5); R = (st >> 1) * 16 + swz / 64; C = (st & 1) * 32 + (swz % 64) / 2; }
__host__ __device__ __forceinline__ int perm32(int rho) { const int n = rho >> 4, i = rho & 15; return 8 * (i >> 2) + 4 * n + (i & 3); }

struct Unit { int pm, pn, pb; };
struct Gemm { const bf16_t* A; const bf16_t* Bt; int M, N, K; const int* rows; };
struct StaticOrder {
    int nM, nN, nwg, G, c;
    __host__ __device__ void init(int M, int N, int G_, int c_) { nM = M / BM; nN = N / BM; nwg = nM * nN; G = G_; c = c_; }
    __host__ __device__ bool next(int i, Unit& u) const {
        const long L = (long)i * G + c; if (L >= nwg) return false;
        int wgid = (int)L; { const int q = nwg / NXCD, r = nwg % NXCD, xcd = wgid % NXCD, off = wgid / NXCD; wgid = (xcd < r ? xcd * (q + 1) : r * (q + 1) + (xcd - r) * q) + off; }
        const int nig = WGM * nN, gid = wgid / nig, fm = gid * WGM, gsz = (nM - fm) < WGM ? (nM - fm) : WGM;
        u.pm = fm + ((wgid % nig) % gsz); u.pn = (wgid % nig) / gsz; u.pb = u.pn; return true;
    }
    __device__ __forceinline__ void a_ready(const Unit&) const {}
    __device__ __forceinline__ void done(const Unit&) const {}
};
__device__ __forceinline__ unsigned cvt_pk_bf16(float lo, float hi) { unsigned r; asm volatile("v_cvt_pk_bf16_f32 %0, %1, %2" : "=v"(r) : "v"(lo), "v"(hi)); return r; }
typedef float f32x2 __attribute__((ext_vector_type(2)));
#define PG8_STR2(x) #x
#define PG8_STR(x) PG8_STR2(x)
template <class Epi, class Sched, bool ALIGN_EPI = false, bool SP2 = false>
__device__ __forceinline__ void gemm_phase(PG8_LAS unsigned char* lds, const Gemm g, const Sched& S, const Epi& E) {
    int tid_ = threadIdx.x; asm volatile("" : "+v"(tid_));
    const int tid = tid_, wid = __builtin_amdgcn_readfirstlane(tid >> 6), lane = tid & 63, wr = wid >> 2, wc = wid & 3, fr = lane & 15, fq = lane >> 4;
    const int K = g.K, nt = K / BK;
    unsigned roffA[4], voffB[2];
#pragma unroll
    for (int i = 0; i < 2; ++i) { int R, C; stage_rc(tid * 16 + i * 8192, R, C); const int Rb = Epi::PERM ? ((R & ~31) + perm32(R & 31)) : R;
        roffA[i] = (unsigned)(R * K + C) * 2u; roffA[2 + i] = (unsigned)((R + HALF) * K + C) * 2u; voffB[i] = (unsigned)(Rb * K + C) * 2u; }
    const size_t kstep = (size_t)(BK * 2);
    const size_t hstep = (size_t)HALF * K * 2;
    const size_t tstep = 2 * hstep;
    const unsigned ldsw = (unsigned)wid * 1024u;
    const int aoff = lds_byte(wr * 64 + fr, fq * 8), boff = lds_byte(wc * 32 + fr, fq * 8);
#define PG8_SA(b, h) (((b) * 2 + (h)) * HTB)
#define PG8_SB(b, h) ((4 + (b) * 2 + (h)) * HTB)
#define PG8_STAGE(bufoff, gbase, voff) do { _Pragma("unroll") for (int _i = 0; _i < 2; ++_i) \
        __builtin_amdgcn_global_load_lds((const unsigned*)((const char*)(gbase) + (voff)[_i]), (PG8_LAS unsigned*)(lds + (bufoff) + ldsw + _i * 8192), 16, 0, 0); } while (0)
#define PG8_STAGEA(bufoff, gbase, h) do { _Pragma("unroll") for (int _i = 0; _i < 2; ++_i) \
        __builtin_amdgcn_global_load_lds((const unsigned*)((const char*)(gbase) + roffA[2 * (h) + _i]), (PG8_LAS unsigned*)(lds + (bufoff) + ldsw + _i * 8192), 16, 0, 0); } while (0)
#define PG8_LDA(dst, b, h) do { _Pragma("unroll") for (int m = 0; m < 4; ++m) _Pragma("unroll") for (int k = 0; k < 2; ++k) dst[m][k] = *(const PG8_LAS bf16x8*)(lds + PG8_SA(b, h) + aoff + m * 2048 + k * 1024); } while (0)
#define PG8_LDB(dst, b, h) do { _Pragma("unroll") for (int n = 0; n < 2; ++n) _Pragma("unroll") for (int k = 0; k < 2; ++k) dst[n][k] = *(const PG8_LAS bf16x8*)(lds + PG8_SB(b, h) + boff + n * 2048 + k * 1024); } while (0)
#define PG8_MMA(ai, bj, At, Bt) do { __builtin_amdgcn_s_setprio(1); _Pragma("unroll") for (int m = 0; m < 4; ++m) _Pragma("unroll") for (int n = 0; n < 2; ++n) _Pragma("unroll") for (int k = 0; k < 2; ++k) \
        acc[ai][bj][m][n] = __builtin_amdgcn_mfma_f32_16x16x32_bf16(Bt[n][k], At[m][k], acc[ai][bj][m][n], 0, 0, 0); __builtin_amdgcn_s_setprio(0); } while (0)
#define PG8_WAIT_V(n) asm volatile("s_waitcnt vmcnt(" #n ")" ::: "memory")
#define PG8_WAIT_L(n) asm volatile("s_waitcnt lgkmcnt(" #n ")" ::: "memory")
#define PG8_BAR __builtin_amdgcn_s_barrier()
#define PG8_SCHED __builtin_amdgcn_sched_barrier(0)
    Unit cur, nxt; int ui = 0;
    if (!S.next(0, cur)) return;
    f32x4 acc[2][2][4][2];
#define PG8_ACC_INIT() do { if (E.mode >= 3) { const PG8_LAS float* bs_ = E.bslot + wid * 64 + 8 * fq; \
            const f32x4 b00_ = *(const PG8_LAS f32x4*)bs_, b01_ = *(const PG8_LAS f32x4*)(bs_ + 4), b10_ = *(const PG8_LAS f32x4*)(bs_ + 32), b11_ = *(const PG8_LAS f32x4*)(bs_ + 36); \
            _Pragma("unroll") for (int a = 0; a < 2; ++a) _Pragma("unroll") for (int m = 0; m < 4; ++m) { acc[a][0][m][0] = b00_; acc[a][0][m][1] = b01_; acc[a][1][m][0] = b10_; acc[a][1][m][1] = b11_; } \
        } else { _Pragma("unroll") for (int a = 0; a < 2; ++a) _Pragma("unroll") for (int b = 0; b < 2; ++b) _Pragma("unroll") for (int m = 0; m < 4; ++m) _Pragma("unroll") for (int n = 0; n < 2; ++n) acc[a][b][m][n] = (f32x4){0.f, 0.f, 0.f, 0.f}; } } while (0)
    if (E.mode >= 3) { __builtin_amdgcn_global_load_lds((const unsigned*)E.bias_src(cur, wc, lane), (PG8_LAS unsigned*)(E.bslot + wid * 64), 4, 0, 0); PG8_WAIT_V(0); }
    PG8_ACC_INIT();
    bf16x8 At[4][2], B0[2][2], B1[2][2];
    const __attribute__((address_space(1))) int* const rows = (const __attribute__((address_space(1))) int*)g.rows; const int r0g = (wid >> 1) * 16 + (lane >> 2); const unsigned cb2g = roffA[0] - (unsigned)(r0g * K) * 2u;
#define PG8_ROWS(dst, pm_) do { _Pragma("unroll") for (int _j = 0; _j < 4; ++_j) dst[_j] = (unsigned)rows[(size_t)(pm_) * BM + r0g + 64 * _j] * (unsigned)(K * 2) + cb2g; } while (0)
    if (rows) { unsigned t4[4]; PG8_ROWS(t4, cur.pm); roffA[0] = t4[0]; roffA[1] = t4[1]; roffA[2] = t4[2]; roffA[3] = t4[3]; }
    const char* cA = rows ? (const char*)g.A : (const char*)g.A + (size_t)cur.pm * tstep; const char* cB = (const char*)g.Bt + (size_t)cur.pb * tstep;
    S.a_ready(cur);
    if constexpr (SP2) {
        PG8_STAGE(PG8_SB(0, 0), cB, voffB); PG8_STAGE(PG8_SB(0, 1), cB + hstep, voffB); PG8_STAGEA(PG8_SA(0, 0), cA, 0); PG8_STAGEA(PG8_SA(0, 1), cA, 1);
        if (wr == 1) PG8_BAR;
        PG8_WAIT_V(2); PG8_BAR;
        PG8_STAGE(PG8_SB(1, 0), cB + kstep, voffB); PG8_STAGEA(PG8_SA(1, 0), cA + kstep, 0); PG8_STAGE(PG8_SB(1, 1), cB + hstep + kstep, voffB);
        PG8_WAIT_V(6); PG8_BAR;
    } else {
        PG8_STAGE(PG8_SB(0, 0), cB, voffB); PG8_STAGEA(PG8_SA(0, 0), cA, 0); PG8_STAGE(PG8_SB(0, 1), cB + hstep, voffB); PG8_STAGEA(PG8_SA(0, 1), cA, 1);
        if (wr == 1) PG8_BAR;
        PG8_WAIT_V(4); PG8_BAR;
        PG8_STAGE(PG8_SB(1, 0), cB + kstep, voffB); PG8_STAGEA(PG8_SA(1, 0), cA + kstep, 0); PG8_STAGE(PG8_SB(1, 1), cB + hstep + kstep, voffB);
        PG8_WAIT_V(6); PG8_BAR;
    }
    unsigned nr4[4] = {0u, 0u, 0u, 0u};
    for (;;) {
        const bool has_next = S.next(ui + 1, nxt);
        const char* nA = (has_next && !rows) ? (const char*)g.A + (size_t)nxt.pm * tstep : cA; const char* nB = has_next ? (const char*)g.Bt + (size_t)nxt.pb * tstep : cB;
#ifdef PG8_LOOP_ALIGN
        asm volatile(".p2align " PG8_STR(PG8_LOOP_ALIGN));
#endif
        for (int t = 0; t < nt; t += 2) {
            const bool last = (t == nt - 2);
            const char* a1 = cA + (size_t)(t + 1) * kstep;
            const char* a2 = last ? nA : cA + (size_t)(t + 2) * kstep; const char* b2 = last ? nB : cB + (size_t)(t + 2) * kstep;
            const char* a3 = a2 + kstep; const char* b3 = b2 + kstep;
            if (last && has_next) S.a_ready(nxt);
            const bool swap_rows = rows != nullptr && last && has_next;
            if (E.mode >= 3 && has_next && t == nt - 4)
                __builtin_amdgcn_global_load_lds((const unsigned*)E.bias_src(nxt, wc, lane), (PG8_LAS unsigned*)(E.bslot + wid * 64), 4, 0, 0);
            if (rows != nullptr && has_next && t == nt - 4) {
                const __attribute__((address_space(1))) int* rp = rows + (size_t)nxt.pm * BM + r0g;
                asm volatile("global_load_dword %0, %4, off\n\tglobal_load_dword %1, %4, off offset:256\n\tglobal_load_dword %2, %4, off offset:512\n\tglobal_load_dword %3, %4, off offset:768"
                             : "=&v"(nr4[0]), "=&v"(nr4[1]), "=&v"(nr4[2]), "=&v"(nr4[3]) : "v"(rp) : "memory"); }
            if constexpr (SP2) {
            PG8_LDB(B0, 0, 0); PG8_LDB(B1, 0, 1); PG8_SCHED; PG8_LDA(At, 0, 0); PG8_STAGEA(PG8_SA(1, 1), a1, 1);
            if (swap_rows) {
#pragma unroll
                for (int _j = 0; _j < 4; ++_j) roffA[_j] = nr4[_j] * (unsigned)(K * 2) + cb2g; }
            PG8_WAIT_V(8); PG8_WAIT_L(0); PG8_BAR; PG8_MMA(0, 0, At, B0); PG8_MMA(0, 1, At, B1); PG8_BAR; PG8_SCHED;
            PG8_LDA(At, 0, 1); PG8_STAGE(PG8_SB(0, 0), b2, voffB); PG8_STAGE(PG8_SB(0, 1), b2 + hstep, voffB); PG8_STAGEA(PG8_SA(0, 0), a2, 0);
            PG8_WAIT_V(8); PG8_WAIT_L(0); PG8_BAR; PG8_MMA(1, 0, At, B0); PG8_MMA(1, 1, At, B1); PG8_BAR; PG8_SCHED;
            PG8_LDB(B0, 1, 0); PG8_LDB(B1, 1, 1); PG8_SCHED; PG8_LDA(At, 1, 0); PG8_STAGEA(PG8_SA(0, 1), a2, 1);
            PG8_WAIT_V(8); PG8_WAIT_L(0); PG8_BAR; PG8_MMA(0, 0, At, B0); PG8_MMA(0, 1, At, B1); PG8_BAR; PG8_SCHED;
            PG8_LDA(At, 1, 1); PG8_STAGE(PG8_SB(1, 0), b3, voffB); PG8_STAGE(PG8_SB(1, 1), b3 + hstep, voffB); PG8_STAGEA(PG8_SA(1, 0), a3, 0);
            PG8_WAIT_V(8); PG8_WAIT_L(0); PG8_BAR; PG8_MMA(1, 0, At, B0); PG8_MMA(1, 1, At, B1); PG8_BAR; PG8_SCHED;
            } else {
            PG8_LDB(B0, 0, 0); PG8_SCHED; PG8_LDA(At, 0, 0); PG8_STAGEA(PG8_SA(1, 1), a1, 1);
            if (swap_rows) {
#pragma unroll
                for (int _j = 0; _j < 4; ++_j) roffA[_j] = nr4[_j] * (unsigned)(K * 2) + cb2g; }
            PG8_WAIT_L(8); PG8_BAR; PG8_WAIT_L(0); PG8_MMA(0, 0, At, B0); PG8_BAR; PG8_SCHED;
            PG8_LDB(B1, 0, 1); PG8_STAGE(PG8_SB(0, 0), b2, voffB);
            PG8_BAR; PG8_WAIT_L(0); PG8_MMA(0, 1, At, B1); PG8_BAR;
            PG8_LDA(At, 0, 1); PG8_STAGEA(PG8_SA(0, 0), a2, 0);
            PG8_BAR; PG8_WAIT_L(0); PG8_MMA(1, 0, At, B0); PG8_BAR; PG8_SCHED;
            PG8_STAGE(PG8_SB(0, 1), b2 + hstep, voffB);
            PG8_WAIT_V(6); PG8_BAR; PG8_MMA(1, 1, At, B1); PG8_BAR;
            PG8_LDB(B0, 1, 0); PG8_SCHED; PG8_LDA(At, 1, 0); PG8_STAGEA(PG8_SA(0, 1), a2, 1);
            PG8_WAIT_L(8); PG8_BAR; PG8_WAIT_L(0); PG8_MMA(0, 0, At, B0); PG8_BAR; PG8_SCHED;
            PG8_LDB(B1, 1, 1); PG8_STAGE(PG8_SB(1, 0), b3, voffB);
            PG8_BAR; PG8_WAIT_L(0); PG8_MMA(0, 1, At, B1); PG8_BAR;
            PG8_LDA(At, 1, 1); PG8_STAGEA(PG8_SA(1, 0), a3, 0);
            PG8_BAR; PG8_WAIT_L(0); PG8_MMA(1, 0, At, B0); PG8_BAR; PG8_SCHED;
            PG8_STAGE(PG8_SB(1, 1), b3 + hstep, voffB);
            PG8_WAIT_V(6); PG8_BAR; PG8_MMA(1, 1, At, B1); PG8_BAR;
            }
        }
        if constexpr (ALIGN_EPI) { if (wr == 0) PG8_BAR; }
        if constexpr (!Epi::AFTER_DRAIN) { E(acc, cur, wr, wc, fr, fq); S.done(cur); }
        if (!has_next) break;
        PG8_ACC_INIT();
        cur = nxt; cA = nA; cB = nB; ++ui;
        if constexpr (ALIGN_EPI) { if (wr == 1) PG8_BAR; }
    }
    PG8_WAIT_V(0);
    if constexpr (!ALIGN_EPI) { if (wr == 0) PG8_BAR; }
    PG8_BAR;
    if constexpr (Epi::AFTER_DRAIN) { E.fused(acc, cur, wr, wc, fr, fq, lds, wid, lane); S.done(cur); }
#undef PG8_ACC_INIT
#undef PG8_SA
#undef PG8_SB
#undef PG8_STAGE
#undef PG8_STAGEA
#undef PG8_ROWS
#undef PG8_LDA
#undef PG8_LDB
#undef PG8_MMA
#undef PG8_WAIT_V
#undef PG8_WAIT_L
#undef PG8_BAR
#undef PG8_SCHED
}
}
constexpr int NWAVES = 8;
constexpr int D = 1024, NBATCH = 8, SEQ = 8192, CTXL = 256, DEPTH = 4;
constexpr int TL = NBATCH * SEQ;
constexpr int TC = NBATCH * CTXL;
constexpr int TT = TL + TC;
constexpr int QKD = 1536, NE = 32;
constexpr int MAXBLK = 1088, MAXROWS = MAXBLK * 256;
constexpr float NORM_EPS = 1e-6f;
constexpr int N_IN = 35;
enum { I_X = 0, I_C, I_CTX, I_CCTX, I_ADAW, I_ADAB, I_NMIX, I_NFFN, I_AWQKV, I_ABQKV, I_AWO, I_ABO, I_ASINK, I_HWIN, I_HBIN, I_HCW, I_HCB,
       I_FW1, I_FB1, I_FW2, I_FB2, I_FW3, I_FB3, I_FFREQ, I_FWOUT, I_HBD, I_HWO, I_HBO, I_RW, I_RB, I_WGU, I_BGU, I_WDN, I_BDN, I_FNORM };

constexpr size_t MiB = 1u << 20;
constexpr size_t WS_CTL = 0, CTL_ZERO_BYTES = 1 * MiB;
constexpr size_t WS_MOD = 1 * MiB;
constexpr size_t WS_ROPE = 2 * MiB;
constexpr size_t WS_A3L = 4 * MiB;
constexpr size_t WS_A3C = 8 * MiB;
constexpr size_t WS_WQK = 9 * MiB;
constexpr size_t WS_WAO = 15 * MiB;
constexpr size_t WS_WHIN = 19 * MiB;
constexpr size_t WS_WHO = 31 * MiB;
constexpr size_t WS_WGU = 35 * MiB;
constexpr size_t WS_WDN = 547 * MiB;
constexpr size_t WS_XC = 803 * MiB;
constexpr size_t WS_H = 811 * MiB;
constexpr size_t WS_POS = 943 * MiB;
constexpr size_t WS_GATE = 945 * MiB;
constexpr size_t WS_DEST = 947 * MiB;
constexpr size_t WS_BIG = 949 * MiB;
constexpr size_t WS_QK = WS_BIG, WS_UT = WS_BIG, WS_YS = WS_BIG;
constexpr size_t WS_O = WS_BIG + 396 * MiB;
constexpr size_t WS_B2 = WS_BIG + 544 * MiB;
constexpr size_t WS_ZT = WS_B2, WS_G = WS_B2 + 132 * MiB, WS_TP = WS_B2 + 388 * MiB  , WS_ACT = WS_B2;
constexpr size_t WS_XB = WS_B2 + 544 * MiB;
constexpr size_t WS_RSRC = WS_XB + 132 * MiB;
constexpr size_t WS_END = WS_RSRC + 2 * MiB;
static_assert(WS_O + (size_t)TT * D * 2 <= WS_B2 && (size_t)MAXROWS * D * 2 <= 544 * MiB && (size_t)3072 * TT * 2 <= 396 * MiB, "ws map");
static_assert(WS_QK + (size_t)TT * QKD * 2 <= WS_O, "ws map 2");
constexpr int CW_BAR = 4096;
constexpr int CW_ECNT = 16384;

constexpr int RING_OFF = 0, RING_BYTES = 131072;
constexpr int LDSCTL_OFF = RING_BYTES, MISC_OFF = LDSCTL_OFF + 320, USER_OFF = RING_BYTES + 512;
constexpr int LDS_BYTES = 147456;

#define GAS __attribute__((address_space(1)))
#define LAS __attribute__((address_space(3)))
#define KAS __attribute__((address_space(4)))
typedef unsigned short bf16;
typedef unsigned v4u __attribute__((ext_vector_type(4)));
typedef unsigned v2u __attribute__((ext_vector_type(2)));
typedef int v4i __attribute__((ext_vector_type(4)));
typedef float f32x4 __attribute__((ext_vector_type(4)));
typedef float f32x16 __attribute__((ext_vector_type(16)));
typedef short bf16x8 __attribute__((ext_vector_type(8)));
typedef GAS unsigned gu32;
#define RLX_AGENT __ATOMIC_RELAXED, __HIP_MEMORY_SCOPE_AGENT
#define LDS_WAIT() asm volatile("s_waitcnt lgkmcnt(0)" ::: "memory")
#define VM_WAIT() asm volatile("s_waitcnt vmcnt(0)" ::: "memory")
__device__ __forceinline__ unsigned f2bf(float f) { unsigned u = __builtin_bit_cast(unsigned, f); return (u + 0x7fffu + ((u >> 16) & 1u)) >> 16; }
__device__ __forceinline__ unsigned pk2(float lo, float hi) { return f2bf(lo) | (f2bf(hi) << 16); }
__device__ __forceinline__ float bf2f(unsigned short b) { return __builtin_bit_cast(float, ((unsigned)b) << 16); }
__device__ __forceinline__ float bflo(unsigned w) { return __builtin_bit_cast(float, w << 16); }
__device__ __forceinline__ float bfhi(unsigned w) { return __builtin_bit_cast(float, w & 0xffff0000u); }
#define XB_TMO      128
#define XB_XCNT(j)  (256  + 64 * (j))
#define XB_XSUB(j)  (1280 + 64 * (j))
#define XB_XGEN(j)  (2304 + 64 * (j))
#define XB_TOP      3328
#define XB_TOPGEN   3392
#define XCD_BAR_WORDS 3456
#define XB_SPIN_CAP (1u << 21)

__device__ __forceinline__ unsigned xb_ld(unsigned* p)              { return __hip_atomic_load(p, __ATOMIC_RELAXED, __HIP_MEMORY_SCOPE_AGENT); }
__device__ __forceinline__ unsigned xb_add(unsigned* p, unsigned v) { return __hip_atomic_fetch_add(p, v, __ATOMIC_RELAXED, __HIP_MEMORY_SCOPE_AGENT); }
__device__ __forceinline__ unsigned xb_xcc_id() { return (unsigned)__builtin_amdgcn_s_getreg((3 << 11) | 20) & 0xFu; }
#define XB_SPIN(cond, bar) do { unsigned _sp = 0; while (cond) { __builtin_amdgcn_s_sleep(1); \
    if ((++_sp & 255u) == 0u) { if (xb_ld(&(bar)[XB_TMO])) break; if (_sp > XB_SPIN_CAP) { atomicAdd(&(bar)[XB_TMO], 1u); break; } } } } while (0)

struct XcdBarrier {
    unsigned* bar; unsigned x;
    volatile LAS unsigned* st;
};

__device__ __forceinline__ XcdBarrier xcd_barrier_post(unsigned* bar, volatile LAS unsigned* st) {
    XcdBarrier b; b.bar = bar; b.x = xb_xcc_id(); b.st = st;
    if (threadIdx.x == 0) (void)xb_add(&bar[XB_XCNT(b.x)], 1u);
    return b;
}
__device__ __forceinline__ void xcd_barrier_complete(unsigned* bar, unsigned x, unsigned& nloc, unsigned& nx) {
    const unsigned G = gridDim.x * gridDim.y * gridDim.z;
    unsigned sum, cnt, mine, sp = 0u;
    for (;;) {
        sum = 0u; cnt = 0u; mine = 0u;
#pragma unroll
        for (unsigned j = 0; j < 16; ++j) { const unsigned c = xb_ld(&bar[XB_XCNT(j)]); sum += c; cnt += (c > 0u) ? 1u : 0u; mine = (j == x) ? c : mine; }
        if (sum == G) break;
        __builtin_amdgcn_s_sleep(1);
        if ((++sp & 255u) == 0u) { if (xb_ld(&bar[XB_TMO])) break; if (sp > XB_SPIN_CAP) { atomicAdd(&bar[XB_TMO], 1u); break; } }
    }
    nloc = mine > 0u ? mine : 1u; nx = cnt > 0u ? cnt : 1u;
}

__device__ __forceinline__ void xcd_barrier(const XcdBarrier& b) {
    asm volatile("s_waitcnt vmcnt(0)" ::: "memory");
    __syncthreads();
    if (threadIdx.x == 0) {
        unsigned* bar = b.bar;
        __builtin_amdgcn_s_waitcnt(0);
        unsigned nloc = b.st[0], nx = b.st[1];
        if (nloc == 0u) { xcd_barrier_complete(bar, b.x, nloc, nx); b.st[0] = nloc; b.st[1] = nx; }
        const unsigned old = xb_add(&bar[XB_XSUB(b.x)], 1u);
        const unsigned gen = old / nloc;
        if (old + 1u == (gen + 1u) * nloc) {
            __builtin_amdgcn_fence(__ATOMIC_RELEASE, "agent");
            asm volatile("s_waitcnt vmcnt(0)" ::: "memory");
            const unsigned og = xb_add(&bar[XB_TOP], 1u);
            const unsigned tg = og / nx;
            if (og + 1u == (tg + 1u) * nx) xb_add(&bar[XB_TOPGEN], 1u);
            else XB_SPIN(xb_ld(&bar[XB_TOPGEN]) == tg, bar);
            __builtin_amdgcn_fence(__ATOMIC_ACQUIRE, "agent");
            xb_add(&bar[XB_XGEN(b.x)], 1u);
            asm volatile("s_waitcnt vmcnt(0)" ::: "memory");
        } else {
            XB_SPIN(xb_ld(&bar[XB_XGEN(b.x)]) == gen, bar);
            __builtin_amdgcn_fence(__ATOMIC_ACQUIRE, "agent");
            asm volatile("s_waitcnt vmcnt(0)" ::: "memory");
        }
    }
    __syncthreads();
}
#ifndef FFT_HOST_TEST
#define FFT_DEV __device__ __forceinline__
#define FFT_LAUNDER(t) asm volatile("" : "+v"(t))
#else
#define FFT_DEV inline
#define FFT_LAUNDER(t) (void)0
#endif
#ifndef FFT_HOST_TEST
#define FFT_FENCE() do { asm volatile("" ::: "memory"); __builtin_amdgcn_sched_barrier(0); } while (0)
#else
#define FFT_FENCE() (void)0
#endif
typedef float cf2 __attribute__((ext_vector_type(2)));
typedef float cf4 __attribute__((ext_vector_type(4)));
constexpr int FFT_N = 16384, FFT_THREADS = 512;
FFT_DEV void fft_cs(float frac, float& c, float& s) {
#ifndef FFT_HOST_TEST
    c = __builtin_amdgcn_cosf(frac); s = __builtin_amdgcn_sinf(frac);
#else
    c = (float)cos(6.283185307179586 * (double)frac); s = (float)sin(6.283185307179586 * (double)frac);
#endif
}
FFT_DEV cf2 cmulf(cf2 a, float c, float s) { cf2 r; r.x = a.x * c - a.y * s; r.y = a.x * s + a.y * c; return r; }
FFT_DEV int fft_swz(int e) { return e ^ (((e >> 5) & 7) << 1); }
FFT_DEV cf2 cmul2(cf2 a, cf2 b) { const cf2 axx = {a.x, a.x}, ayy = {a.y, a.y}, bs = {-b.y, b.x}; return ayy * bs + axx * b; }
FFT_DEV cf2 cmulc(cf2 a, cf2 b) { const cf2 axx = {a.x, a.x}, ayy = {a.y, a.y}, bs = {b.y, b.x}, bn = {b.x, -b.y}; return ayy * bs + axx * bn; }
FFT_DEV cf2 tw32(int j) {
    constexpr float C[9] = {1.0f, 0.98078528040323044913f, 0.92387953251128675613f, 0.83146961230254523708f, 0.70710678118654752440f, 0.55557023301960222474f, 0.38268343236508977173f, 0.19509032201612826785f, 0.0f};
    const int q = (j >> 3) & 3, r = j & 7; float c, sn;
    if (q == 0) { c = C[r]; sn = C[8 - r]; } else if (q == 1) { c = -C[8 - r]; sn = C[r]; } else if (q == 2) { c = -C[r]; sn = -C[8 - r]; } else { c = C[8 - r]; sn = -C[r]; }
    cf2 w; w.x = c; w.y = -sn; return w;
}
template <bool TW> FFT_DEV void bfly_fwd_w(cf2& a0, cf2& a1, cf2& a2, cf2& a3, cf2 w1, cf2 w2, cf2 w3) {
    const cf2 t0 = a0 + a2, t1 = a0 - a2, t2 = a1 + a3, t3 = a1 - a3;
    cf2 y0 = t0 + t2, y2 = t0 - t2, y1, y3;
    y1.x = t1.x + t3.y; y1.y = t1.y - t3.x;
    y3.x = t1.x - t3.y; y3.y = t1.y + t3.x;
    if (TW) { y1 = cmul2(y1, w1); y2 = cmul2(y2, w2); y3 = cmul2(y3, w3); }
    a0 = y0; a1 = y1; a2 = y2; a3 = y3;
}
template <bool TW> FFT_DEV void bfly_inv_w(cf2& a0, cf2& a1, cf2& a2, cf2& a3, cf2 w1, cf2 w2, cf2 w3) {
    if (TW) { a1 = cmulc(a1, w1); a2 = cmulc(a2, w2); a3 = cmulc(a3, w3); }
    const cf2 t0 = a0 + a2, t1 = a0 - a2, t2 = a1 + a3, t3 = a1 - a3;
    cf2 y0 = t0 + t2, y2 = t0 - t2, y1, y3;
    y1.x = t1.x - t3.y; y1.y = t1.y + t3.x;
    y3.x = t1.x + t3.y; y3.y = t1.y - t3.x;
    a0 = y0; a1 = y1; a2 = y2; a3 = y3;
}
FFT_DEV cf2 fft_w(float frac) { float c, sn; fft_cs(frac, c, sn); cf2 w; w.x = c; w.y = -sn; return w; }
template <bool TW> FFT_DEV void bfly_fwd(cf2& a0, cf2& a1, cf2& a2, cf2& a3, float f) {
    const cf2 t0 = a0 + a2, t1 = a0 - a2, t2 = a1 + a3, t3 = a1 - a3;
    cf2 y0 = t0 + t2, y2 = t0 - t2, y1, y3;
    y1.x = t1.x + t3.y; y1.y = t1.y - t3.x;
    y3.x = t1.x - t3.y; y3.y = t1.y + t3.x;
    if (TW) { float c1, s1, c2, s2, c3, s3; fft_cs(f, c1, s1); fft_cs(2.0f * f, c2, s2); fft_cs(3.0f * f, c3, s3);
        y1 = cmulf(y1, c1, -s1); y2 = cmulf(y2, c2, -s2); y3 = cmulf(y3, c3, -s3); }
    a0 = y0; a1 = y1; a2 = y2; a3 = y3;
}
template <bool TW> FFT_DEV void bfly_inv(cf2& a0, cf2& a1, cf2& a2, cf2& a3, float f) {
    if (TW) { float c1, s1, c2, s2, c3, s3; fft_cs(f, c1, s1); fft_cs(2.0f * f, c2, s2); fft_cs(3.0f * f, c3, s3);
        a1 = cmulf(a1, c1, s1); a2 = cmulf(a2, c2, s2); a3 = cmulf(a3, c3, s3); }
    const cf2 t0 = a0 + a2, t1 = a0 - a2, t2 = a1 + a3, t3 = a1 - a3;
    cf2 y0 = t0 + t2, y2 = t0 - t2, y1, y3;
    y1.x = t1.x - t3.y; y1.y = t1.y + t3.x;
    y3.x = t1.x + t3.y; y3.y = t1.y - t3.x;
    a0 = y0; a1 = y1; a2 = y2; a3 = y3;
}
template <class PT> FFT_DEV void fft_fwd_first(PT X, const float (&za)[16], const float (&zb)[16], int tid) {
    FFT_LAUNDER(tid);
    const cf2 wt1 = fft_w((float)tid * (1.0f / 16384.0f)), wt2 = cmul2(wt1, wt1), wt3 = cmul2(wt2, wt1);
#pragma unroll
    for (int q = 0; q < 8; ++q) {
        const int k = tid + FFT_THREADS * q;
        cf2 a0, a1, a2, a3; a0.x = za[q]; a0.y = zb[q]; a1.x = za[q + 8]; a1.y = zb[q + 8]; a2.x = 0.f; a2.y = 0.f; a3 = a2;
        bfly_fwd_w<true>(a0, a1, a2, a3, cmul2(wt1, tw32(q)), cmul2(wt2, tw32(2 * q)), cmul2(wt3, tw32(3 * q)));
        const int sk = fft_swz(k);
        X[sk] = a0; X[sk + 4096] = a1; X[sk + 8192] = a2; X[sk + 12288] = a3;
        FFT_FENCE();
    }
}
template <class PT, class SP> FFT_DEV void fft_fwd_first_full(PT X, SP src, float scale, int tid) {
    FFT_LAUNDER(tid);
    const cf2 wt1 = fft_w((float)tid * (1.0f / 16384.0f)), wt2 = cmul2(wt1, wt1), wt3 = cmul2(wt2, wt1);
#pragma unroll
    for (int q = 0; q < 8; ++q) {
        const int k = tid + FFT_THREADS * q;
        cf2 a0, a1, a2, a3; a0.x = src[k] * scale; a0.y = 0.f; a1.x = src[k + 4096] * scale; a1.y = 0.f; a2.x = src[k + 8192] * scale; a2.y = 0.f; a3.x = src[k + 12288] * scale; a3.y = 0.f;
        bfly_fwd_w<true>(a0, a1, a2, a3, cmul2(wt1, tw32(q)), cmul2(wt2, tw32(2 * q)), cmul2(wt3, tw32(3 * q)));
        const int sk = fft_swz(k);
        X[sk] = a0; X[sk + 4096] = a1; X[sk + 8192] = a2; X[sk + 12288] = a3;
        if (q & 1) FFT_FENCE();
    }
}
template <class PT, class SP> FFT_DEV void fft_fwd_first_taps(PT X, SP src, float scale, int tid) {
    FFT_LAUNDER(tid);
    const cf2 wt1 = fft_w((float)tid * (1.0f / 16384.0f)), wt2 = cmul2(wt1, wt1), wt3 = cmul2(wt2, wt1);
#pragma unroll
    for (int q = 0; q < 8; ++q) {
        const int k = tid + FFT_THREADS * q;
        cf2 a0, a1, a2, a3; a0.x = src[k] * scale; a0.y = 0.f; a1.x = src[k + 4096] * scale; a1.y = 0.f; a2.x = k == 0 ? 0.f : src[16384 - (k == 0 ? 1 : k)] * scale; a2.y = 0.f; a3.x = src[12288 - k] * scale; a3.y = 0.f;
        bfly_fwd_w<true>(a0, a1, a2, a3, cmul2(wt1, tw32(q)), cmul2(wt2, tw32(2 * q)), cmul2(wt3, tw32(3 * q)));
        const int sk = fft_swz(k);
        X[sk] = a0; X[sk + 4096] = a1; X[sk + 8192] = a2; X[sk + 12288] = a3;
        if (q & 1) FFT_FENCE();
    }
}
template <int S2> FFT_DEV int fft_dbl_idx(int base, int i) {
    if (S2 == 256) return fft_swz(base) + S2 * i;
    if (S2 == 16) return (base ^ ((i >> 1) << 1)) + S2 * i;
    return fft_swz(base + S2 * i);
}
template <int P, class PT> FFT_DEV void fft_fwd_double(PT X, int tid) {
    FFT_LAUNDER(tid);
    constexpr int LS2 = 2 * (5 - P), S2 = 1 << LS2, NCUR = 1 << (2 * (7 - P));
#pragma unroll 1
    for (int q = 0; q < 2; ++q) {
        const int g = tid + FFT_THREADS * q, blk = g >> LS2, k = g & (S2 - 1), base = blk * NCUR + k;
        cf2 s[16];
#pragma unroll
        for (int i = 0; i < 16; ++i) s[i] = X[fft_dbl_idx<S2>(base, i)];
        const cf2 w1 = fft_w((float)k * (1.0f / (float)NCUR)), w2 = cmul2(w1, w1), w3 = cmul2(w2, w1), v1 = cmul2(w2, w2), v2 = cmul2(v1, v1), v3 = cmul2(v2, v1);
#pragma unroll
        for (int i0 = 0; i0 < 4; ++i0) bfly_fwd_w<true>(s[i0], s[i0 + 4], s[i0 + 8], s[i0 + 12], cmul2(w1, tw32(2 * i0)), cmul2(w2, tw32(4 * i0)), cmul2(w3, tw32(6 * i0)));
#pragma unroll
        for (int m = 0; m < 4; ++m) bfly_fwd_w<true>(s[4 * m], s[4 * m + 1], s[4 * m + 2], s[4 * m + 3], v1, v2, v3);
#pragma unroll
        for (int i = 0; i < 16; ++i) X[fft_dbl_idx<S2>(base, i)] = s[i];
    }
}
template <int P, class PT> FFT_DEV void fft_inv_double(PT X, int tid) {
    FFT_LAUNDER(tid);
    constexpr int LS2 = 2 * (5 - P), S2 = 1 << LS2, NCUR = 1 << (2 * (7 - P));
#pragma unroll 1
    for (int q = 0; q < 2; ++q) {
        const int g = tid + FFT_THREADS * q, blk = g >> LS2, k = g & (S2 - 1), base = blk * NCUR + k;
        cf2 s[16];
#pragma unroll
        for (int i = 0; i < 16; ++i) s[i] = X[fft_dbl_idx<S2>(base, i)];
        const cf2 w1 = fft_w((float)k * (1.0f / (float)NCUR)), w2 = cmul2(w1, w1), w3 = cmul2(w2, w1), v1 = cmul2(w2, w2), v2 = cmul2(v1, v1), v3 = cmul2(v2, v1);
#pragma unroll
        for (int m = 0; m < 4; ++m) bfly_inv_w<true>(s[4 * m], s[4 * m + 1], s[4 * m + 2], s[4 * m + 3], v1, v2, v3);
#pragma unroll
        for (int i0 = 0; i0 < 4; ++i0) bfly_inv_w<true>(s[i0], s[i0 + 4], s[i0 + 8], s[i0 + 12], cmul2(w1, tw32(2 * i0)), cmul2(w2, tw32(4 * i0)), cmul2(w3, tw32(6 * i0)));
#pragma unroll
        for (int i = 0; i < 16; ++i) X[fft_dbl_idx<S2>(base, i)] = s[i];
    }
}
template <class PT> FFT_DEV void fft_load_group(PT X, int g, cf2 (&s)[16]) {
    const int m2 = ((g >> 1) & 7) << 1;
#pragma unroll
    for (int c = 0; c < 8; ++c) { const int e = 16 * g + ((2 * c) ^ m2); s[2 * c] = X[e]; s[2 * c + 1] = X[e + 1]; }
}
template <class PT> FFT_DEV void fft_store_group(PT X, int g, const cf2 (&s)[16]) {
    const int m2 = ((g >> 1) & 7) << 1;
#pragma unroll
    for (int c = 0; c < 8; ++c) { const int e = 16 * g + ((2 * c) ^ m2); X[e] = s[2 * c]; X[e + 1] = s[2 * c + 1]; }
}
FFT_DEV void fft_last2_fwd(cf2 (&s)[16]) {
#pragma unroll
    for (int i0 = 0; i0 < 4; ++i0) bfly_fwd_w<true>(s[i0], s[i0 + 4], s[i0 + 8], s[i0 + 12], tw32(2 * i0), tw32(4 * i0), tw32(6 * i0));
#pragma unroll
    for (int m = 0; m < 4; ++m) bfly_fwd_w<false>(s[4 * m], s[4 * m + 1], s[4 * m + 2], s[4 * m + 3], tw32(0), tw32(0), tw32(0));
}
FFT_DEV void fft_last2_inv(cf2 (&s)[16]) {
#pragma unroll
    for (int m = 0; m < 4; ++m) bfly_inv_w<false>(s[4 * m], s[4 * m + 1], s[4 * m + 2], s[4 * m + 3], tw32(0), tw32(0), tw32(0));
#pragma unroll
    for (int i0 = 0; i0 < 4; ++i0) bfly_inv_w<true>(s[i0], s[i0 + 4], s[i0 + 8], s[i0 + 12], tw32(2 * i0), tw32(4 * i0), tw32(6 * i0));
}
template <class PT, class GP> FFT_DEV void fft_mid_store(PT X, GP G, float scale, float add, int tid) {
    FFT_LAUNDER(tid);
#pragma unroll 1
    for (int q = 0; q < 2; ++q) { const int g = tid + FFT_THREADS * q; cf2 s[16]; fft_load_group(X, g, s); fft_last2_fwd(s);
#pragma unroll
        for (int c = 0; c < 8; ++c) { cf4 w; w.x = (s[2 * c].x + add) * scale; w.y = s[2 * c].y * scale; w.z = (s[2 * c + 1].x + add) * scale; w.w = s[2 * c + 1].y * scale; G[c * 1024 + g] = w; } }
}
template <class PT, class GP> FFT_DEV void fft_mid_mul(PT X, GP G, int tid) {
    FFT_LAUNDER(tid);
#pragma unroll 1
    for (int q = 0; q < 2; ++q) { const int g = tid + FFT_THREADS * q; cf2 s[16]; cf4 w[4];
#pragma unroll
        for (int c = 0; c < 4; ++c) w[c] = G[c * 1024 + g];
        fft_load_group(X, g, s); fft_last2_fwd(s);
#pragma unroll
        for (int h = 0; h < 2; ++h) {
#pragma unroll
            for (int c4 = 0; c4 < 4; ++c4) { const int c = 4 * h + c4; const cf4 wc = w[c4]; if (h == 0) w[c4] = G[(c + 4) * 1024 + g];
                cf2 a = s[2 * c], b = s[2 * c + 1], r; r.x = a.x * wc.x - a.y * wc.y; r.y = a.x * wc.y + a.y * wc.x; s[2 * c] = r;
                r.x = b.x * wc.z - b.y * wc.w; r.y = b.x * wc.w + b.y * wc.z; s[2 * c + 1] = r; } }
        fft_last2_inv(s); fft_store_group(X, g, s); }
}
template <class PT> FFT_DEV void fft_inv_last(PT X, float (&za)[16], float (&zb)[16], int tid) {
    FFT_LAUNDER(tid);
    const cf2 wt1 = fft_w((float)tid * (1.0f / 16384.0f)), wt2 = cmul2(wt1, wt1), wt3 = cmul2(wt2, wt1);
#pragma unroll
    for (int q = 0; q < 8; ++q) {
        const int k = tid + FFT_THREADS * q;
        const int sk = fft_swz(k);
        cf2 a0 = X[sk], a1 = X[sk + 4096], a2 = X[sk + 8192], a3 = X[sk + 12288];
        bfly_inv_w<true>(a0, a1, a2, a3, cmul2(wt1, tw32(q)), cmul2(wt2, tw32(2 * q)), cmul2(wt3, tw32(3 * q)));
        za[q] = a0.x; zb[q] = a0.y; za[q + 8] = a1.x; zb[q + 8] = a1.y;
        FFT_FENCE();
    }
}
template <int Q0, class PT> FFT_DEV void fft_inv_last_part(PT X, float (&za)[8], float (&zb)[8], int tid) {
    FFT_LAUNDER(tid);
    const cf2 wt1 = fft_w((float)tid * (1.0f / 16384.0f)), wt2 = cmul2(wt1, wt1), wt3 = cmul2(wt2, wt1);
#pragma unroll
    for (int q = Q0; q < Q0 + 4; ++q) {
        const int k = tid + FFT_THREADS * q;
        const int sk = fft_swz(k);
        cf2 a0 = X[sk], a1 = X[sk + 4096], a2 = X[sk + 8192], a3 = X[sk + 12288];
        bfly_inv_w<true>(a0, a1, a2, a3, cmul2(wt1, tw32(q)), cmul2(wt2, tw32(2 * q)), cmul2(wt3, tw32(3 * q)));
        za[q - Q0] = a0.x; zb[q - Q0] = a0.y; za[4 + q - Q0] = a1.x; zb[4 + q - Q0] = a1.y;
    }
}
namespace pg8 {
enum { EPI_QK = 0, EPI_T = 1, EPI_RES = 2, EPI_SWIGLU = 3, EPI_DOWN = 4 };
struct EpiAny {
    static constexpr bool PERM = true, AFTER_DRAIN = false;
    int mode, ldc;
    bf16_t* O;
    float* f0; float* f1;
    const float* p0; const float* p1; const float* p2; const float* p3;
    PG8_LAS float* bslot;
    __device__ __forceinline__ void epi_qk(const f32x4 (&acc)[2][2][4][2], const Unit& u, int wr, int wc, int fr, int fq) const {
        const int row0 = u.pm * BM + wr * 64 + fr;
        const bool latent = u.pm < 256;
#pragma unroll
        for (int bj = 0; bj < 2; ++bj) {
            const int cs = u.pn * BM + bj * HALF + wc * 32 + 8 * fq;
            const int hb = cs & ~63, jj = (cs & 63) >> 3;
            const bool isv = u.pn >= 5;
            const f32x4 b0 = *(const f32x4*)(p0 + (isv ? cs : hb + 4 * jj)), b1 = *(const f32x4*)(p0 + (isv ? cs + 4 : hb + 32 + 4 * jj));
#pragma unroll
            for (int ai = 0; ai < 2; ++ai)
#pragma unroll
                for (int m = 0; m < 4; ++m) {
                    const int row = row0 + ai * HALF + m * 16;
                    f32x4 x1 = acc[ai][bj][m][0] + b0, x2 = acc[ai][bj][m][1] + b1;
                    if (latent && !isv) {
                        const float* rp = p1 + ((size_t)(row & 8191) * 32 + 4 * jj) * 2;
                        const f32x4 cs0 = *(const f32x4*)rp, cs1 = *(const f32x4*)(rp + 4);
                        const f32x4 c = (f32x4){cs0[0], cs0[2], cs1[0], cs1[2]}, s = (f32x4){cs0[1], cs0[3], cs1[1], cs1[3]};
                        const f32x4 o1 = x1 * c - x2 * s, o2 = x1 * s + x2 * c; x1 = o1; x2 = o2;
                    }
                    if (u.pn < 4) { x1 *= 0.18033688011112042f; x2 *= 0.18033688011112042f; }
                    u32x4 w; w.x = cvt_pk_bf16(x1[0], x1[1]); w.y = cvt_pk_bf16(x1[2], x1[3]); w.z = cvt_pk_bf16(x2[0], x2[1]); w.w = cvt_pk_bf16(x2[2], x2[3]);
                    *(u32x4*)(O + (size_t)row * 1536 + cs) = w;
                }
        }
    }
    __device__ __forceinline__ void epi_t(const f32x4 (&acc)[2][2][4][2], const Unit& u, int wr, int wc, int fr, int fq) const {
        const int row0 = u.pm * BM + wr * 64 + fr, col0 = u.pn * BM + wc * 32 + 8 * fq;
        float bvs[8];
#pragma unroll
        for (int q = 0; q < 8; ++q) bvs[q] = p0[row0 + (q >> 2) * HALF + (q & 3) * 16];
#pragma unroll
        for (int ai = 0; ai < 2; ++ai)
#pragma unroll
            for (int m = 0; m < 4; ++m) { const int row = row0 + ai * HALF + m * 16; const float bv = bvs[ai * 4 + m]; bf16_t* rowp = O + (size_t)row * ldc + col0;
#pragma unroll
                for (int bj = 0; bj < 2; ++bj) { const f32x4 v0 = acc[ai][bj][m][0] + bv, v1 = acc[ai][bj][m][1] + bv;
                    u32x4 w; w.x = cvt_pk_bf16(v0[0], v0[1]); w.y = cvt_pk_bf16(v0[2], v0[3]); w.z = cvt_pk_bf16(v1[0], v1[1]); w.w = cvt_pk_bf16(v1[2], v1[3]);
                    *(u32x4*)(rowp + bj * HALF) = w; } }
    }
    __device__ __forceinline__ void epi_res(const f32x4 (&acc)[2][2][4][2], const Unit& u, int wr, int wc, int fr, int fq) const {
        const bool latent = u.pm < 256;
        const int row0 = u.pm * BM + wr * 64 + fr, col0 = u.pn * BM + wc * 32 + 8 * fq;
        const float* gp = p3 + (size_t)(latent ? (u.pm >> 5) : 8) * 6144 + col0; const float* bp = p2 + col0;
        const float* srcf = p0 ? (latent ? p0 : p1 - (size_t)TL * 1024) : nullptr;
#pragma unroll
        for (int bj = 0; bj < 2; ++bj) { const f32x4 b0 = *(const f32x4*)(bp + bj * HALF), b1 = *(const f32x4*)(bp + bj * HALF + 4), g0 = *(const f32x4*)(gp + bj * HALF), g1 = *(const f32x4*)(gp + bj * HALF + 4);
#pragma unroll
            for (int ai = 0; ai < 2; ++ai)
#pragma unroll
                for (int m = 0; m < 4; ++m) { const size_t off = (size_t)(row0 + ai * HALF + m * 16) * 1024 + col0 + bj * HALF;
                    f32x4 x0, x1;
                    if (srcf) { x0 = *(const f32x4*)(srcf + off); x1 = *(const f32x4*)(srcf + off + 4); }
                    else { const u32x4 r = *(const u32x4*)(O + off); x0 = (f32x4){__builtin_bit_cast(float, r.x << 16), __builtin_bit_cast(float, r.x & 0xffff0000u), __builtin_bit_cast(float, r.y << 16), __builtin_bit_cast(float, r.y & 0xffff0000u)};
                        x1 = (f32x4){__builtin_bit_cast(float, r.z << 16), __builtin_bit_cast(float, r.z & 0xffff0000u), __builtin_bit_cast(float, r.w << 16), __builtin_bit_cast(float, r.w & 0xffff0000u)}; }
                    const f32x4 v0 = x0 + g0 * (acc[ai][bj][m][0] + b0), v1 = x1 + g1 * (acc[ai][bj][m][1] + b1);
                    u32x4 w; w.x = cvt_pk_bf16(v0[0], v0[1]); w.y = cvt_pk_bf16(v0[2], v0[3]); w.z = cvt_pk_bf16(v1[0], v1[1]); w.w = cvt_pk_bf16(v1[2], v1[3]);
                    *(u32x4*)(O + off) = w; } }
    }
    __device__ __forceinline__ const float* bias_src(const Unit& u, int wc, int lane) const {
        if (mode == EPI_SWIGLU) return p0 + (size_t)((u.pb >> 3) & 31) * 2048 + (lane >> 5) * 1024 + u.pn * HALF + wc * 32 + (lane & 31);
        return p0 + (size_t)((u.pb >> 2) & 31) * 1024 + u.pn * BM + (lane >> 5) * HALF + wc * 32 + (lane & 31);
    }
    __device__ __forceinline__ void epi_swiglu(const f32x4 (&acc)[2][2][4][2], const Unit& u, int wr, int wc, int fr, int fq) const {
        const int e = (u.pb >> 3) & 31;
        const int row0 = u.pm * BM + wr * 64 + fr, col0 = u.pn * HALF + wc * 32 + 8 * fq;
        (void)e;
#pragma unroll
        for (int ai = 0; ai < 2; ++ai)
#pragma unroll
            for (int m = 0; m < 4; ++m) {
                f32x4 a[2];
#pragma unroll
                for (int n = 0; n < 2; ++n) {
                    f32x4 g = acc[ai][0][m][n], up = acc[ai][1][m][n];
#pragma unroll
                    for (int t = 0; t < 4; ++t) { const float gg = fminf(g[t], 7.0f), uu = fminf(fmaxf(up[t], -7.0f), 7.0f);
                        const float sg = __builtin_amdgcn_rcpf(1.0f + __builtin_amdgcn_exp2f(-2.4554669595930157f * gg)); a[n][t] = gg * sg * (uu + 1.0f); }
                }
                u32x4 w; w.x = cvt_pk_bf16(a[0][0], a[0][1]); w.y = cvt_pk_bf16(a[0][2], a[0][3]); w.z = cvt_pk_bf16(a[1][0], a[1][1]); w.w = cvt_pk_bf16(a[1][2], a[1][3]);
                *(u32x4*)(O + (size_t)(row0 + ai * HALF + m * 16) * 1024 + col0) = w;
            }
    }
    __device__ __forceinline__ void epi_down(const f32x4 (&acc)[2][2][4][2], const Unit& u, int wr, int wc, int fr, int fq) const {
        const int e = (u.pb >> 2) & 31;
        const int row0 = u.pm * BM + wr * 64 + fr, col0 = u.pn * BM + wc * 32 + 8 * fq;
        (void)e;
#pragma unroll
        for (int bj = 0; bj < 2; ++bj) {
#pragma unroll
            for (int ai = 0; ai < 2; ++ai)
#pragma unroll
                for (int m = 0; m < 4; ++m) { const f32x4 v0 = acc[ai][bj][m][0], v1 = acc[ai][bj][m][1];
                    u32x4 w; w.x = cvt_pk_bf16(v0[0], v0[1]); w.y = cvt_pk_bf16(v0[2], v0[3]); w.z = cvt_pk_bf16(v1[0], v1[1]); w.w = cvt_pk_bf16(v1[2], v1[3]);
                    *(u32x4*)(O + (size_t)(row0 + ai * HALF + m * 16) * 1024 + col0 + bj * HALF) = w; } }
    }
    __device__ __forceinline__ void operator()(const f32x4 (&acc)[2][2][4][2], const Unit& u, int wr, int wc, int fr, int fq) const {
        if (mode == EPI_QK) epi_qk(acc, u, wr, wc, fr, fq);
        else if (mode == EPI_T) epi_t(acc, u, wr, wc, fr, fq);
        else if (mode == EPI_RES) epi_res(acc, u, wr, wc, fr, fq);
        else if (mode == EPI_SWIGLU) epi_swiglu(acc, u, wr, wc, fr, fq);
        else epi_down(acc, u, wr, wc, fr, fq);
    }
};
struct AnyOrder {
    int moe; StaticOrder so;
    const PG8_LAS int* rb2e; int nblk, lg, wbase;
    __device__ __forceinline__ bool next(int i, Unit& u) const {
        if (!moe) return so.next(i, u);
        const int x = so.c & 7, j = so.c >> 3, per = (so.G >> 3) >> lg;
        const int rb = (i * 8 + x) * per + (j >> lg); if (rb >= nblk) return false;
        const int e = rb2e[rb];
        u.pm = rb; u.pn = j & ((1 << lg) - 1); u.pb = ((wbase + e) << lg) + u.pn; return true;
    }
    __device__ __forceinline__ void a_ready(const Unit&) const {}
    __device__ __forceinline__ void done(const Unit&) const {}
};
}
struct Frame {
    LAS unsigned char* lds;
    volatile LAS unsigned* MISC;
    gu32* ctl;
    int tid, lane, wave;
    int vcu, G, bx;
    const float* const KAS* in;
    float* out; unsigned char* ws;
};
__device__ __forceinline__ float wave_sum(float v) {
#pragma unroll
    for (int o = 1; o < 64; o <<= 1) v += __shfl_xor(v, o);
    return v;
}
__device__ __forceinline__ void block_sum2(Frame& F, LAS float* red, float& a, float& b) {
    a = wave_sum(a); b = wave_sum(b);
    __syncthreads();
    if (F.lane == 0) { red[F.wave * 2] = a; red[F.wave * 2 + 1] = b; }
    __syncthreads();
    float sa = 0.f, sb = 0.f;
#pragma unroll
    for (int w = 0; w < NWAVES; ++w) { sa += red[2 * w]; sb += red[2 * w + 1]; }
    a = sa; b = sb;
}

template <int MODE>
__device__ __forceinline__ void tr_item(const float* W, int N, bf16* WT, bf16* WT2, LAS float* scr, int item, int lane) {
    const int nblk = N / 32, kb = item / nblk, nb = item % nblk, k0 = 64 * kb, n0 = 32 * nb;
#pragma unroll 8
    for (int i = 0; i < 32; ++i) { const int kk = 2 * i + (lane >> 5); scr[kk * 33 + (lane & 31)] = W[(size_t)(k0 + kk) * N + n0 + (lane & 31)]; }
    LDS_WAIT(); asm volatile("" ::: "memory");
    const int c = lane & 7;
#pragma unroll
    for (int j = 0; j < 4; ++j) { const int n = (lane >> 3) + 8 * j; const LAS float* s = scr + (8 * c) * 33 + n;
        const int ns = n0 + n; int d = ns; bf16* dst = WT;
        if (MODE == 1) { const int n2 = ns & 1023; d = 256 * (n2 >> 7) + (n2 & 127) + (ns >= 1024 ? 128 : 0); }
        if (MODE == 2) { if (ns < 1280) { const int hb = ns & ~63, dd = ns & 63, d2 = dd & 31; d = hb + 8 * (d2 >> 2) + (d2 & 3) + (dd >= 32 ? 4 : 0); } }
        v4u o; o.x = pk2(s[0 * 33], s[1 * 33]); o.y = pk2(s[2 * 33], s[3 * 33]); o.z = pk2(s[4 * 33], s[5 * 33]); o.w = pk2(s[6 * 33], s[7 * 33]);
        *(GAS v4u*)(dst + (size_t)d * 1024 + k0 + 8 * c) = o; }
    LDS_WAIT(); asm volatile("" ::: "memory");
}
__device__ __forceinline__ float silu_f(float v) { return v / (1.0f + expf(-v)); }
__device__ __forceinline__ void p0_prologue(Frame& F) {
    const int tid = F.tid, lane = F.lane;
    if (F.bx < 192) {
        LAS float* sv = (LAS float*)F.lds;
        LAS float* part = sv + 1024 * 12;
        for (int i = tid; i < 1024 * 9; i += NWAVES * 64) { const int r = i >> 10, k = i & 1023; const float v = (r < 8) ? F.in[I_C][r * 1024 + k] : F.in[I_CCTX][k]; sv[k * 12 + r] = silu_f(v); }
        __syncthreads();
        const int l = F.bx / 48, n0 = (F.bx % 48) * 128, kb = 128 * F.wave;
        const float* wp = F.in[I_ADAW] + ((size_t)l * 1024 + kb) * 6144 + n0 + 2 * lane;
        float acc0[9], acc1[9];
#pragma unroll
        for (int r = 0; r < 9; ++r) { acc0[r] = 0.f; acc1[r] = 0.f; }
#pragma unroll 1
        for (int k0 = 0; k0 < 128; k0 += 16) { float wx[16], wy[16];
#pragma unroll
            for (int u = 0; u < 16; ++u) { const GAS float* q = (const GAS float*)(wp + (size_t)(k0 + u) * 6144); wx[u] = q[0]; wy[u] = q[1]; }
#pragma unroll
            for (int u = 0; u < 16; ++u) { const LAS float* sk = sv + (kb + k0 + u) * 12;
                const f32x4 s0 = *(const LAS f32x4*)sk, s1 = *(const LAS f32x4*)(sk + 4); const float s8 = sk[8];
#pragma unroll
                for (int r = 0; r < 4; ++r) { acc0[r] += s0[r] * wx[u]; acc1[r] += s0[r] * wy[u]; acc0[4 + r] += s1[r] * wx[u]; acc1[4 + r] += s1[r] * wy[u]; }
                acc0[8] += s8 * wx[u]; acc1[8] += s8 * wy[u]; } }
#pragma unroll
        for (int r = 0; r < 9; ++r) { part[(F.wave * 9 + r) * 128 + 2 * lane] = acc0[r]; part[(F.wave * 9 + r) * 128 + 2 * lane + 1] = acc1[r]; }
        __syncthreads();
        for (int i = tid; i < 9 * 128; i += NWAVES * 64) { const int r = i >> 7, cix = i & 127; float t = F.in[I_ADAB][l * 6144 + n0 + cix];
#pragma unroll
            for (int w = 0; w < NWAVES; ++w) t += part[(w * 9 + r) * 128 + cix];
            ((float*)(F.ws + WS_MOD))[((size_t)l * 9 + r) * 6144 + n0 + cix] = t; }
        __syncthreads();
    }
    if (F.bx >= 192) {
        float* rt = (float*)(F.ws + WS_ROPE);
        for (int e = (F.bx - 192) * 512 + tid; e < 8192 * 32; e += 64 * 512) { const int pos = e >> 5, i = e & 31;
            const float inv = expf(-(float)(i & 15) * (1.0f / 16.0f) * 9.210340371976184f);
            const float ang = (float)((i < 16) ? (pos >> 6) : (pos & 63)) * inv; float sn, cs; sincosf(ang, &sn, &cs);
            rt[2 * e] = cs; rt[2 * e + 1] = sn; }
    }
    const int gw = F.vcu * NWAVES + F.wave, NGW = F.G * NWAVES;
    for (int task = gw; task < 2 * (8192 + 256); task += NGW) {
        const int j = task / 8448, tt = task % 8448; const bool lat = tt < 8192; const int t = lat ? tt : tt - 8192, L = lat ? 8192 : 256;
        float* dst = lat ? (float*)(F.ws + WS_A3L) + ((size_t)j * 8192 + t) * 64 : (float*)(F.ws + WS_A3C) + ((size_t)j * 256 + t) * 64;
        const float tl = (float)t / (float)(L - 1), w = 6.283185307179586f * (float)t / (float)L;
        float z = 0.f;
        if (lane == 0) z = tl;
        else if (lane <= 32) { const int mI = (lane - 1) & 15; const float band = 1e-4f + (float)mI * ((15.0f - 1e-4f) / 15.0f); z = (lane <= 16) ? cosf(band * w) : -sinf(band * w); }
        const float fr = F.in[I_FFREQ][j * 64 + lane];
        const float* w1 = F.in[I_FW1] + (size_t)j * 33 * 64; const float* w2 = F.in[I_FW2] + (size_t)j * 64 * 64; const float* w3 = F.in[I_FW3] + (size_t)j * 64 * 64;
        float a = F.in[I_FB1][j * 64 + lane];
        for (int i = 0; i < 33; ++i) a += __shfl(z, i) * w1[i * 64 + lane];
        a = sinf(fr * a);
        float a2 = F.in[I_FB2][j * 64 + lane];
        for (int k = 0; k < 64; ++k) a2 += __shfl(a, k) * w2[k * 64 + lane];
        a2 = sinf(fr * a2);
        float a3 = F.in[I_FB3][j * 64 + lane];
        for (int k = 0; k < 64; ++k) a3 += __shfl(a2, k) * w3[k * 64 + lane];
        if (lat) ((bf16*)(F.ws + WS_A3L))[(size_t)j * 8192 * 64 + ((((size_t)(t >> 5) * 4 + (lane >> 4)) * 64 + (t & 31) + 32 * ((lane >> 3) & 1)) << 3) + (lane & 7)] = (bf16)f2bf(sinf(fr * a3));
        else dst[lane] = sinf(fr * a3);
    }
    LAS float* scr = (LAS float*)(F.lds + RING_OFF + F.wave * 16384);
    constexpr int NI_GU = 128 * 1024, NI_DN = 128 * 512, NI_QKV = 2 * 768, NI_AO = 2 * 512, NI_HIN = 2 * 1536, NI_HO = 2 * 512;
    constexpr int NITEMS = NI_GU + NI_DN + NI_QKV + NI_AO + NI_HIN + NI_HO;
    for (int it = gw; it < NITEMS; it += NGW) {
        int r = it;
        if (r < NI_GU) { const int mat = r >> 10; tr_item<1>(F.in[I_WGU] + (size_t)mat * 1024 * 2048, 2048, (bf16*)(F.ws + WS_WGU) + (size_t)mat * 2048 * 1024, nullptr, scr, r & 1023, lane); continue; } r -= NI_GU;
        if (r < NI_DN) { const int mat = r >> 9; tr_item<0>(F.in[I_WDN] + (size_t)mat * 1024 * 1024, 1024, (bf16*)(F.ws + WS_WDN) + (size_t)mat * 1024 * 1024, nullptr, scr, r & 511, lane); continue; } r -= NI_DN;
        if (r < NI_QKV) { const int mat = r / 768; tr_item<2>(F.in[I_AWQKV] + (size_t)mat * 1024 * 1536, 1536, (bf16*)(F.ws + WS_WQK) + (size_t)mat * 1536 * 1024, nullptr, scr, r % 768, lane); continue; } r -= NI_QKV;
        if (r < NI_AO) { const int mat = r >> 9; tr_item<0>(F.in[I_AWO] + (size_t)mat * 1024 * 1024, 1024, (bf16*)(F.ws + WS_WAO) + (size_t)mat * 1024 * 1024, nullptr, scr, r & 511, lane); continue; } r -= NI_AO;
        if (r < NI_HIN) { const int mat = r / 1536; tr_item<0>(F.in[I_HWIN] + (size_t)mat * 1024 * 3072, 3072, (bf16*)(F.ws + WS_WHIN) + (size_t)mat * 3072 * 1024, nullptr, scr, r % 1536, lane); continue; } r -= NI_HIN;
        { const int mat = r >> 9; tr_item<0>(F.in[I_HWO] + (size_t)mat * 1024 * 1024, 1024, (bf16*)(F.ws + WS_WHO) + (size_t)mat * 1024 * 1024, nullptr, scr, r & 511, lane); }
    }
}

__device__ __forceinline__ void row8_unpack(const v4u w, f32x4& a, f32x4& b) { a = (f32x4){bflo(w.x), bfhi(w.x), bflo(w.y), bfhi(w.y)}; b = (f32x4){bflo(w.z), bfhi(w.z), bflo(w.w), bfhi(w.w)}; }
__device__ __forceinline__ v4u row8_pack(const f32x4 a, const f32x4 b) { v4u w; w.x = pk2(a.x, a.y); w.y = pk2(a.z, a.w); w.z = pk2(b.x, b.y); w.w = pk2(b.z, b.w); return w; }
#define ROW8_F32(ptr, jj, hf, lane) (((const f32x4*)(ptr))[128 * (jj) + 2 * (lane) + (hf)])
__device__ __forceinline__ void norm_mod_store(Frame& F, const f32x4 (&v)[4], const float* gain, const float* shift, const float* scale, bf16* orow) {
    float s2 = 0.f;
#pragma unroll
    for (int j = 0; j < 4; ++j) s2 += (v[j].x * v[j].x + v[j].y * v[j].y) + (v[j].z * v[j].z + v[j].w * v[j].w);
    const float rstd = 1.0f / sqrtf(wave_sum(s2) * (1.0f / D) + NORM_EPS);
#pragma unroll
    for (int jj = 0; jj < 2; ++jj) { f32x4 h[2];
#pragma unroll
        for (int hf = 0; hf < 2; ++hf) h[hf] = v[2 * jj + hf] * rstd * ROW8_F32(gain, jj, hf, F.lane) * (ROW8_F32(scale, jj, hf, F.lane) + 1.0f) + ROW8_F32(shift, jj, hf, F.lane);
        ((GAS v4u*)orow)[64 * jj + F.lane] = row8_pack(h[0], h[1]); }
}
__device__ __forceinline__ int mod_row(int row) { return row < TL ? (row >> 13) : 8; }
__device__ __forceinline__ int rows_of_layer(int l) { return l >= 2 ? TL : TT; }
__device__ __forceinline__ void norm0_phase(Frame& F) {
    const int gw = F.vcu * NWAVES + F.wave, NGW = F.G * NWAVES;
    const float* mod = (const float*)(F.ws + WS_MOD);
    for (int row = gw; row < TT; row += NGW) {
        const float* xr = row < TL ? F.in[I_X] + (size_t)row * D : F.in[I_CTX] + (size_t)(row - TL) * D;
        f32x4 v[4];
#pragma unroll
        for (int j = 0; j < 4; ++j) v[j] = ((const GAS f32x4*)xr)[128 * (j >> 1) + 2 * F.lane + (j & 1)];
        const float* mr = mod + (size_t)mod_row(row) * 6144;
        norm_mod_store(F, v, F.in[I_NMIX], mr, mr + 1024, (bf16*)(F.ws + WS_H) + (size_t)row * D);
    }
}

__device__ __forceinline__ void attn_phase(Frame& F, int j, int nunits) {
    const bf16* QK = (const bf16*)(F.ws + WS_QK); bf16* O = (bf16*)(F.ws + WS_O);
    const float* sinks = F.in[I_ASINK] + j * 16;
    LAS bf16* Ks0 = (LAS bf16*)(F.lds);
    const int w = F.wave, lane = F.lane, r = lane & 31, h = lane >> 5, tid = F.tid;
    float snk[4];
#pragma unroll
    for (int i = 0; i < 4; ++i) snk[i] = sinks[4 * i + (w >> 1)];
    for (int u = F.vcu; u < nunits; u += F.G) {
        int b, kvh, q0; const bool isctx = u >= 4096;
        if (!isctx) { b = u >> 9; kvh = (u >> 7) & 3; q0 = (u & 127) * 64; } else { const int u2 = u - 4096; b = u2 >> 4; kvh = (u2 >> 2) & 3; q0 = (u2 & 3) * 64; }
        const int head = kvh * 4 + (w >> 1), qrow = q0 + 32 * (w & 1) + r;
        const size_t tokq = isctx ? (size_t)TL + b * CTXL + qrow : (size_t)b * SEQ + qrow;
        const bf16* qp = QK + tokq * QKD + head * 64 + 8 * h;
        v4u bqv[4];
#pragma unroll
        for (int s = 0; s < 4; ++s) asm volatile("global_load_dwordx4 %0, %1, off" : "=&v"(bqv[s]) : "v"((const GAS v4u*)(qp + 16 * s)) : "memory");
        float m = (kvh == 0 ? snk[0] : kvh == 1 ? snk[1] : kvh == 2 ? snk[2] : snk[3]) * 1.4426950408889634f, l = 1.0f;
        f32x16 o0, o1;
#pragma unroll
        for (int i = 0; i < 16; ++i) { o0[i] = 0.f; o1[i] = 0.f; }
        const int jl0 = isctx ? 0 : (q0 >= 128 ? 0 : (128 - q0) >> 6), jl1 = isctx ? 0 : (q0 + 192 <= SEQ ? 5 : (SEQ + 128 - q0) >> 6), nl = jl1 - jl0, ntile = nl + 4;
        const int srow = tid >> 3, sch = tid & 7;
#define ATT_KEY0(i) ((i) < nl ? (size_t)b * SEQ + (q0 - 128 + 64 * (jl0 + (i))) : (size_t)TL + b * CTXL + 64 * ((i) - nl))
#define ATT_LOAD(kv, vv, i) do { const size_t kt_ = ATT_KEY0(i); const GAS v4u* pk_ = (const GAS v4u*)(QK + (kt_ + srow) * QKD + 1024 + kvh * 64 + sch * 8); const GAS v4u* pv_ = (const GAS v4u*)(QK + (kt_ + lane) * QKD + 1280 + kvh * 64 + w * 8); \
            asm volatile("global_load_dwordx4 %0, %2, off\n\tglobal_load_dwordx4 %1, %3, off" : "=&v"(kv), "=&v"(vv) : "v"(pk_), "v"(pv_) : "memory"); } while (0)
#define ATT_WAIT2() asm volatile("s_waitcnt vmcnt(2)" ::: "memory")
#define ATT_WRITE(kv, vv, bufi) do { LAS bf16* ks_ = Ks0 + (bufi) * 9216; LAS bf16* vs_ = ks_ + 4608; *(LAS v4u*)(ks_ + srow * 72 + sch * 8) = kv;     \
            LAS bf16* vd = vs_ + (w * 8) * 72 + lane; \
            vd[0] = (bf16)(vv.x & 0xffffu); vd[72] = (bf16)(vv.x >> 16); vd[144] = (bf16)(vv.y & 0xffffu); vd[216] = (bf16)(vv.y >> 16); \
            vd[288] = (bf16)(vv.z & 0xffffu); vd[360] = (bf16)(vv.z >> 16); vd[432] = (bf16)(vv.w & 0xffffu); vd[504] = (bf16)(vv.w >> 16); } while (0)
        v4u kvA, vvA, kvB, vvB;
        ATT_LOAD(kvA, vvA, 0);
        ATT_LOAD(kvB, vvB, 1);
        ATT_WAIT2();
        asm volatile("" : "+v"(bqv[0]), "+v"(bqv[1]), "+v"(bqv[2]), "+v"(bqv[3]));
        ATT_WRITE(kvA, vvA, 0);
        ATT_LOAD(kvA, vvA, 2);
        __syncthreads();
        auto tile_step = [&](const int it, v4u& kvN, v4u& vvN) __attribute__((always_inline)) {
            const int cur = it & 1;
            const bool local = it < nl; const int kp0 = q0 - 128 + 64 * (jl0 + it);
            const LAS bf16* Ks = Ks0 + cur * 9216; const LAS bf16* Vs = Ks + 4608;
            if (it + 1 < ntile) { ATT_WAIT2(); ATT_WRITE(kvN, vvN, cur ^ 1); }
            { const int i3 = it + 3 < ntile ? it + 3 : ntile - 1; ATT_LOAD(kvN, vvN, i3); }
            f32x16 st0, st1;
#pragma unroll
            for (int i = 0; i < 16; ++i) { st0[i] = 0.f; st1[i] = 0.f; }
#pragma unroll
            for (int s = 0; s < 4; ++s) {
                const bf16x8 a0 = *(const LAS bf16x8*)(Ks + r * 72 + 16 * s + 8 * h), a1 = *(const LAS bf16x8*)(Ks + (32 + r) * 72 + 16 * s + 8 * h);
                st0 = __builtin_amdgcn_mfma_f32_32x32x16_bf16(a0, __builtin_bit_cast(bf16x8, bqv[s]), st0, 0, 0, 0);
                st1 = __builtin_amdgcn_mfma_f32_32x32x16_bf16(a1, __builtin_bit_cast(bf16x8, bqv[s]), st1, 0, 0, 0);
            }
            const bool edge = local && (jl0 + it == 0 || jl0 + it == 4);
            if (edge) {
                const int dq = qrow - kp0 - 4 * h;
#pragma unroll
                for (int i = 0; i < 16; ++i) { const int d0 = dq - ((i & 3) + 8 * (i >> 2)), d1 = d0 - 32;
                    st0[i] = ((unsigned)(d0 + 128) > 256u) ? -1e30f : st0[i]; st1[i] = ((unsigned)(d1 + 128) > 256u) ? -1e30f : st1[i]; }
            }
            float mx = fmaxf(st0[0], st1[0]);
#pragma unroll
            for (int i = 1; i < 16; ++i) mx = __builtin_fmaxf(__builtin_fmaxf(mx, st0[i]), st1[i]);
            mx = fmaxf(mx, __shfl_xor(mx, 32));
            const float mn = fmaxf(m, mx), alpha = __builtin_amdgcn_exp2f(m - mn); m = mn;
#pragma unroll
            for (int i = 0; i < 16; ++i) { st0[i] = __builtin_amdgcn_exp2f(st0[i] - mn); st1[i] = __builtin_amdgcn_exp2f(st1[i] - mn); }
            f32x16 lsum;
#pragma unroll
            for (int i = 0; i < 16; ++i) lsum[i] = 0.f;
            if (!__all(alpha == 1.0f)) {
#pragma unroll
                for (int i = 0; i < 16; ++i) { o0[i] *= alpha; o1[i] *= alpha; } }
#pragma unroll
            for (int sp = 0; sp < 4; ++sp) {
                unsigned pw[4];
#pragma unroll
                for (int e = 0; e < 4; ++e) { const int i0 = 8 * (sp & 1) + 2 * e; pw[e] = (sp < 2) ? pg8::cvt_pk_bf16(st0[i0], st0[i0 + 1]) : pg8::cvt_pk_bf16(st1[i0], st1[i0 + 1]); }
                const bf16x8 pf = __builtin_bit_cast(bf16x8, (v4u){pw[0], pw[1], pw[2], pw[3]});
                lsum = __builtin_amdgcn_mfma_f32_32x32x16_bf16(__builtin_bit_cast(bf16x8, (v4u){0x3f803f80u, 0x3f803f80u, 0x3f803f80u, 0x3f803f80u}), pf, lsum, 0, 0, 0);
#pragma unroll
                for (int dt = 0; dt < 2; ++dt) {
                    const LAS bf16* vp = Vs + (32 * dt + r) * 72 + 16 * sp + 4 * h;
                    const v2u va = *(const LAS v2u*)vp, vb = *(const LAS v2u*)(vp + 8);
                    const bf16x8 vf = __builtin_bit_cast(bf16x8, (v4u){va.x, va.y, vb.x, vb.y});
                    if (dt == 0) o0 = __builtin_amdgcn_mfma_f32_32x32x16_bf16(vf, pf, o0, 0, 0, 0); else o1 = __builtin_amdgcn_mfma_f32_32x32x16_bf16(vf, pf, o1, 0, 0, 0);
                }
            }
            l = l * alpha + lsum[0];
            __syncthreads();
        };
#pragma unroll 1
        for (int it = 0;; it += 2) {
            tile_step(it, kvB, vvB);
            if (it + 1 >= ntile) break;
            tile_step(it + 1, kvA, vvA);
            if (it + 2 >= ntile) break;
        }
#undef ATT_KEY0
#undef ATT_WAIT2
#undef ATT_LOAD
#undef ATT_WRITE
        const float inv = 1.0f / l;
        bf16* op = O + tokq * D + head * 64 + 4 * h;
#pragma unroll
        for (int g = 0; g < 4; ++g) {
            v2u w0, w1; w0.x = pg8::cvt_pk_bf16(o0[4 * g] * inv, o0[4 * g + 1] * inv); w0.y = pg8::cvt_pk_bf16(o0[4 * g + 2] * inv, o0[4 * g + 3] * inv);
            w1.x = pg8::cvt_pk_bf16(o1[4 * g] * inv, o1[4 * g + 1] * inv); w1.y = pg8::cvt_pk_bf16(o1[4 * g + 2] * inv, o1[4 * g + 3] * inv);
            *(GAS v2u*)(op + 8 * g) = w0; *(GAS v2u*)(op + 32 + 8 * g) = w1;
        }
    }
}
__device__ __forceinline__ float sconv3(const bf16* p, int n, int L, float w0, float w1, float w2, float cb) {
    const float a = (n > 0) ? bf2f(p[n - 1]) : 0.f, b = bf2f(p[n]), c = (n < L - 1) ? bf2f(p[n + 1]) : 0.f;
    return cb + w0 * a + w1 * b + w2 * c;
}
struct HyRaw { v4u raw[4]; unsigned short lf[4], rt[4]; };
__device__ __forceinline__ void hy_stage_load(const bf16* p, HyRaw& R, int tid) {
#pragma unroll
    for (int ch = 0; ch < 2; ++ch)
#pragma unroll
        for (int b = 0; b < 2; ++b) {
            const int n0 = 8 * tid + 4096 * ch; const bf16* pb = p + (size_t)b * SEQ;
            R.raw[2 * ch + b] = *(const GAS v4u*)(pb + n0);
            R.lf[2 * ch + b] = n0 > 0 ? pb[n0 - 1] : (unsigned short)0; R.rt[2 * ch + b] = n0 + 8 < SEQ ? pb[n0 + 8] : (unsigned short)0;
        }
}
__device__ __forceinline__ void hy_stage_write(const HyRaw& R, float w0, float w1, float w2, float cb, LAS float* S, int tid) {
#pragma unroll
    for (int ch = 0; ch < 2; ++ch)
#pragma unroll
        for (int b = 0; b < 2; ++b) {
            const int n0 = 8 * tid + 4096 * ch; const v4u raw = R.raw[2 * ch + b];
            float x[10]; x[0] = bf2f(R.lf[2 * ch + b]); x[1] = bflo(raw.x); x[2] = bfhi(raw.x); x[3] = bflo(raw.y); x[4] = bfhi(raw.y); x[5] = bflo(raw.z); x[6] = bfhi(raw.z); x[7] = bflo(raw.w); x[8] = bfhi(raw.w); x[9] = bf2f(R.rt[2 * ch + b]);
            f32x4 lo, hi;
#pragma unroll
            for (int e = 0; e < 4; ++e) { lo[e] = cb + w0 * x[e] + w1 * x[e + 1] + w2 * x[e + 2]; hi[e] = cb + w0 * x[e + 4] + w1 * x[e + 5] + w2 * x[e + 6]; }
            *(LAS f32x4*)(S + b * 8192 + n0) = lo; *(LAS f32x4*)(S + b * 8192 + n0 + 4) = hi;
        }
}
__device__ __forceinline__ void hyena_phase(Frame& F, int j, bool with_ctx) {
    LAS cf2* X = (LAS cf2*)F.lds;
    LAS float* red = (LAS float*)(F.lds + USER_OFF + 1024);
    const int tid0 = F.tid;
    const bf16* Ut = (const bf16*)(F.ws + WS_UT); bf16* Zt = (bf16*)(F.ws + WS_ZT);
    const bf16* a3b = (const bf16*)(F.ws + WS_A3L) + (size_t)j * 8192 * 64; const float* a3c = (const float*)(F.ws + WS_A3C) + (size_t)j * 256 * 64;
    const float* wout = F.in[I_FWOUT] + (size_t)j * 64 * 4096; const float* convw = F.in[I_HCW] + (size_t)j * 3 * 3072; const float* convb = F.in[I_HCB] + (size_t)j * 3072;
    const float* biasd = F.in[I_HBD] + (size_t)j * 2 * 1024;
    LAS float* U4 = (LAS float*)(F.lds + USER_OFF + 2048);
    LAS float* nrm = (LAS float*)(F.lds + USER_OFF + 1536);
    LAS float* red8 = (LAS float*)(F.lds + USER_OFF + 1280);
#ifndef PROBE_HY_TAPS
#define PROBE_HY_TAPS 1
#endif
#pragma unroll 1
    for (int cc0 = 0; cc0 < 4; ++cc0) { const int c = F.vcu + 256 * cc0;
        if (cc0 == 0)
    {
        int tid = tid0; asm volatile("" : "+v"(tid));
        __syncthreads();
        for (int i = tid; i < 1024; i += NWAVES * 64) { const int cc = i >> 8, k = (i >> 2) & 63, q = i & 3; U4[i] = wout[(size_t)k * 4096 + q * 1024 + F.vcu + 256 * cc]; }
        __syncthreads();
        const int n = tid & 31, h = (tid >> 5) & 1, wv = tid >> 6, q = n & 3, cc = (n >> 2) & 3, sb = n >> 4, c = F.vcu + 256 * cc;
        bf16x8 bw[4];
#pragma unroll
        for (int f4 = 0; f4 < 4; ++f4) { unsigned pw[4];
#pragma unroll
            for (int e = 0; e < 4; ++e) { const int k0 = 16 * f4 + 8 * h + 2 * e; pw[e] = pk2(U4[cc * 256 + 4 * k0 + q], U4[cc * 256 + 4 * (k0 + 1) + q]); }
            bw[f4] = __builtin_bit_cast(bf16x8, (v4u){pw[0], pw[1], pw[2], pw[3]}); }
        const bf16x8 zero8 = __builtin_bit_cast(bf16x8, (v4u){0u, 0u, 0u, 0u});
        const float na = -(3.0701134573253945f + (15.350567286626973f - 3.0701134573253945f) * (float)c * (1.0f / 1023.0f)) * (1.0f / 8191.0f);
        const float r1 = expf(na), r2 = expf(2.0f * na), r3 = expf(3.0f * na);
        float sm = 0.f;
        float* tq = (float*)(F.ws + WS_TP) + (size_t)c * 2 * FFT_N + (size_t)(q & 1) * FFT_N + (q >> 1) * 8192;
#pragma unroll 1
        for (int i = 0; i < 16; ++i) {
            const int T0 = 64 * (wv + 8 * i);
            const bf16* ap = a3b + (size_t)T0 * 64 + 8 * (tid & 63);
            f32x16 acc;
#pragma unroll
            for (int e = 0; e < 16; ++e) acc[e] = 0.f;
#pragma unroll
            for (int s8 = 0; s8 < 2; ++s8)
#pragma unroll
                for (int f4 = 0; f4 < 4; ++f4)
                    acc = __builtin_amdgcn_mfma_f32_32x32x16_bf16(*(const GAS bf16x8*)(ap + (s8 * 4 + f4) * 512), sb == s8 ? bw[f4] : zero8, acc, 0, 0, 0);
#pragma unroll
            for (int g = 0; g < 4; ++g) { const int t = T0 + 32 * sb + 8 * g + 4 * h; const float d0 = expf(na * (float)t);
                f32x4 val = (f32x4){acc[4 * g] * d0, acc[4 * g + 1] * (d0 * r1), acc[4 * g + 2] * (d0 * r2), acc[4 * g + 3] * (d0 * r3)};
                sm += ((q >= 2 && t == 0) ? 0.f : fabsf(val.x)) + fabsf(val.y) + fabsf(val.z) + fabsf(val.w);
                *(GAS f32x4*)(tq + t) = val; }
        }
        sm += __shfl_xor(sm, 2); sm += __shfl_xor(sm, 16); sm += __shfl_xor(sm, 32);
        if ((tid & 50) == 0) red8[wv * 8 + 2 * cc + (q & 1)] = sm;
        __syncthreads();
        if (tid < 8) { float t8 = 0.f;
#pragma unroll
            for (int w = 0; w < NWAVES; ++w) t8 += red8[w * 8 + tid]; nrm[tid] = t8; }
        VM_WAIT();
        __syncthreads();
    }
        int tid = tid0; asm volatile("" : "+v"(tid));
        float* tp = (float*)(F.ws + WS_TP) + (size_t)c * 2 * FFT_N;
        float* Gc = (float*)(F.ws + WS_G) + (size_t)c * 2 * FFT_N * 2;
        __syncthreads();
        const float sum0 = nrm[2 * cc0], sum1 = nrm[2 * cc0 + 1];
        LAS float* U = U4 + cc0 * 256;
        const float absd = 3.0701134573253945f + (15.350567286626973f - 3.0701134573253945f) * (float)c * (1.0f / 1023.0f);
#pragma unroll 1
#ifndef PROBE_HY_SPEC
#define PROBE_HY_SPEC 2
#endif
        for (int o4 = 0; o4 < PROBE_HY_SPEC; ++o4) { const int o = o4 & 1;
            fft_fwd_first_taps(X, (const GAS float*)(tp + (size_t)o * FFT_N), 1.0f / (o == 0 ? sum0 : sum1), tid); __syncthreads();
            fft_fwd_double<1>(X, tid); __syncthreads();
            fft_fwd_double<3>(X, tid); __syncthreads();
            fft_mid_store(X, (GAS cf4*)(Gc + (size_t)o * FFT_N * 2), 1.0f / (float)FFT_N, biasd[o * 1024 + c], tid); __syncthreads();
        }
        VM_WAIT();
        __syncthreads();
        const float cwv0 = convw[2048 + c], cwv1 = convw[3072 + 2048 + c], cwv2 = convw[6144 + 2048 + c], cbv = convb[2048 + c];
        const float cwa0 = convw[c], cwa1 = convw[3072 + c], cwa2 = convw[6144 + c], cba = convb[c];
        const float cwb0 = convw[1024 + c], cwb1 = convw[3072 + 1024 + c], cwb2 = convw[6144 + 1024 + c], cbb = convb[1024 + c];
        const float d0 = biasd[c], d1 = biasd[1024 + c];
#ifndef PROBE_HY_PAIRS
#define PROBE_HY_PAIRS 4
#endif
        HyRaw rv, rg;
        hy_stage_load(Ut + (size_t)(2048 + c) * TT, rv, tid);
#pragma unroll 1
        for (int pr8 = 0; pr8 < PROBE_HY_PAIRS; ++pr8) { const int pr = pr8 & 3;
            const size_t tb0 = (size_t)(2 * pr) * SEQ;
            LAS float* S = (LAS float*)F.lds;
            float z0[16], z1[16];
            __syncthreads();
            hy_stage_write(rv, cwv0, cwv1, cwv2, cbv, S, tid); __syncthreads();
#pragma unroll
            for (int i = 0; i < 16; ++i) { z0[i] = S[tid + 512 * i]; z1[i] = S[8192 + tid + 512 * i]; }
#pragma unroll 1
            for (int o = 0; o < 2; ++o) {
                __syncthreads();
                fft_fwd_first(X, z0, z1, tid);
                hy_stage_load(Ut + (size_t)(o == 0 ? c : 1024 + c) * TT + tb0, rg, tid);
                if (o == 1) hy_stage_load(Ut + (size_t)(2048 + c) * TT + (size_t)(2 * ((pr8 + 1) & 3)) * SEQ, rv, tid);
                __syncthreads();
                fft_fwd_double<1>(X, tid); __syncthreads();
                fft_fwd_double<3>(X, tid); __syncthreads();
                fft_mid_mul(X, (const GAS cf4*)(Gc + (size_t)o * FFT_N * 2), tid); __syncthreads();
                fft_inv_double<3>(X, tid); __syncthreads();
                fft_inv_double<1>(X, tid); __syncthreads();
                fft_inv_last(X, z0, z1, tid); __syncthreads();
                hy_stage_write(rg, o == 0 ? cwa0 : cwb0, o == 0 ? cwa1 : cwb1, o == 0 ? cwa2 : cwb2, o == 0 ? cba : cbb, S, tid); __syncthreads();
#pragma unroll
                for (int i = 0; i < 16; ++i) { z0[i] *= S[tid + 512 * i]; z1[i] *= S[8192 + tid + 512 * i]; }
            }
            __syncthreads();
#pragma unroll
            for (int i = 0; i < 16; ++i) { S[tid + 512 * i] = z0[i]; S[8192 + tid + 512 * i] = z1[i]; }
            __syncthreads();
#pragma unroll
            for (int ch = 0; ch < 2; ++ch)
#pragma unroll
                for (int b = 0; b < 2; ++b) { const int n0 = 8 * tid + 4096 * ch; const f32x4 lo = *(const LAS f32x4*)(S + b * 8192 + n0), hi = *(const LAS f32x4*)(S + b * 8192 + n0 + 4);
                    v4u w; w.x = pk2(lo.x, lo.y); w.y = pk2(lo.z, lo.w); w.z = pk2(hi.x, hi.y); w.w = pk2(hi.z, hi.w);
                    *(GAS v4u*)(Zt + (size_t)c * TT + tb0 + (size_t)b * SEQ + n0) = w; }
        }
        if (!with_ctx) continue;
        asm volatile("" : "+v"(tid));
        __syncthreads();
        LAS float* tap0 = (LAS float*)F.lds; LAS float* tap1 = tap0 + 512; LAS float* vb = tap0 + 1024; LAS float* zb = tap0 + 1024 + 2048;
        {
            float f0 = 0.f, f1 = 0.f, b0 = 0.f, b1 = 0.f, s0 = 0.f, s1 = 0.f;
            if (tid < 256) { const int t = tid; const GAS f32x4* ar = (const GAS f32x4*)(a3c + (size_t)t * 64); f32x4 acc = (f32x4){0.f, 0.f, 0.f, 0.f};
#pragma unroll 4
                for (int k4 = 0; k4 < 16; ++k4) { const f32x4 a = ar[k4];
                    acc += a[0] * *(const LAS f32x4*)(U + 16 * k4) + a[1] * *(const LAS f32x4*)(U + 16 * k4 + 4) + a[2] * *(const LAS f32x4*)(U + 16 * k4 + 8) + a[3] * *(const LAS f32x4*)(U + 16 * k4 + 12); }
                const float dec = expf(-((float)t * (1.0f / 255.0f)) * absd);
                f0 = acc[0] * dec; f1 = acc[1] * dec; b0 = acc[2] * dec; b1 = acc[3] * dec;
                s0 = fabsf(f0) + (t > 0 ? fabsf(b0) : 0.f); s1 = fabsf(f1) + (t > 0 ? fabsf(b1) : 0.f); }
            block_sum2(F, red, s0, s1);
            if (tid < 256) { const float i0 = 1.0f / s0, i1 = 1.0f / s1; tap0[256 + tid] = f0 * i0; tap1[256 + tid] = f1 * i1; if (tid > 0) { tap0[256 - tid] = b0 * i0; tap1[256 - tid] = b1 * i1; } else { tap0[0] = 0.f; tap1[0] = 0.f; } }
        }
        const int cb_ = tid >> 6, n0 = (tid & 63) * 4;
        const size_t tcx = (size_t)TL + (size_t)cb_ * CTXL;
        float vloc[4], zloc[4];
        { const bf16* pv = Ut + (size_t)(2048 + c) * TT + tcx;
#pragma unroll
          for (int e = 0; e < 4; ++e) { vloc[e] = sconv3(pv, n0 + e, CTXL, cwv0, cwv1, cwv2, cbv); vb[cb_ * 256 + n0 + e] = vloc[e]; } }
        __syncthreads();
        { const bf16* pa = Ut + (size_t)c * TT + tcx; float acc[4] = {0.f, 0.f, 0.f, 0.f};
          for (int mI = 0; mI < 256; ++mI) { const float vv = vb[cb_ * 256 + mI];
#pragma unroll
              for (int e = 0; e < 4; ++e) acc[e] += tap0[256 + n0 + e - mI] * vv; }
#pragma unroll
          for (int e = 0; e < 4; ++e) { zloc[e] = sconv3(pa, n0 + e, CTXL, cwa0, cwa1, cwa2, cba) * (acc[e] + vloc[e] * d0); zb[cb_ * 256 + n0 + e] = zloc[e]; } }
        __syncthreads();
        { const bf16* pb = Ut + (size_t)(1024 + c) * TT + tcx; float acc[4] = {0.f, 0.f, 0.f, 0.f};
          for (int mI = 0; mI < 256; ++mI) { const float vv = zb[cb_ * 256 + mI];
#pragma unroll
              for (int e = 0; e < 4; ++e) acc[e] += tap1[256 + n0 + e - mI] * vv; }
#pragma unroll
          for (int e = 0; e < 4; ++e) { const float ov = sconv3(pb, n0 + e, CTXL, cwb0, cwb1, cwb2, cbb) * (acc[e] + zloc[e] * d1); Zt[(size_t)c * TT + tcx + n0 + e] = (bf16)f2bf(ov); } }
    }
}
__device__ __forceinline__ void transpose_phase(Frame& F, int ncols) {
    const bf16* Zt = (const bf16*)(F.ws + WS_ZT); bf16* Z = (bf16*)(F.ws + WS_O);
    LAS bf16* T = (LAS bf16*)(F.lds + F.wave * 16384);
    const int gw = F.vcu * NWAVES + F.wave, NGW = F.G * NWAVES, lane = F.lane;
    for (int item = gw; item < 16 * (ncols / 64); item += NGW) {
        const int ct = item & 15, tt = item >> 4;
#pragma unroll
        for (int i = 0; i < 8; ++i) { const int cr = (lane >> 3) + 8 * i, ch = lane & 7;
            const v4u v = *(const GAS v4u*)(Zt + (size_t)(ct * 64 + cr) * TT + (size_t)tt * 64 + ch * 8); *(LAS v4u*)(T + cr * 72 + ch * 8) = v; }
        LDS_WAIT(); asm volatile("" ::: "memory");
#pragma unroll
        for (int i = 0; i < 8; ++i) { const int tok = (lane >> 3) + 8 * i, cc = (lane & 7) * 8;
            unsigned short e[8];
#pragma unroll
            for (int q = 0; q < 8; ++q) e[q] = T[(cc + q) * 72 + tok];
            v4u o; o.x = e[0] | ((unsigned)e[1] << 16); o.y = e[2] | ((unsigned)e[3] << 16); o.z = e[4] | ((unsigned)e[5] << 16); o.w = e[6] | ((unsigned)e[7] << 16);
            *(GAS v4u*)(Z + (size_t)(tt * 64 + tok) * D + ct * 64 + cc) = o; }
        LDS_WAIT(); asm volatile("" ::: "memory");
    }
}

__device__ __forceinline__ void router_phase(Frame& F, int l) {
    const int nrows = rows_of_layer(l);
    constexpr int RR = 6;
    LAS bf16* Whi = (LAS bf16*)F.lds; LAS bf16* Wlo = Whi + 32 * 1024;
    LAS int* cnt = (LAS int*)(F.lds + USER_OFF); LAS int* base = cnt + 32; LAS int* rec = cnt + 64;
    const int tid = F.tid, lane = F.lane, wave = F.wave;
    const float* rw = F.in[I_RW] + (size_t)l * 1024 * 32;
    __syncthreads();
#pragma unroll 1
    for (int i0 = tid; i0 < 1024 * 32; i0 += 16 * NWAVES * 64) { float wv[16];
#pragma unroll
        for (int u = 0; u < 16; ++u) wv[u] = rw[i0 + u * NWAVES * 64];
#pragma unroll
        for (int u = 0; u < 16; ++u) { const int i = i0 + u * NWAVES * 64, k = i >> 5, e = i & 31; const float w = wv[u]; const unsigned hi = f2bf(w), lo = f2bf(w - bflo(hi));
            const int idx = e * 1024 + ((((k >> 3) ^ (e & 15)) << 3) | (k & 7)); Whi[idx] = (bf16)hi; Wlo[idx] = (bf16)lo; } }
    if (tid < 32) cnt[tid] = 0;
    __syncthreads();
    const float* mod = (const float*)(F.ws + WS_MOD) + (size_t)l * 9 * 6144;
    const float* gain = F.in[I_NFFN] + (size_t)l * D;
    const int gw = F.vcu * NWAVES + wave, NGW = F.G * NWAVES;
    bf16* H = (bf16*)(F.ws + WS_H);
#ifndef PROBE_RT_NORM
#define PROBE_RT_NORM 1
#endif
#pragma unroll 1
    for (int rep = 0; rep < PROBE_RT_NORM; ++rep)
    for (int row0 = gw; row0 < nrows; row0 += RR * NGW) {
        f32x4 v[RR][4]; float s2[RR];
#pragma unroll
        for (int r = 0; r < RR; ++r) { const int row = row0 + r * NGW < nrows ? row0 + r * NGW : row0;
            const GAS v4u* xr = (const GAS v4u*)((const bf16*)(F.ws + WS_XB) + (size_t)row * D) + lane;
#pragma unroll
            for (int jj = 0; jj < 2; ++jj) row8_unpack(xr[64 * jj], v[r][2 * jj], v[r][2 * jj + 1]); }
#pragma unroll
        for (int r = 0; r < RR; ++r) { s2[r] = 0.f;
#pragma unroll
            for (int jj = 0; jj < 4; ++jj) s2[r] += (v[r][jj].x * v[r][jj].x + v[r][jj].y * v[r][jj].y) + (v[r][jj].z * v[r][jj].z + v[r][jj].w * v[r][jj].w); }
#pragma unroll
        for (int o = 1; o < 64; o <<= 1) {
#pragma unroll
            for (int r = 0; r < RR; ++r) s2[r] += __shfl_xor(s2[r], o); }
#pragma unroll
        for (int r = 0; r < RR; ++r) { const int row = row0 + r * NGW < nrows ? row0 + r * NGW : row0;
            const float rstd = 1.0f / sqrtf(s2[r] * (1.0f / D) + NORM_EPS);
            const float* mr = mod + (size_t)mod_row(row) * 6144;
#pragma unroll
            for (int jj = 0; jj < 2; ++jj) { f32x4 hq[2];
#pragma unroll
                for (int hf = 0; hf < 2; ++hf) hq[hf] = v[r][2 * jj + hf] * rstd * ROW8_F32(gain, jj, hf, lane) * (ROW8_F32(mr + 4 * 1024, jj, hf, lane) + 1.0f) + ROW8_F32(mr + 3 * 1024, jj, hf, lane);
                ((GAS v4u*)(H + (size_t)row * D))[64 * jj + lane] = row8_pack(hq[0], hq[1]); } }
    }
    VM_WAIT();
    asm volatile("" ::: "memory");
    const int r32 = lane & 31, hh2 = lane >> 5;
    const float rb = F.in[I_RB][l * 32 + r32];
    const int nmine = (nrows - gw + NGW - 1) / NGW;
    for (int tile = 0; tile * 32 < nmine; ++tile) {
        const int irow = 32 * tile + r32; const size_t arow = (size_t)gw + (size_t)NGW * (irow < nmine ? irow : 0);
        const bf16* ap = H + arow * D + 8 * hh2;
        const LAS bf16* bh = Whi + r32 * 1024; const LAS bf16* bl = Wlo + r32 * 1024;
        f32x16 acc;
#pragma unroll
        for (int i = 0; i < 16; ++i) acc[i] = 0.f;
#pragma unroll 1
        for (int s0 = 0; s0 < 64; s0 += 32) {
            bf16x8 a[32];
#pragma unroll
            for (int u = 0; u < 32; ++u) a[u] = *(const GAS bf16x8*)(ap + 16 * (s0 + u));
            __builtin_amdgcn_sched_barrier(0);
#pragma unroll
            for (int u = 0; u < 32; ++u) {
                const int cb = ((2 * (s0 + u) + hh2) ^ (r32 & 15)) << 3;
                const bf16x8 b1 = *(const LAS bf16x8*)(bh + cb), b2 = *(const LAS bf16x8*)(bl + cb);
                acc = __builtin_amdgcn_mfma_f32_32x32x16_bf16(a[u], b1, acc, 0, 0, 0);
                acc = __builtin_amdgcn_mfma_f32_32x32x16_bf16(a[u], b2, acc, 0, 0, 0);
            }
            __builtin_amdgcn_sched_barrier(0);
        }
#pragma unroll 2
        for (int i = 0; i < 16; ++i) {
            if (32 * tile + (i & 3) + 8 * (i >> 2) >= nmine) continue;
            const float mine = acc[i] + rb; int rank = 0;
#pragma unroll 8
            for (int e2 = 0; e2 < 32; ++e2) { const float sv = __shfl(mine, (lane & 32) | e2); rank += (sv > mine || (sv == mine && e2 < r32)) ? 1 : 0; }
            const int rr = (i & 3) + 8 * (i >> 2);
#pragma unroll
            for (int hsel = 0; hsel < 2; ++hsel) {
                const int it = 32 * tile + rr + 4 * hsel;
                float tv[4]; int te[4];
#pragma unroll
                for (int k = 0; k < 4; ++k) { const unsigned long long mk = __ballot(rank == k) & (hsel ? 0xffffffff00000000ull : 0x00000000ffffffffull); const int src = __ffsll((long long)mk) - 1;
                    te[k] = src & 31; tv[k] = __builtin_bit_cast(float, __builtin_amdgcn_readlane(__builtin_bit_cast(int, mine), src)); }
                if (it < nmine) {
                    const size_t row = (size_t)gw + (size_t)NGW * it;
                    const float e1 = __expf(tv[1] - tv[0]), e2 = __expf(tv[2] - tv[0]), e3 = __expf(tv[3] - tv[0]), isum = 1.0f / (1.0f + e1 + e2 + e3);
                    if (lane == 0) *(GAS f32x4*)((float*)(F.ws + WS_GATE) + row * 4) = (f32x4){isum, e1 * isum, e2 * isum, e3 * isum};
                    if (lane < 4) { const int tel = lane == 0 ? te[0] : lane == 1 ? te[1] : lane == 2 ? te[2] : te[3];
                        const int rk = __hip_atomic_fetch_add(cnt + tel, 1, __ATOMIC_RELAXED, __HIP_MEMORY_SCOPE_WORKGROUP); rec[(wave * 64 + it) * 4 + lane] = tel | (rk << 8); }
                }
            }
        }
    }
    __syncthreads();
    if (tid < 32) base[tid] = (int)__hip_atomic_fetch_add((unsigned*)(F.ctl + CW_ECNT + l * 32 + tid), (unsigned)cnt[tid], RLX_AGENT);
    __syncthreads();
    for (int it = 0; it < nmine; ++it) {
        if (lane < 4) { const int rc = rec[(wave * 64 + it) * 4 + lane], e = rc & 255; ((int*)(F.ws + WS_POS))[((size_t)gw + (size_t)NGW * it) * 4 + lane] = e | ((base[e] + (rc >> 8)) << 8); }
    }
}
__device__ __forceinline__ void load_blkstart(Frame& F, int l, LAS int* blkstart) {
    __syncthreads();
    if (F.tid < 32) {
        const unsigned c = __hip_atomic_load((unsigned*)(F.ctl + CW_ECNT + l * 32 + F.tid), RLX_AGENT); const int nb = (int)((c + 255u) >> 8); int s = nb;
#pragma unroll
        for (int o = 1; o < 32; o <<= 1) { const int t = __shfl_up(s, o); if (F.tid >= o) s += t; }
        blkstart[F.tid] = s - nb; if (F.tid == 31) blkstart[32] = s; }
    __syncthreads();
    for (int rb = F.tid; rb < MAXBLK; rb += NWAVES * 64) { int e = 0;
#pragma unroll 1
        for (int q = 1; q < 32; ++q) e += (blkstart[q] <= rb) ? 1 : 0;
        blkstart[64 + rb] = e; }
    __syncthreads();
}
__device__ __forceinline__ void index_phase(Frame& F, int l) {
    const int nrows = rows_of_layer(l);
    LAS int* blkstart = (LAS int*)(F.lds + USER_OFF + 8192);
    load_blkstart(F, l, blkstart);
    const int* POS = (const int*)(F.ws + WS_POS); int* DEST = (int*)(F.ws + WS_DEST); int* RSRC = (int*)(F.ws + WS_RSRC);
    const int gt = F.vcu * (NWAVES * 64) + F.tid, NT = F.G * NWAVES * 64;
    for (int a = gt; a < nrows * 4; a += NT) { const int pk = POS[a], e = pk & 255, rk = pk >> 8, d = blkstart[e] * 256 + rk; DEST[a] = d; RSRC[d] = a >> 2; }
    if (F.bx < 32) { const int e = F.bx; const int cnt = (int)__hip_atomic_load((unsigned*)(F.ctl + CW_ECNT + l * 32 + e), RLX_AGENT), end = (blkstart[e + 1] - blkstart[e]) * 256;
        for (int p2 = cnt + F.tid; p2 < end; p2 += NWAVES * 64) RSRC[blkstart[e] * 256 + p2] = 0; }
}
__device__ __forceinline__ void combine_phase(Frame& F, int l, bool dry = false) {
    constexpr int RR = 3;
    const int gw = F.vcu * NWAVES + F.wave, NGW = F.G * NWAVES, lane = F.lane;
    const bf16* YS = (const bf16*)(F.ws + WS_YS); const int* POS = (const int*)(F.ws + WS_DEST); const float* GT = (const float*)(F.ws + WS_GATE);
    const float* mod = (const float*)(F.ws + WS_MOD);
    const int nrows = rows_of_layer(l);
    v4i psn[RR]; f32x4 gtn[RR];
#pragma unroll
    for (int r = 0; r < RR; ++r) { const int rw = gw + r * NGW < nrows ? gw + r * NGW : gw; psn[r] = *(const GAS v4i*)(POS + (size_t)rw * 4); gtn[r] = *(const GAS f32x4*)(GT + (size_t)rw * 4); }
    for (int row0 = gw; row0 < nrows; row0 += RR * NGW) {
        v4i ps[RR]; f32x4 gt[RR]; f32x4 v[RR][4]; int rows[RR];
#pragma unroll
        for (int r = 0; r < RR; ++r) { rows[r] = row0 + r * NGW < nrows ? row0 + r * NGW : row0; ps[r] = psn[r]; gt[r] = gtn[r]; }
        { const int nx0 = row0 + RR * NGW < nrows ? row0 + RR * NGW : row0;
#pragma unroll
          for (int r = 0; r < RR; ++r) { const int rw = nx0 + r * NGW < nrows ? nx0 + r * NGW : nx0; psn[r] = *(const GAS v4i*)(POS + (size_t)rw * 4); gtn[r] = *(const GAS f32x4*)(GT + (size_t)rw * 4); } }
#pragma unroll
        for (int r = 0; r < RR; ++r) { const int row = rows[r];
            const GAS v4u* xr = (const GAS v4u*)((const bf16*)(F.ws + WS_XB) + (size_t)row * D) + lane;
            const float* g2 = mod + ((size_t)l * 9 + mod_row(row)) * 6144 + 5 * 1024;
#pragma unroll
            for (int jj = 0; jj < 2; ++jj) {
                f32x4 y0 = (f32x4){0.f, 0.f, 0.f, 0.f}, y1 = y0;
#pragma unroll
                for (int k = 0; k < 4; ++k) { f32x4 a, b; row8_unpack(*(const GAS v4u*)(YS + (size_t)ps[r][k] * D + 512 * jj + 8 * lane), a, b); y0 += gt[r][k] * a; y1 += gt[r][k] * b; }
                f32x4 xa, xb2; row8_unpack(xr[64 * jj], xa, xb2);
                v[r][2 * jj] = xa + ROW8_F32(g2, jj, 0, lane) * y0; v[r][2 * jj + 1] = xb2 + ROW8_F32(g2, jj, 1, lane) * y1;
            } }
#pragma unroll
        for (int r = 0; r < RR; ++r) { const int row = rows[r];
            if (r > 0 && row0 + r * NGW >= nrows) continue;
            bf16* xw = (bf16*)(F.ws + (dry ? WS_ACT : WS_XB)) + (size_t)row * D; bf16* hw = (bf16*)(F.ws + (dry ? WS_ACT + 270 * MiB : WS_H)) + (size_t)row * D;
            if (l < DEPTH - 1) {
#pragma unroll
                for (int jj = 0; jj < 2; ++jj) ((GAS v4u*)xw)[64 * jj + lane] = row8_pack(v[r][2 * jj], v[r][2 * jj + 1]);
                const float* mr = mod + ((size_t)(l + 1) * 9 + mod_row(row)) * 6144;
                norm_mod_store(F, v[r], F.in[I_NMIX] + (size_t)(l + 1) * D, mr, mr + 1024, hw);
            } else {
                float s2 = 0.f;
#pragma unroll
                for (int jj = 0; jj < 4; ++jj) s2 += (v[r][jj].x * v[r][jj].x + v[r][jj].y * v[r][jj].y) + (v[r][jj].z * v[r][jj].z + v[r][jj].w * v[r][jj].w);
                const float rstd = 1.0f / sqrtf(wave_sum(s2) * (1.0f / D) + NORM_EPS);
#pragma unroll
                for (int q = 0; q < 4; ++q) ((GAS f32x4*)(dry ? (float*)(F.ws + WS_ACT) + (size_t)row * D : F.out + (size_t)row * D))[128 * (q >> 1) + 2 * lane + (q & 1)] = v[r][q] * rstd * ROW8_F32(F.in[I_FNORM], q >> 1, q & 1, lane);
            }
        }
    }
}
constexpr int N_PHASES = 1 + 10 * DEPTH;
#ifndef PG8_SP2
#define PG8_SP2 true
#endif
#ifndef PG8_ALIGN_EPI
#define PG8_ALIGN_EPI true
#endif
__host__ __device__ inline bool phase_exists(int ph) { if (ph == 0) return true; const int l = (ph - 1) / 10, k = (ph - 1) % 10; return !((k == 0 && l != 0) || (k == 3 && (l & 1) == 0)); }
struct Args { const float* in[N_IN]; float* out; unsigned char* ws; int ph_lo, ph_hi, use_bar, pad; };
__global__ void __launch_bounds__(NWAVES * 64, 2) fwd_kernel(Args args) {
    extern __shared__ __attribute__((aligned(16))) unsigned char lds[];
    Frame F;
    F.lds = (LAS unsigned char*)lds;
    F.MISC = (volatile LAS unsigned*)(F.lds + MISC_OFF);
    F.tid = threadIdx.x; F.lane = F.tid & 63; F.wave = __builtin_amdgcn_readfirstlane(F.tid >> 6);
    F.G = gridDim.x; { const int bx = blockIdx.x; F.vcu = (F.G % 8 == 0) ? (bx % 8) * (F.G / 8) + bx / 8 : bx; }
    const KAS Args* ap = (const KAS Args*)__builtin_amdgcn_kernarg_segment_ptr();
    F.in = ap->in; F.out = ap->out; F.ws = ap->ws;
    F.ctl = (gu32*)(F.ws + WS_CTL);
    const int use_bar = ap->use_bar;
    for (int u = F.tid; u < (USER_OFF - LDSCTL_OFF) / 4; u += NWAVES * 64) ((LAS unsigned*)(F.lds + LDSCTL_OFF))[u] = 0u;
    __syncthreads();
    XcdBarrier bar; bar.bar = (unsigned*)(F.ctl + CW_BAR); bar.x = 0; bar.st = nullptr;
    if (use_bar) bar = xcd_barrier_post((unsigned*)(F.ctl + CW_BAR), F.MISC + 8);
    const int hi = ap->ph_hi;
    LAS int* blkstart = (LAS int*)(F.lds + USER_OFF + 8192);
#ifndef PROBE_REP_MASK
#define PROBE_REP_MASK 0
#define PROBE_REP_KIND 2
#endif
    int rep_done = 0;
#pragma unroll 1
    for (int ph = ap->ph_lo; ph < hi; ++ph) {
        if (!phase_exists(ph)) continue;
        { int t_ = threadIdx.x; asm volatile("" : "+v"(t_)); F.tid = t_; F.lane = t_ & 63; F.wave = __builtin_amdgcn_readfirstlane(t_ >> 6);
          const KAS Args* a_ = ap; asm volatile("" : "+s"(a_)); F.in = a_->in;
          unsigned char* w_ = a_->ws; asm volatile("" : "+s"(w_)); F.ws = w_; float* o_ = a_->out; asm volatile("" : "+s"(o_)); F.out = o_;
          int v_ = F.vcu; asm volatile("" : "+s"(v_)); F.vcu = v_; int g_ = (int)gridDim.x; asm volatile("" : "+s"(g_)); F.G = g_; int b_ = (int)blockIdx.x; asm volatile("" : "+s"(b_)); F.bx = b_; }
        const int l = ph == 0 ? 0 : (ph - 1) / 10, k = ph == 0 ? -1 : (ph - 1) % 10, kind = l & 1, j = l >> 1;
        if (k == -1) {
#ifndef NO_P0
            p0_prologue(F);
#endif
        }
        else if (k == 0) norm0_phase(F);
        else if (k == 2) {
#ifndef NO_ATTN
            if (kind == 0) attn_phase(F, j, l == 0 ? 4096 + 128 : 4096);
#endif
#ifndef NO_HY
            if (kind == 1) hyena_phase(F, j, l == 1);
#endif
        }
#ifndef NO_TR
        else if (k == 3) transpose_phase(F, rows_of_layer(l));
#endif
#ifndef NO_ROUTER
        else if (k == 5) router_phase(F, l);
#endif
#ifndef NO_GATHER
        else if (k == 6) index_phase(F, l);
#endif
#ifndef NO_COMB
        else if (k == 9) combine_phase(F, l, ((PROBE_REP_MASK >> 10) & 1) != 0 && !rep_done);
#endif
        else if (k == 1 || k == 4 || k == 7 || k == 8) {
            pg8::Gemm g; pg8::AnyOrder S; pg8::EpiAny E;
            S.moe = 0; S.rb2e = blkstart + 64; S.nblk = 0; S.lg = 0; S.wbase = l * 32;
            E.bslot = (PG8_LAS float*)(F.lds + USER_OFF); E.ldc = TT; E.O = nullptr; E.f0 = nullptr; E.f1 = nullptr; E.p0 = nullptr; E.p1 = nullptr; E.p2 = nullptr; E.p3 = nullptr;
            if (k == 1 && kind == 0) {
                g = pg8::Gemm{(const bf16*)(F.ws + WS_H), (const bf16*)(F.ws + WS_WQK) + (size_t)j * QKD * 1024, TT, QKD, D}; S.so.init(TT, QKD, F.G, F.bx);
                E.mode = pg8::EPI_QK; E.O = (bf16*)(F.ws + WS_QK); E.p0 = F.in[I_ABQKV] + (size_t)j * 1536; E.p1 = (const float*)(F.ws + WS_ROPE);
            } else if (k == 1) {
                g = pg8::Gemm{(const bf16*)(F.ws + WS_WHIN) + (size_t)j * 3072 * 1024, (const bf16*)(F.ws + WS_H), 3072, rows_of_layer(l), D}; S.so.init(3072, rows_of_layer(l), F.G, F.bx);
                E.mode = pg8::EPI_T; E.O = (bf16*)(F.ws + WS_UT); E.p0 = F.in[I_HBIN] + (size_t)j * 3072;
            } else if (k == 4) {
                g = pg8::Gemm{(const bf16*)(F.ws + WS_O), kind == 0 ? (const bf16*)(F.ws + WS_WAO) + (size_t)j * 1024 * 1024 : (const bf16*)(F.ws + WS_WHO) + (size_t)j * 1024 * 1024, rows_of_layer(l), D, D};
                S.so.init(rows_of_layer(l), D, F.G, F.bx);
                E.mode = pg8::EPI_RES; E.p0 = l == 0 ? F.in[I_X] : nullptr; E.p1 = l == 0 ? F.in[I_CTX] : nullptr; E.O = (bf16*)(F.ws + WS_XB);
                E.p2 = kind == 0 ? F.in[I_ABO] + (size_t)j * 1024 : F.in[I_HBO] + (size_t)j * 1024; E.p3 = (const float*)(F.ws + WS_MOD) + (size_t)l * 9 * 6144 + 2 * 1024;
            } else {
                load_blkstart(F, l, blkstart);
                S.moe = 1; S.nblk = blkstart[32]; S.so.G = F.G; S.so.c = F.bx; S.so.nM = 0; S.so.nN = 0; S.so.nwg = 0;
                if (k == 7) { g = pg8::Gemm{(const bf16*)(F.ws + WS_H), (const bf16*)(F.ws + WS_WGU), MAXROWS, 2048, D, (const int*)(F.ws + WS_RSRC)}; S.lg = 3; E.mode = pg8::EPI_SWIGLU; E.O = (bf16*)(F.ws + WS_ACT); E.p0 = F.in[I_BGU] + (size_t)l * 32 * 2048; }
                else { g = pg8::Gemm{(const bf16*)(F.ws + WS_ACT), (const bf16*)(F.ws + WS_WDN), MAXROWS, 1024, D}; S.lg = 2; E.mode = pg8::EPI_DOWN; E.O = (bf16*)(F.ws + WS_YS); E.p0 = F.in[I_BDN] + (size_t)l * 32 * 1024; }
            }
#ifndef NO_G1
            pg8::gemm_phase<pg8::EpiAny, pg8::AnyOrder, PG8_ALIGN_EPI, PG8_SP2>(F.lds + RING_OFF, g, S, E);
#endif
        }
        if (use_bar && ph != N_PHASES - 1) xcd_barrier(bar);
#ifdef PROBE_DOUBLE_BAR
        if (use_bar && ph != N_PHASES - 1) xcd_barrier(bar);
#endif
        if (PROBE_REP_MASK != 0) { if (((PROBE_REP_MASK >> (k + 1)) & 1) && (PROBE_REP_KIND == 2 || kind == PROBE_REP_KIND) && !rep_done) { rep_done = 1; --ph;
                if (k == 5) { if (F.bx == 0 && F.tid < 32) __hip_atomic_store((unsigned*)(F.ctl + CW_ECNT + l * 32 + F.tid), 0u, RLX_AGENT); xcd_barrier(bar); }
            } else rep_done = 0; }
    }
}

extern "C" void kernel_launch(void* const* d_in, const int* in_sizes, int n_in, void* d_out, int out_size, void* d_ws, size_t ws_size, hipStream_t stream) {
    static int grid = 0;
    if (grid == 0) {
        if (n_in != N_IN || out_size != TL * D || ws_size < WS_END) { fprintf(stderr, "kernel_launch: unexpected shapes (n_in %d, out %d, ws %zu < %zu)\n", n_in, out_size, ws_size, (size_t)WS_END); grid = -1; return; }
        if (hipFuncSetAttribute((const void*)fwd_kernel, hipFuncAttributeMaxDynamicSharedMemorySize, LDS_BYTES) != hipSuccess) { fprintf(stderr, "kernel_launch: hipFuncSetAttribute failed\n"); grid = -1; return; }
        int per_cu = 0;
        if (hipOccupancyMaxActiveBlocksPerMultiprocessor(&per_cu, (const void*)fwd_kernel, NWAVES * 64, LDS_BYTES) != hipSuccess || per_cu < 1) fprintf(stderr, "kernel_launch: occupancy query says %d\n", per_cu);
        (void)hipGetLastError();
        grid = 256;
    }
    if (grid < 0) return;
    if (hipMemsetAsync((char*)d_ws + WS_CTL, 0, CTL_ZERO_BYTES, stream) != hipSuccess) return;
    Args a{};
    for (int i = 0; i < N_IN; ++i) a.in[i] = (const float*)d_in[i];
    a.out = (float*)d_out; a.ws = (unsigned char*)d_ws; a.pad = 0;
#if MK_ONE_LAUNCH
    a.ph_lo = 0; a.ph_hi = N_PHASES; a.use_bar = 1;
    hipLaunchKernelGGL(fwd_kernel, dim3(grid), dim3(NWAVES * 64), LDS_BYTES, stream, a);
#else
    for (int ph = 0; ph < N_PHASES; ++ph) {
        if (!phase_exists(ph)) continue;
        a.ph_lo = ph; a.ph_hi = ph + 1; a.use_bar = 0;
        hipLaunchKernelGGL(fwd_kernel, dim3(grid), dim3(NWAVES * 64), LDS_BYTES, stream, a);
    }
#endif
}
```

```cpp
#include <hip/hip_runtime.h>
#include <cstdio>
#include <cstdint>
#include <cmath>
#define MK_ONE_LAUNCH 1
namespace pg8 {
#define PG8_LAS __attribute__((address_space(3)))
typedef unsigned short bf16_t;
typedef short bf16x8 __attribute__((ext_vector_type(8)));
typedef float f32x4 __attribute__((ext_vector_type(4)));
typedef unsigned u32x4 __attribute__((ext_vector_type(4)));
constexpr int BM = 256, BK = 64, HALF = 128, HTB = HALF * BK * 2  , STAGE_BYTES = 8 * HTB, NXCD = 8, WGM = 8;

__host__ __device__ __forceinline__ int lds_byte(int r, int c) { const int st = (r >> 4) * 2 + (c >> 5), rr = r & 15, cc = c & 31, ob = rr * 64 + cc * 2; return st * 1024 + (ob ^ (((ob >> 9) & 1) << 5)); }
__host__ __device__ __forceinline__ void stage_rc(int b, int& R, int& C) { const int st = b / 1024, sb = b % 1024, swz = sb ^ (((sb >> 9) & 1) << 5); R = (st >> 1) * 16 + swz / 64; C = (st & 1) * 32 + (swz % 64) / 2; }
__host__ __device__ __forceinline__ int perm32(int rho) { const int n = rho >> 4, i = rho & 15; return 8 * (i >> 2) + 4 * n + (i & 3); }

struct Unit { int pm, pn, pb; };
struct Gemm { const bf16_t* A; const bf16_t* Bt; int M, N, K; const int* rows; };
struct StaticOrder {
    int nM, nN, nwg, G, c;
    __host__ __device__ void init(int M, int N, int G_, int c_) { nM = M / BM; nN = N / BM; nwg = nM * nN; G = G_; c = c_; }
    __host__ __device__ bool next(int i, Unit& u) const {
        const long L = (long)i * G + c; if (L >= nwg) return false;
        int wgid = (int)L; { const int q = nwg / NXCD, r = nwg % NXCD, xcd = wgid % NXCD, off = wgid / NXCD; wgid = (xcd < r ? xcd * (q + 1) : r * (q + 1) + (xcd - r) * q) + off; }
        const int nig = WGM * nN, gid = wgid / nig, fm = gid * WGM, gsz = (nM - fm) < WGM ? (nM - fm) : WGM;
        u.pm = fm + ((wgid % nig) % gsz); u.pn = (wgid % nig) / gsz; u.pb = u.pn; return true;
    }
    __device__ __forceinline__ void a_ready(const Unit&) const {}
    __device__ __forceinline__ void done(const Unit&) const {}
};
__device__ __forceinline__ unsigned cvt_pk_bf16(float lo, float hi) { unsigned r; asm volatile("v_cvt_pk_bf16_f32 %0, %1, %2" : "=v"(r) : "v"(lo), "v"(hi)); return r; }
typedef float f32x2 __attribute__((ext_vector_type(2)));
#define PG8_STR2(x) #x
#define PG8_STR(x) PG8_STR2(x)
template <class Epi, class Sched, bool ALIGN_EPI = false, bool SP2 = false>
__device__ __forceinline__ void gemm_phase(PG8_LAS unsigned char* lds, const Gemm g, const Sched& S, const Epi& E) {
    int tid_ = threadIdx.x; asm volatile("" : "+v"(tid_));
    const int tid = tid_, wid = __builtin_amdgcn_readfirstlane(tid >> 6), lane = tid & 63, wr = wid >> 2, wc = wid & 3, fr = lane & 15, fq = lane >> 4;
    const int K = g.K, nt = K / BK;
    unsigned roffA[4], voffB[2];
#pragma unroll
    for (int i = 0; i < 2; ++i) { int R, C; stage_rc(tid * 16 + i * 8192, R, C); const int Rb = Epi::PERM ? ((R & ~31) + perm32(R & 31)) : R;
        roffA[i] = (unsigned)(R * K + C) * 2u; roffA[2 + i] = (unsigned)((R + HALF) * K + C) * 2u; voffB[i] = (unsigned)(Rb * K + C) * 2u; }
    const size_t kstep = (size_t)(BK * 2);
    const size_t hstep = (size_t)HALF * K * 2;
    const size_t tstep = 2 * hstep;
    const unsigned ldsw = (unsigned)wid * 1024u;
    const int aoff = lds_byte(wr * 64 + fr, fq * 8), boff = lds_byte(wc * 32 + fr, fq * 8);
#define PG8_SA(b, h) (((b) * 2 + (h)) * HTB)
#define PG8_SB(b, h) ((4 + (b) * 2 + (h)) * HTB)
#define PG8_STAGE(bufoff, gbase, voff) do { _Pragma("unroll") for (int _i = 0; _i < 2; ++_i) \
        __builtin_amdgcn_global_load_lds((const unsigned*)((const char*)(gbase) + (voff)[_i]), (PG8_LAS unsigned*)(lds + (bufoff) + ldsw + _i * 8192), 16, 0, 0); } while (0)
#define PG8_STAGEA(bufoff, gbase, h) do { _Pragma("unroll") for (int _i = 0; _i < 2; ++_i) \
        __builtin_amdgcn_global_load_lds((const unsigned*)((const char*)(gbase) + roffA[2 * (h) + _i]), (PG8_LAS unsigned*)(lds + (bufoff) + ldsw + _i * 8192), 16, 0, 0); } while (0)
#define PG8_LDA(dst, b, h) do { _Pragma("unroll") for (int m = 0; m < 4; ++m) _Pragma("unroll") for (int k = 0; k < 2; ++k) dst[m][k] = *(const PG8_LAS bf16x8*)(lds + PG8_SA(b, h) + aoff + m * 2048 + k * 1024); } while (0)
#define PG8_LDB(dst, b, h) do { _Pragma("unroll") for (int n = 0; n < 2; ++n) _Pragma("unroll") for (int k = 0; k < 2; ++k) dst[n][k] = *(const PG8_LAS bf16x8*)(lds + PG8_SB(b, h) + boff + n * 2048 + k * 1024); } while (0)
#define PG8_MMA(ai, bj, At, Bt) do { __builtin_amdgcn_s_setprio(1); _Pragma("unroll") for (int m = 0; m < 4; ++m) _Pragma("unroll") for (int n = 0; n < 2; ++n) _Pragma("unroll") for (int k = 0; k < 2; ++k) \
        acc[ai][bj][m][n] = __builtin_amdgcn_mfma_f32_16x16x32_bf16(Bt[n][k], At[m][k], acc[ai][bj][m][n], 0, 0, 0); __builtin_amdgcn_s_setprio(0); } while (0)
#define PG8_WAIT_V(n) asm volatile("s_waitcnt vmcnt(" #n ")" ::: "memory")
#define PG8_WAIT_L(n) asm volatile("s_waitcnt lgkmcnt(" #n ")" ::: "memory")
#define PG8_BAR __builtin_amdgcn_s_barrier()
#define PG8_SCHED __builtin_amdgcn_sched_barrier(0)
    Unit cur, nxt; int ui = 0;
    if (!S.next(0, cur)) return;
    f32x4 acc[2][2][4][2];
#define PG8_ACC_INIT() do { if (E.mode >= 3) { const PG8_LAS float* bs_ = E.bslot + wid * 64 + 8 * fq; \
            const f32x4 b00_ = *(const PG8_LAS f32x4*)bs_, b01_ = *(const PG8_LAS f32x4*)(bs_ + 4), b10_ = *(const PG8_LAS f32x4*)(bs_ + 32), b11_ = *(const PG8_LAS f32x4*)(bs_ + 36); \
            _Pragma("unroll") for (int a = 0; a < 2; ++a) _Pragma("unroll") for (int m = 0; m < 4; ++m) { acc[a][0][m][0] = b00_; acc[a][0][m][1] = b01_; acc[a][1][m][0] = b10_; acc[a][1][m][1] = b11_; } \
        } else { _Pragma("unroll") for (int a = 0; a < 2; ++a) _Pragma("unroll") for (int b = 0; b < 2; ++b) _Pragma("unroll") for (int m = 0; m < 4; ++m) _Pragma("unroll") for (int n = 0; n < 2; ++n) acc[a][b][m][n] = (f32x4){0.f, 0.f, 0.f, 0.f}; } } while (0)
    if (E.mode >= 3) { __builtin_amdgcn_global_load_lds((const unsigned*)E.bias_src(cur, wc, lane), (PG8_LAS unsigned*)(E.bslot + wid * 64), 4, 0, 0); PG8_WAIT_V(0); }
    PG8_ACC_INIT();
    bf16x8 At[4][2], B0[2][2], B1[2][2];
    const __attribute__((address_space(1))) int* const rows = (const __attribute__((address_space(1))) int*)g.rows; const int r0g = (wid >> 1) * 16 + (lane >> 2); const unsigned cb2g = roffA[0] - (unsigned)(r0g * K) * 2u;
#define PG8_ROWS(dst, pm_) do { _Pragma("unroll") for (int _j = 0; _j < 4; ++_j) dst[_j] = (unsigned)rows[(size_t)(pm_) * BM + r0g + 64 * _j] * (unsigned)(K * 2) + cb2g; } while (0)
    if (rows) { unsigned t4[4]; PG8_ROWS(t4, cur.pm); roffA[0] = t4[0]; roffA[1] = t4[1]; roffA[2] = t4[2]; roffA[3] = t4[3]; }
    const char* cA = rows ? (const char*)g.A : (const char*)g.A + (size_t)cur.pm * tstep; const char* cB = (const char*)g.Bt + (size_t)cur.pb * tstep;
    S.a_ready(cur);
    if constexpr (SP2) {
        PG8_STAGE(PG8_SB(0, 0), cB, voffB); PG8_STAGE(PG8_SB(0, 1), cB + hstep, voffB); PG8_STAGEA(PG8_SA(0, 0), cA, 0); PG8_STAGEA(PG8_SA(0, 1), cA, 1);
        if (wr == 1) PG8_BAR;
        PG8_WAIT_V(2); PG8_BAR;
        PG8_STAGE(PG8_SB(1, 0), cB + kstep, voffB); PG8_STAGEA(PG8_SA(1, 0), cA + kstep, 0); PG8_STAGE(PG8_SB(1, 1), cB + hstep + kstep, voffB);
        PG8_WAIT_V(6); PG8_BAR;
    } else {
        PG8_STAGE(PG8_SB(0, 0), cB, voffB); PG8_STAGEA(PG8_SA(0, 0), cA, 0); PG8_STAGE(PG8_SB(0, 1), cB + hstep, voffB); PG8_STAGEA(PG8_SA(0, 1), cA, 1);
        if (wr == 1) PG8_BAR;
        PG8_WAIT_V(4); PG8_BAR;
        PG8_STAGE(PG8_SB(1, 0), cB + kstep, voffB); PG8_STAGEA(PG8_SA(1, 0), cA + kstep, 0); PG8_STAGE(PG8_SB(1, 1), cB + hstep + kstep, voffB);
        PG8_WAIT_V(6); PG8_BAR;
    }
    unsigned nr4[4] = {0u, 0u, 0u, 0u};
    for (;;) {
        const bool has_next = S.next(ui + 1, nxt);
        const char* nA = (has_next && !rows) ? (const char*)g.A + (size_t)nxt.pm * tstep : cA; const char* nB = has_next ? (const char*)g.Bt + (size_t)nxt.pb * tstep : cB;
#ifdef PG8_LOOP_ALIGN
        asm volatile(".p2align " PG8_STR(PG8_LOOP_ALIGN));
#endif
        for (int t = 0; t < nt; t += 2) {
            const bool last = (t == nt - 2);
            const char* a1 = cA + (size_t)(t + 1) * kstep;
            const char* a2 = last ? nA : cA + (size_t)(t + 2) * kstep; const char* b2 = last ? nB : cB + (size_t)(t + 2) * kstep;
            const char* a3 = a2 + kstep; const char* b3 = b2 + kstep;
            if (last && has_next) S.a_ready(nxt);
            const bool swap_rows = rows != nullptr && last && has_next;
            if (E.mode >= 3 && has_next && t == nt - 4)
                __builtin_amdgcn_global_load_lds((const unsigned*)E.bias_src(nxt, wc, lane), (PG8_LAS unsigned*)(E.bslot + wid * 64), 4, 0, 0);
            if (rows != nullptr && has_next && t == nt - 4) {
                const __attribute__((address_space(1))) int* rp = rows + (size_t)nxt.pm * BM + r0g;
                asm volatile("global_load_dword %0, %4, off\n\tglobal_load_dword %1, %4, off offset:256\n\tglobal_load_dword %2, %4, off offset:512\n\tglobal_load_dword %3, %4, off offset:768"
                             : "=&v"(nr4[0]), "=&v"(nr4[1]), "=&v"(nr4[2]), "=&v"(nr4[3]) : "v"(rp) : "memory"); }
            if constexpr (SP2) {
            PG8_LDB(B0, 0, 0); PG8_LDB(B1, 0, 1); PG8_SCHED; PG8_LDA(At, 0, 0); PG8_STAGEA(PG8_SA(1, 1), a1, 1);
            if (swap_rows) {
#pragma unroll
                for (int _j = 0; _j < 4; ++_j) roffA[_j] = nr4[_j] * (unsigned)(K * 2) + cb2g; }
            PG8_WAIT_V(8); PG8_WAIT_L(0); PG8_BAR; PG8_MMA(0, 0, At, B0); PG8_MMA(0, 1, At, B1); PG8_BAR; PG8_SCHED;
            PG8_LDA(At, 0, 1); PG8_STAGE(PG8_SB(0, 0), b2, voffB); PG8_STAGE(PG8_SB(0, 1), b2 + hstep, voffB); PG8_STAGEA(PG8_SA(0, 0), a2, 0);
            PG8_WAIT_V(8); PG8_WAIT_L(0); PG8_BAR; PG8_MMA(1, 0, At, B0); PG8_MMA(1, 1, At, B1); PG8_BAR; PG8_SCHED;
            PG8_LDB(B0, 1, 0); PG8_LDB(B1, 1, 1); PG8_SCHED; PG8_LDA(At, 1, 0); PG8_STAGEA(PG8_SA(0, 1), a2, 1);
            PG8_WAIT_V(8); PG8_WAIT_L(0); PG8_BAR; PG8_MMA(0, 0, At, B0); PG8_MMA(0, 1, At, B1); PG8_BAR; PG8_SCHED;
            PG8_LDA(At, 1, 1); PG8_STAGE(PG8_SB(1, 0), b3, voffB); PG8_STAGE(PG8_SB(1, 1), b3 + hstep, voffB); PG8_STAGEA(PG8_SA(1, 0), a3, 0);
            PG8_WAIT_V(8); PG8_WAIT_L(0); PG8_BAR; PG8_MMA(1, 0, At, B0); PG8_MMA(1, 1, At, B1); PG8_BAR; PG8_SCHED;
            } else {
            PG8_LDB(B0, 0, 0); PG8_SCHED; PG8_LDA(At, 0, 0); PG8_STAGEA(PG8_SA(1, 1), a1, 1);
            if (swap_rows) {
#pragma unroll
                for (int _j = 0; _j < 4; ++_j) roffA[_j] = nr4[_j] * (unsigned)(K * 2) + cb2g; }
            PG8_WAIT_L(8); PG8_BAR; PG8_WAIT_L(0); PG8_MMA(0, 0, At, B0); PG8_BAR; PG8_SCHED;
            PG8_LDB(B1, 0, 1); PG8_STAGE(PG8_SB(0, 0), b2, voffB);
            PG8_BAR; PG8_WAIT_L(0); PG8_MMA(0, 1, At, B1); PG8_BAR;
            PG8_LDA(At, 0, 1); PG8_STAGEA(PG8_SA(0, 0), a2, 0);
            PG8_BAR; PG8_WAIT_L(0); PG8_MMA(1, 0, At, B0); PG8_BAR; PG8_SCHED;
            PG8_STAGE(PG8_SB(0, 1), b2 + hstep, voffB);
            PG8_WAIT_V(6); PG8_BAR; PG8_MMA(1, 1, At, B1); PG8_BAR;
            PG8_LDB(B0, 1, 0); PG8_SCHED; PG8_LDA(At, 1, 0); PG8_STAGEA(PG8_SA(0, 1), a2, 1);
            PG8_WAIT_L(8); PG8_BAR; PG8_WAIT_L(0); PG8_MMA(0, 0, At, B0); PG8_BAR; PG8_SCHED;
            PG8_LDB(B1, 1, 1); PG8_STAGE(PG8_SB(1, 0), b3, voffB);
            PG8_BAR; PG8_WAIT_L(0); PG8_MMA(0, 1, At, B1); PG8_BAR;
            PG8_LDA(At, 1, 1); PG8_STAGEA(PG8_SA(1, 0), a3, 0);
            PG8_BAR; PG8_WAIT_L(0); PG8_MMA(1, 0, At, B0); PG8_BAR; PG8_SCHED;
            PG8_STAGE(PG8_SB(1, 1), b3 + hstep, voffB);
            PG8_WAIT_V(6); PG8_BAR; PG8_MMA(1, 1, At, B1); PG8_BAR;
            }
        }
        if constexpr (ALIGN_EPI) { if (wr == 0) PG8_BAR; }
        if constexpr (!Epi::AFTER_DRAIN) { E(acc, cur, wr, wc, fr, fq); S.done(cur); }
        if (!has_next) break;
        PG8_ACC_INIT();
        cur = nxt; cA = nA; cB = nB; ++ui;
        if constexpr (ALIGN_EPI) { if (wr == 1) PG8_BAR; }
    }
    PG8_WAIT_V(0);
    if constexpr (!ALIGN_EPI) { if (wr == 0) PG8_BAR; }
    PG8_BAR;
    if constexpr (Epi::AFTER_DRAIN) { E.fused(acc, cur, wr, wc, fr, fq, lds, wid, lane); S.done(cur); }
#undef PG8_ACC_INIT
#undef PG8_SA
#undef PG8_SB
#undef PG8_STAGE
#undef PG8_STAGEA
#undef PG8_ROWS
#undef PG8_LDA
#undef PG8_LDB
#undef PG8_MMA
#undef PG8_WAIT_V
#undef PG8_WAIT_L
#undef PG8_BAR
#undef PG8_SCHED
}
}
constexpr int NWAVES = 8;
constexpr int D = 1024, NBATCH = 8, SEQ = 8192, CTXL = 256, DEPTH = 4;
constexpr int TL = NBATCH * SEQ;
constexpr int TC = NBATCH * CTXL;
constexpr int TT = TL + TC;
constexpr int QKD = 1536, NE = 32;
constexpr int MAXBLK = 1088, MAXROWS = MAXBLK * 256;
constexpr float NORM_EPS = 1e-6f;
constexpr int N_IN = 35;
enum { I_X = 0, I_C, I_CTX, I_CCTX, I_ADAW, I_ADAB, I_NMIX, I_NFFN, I_AWQKV, I_ABQKV, I_AWO, I_ABO, I_ASINK, I_HWIN, I_HBIN, I_HCW, I_HCB,
       I_FW1, I_FB1, I_FW2, I_FB2, I_FW3, I_FB3, I_FFREQ, I_FWOUT, I_HBD, I_HWO, I_HBO, I_RW, I_RB, I_WGU, I_BGU, I_WDN, I_BDN, I_FNORM };

constexpr size_t MiB = 1u << 20;
constexpr size_t WS_CTL = 0, CTL_ZERO_BYTES = 1 * MiB;
constexpr size_t WS_MOD = 1 * MiB;
constexpr size_t WS_ROPE = 2 * MiB;
constexpr size_t WS_A3L = 4 * MiB;
constexpr size_t WS_A3C = 8 * MiB;
constexpr size_t WS_WQK = 9 * MiB;
constexpr size_t WS_WAO = 15 * MiB;
constexpr size_t WS_WHIN = 19 * MiB;
constexpr size_t WS_WHO = 31 * MiB;
constexpr size_t WS_WGU = 35 * MiB;
constexpr size_t WS_WDN = 547 * MiB;
constexpr size_t WS_XC = 803 * MiB;
constexpr size_t WS_H = 811 * MiB;
constexpr size_t WS_POS = 943 * MiB;
constexpr size_t WS_GATE = 945 * MiB;
constexpr size_t WS_DEST = 947 * MiB;
constexpr size_t WS_BIG = 949 * MiB;
constexpr size_t WS_QK = WS_BIG, WS_UT = WS_BIG, WS_YS = WS_BIG;
constexpr size_t WS_O = WS_BIG + 396 * MiB;
constexpr size_t WS_B2 = WS_BIG + 544 * MiB;
constexpr size_t WS_ZT = WS_B2, WS_G = WS_B2 + 132 * MiB, WS_TP = WS_B2 + 388 * MiB  , WS_ACT = WS_B2;
constexpr size_t WS_XB = WS_B2 + 544 * MiB;
constexpr size_t WS_RSRC = WS_XB + 132 * MiB;
constexpr size_t WS_END = WS_RSRC + 2 * MiB;
static_assert(WS_O + (size_t)TT * D * 2 <= WS_B2 && (size_t)MAXROWS * D * 2 <= 544 * MiB && (size_t)3072 * TT * 2 <= 396 * MiB, "ws map");
static_assert(WS_QK + (size_t)TT * QKD * 2 <= WS_O, "ws map 2");
constexpr int CW_BAR = 4096;
constexpr int CW_ECNT = 16384;

constexpr int RING_OFF = 0, RING_BYTES = 131072;
constexpr int LDSCTL_OFF = RING_BYTES, MISC_OFF = LDSCTL_OFF + 320, USER_OFF = RING_BYTES + 512;
constexpr int LDS_BYTES = 147456;

#define GAS __attribute__((address_space(1)))
#define LAS __attribute__((address_space(3)))
#define KAS __attribute__((address_space(4)))
typedef unsigned short bf16;
typedef unsigned v4u __attribute__((ext_vector_type(4)));
typedef unsigned v2u __attribute__((ext_vector_type(2)));
typedef int v4i __attribute__((ext_vector_type(4)));
typedef float f32x4 __attribute__((ext_vector_type(4)));
typedef float f32x16 __attribute__((ext_vector_type(16)));
typedef short bf16x8 __attribute__((ext_vector_type(8)));
typedef GAS unsigned gu32;
#define RLX_AGENT __ATOMIC_RELAXED, __HIP_MEMORY_SCOPE_AGENT
#define LDS_WAIT() asm volatile("s_waitcnt lgkmcnt(0)" ::: "memory")
#define VM_WAIT() asm volatile("s_waitcnt vmcnt(0)" ::: "memory")
__device__ __forceinline__ unsigned f2bf(float f) { unsigned u = __builtin_bit_cast(unsigned, f); return (u + 0x7fffu + ((u >> 16) & 1u)) >> 16; }
__device__ __forceinline__ unsigned pk2(float lo, float hi) { return f2bf(lo) | (f2bf(hi) << 16); }
__device__ __forceinline__ float bf2f(unsigned short b) { return __builtin_bit_cast(float, ((unsigned)b) << 16); }
__device__ __forceinline__ float bflo(unsigned w) { return __builtin_bit_cast(float, w << 16); }
__device__ __forceinline__ float bfhi(unsigned w) { return __builtin_bit_cast(float, w & 0xffff0000u); }
#define XB_TMO      128
#define XB_XCNT(j)  (256  + 64 * (j))
#define XB_XSUB(j)  (1280 + 64 * (j))
#define XB_XGEN(j)  (2304 + 64 * (j))
#define XB_TOP      3328
#define XB_TOPGEN   3392
#define XCD_BAR_WORDS 3456
#define XB_SPIN_CAP (1u << 21)

__device__ __forceinline__ unsigned xb_ld(unsigned* p)              { return __hip_atomic_load(p, __ATOMIC_RELAXED, __HIP_MEMORY_SCOPE_AGENT); }
__device__ __forceinline__ unsigned xb_add(unsigned* p, unsigned v) { return __hip_atomic_fetch_add(p, v, __ATOMIC_RELAXED, __HIP_MEMORY_SCOPE_AGENT); }
__device__ __forceinline__ unsigned xb_xcc_id() { return (unsigned)__builtin_amdgcn_s_getreg((3 << 11) | 20) & 0xFu; }
#define XB_SPIN(cond, bar) do { unsigned _sp = 0; while (cond) { __builtin_amdgcn_s_sleep(1); \
    if ((++_sp & 255u) == 0u) { if (xb_ld(&(bar)[XB_TMO])) break; if (_sp > XB_SPIN_CAP) { atomicAdd(&(bar)[XB_TMO], 1u); break; } } } } while (0)

struct XcdBarrier {
    unsigned* bar; unsigned x;
    volatile LAS unsigned* st;
};

__device__ __forceinline__ XcdBarrier xcd_barrier_post(unsigned* bar, volatile LAS unsigned* st) {
    XcdBarrier b; b.bar = bar; b.x = xb_xcc_id(); b.st = st;
    if (threadIdx.x == 0) (void)xb_add(&bar[XB_XCNT(b.x)], 1u);
    return b;
}
__device__ __forceinline__ void xcd_barrier_complete(unsigned* bar, unsigned x, unsigned& nloc, unsigned& nx) {
    const unsigned G = gridDim.x * gridDim.y * gridDim.z;
    unsigned sum, cnt, mine, sp = 0u;
    for (;;) {
        sum = 0u; cnt = 0u; mine = 0u;
#pragma unroll
        for (unsigned j = 0; j < 16; ++j) { const unsigned c = xb_ld(&bar[XB_XCNT(j)]); sum += c; cnt += (c > 0u) ? 1u : 0u; mine = (j == x) ? c : mine; }
        if (sum == G) break;
        __builtin_amdgcn_s_sleep(1);
        if ((++sp & 255u) == 0u) { if (xb_ld(&bar[XB_TMO])) break; if (sp > XB_SPIN_CAP) { atomicAdd(&bar[XB_TMO], 1u); break; } }
    }
    nloc = mine > 0u ? mine : 1u; nx = cnt > 0u ? cnt : 1u;
}

__device__ __forceinline__ void xcd_barrier(const XcdBarrier& b) {
    asm volatile("s_waitcnt vmcnt(0)" ::: "memory");
    __syncthreads();
    if (threadIdx.x == 0) {
        unsigned* bar = b.bar;
        __builtin_amdgcn_s_waitcnt(0);
        unsigned nloc = b.st[0], nx = b.st[1];
        if (nloc == 0u) { xcd_barrier_complete(bar, b.x, nloc, nx); b.st[0] = nloc; b.st[1] = nx; }
        const unsigned old = xb_add(&bar[XB_XSUB(b.x)], 1u);
        const unsigned gen = old / nloc;
        if (old + 1u == (gen + 1u) * nloc) {
            __builtin_amdgcn_fence(__ATOMIC_RELEASE, "agent");
            asm volatile("s_waitcnt vmcnt(0)" ::: "memory");
            const unsigned og = xb_add(&bar[XB_TOP], 1u);
            const unsigned tg = og / nx;
            if (og + 1u == (tg + 1u) * nx) xb_add(&bar[XB_TOPGEN], 1u);
            else XB_SPIN(xb_ld(&bar[XB_TOPGEN]) == tg, bar);
            __builtin_amdgcn_fence(__ATOMIC_ACQUIRE, "agent");
            xb_add(&bar[XB_XGEN(b.x)], 1u);
            asm volatile("s_waitcnt vmcnt(0)" ::: "memory");
        } else {
            XB_SPIN(xb_ld(&bar[XB_XGEN(b.x)]) == gen, bar);
            __builtin_amdgcn_fence(__ATOMIC_ACQUIRE, "agent");
            asm volatile("s_waitcnt vmcnt(0)" ::: "memory");
        }
    }
    __syncthreads();
}
#ifndef FFT_HOST_TEST
#define FFT_DEV __device__ __forceinline__
#define FFT_LAUNDER(t) asm volatile("" : "+v"(t))
#else
#define FFT_DEV inline
#define FFT_LAUNDER(t) (void)0
#endif
#ifndef FFT_HOST_TEST
#define FFT_FENCE() do { asm volatile("" ::: "memory"); __builtin_amdgcn_sched_barrier(0); } while (0)
#else
#define FFT_FENCE() (void)0
#endif
typedef float cf2 __attribute__((ext_vector_type(2)));
typedef float cf4 __attribute__((ext_vector_type(4)));
constexpr int FFT_N = 16384, FFT_THREADS = 512;
FFT_DEV void fft_cs(float frac, float& c, float& s) {
#ifndef FFT_HOST_TEST
    c = __builtin_amdgcn_cosf(frac); s = __builtin_amdgcn_sinf(frac);
#else
    c = (float)cos(6.283185307179586 * (double)frac); s = (float)sin(6.283185307179586 * (double)frac);
#endif
}
FFT_DEV cf2 cmulf(cf2 a, float c, float s) { cf2 r; r.x = a.x * c - a.y * s; r.y = a.x * s + a.y * c; return r; }
FFT_DEV int fft_swz(int e) { return e ^ (((e >> 5) & 7) << 1); }
FFT_DEV cf2 cmul2(cf2 a, cf2 b) { const cf2 axx = {a.x, a.x}, ayy = {a.y, a.y}, bs = {-b.y, b.x}; return ayy * bs + axx * b; }
FFT_DEV cf2 cmulc(cf2 a, cf2 b) { const cf2 axx = {a.x, a.x}, ayy = {a.y, a.y}, bs = {b.y, b.x}, bn = {b.x, -b.y}; return ayy * bs + axx * bn; }
FFT_DEV cf2 tw32(int j) {
    constexpr float C[9] = {1.0f, 0.98078528040323044913f, 0.92387953251128675613f, 0.83146961230254523708f, 0.70710678118654752440f, 0.55557023301960222474f, 0.38268343236508977173f, 0.19509032201612826785f, 0.0f};
    const int q = (j >> 3) & 3, r = j & 7; float c, sn;
    if (q == 0) { c = C[r]; sn = C[8 - r]; } else if (q == 1) { c = -C[8 - r]; sn = C[r]; } else if (q == 2) { c = -C[r]; sn = -C[8 - r]; } else { c = C[8 - r]; sn = -C[r]; }
    cf2 w; w.x = c; w.y = -sn; return w;
}
template <bool TW> FFT_DEV void bfly_fwd_w(cf2& a0, cf2& a1, cf2& a2, cf2& a3, cf2 w1, cf2 w2, cf2 w3) {
    const cf2 t0 = a0 + a2, t1 = a0 - a2, t2 = a1 + a3, t3 = a1 - a3;
    cf2 y0 = t0 + t2, y2 = t0 - t2, y1, y3;
    y1.x = t1.x + t3.y; y1.y = t1.y - t3.x;
    y3.x = t1.x - t3.y; y3.y = t1.y + t3.x;
    if (TW) { y1 = cmul2(y1, w1); y2 = cmul2(y2, w2); y3 = cmul2(y3, w3); }
    a0 = y0; a1 = y1; a2 = y2; a3 = y3;
}
template <bool TW> FFT_DEV void bfly_inv_w(cf2& a0, cf2& a1, cf2& a2, cf2& a3, cf2 w1, cf2 w2, cf2 w3) {
    if (TW) { a1 = cmulc(a1, w1); a2 = cmulc(a2, w2); a3 = cmulc(a3, w3); }
    const cf2 t0 = a0 + a2, t1 = a0 - a2, t2 = a1 + a3, t3 = a1 - a3;
    cf2 y0 = t0 + t2, y2 = t0 - t2, y1, y3;
    y1.x = t1.x - t3.y; y1.y = t1.y + t3.x;
    y3.x = t1.x + t3.y; y3.y = t1.y - t3.x;
    a0 = y0; a1 = y1; a2 = y2; a3 = y3;
}
FFT_DEV cf2 fft_w(float frac) { float c, sn; fft_cs(frac, c, sn); cf2 w; w.x = c; w.y = -sn; return w; }
template <bool TW> FFT_DEV void bfly_fwd(cf2& a0, cf2& a1, cf2& a2, cf2& a3, float f) {
    const cf2 t0 = a0 + a2, t1 = a0 - a2, t2 = a1 + a3, t3 = a1 - a3;
    cf2 y0 = t0 + t2, y2 = t0 - t2, y1, y3;
    y1.x = t1.x + t3.y; y1.y = t1.y - t3.x;
    y3.x = t1.x - t3.y; y3.y = t1.y + t3.x;
    if (TW) { float c1, s1, c2, s2, c3, s3; fft_cs(f, c1, s1); fft_cs(2.0f * f, c2, s2); fft_cs(3.0f * f, c3, s3);
        y1 = cmulf(y1, c1, -s1); y2 = cmulf(y2, c2, -s2); y3 = cmulf(y3, c3, -s3); }
    a0 = y0; a1 = y1; a2 = y2; a3 = y3;
}
template <bool TW> FFT_DEV void bfly_inv(cf2& a0, cf2& a1, cf2& a2, cf2& a3, float f) {
    if (TW) { float c1, s1, c2, s2, c3, s3; fft_cs(f, c1, s1); fft_cs(2.0f * f, c2, s2); fft_cs(3.0f * f, c3, s3);
        a1 = cmulf(a1, c1, s1); a2 = cmulf(a2, c2, s2); a3 = cmulf(a3, c3, s3); }
    const cf2 t0 = a0 + a2, t1 = a0 - a2, t2 = a1 + a3, t3 = a1 - a3;
    cf2 y0 = t0 + t2, y2 = t0 - t2, y1, y3;
    y1.x = t1.x - t3.y; y1.y = t1.y + t3.x;
    y3.x = t1.x + t3.y; y3.y = t1.y - t3.x;
    a0 = y0; a1 = y1; a2 = y2; a3 = y3;
}
template <class PT> FFT_DEV void fft_fwd_first(PT X, const float (&za)[16], const float (&zb)[16], int tid) {
    FFT_LAUNDER(tid);
    const cf2 wt1 = fft_w((float)tid * (1.0f / 16384.0f)), wt2 = cmul2(wt1, wt1), wt3 = cmul2(wt2, wt1);
#pragma unroll
    for (int q = 0; q < 8; ++q) {
        const int k = tid + FFT_THREADS * q;
        cf2 a0, a1, a2, a3; a0.x = za[q]; a0.y = zb[q]; a1.x = za[q + 8]; a1.y = zb[q + 8]; a2.x = 0.f; a2.y = 0.f; a3 = a2;
        bfly_fwd_w<true>(a0, a1, a2, a3, cmul2(wt1, tw32(q)), cmul2(wt2, tw32(2 * q)), cmul2(wt3, tw32(3 * q)));
        const int sk = fft_swz(k);
        X[sk] = a0; X[sk + 4096] = a1; X[sk + 8192] = a2; X[sk + 12288] = a3;
        FFT_FENCE();
    }
}
template <class PT, class SP> FFT_DEV void fft_fwd_first_full(PT X, SP src, float scale, int tid) {
    FFT_LAUNDER(tid);
    const cf2 wt1 = fft_w((float)tid * (1.0f / 16384.0f)), wt2 = cmul2(wt1, wt1), wt3 = cmul2(wt2, wt1);
#pragma unroll
    for (int q = 0; q < 8; ++q) {
        const int k = tid + FFT_THREADS * q;
        cf2 a0, a1, a2, a3; a0.x = src[k] * scale; a0.y = 0.f; a1.x = src[k + 4096] * scale; a1.y = 0.f; a2.x = src[k + 8192] * scale; a2.y = 0.f; a3.x = src[k + 12288] * scale; a3.y = 0.f;
        bfly_fwd_w<true>(a0, a1, a2, a3, cmul2(wt1, tw32(q)), cmul2(wt2, tw32(2 * q)), cmul2(wt3, tw32(3 * q)));
        const int sk = fft_swz(k);
        X[sk] = a0; X[sk + 4096] = a1; X[sk + 8192] = a2; X[sk + 12288] = a3;
        if (q & 1) FFT_FENCE();
    }
}
template <class PT, class SP> FFT_DEV void fft_fwd_first_taps(PT X, SP src, float scale, int tid) {
    FFT_LAUNDER(tid);
    const cf2 wt1 = fft_w((float)tid * (1.0f / 16384.0f)), wt2 = cmul2(wt1, wt1), wt3 = cmul2(wt2, wt1);
#pragma unroll
    for (int q = 0; q < 8; ++q) {
        const int k = tid + FFT_THREADS * q;
        cf2 a0, a1, a2, a3; a0.x = src[k] * scale; a0.y = 0.f; a1.x = src[k + 4096] * scale; a1.y = 0.f; a2.x = k == 0 ? 0.f : src[16384 - (k == 0 ? 1 : k)] * scale; a2.y = 0.f; a3.x = src[12288 - k] * scale; a3.y = 0.f;
        bfly_fwd_w<true>(a0, a1, a2, a3, cmul2(wt1, tw32(q)), cmul2(wt2, tw32(2 * q)), cmul2(wt3, tw32(3 * q)));
        const int sk = fft_swz(k);
        X[sk] = a0; X[sk + 4096] = a1; X[sk + 8192] = a2; X[sk + 12288] = a3;
        if (q & 1) FFT_FENCE();
    }
}
template <int S2> FFT_DEV int fft_dbl_idx(int base, int i) {
    if (S2 == 256) return fft_swz(base) + S2 * i;
    if (S2 == 16) return (base ^ ((i >> 1) << 1)) + S2 * i;
    return fft_swz(base + S2 * i);
}
template <int P, class PT> FFT_DEV void fft_fwd_double(PT X, int tid) {
    FFT_LAUNDER(tid);
    constexpr int LS2 = 2 * (5 - P), S2 = 1 << LS2, NCUR = 1 << (2 * (7 - P));
#pragma unroll 1
    for (int q = 0; q < 2; ++q) {
        const int g = tid + FFT_THREADS * q, blk = g >> LS2, k = g & (S2 - 1), base = blk * NCUR + k;
        cf2 s[16];
#pragma unroll
        for (int i = 0; i < 16; ++i) s[i] = X[fft_dbl_idx<S2>(base, i)];
        const cf2 w1 = fft_w((float)k * (1.0f / (float)NCUR)), w2 = cmul2(w1, w1), w3 = cmul2(w2, w1), v1 = cmul2(w2, w2), v2 = cmul2(v1, v1), v3 = cmul2(v2, v1);
#pragma unroll
        for (int i0 = 0; i0 < 4; ++i0) bfly_fwd_w<true>(s[i0], s[i0 + 4], s[i0 + 8], s[i0 + 12], cmul2(w1, tw32(2 * i0)), cmul2(w2, tw32(4 * i0)), cmul2(w3, tw32(6 * i0)));
#pragma unroll
        for (int m = 0; m < 4; ++m) bfly_fwd_w<true>(s[4 * m], s[4 * m + 1], s[4 * m + 2], s[4 * m + 3], v1, v2, v3);
#pragma unroll
        for (int i = 0; i < 16; ++i) X[fft_dbl_idx<S2>(base, i)] = s[i];
    }
}
template <int P, class PT> FFT_DEV void fft_inv_double(PT X, int tid) {
    FFT_LAUNDER(tid);
    constexpr int LS2 = 2 * (5 - P), S2 = 1 << LS2, NCUR = 1 << (2 * (7 - P));
#pragma unroll 1
    for (int q = 0; q < 2; ++q) {
        const int g = tid + FFT_THREADS * q, blk = g >> LS2, k = g & (S2 - 1), base = blk * NCUR + k;
        cf2 s[16];
#pragma unroll
        for (int i = 0; i < 16; ++i) s[i] = X[fft_dbl_idx<S2>(base, i)];
        const cf2 w1 = fft_w((float)k * (1.0f / (float)NCUR)), w2 = cmul2(w1, w1), w3 = cmul2(w2, w1), v1 = cmul2(w2, w2), v2 = cmul2(v1, v1), v3 = cmul2(v2, v1);
#pragma unroll
        for (int m = 0; m < 4; ++m) bfly_inv_w<true>(s[4 * m], s[4 * m + 1], s[4 * m + 2], s[4 * m + 3], v1, v2, v3);
#pragma unroll
        for (int i0 = 0; i0 < 4; ++i0) bfly_inv_w<true>(s[i0], s[i0 + 4], s[i0 + 8], s[i0 + 12], cmul2(w1, tw32(2 * i0)), cmul2(w2, tw32(4 * i0)), cmul2(w3, tw32(6 * i0)));
#pragma unroll
        for (int i = 0; i < 16; ++i) X[fft_dbl_idx<S2>(base, i)] = s[i];
    }
}
template <class PT> FFT_DEV void fft_load_group(PT X, int g, cf2 (&s)[16]) {
    const int m2 = ((g >> 1) & 7) << 1;
#pragma unroll
    for (int c = 0; c < 8; ++c) { const int e = 16 * g + ((2 * c) ^ m2); s[2 * c] = X[e]; s[2 * c + 1] = X[e + 1]; }
}
template <class PT> FFT_DEV void fft_store_group(PT X, int g, const cf2 (&s)[16]) {
    const int m2 = ((g >> 1) & 7) << 1;
#pragma unroll
    for (int c = 0; c < 8; ++c) { const int e = 16 * g + ((2 * c) ^ m2); X[e] = s[2 * c]; X[e + 1] = s[2 * c + 1]; }
}
FFT_DEV void fft_last2_fwd(cf2 (&s)[16]) {
#pragma unroll
    for (int i0 = 0; i0 < 4; ++i0) bfly_fwd_w<true>(s[i0], s[i0 + 4], s[i0 + 8], s[i0 + 12], tw32(2 * i0), tw32(4 * i0), tw32(6 * i0));
#pragma unroll
    for (int m = 0; m < 4; ++m) bfly_fwd_w<false>(s[4 * m], s[4 * m + 1], s[4 * m + 2], s[4 * m + 3], tw32(0), tw32(0), tw32(0));
}
FFT_DEV void fft_last2_inv(cf2 (&s)[16]) {
#pragma unroll
    for (int m = 0; m < 4; ++m) bfly_inv_w<false>(s[4 * m], s[4 * m + 1], s[4 * m + 2], s[4 * m + 3], tw32(0), tw32(0), tw32(0));
#pragma unroll
    for (int i0 = 0; i0 < 4; ++i0) bfly_inv_w<true>(s[i0], s[i0 + 4], s[i0 + 8], s[i0 + 12], tw32(2 * i0), tw32(4 * i0), tw32(6 * i0));
}
template <class PT, class GP> FFT_DEV void fft_mid_store(PT X, GP G, float scale, float add, int tid) {
    FFT_LAUNDER(tid);
#pragma unroll 1
    for (int q = 0; q < 2; ++q) { const int g = tid + FFT_THREADS * q; cf2 s[16]; fft_load_group(X, g, s); fft_last2_fwd(s);
#pragma unroll
        for (int c = 0; c < 8; ++c) { cf4 w; w.x = (s[2 * c].x + add) * scale; w.y = s[2 * c].y * scale; w.z = (s[2 * c + 1].x + add) * scale; w.w = s[2 * c + 1].y * scale; G[c * 1024 + g] = w; } }
}
template <class PT, class GP> FFT_DEV void fft_mid_mul(PT X, GP G, int tid) {
    FFT_LAUNDER(tid);
#pragma unroll 1
    for (int q = 0; q < 2; ++q) { const int g = tid + FFT_THREADS * q; cf2 s[16]; cf4 w[4];
#pragma unroll
        for (int c = 0; c < 4; ++c) w[c] = G[c * 1024 + g];
        fft_load_group(X, g, s); fft_last2_fwd(s);
#pragma unroll
        for (int h = 0; h < 2; ++h) {
#pragma unroll
            for (int c4 = 0; c4 < 4; ++c4) { const int c = 4 * h + c4; const cf4 wc = w[c4]; if (h == 0) w[c4] = G[(c + 4) * 1024 + g];
                cf2 a = s[2 * c], b = s[2 * c + 1], r; r.x = a.x * wc.x - a.y * wc.y; r.y = a.x * wc.y + a.y * wc.x; s[2 * c] = r;
                r.x = b.x * wc.z - b.y * wc.w; r.y = b.x * wc.w + b.y * wc.z; s[2 * c + 1] = r; } }
        fft_last2_inv(s); fft_store_group(X, g, s); }
}
template <class PT> FFT_DEV void fft_inv_last(PT X, float (&za)[16], float (&zb)[16], int tid) {
    FFT_LAUNDER(tid);
    const cf2 wt1 = fft_w((float)tid * (1.0f / 16384.0f)), wt2 = cmul2(wt1, wt1), wt3 = cmul2(wt2, wt1);
#pragma unroll
    for (int q = 0; q < 8; ++q) {
        const int k = tid + FFT_THREADS * q;
        const int sk = fft_swz(k);
        cf2 a0 = X[sk], a1 = X[sk + 4096], a2 = X[sk + 8192], a3 = X[sk + 12288];
        bfly_inv_w<true>(a0, a1, a2, a3, cmul2(wt1, tw32(q)), cmul2(wt2, tw32(2 * q)), cmul2(wt3, tw32(3 * q)));
        za[q] = a0.x; zb[q] = a0.y; za[q + 8] = a1.x; zb[q + 8] = a1.y;
        FFT_FENCE();
    }
}
template <int Q0, class PT> FFT_DEV void fft_inv_last_part(PT X, float (&za)[8], float (&zb)[8], int tid) {
    FFT_LAUNDER(tid);
    const cf2 wt1 = fft_w((float)tid * (1.0f / 16384.0f)), wt2 = cmul2(wt1, wt1), wt3 = cmul2(wt2, wt1);
#pragma unroll
    for (int q = Q0; q < Q0 + 4; ++q) {
        const int k = tid + FFT_THREADS * q;
        const int sk = fft_swz(k);
        cf2 a0 = X[sk], a1 = X[sk + 4096], a2 = X[sk + 8192], a3 = X[sk + 12288];
        bfly_inv_w<true>(a0, a1, a2, a3, cmul2(wt1, tw32(q)), cmul2(wt2, tw32(2 * q)), cmul2(wt3, tw32(3 * q)));
        za[q - Q0] = a0.x; zb[q - Q0] = a0.y; za[4 + q - Q0] = a1.x; zb[4 + q - Q0] = a1.y;
    }
}
namespace pg8 {
enum { EPI_QK = 0, EPI_T = 1, EPI_RES = 2, EPI_SWIGLU = 3, EPI_DOWN = 4 };
struct EpiAny {
    static constexpr bool PERM = true, AFTER_DRAIN = false;
    int mode, ldc;
    bf16_t* O;
    float* f0; float* f1;
    const float* p0; const float* p1; const float* p2; const float* p3;
    PG8_LAS float* bslot;
    __device__ __forceinline__ void epi_qk(const f32x4 (&acc)[2][2][4][2], const Unit& u, int wr, int wc, int fr, int fq) const {
        const int row0 = u.pm * BM + wr * 64 + fr;
        const bool latent = u.pm < 256;
#pragma unroll
        for (int bj = 0; bj < 2; ++bj) {
            const int cs = u.pn * BM + bj * HALF + wc * 32 + 8 * fq;
            const int hb = cs & ~63, jj = (cs & 63) >> 3;
            const bool isv = u.pn >= 5;
            const f32x4 b0 = *(const f32x4*)(p0 + (isv ? cs : hb + 4 * jj)), b1 = *(const f32x4*)(p0 + (isv ? cs + 4 : hb + 32 + 4 * jj));
#pragma unroll
            for (int ai = 0; ai < 2; ++ai)
#pragma unroll
                for (int m = 0; m < 4; ++m) {
                    const int row = row0 + ai * HALF + m * 16;
                    f32x4 x1 = acc[ai][bj][m][0] + b0, x2 = acc[ai][bj][m][1] + b1;
                    if (latent && !isv) {
                        const float* rp = p1 + ((size_t)(row & 8191) * 32 + 4 * jj) * 2;
                        const f32x4 cs0 = *(const f32x4*)rp, cs1 = *(const f32x4*)(rp + 4);
                        const f32x4 c = (f32x4){cs0[0], cs0[2], cs1[0], cs1[2]}, s = (f32x4){cs0[1], cs0[3], cs1[1], cs1[3]};
                        const f32x4 o1 = x1 * c - x2 * s, o2 = x1 * s + x2 * c; x1 = o1; x2 = o2;
                    }
                    if (u.pn < 4) { x1 *= 0.18033688011112042f; x2 *= 0.18033688011112042f; }
                    u32x4 w; w.x = cvt_pk_bf16(x1[0], x1[1]); w.y = cvt_pk_bf16(x1[2], x1[3]); w.z = cvt_pk_bf16(x2[0], x2[1]); w.w = cvt_pk_bf16(x2[2], x2[3]);
                    *(u32x4*)(O + (size_t)row * 1536 + cs) = w;
                }
        }
    }
    __device__ __forceinline__ void epi_t(const f32x4 (&acc)[2][2][4][2], const Unit& u, int wr, int wc, int fr, int fq) const {
        const int row0 = u.pm * BM + wr * 64 + fr, col0 = u.pn * BM + wc * 32 + 8 * fq;
        float bvs[8];
#pragma unroll
        for (int q = 0; q < 8; ++q) bvs[q] = p0[row0 + (q >> 2) * HALF + (q & 3) * 16];
#pragma unroll
        for (int ai = 0; ai < 2; ++ai)
#pragma unroll
            for (int m = 0; m < 4; ++m) { const int row = row0 + ai * HALF + m * 16; const float bv = bvs[ai * 4 + m]; bf16_t* rowp = O + (size_t)row * ldc + col0;
#pragma unroll
                for (int bj = 0; bj < 2; ++bj) { const f32x4 v0 = acc[ai][bj][m][0] + bv, v1 = acc[ai][bj][m][1] + bv;
                    u32x4 w; w.x = cvt_pk_bf16(v0[0], v0[1]); w.y = cvt_pk_bf16(v0[2], v0[3]); w.z = cvt_pk_bf16(v1[0], v1[1]); w.w = cvt_pk_bf16(v1[2], v1[3]);
                    *(u32x4*)(rowp + bj * HALF) = w; } }
    }
    __device__ __forceinline__ void epi_res(const f32x4 (&acc)[2][2][4][2], const Unit& u, int wr, int wc, int fr, int fq) const {
        const bool latent = u.pm < 256;
        const int row0 = u.pm * BM + wr * 64 + fr, col0 = u.pn * BM + wc * 32 + 8 * fq;
        const float* gp = p3 + (size_t)(latent ? (u.pm >> 5) : 8) * 6144 + col0; const float* bp = p2 + col0;
        const float* srcf = p0 ? (latent ? p0 : p1 - (size_t)TL * 1024) : nullptr;
#pragma unroll
        for (int bj = 0; bj < 2; ++bj) { const f32x4 b0 = *(const f32x4*)(bp + bj * HALF), b1 = *(const f32x4*)(bp + bj * HALF + 4), g0 = *(const f32x4*)(gp + bj * HALF), g1 = *(const f32x4*)(gp + bj * HALF + 4);
#pragma unroll
            for (int ai = 0; ai < 2; ++ai)
#pragma unroll
                for (int m = 0; m < 4; ++m) { const size_t off = (size_t)(row0 + ai * HALF + m * 16) * 1024 + col0 + bj * HALF;
                    f32x4 x0, x1;
                    if (srcf) { x0 = *(const f32x4*)(srcf + off); x1 = *(const f32x4*)(srcf + off + 4); }
                    else { const u32x4 r = *(const u32x4*)(O + off); x0 = (f32x4){__builtin_bit_cast(float, r.x << 16), __builtin_bit_cast(float, r.x & 0xffff0000u), __builtin_bit_cast(float, r.y << 16), __builtin_bit_cast(float, r.y & 0xffff0000u)};
                        x1 = (f32x4){__builtin_bit_cast(float, r.z << 16), __builtin_bit_cast(float, r.z & 0xffff0000u), __builtin_bit_cast(float, r.w << 16), __builtin_bit_cast(float, r.w & 0xffff0000u)}; }
                    const f32x4 v0 = x0 + g0 * (acc[ai][bj][m][0] + b0), v1 = x1 + g1 * (acc[ai][bj][m][1] + b1);
                    u32x4 w; w.x = cvt_pk_bf16(v0[0], v0[1]); w.y = cvt_pk_bf16(v0[2], v0[3]); w.z = cvt_pk_bf16(v1[0], v1[1]); w.w = cvt_pk_bf16(v1[2], v1[3]);
                    *(u32x4*)(O + off) = w; } }
    }
    __device__ __forceinline__ const float* bias_src(const Unit& u, int wc, int lane) const {
        if (mode == EPI_SWIGLU) return p0 + (size_t)((u.pb >> 3) & 31) * 2048 + (lane >> 5) * 1024 + u.pn * HALF + wc * 32 + (lane & 31);
        return p0 + (size_t)((u.pb >> 2) & 31) * 1024 + u.pn * BM + (lane >> 5) * HALF + wc * 32 + (lane & 31);
    }
    __device__ __forceinline__ void epi_swiglu(const f32x4 (&acc)[2][2][4][2], const Unit& u, int wr, int wc, int fr, int fq) const {
        const int e = (u.pb >> 3) & 31;
        const int row0 = u.pm * BM + wr * 64 + fr, col0 = u.pn * HALF + wc * 32 + 8 * fq;
        (void)e;
#pragma unroll
        for (int ai = 0; ai < 2; ++ai)
#pragma unroll
            for (int m = 0; m < 4; ++m) {
                f32x4 a[2];
#pragma unroll
                for (int n = 0; n < 2; ++n) {
                    f32x4 g = acc[ai][0][m][n], up = acc[ai][1][m][n];
#pragma unroll
                    for (int t = 0; t < 4; ++t) { const float gg = fminf(g[t], 7.0f), uu = fminf(fmaxf(up[t], -7.0f), 7.0f);
                        const float sg = __builtin_amdgcn_rcpf(1.0f + __builtin_amdgcn_exp2f(-2.4554669595930157f * gg)); a[n][t] = gg * sg * (uu + 1.0f); }
                }
                u32x4 w; w.x = cvt_pk_bf16(a[0][0], a[0][1]); w.y = cvt_pk_bf16(a[0][2], a[0][3]); w.z = cvt_pk_bf16(a[1][0], a[1][1]); w.w = cvt_pk_bf16(a[1][2], a[1][3]);
                *(u32x4*)(O + (size_t)(row0 + ai * HALF + m * 16) * 1024 + col0) = w;
            }
    }
    __device__ __forceinline__ void epi_down(const f32x4 (&acc)[2][2][4][2], const Unit& u, int wr, int wc, int fr, int fq) const {
        const int e = (u.pb >> 2) & 31;
        const int row0 = u.pm * BM + wr * 64 + fr, col0 = u.pn * BM + wc * 32 + 8 * fq;
        (void)e;
#pragma unroll
        for (int bj = 0; bj < 2; ++bj) {
#pragma unroll
            for (int ai = 0; ai < 2; ++ai)
#pragma unroll
                for (int m = 0; m < 4; ++m) { const f32x4 v0 = acc[ai][bj][m][0], v1 = acc[ai][bj][m][1];
                    u32x4 w; w.x = cvt_pk_bf16(v0[0], v0[1]); w.y = cvt_pk_bf16(v0[2], v0[3]); w.z = cvt_pk_bf16(v1[0], v1[1]); w.w = cvt_pk_bf16(v1[2], v1[3]);
                    *(u32x4*)(O + (size_t)(row0 + ai * HALF + m * 16) * 1024 + col0 + bj * HALF) = w; } }
    }
    __device__ __forceinline__ void operator()(const f32x4 (&acc)[2][2][4][2], const Unit& u, int wr, int wc, int fr, int fq) const {
        if (mode == EPI_QK) epi_qk(acc, u, wr, wc, fr, fq);
        else if (mode == EPI_T) epi_t(acc, u, wr, wc, fr, fq);
        else if (mode == EPI_RES) epi_res(acc, u, wr, wc, fr, fq);
        else if (mode == EPI_SWIGLU) epi_swiglu(acc, u, wr, wc, fr, fq);
        else epi_down(acc, u, wr, wc, fr, fq);
    }
};
struct AnyOrder {
    int moe; StaticOrder so;
    const PG8_LAS int* rb2e; int nblk, lg, wbase;
    __device__ __forceinline__ bool next(int i, Unit& u) const {
        if (!moe) return so.next(i, u);
        const int x = so.c & 7, j = so.c >> 3, per = (so.G >> 3) >> lg;
        const int rb = (i * 8 + x) * per + (j >> lg); if (rb >= nblk) return false;
        const int e = rb2e[rb];
        u.pm = rb; u.pn = j & ((1 << lg) - 1); u.pb = ((wbase + e) << lg) + u.pn; return true;
    }
    __device__ __forceinline__ void a_ready(const Unit&) const {}
    __device__ __forceinline__ void done(const Unit&) const {}
};
}
struct Frame {
    LAS unsigned char* lds;
    volatile LAS unsigned* MISC;
    gu32* ctl;
    int tid, lane, wave;
    int vcu, G, bx;
    const float* const KAS* in;
    float* out; unsigned char* ws;
};
__device__ __forceinline__ float wave_sum(float v) {
#pragma unroll
    for (int o = 1; o < 64; o <<= 1) v += __shfl_xor(v, o);
    return v;
}
__device__ __forceinline__ void block_sum2(Frame& F, LAS float* red, float& a, float& b) {
    a = wave_sum(a); b = wave_sum(b);
    __syncthreads();
    if (F.lane == 0) { red[F.wave * 2] = a; red[F.wave * 2 + 1] = b; }
    __syncthreads();
    float sa = 0.f, sb = 0.f;
#pragma unroll
    for (int w = 0; w < NWAVES; ++w) { sa += red[2 * w]; sb += red[2 * w + 1]; }
    a = sa; b = sb;
}

template <int MODE>
__device__ __forceinline__ void tr_item(const float* W, int N, bf16* WT, bf16* WT2, LAS float* scr, int item, int lane) {
    const int nblk = N / 32, kb = item / nblk, nb = item % nblk, k0 = 64 * kb, n0 = 32 * nb;
#pragma unroll 8
    for (int i = 0; i < 32; ++i) { const int kk = 2 * i + (lane >> 5); scr[kk * 33 + (lane & 31)] = W[(size_t)(k0 + kk) * N + n0 + (lane & 31)]; }
    LDS_WAIT(); asm volatile("" ::: "memory");
    const int c = lane & 7;
#pragma unroll
    for (int j = 0; j < 4; ++j) { const int n = (lane >> 3) + 8 * j; const LAS float* s = scr + (8 * c) * 33 + n;
        const int ns = n0 + n; int d = ns; bf16* dst = WT;
        if (MODE == 1) { const int n2 = ns & 1023; d = 256 * (n2 >> 7) + (n2 & 127) + (ns >= 1024 ? 128 : 0); }
        if (MODE == 2) { if (ns < 1280) { const int hb = ns & ~63, dd = ns & 63, d2 = dd & 31; d = hb + 8 * (d2 >> 2) + (d2 & 3) + (dd >= 32 ? 4 : 0); } }
        v4u o; o.x = pk2(s[0 * 33], s[1 * 33]); o.y = pk2(s[2 * 33], s[3 * 33]); o.z = pk2(s[4 * 33], s[5 * 33]); o.w = pk2(s[6 * 33], s[7 * 33]);
        *(GAS v4u*)(dst + (size_t)d * 1024 + k0 + 8 * c) = o; }
    LDS_WAIT(); asm volatile("" ::: "memory");
}
__device__ __forceinline__ float silu_f(float v) { return v / (1.0f + expf(-v)); }
__device__ __forceinline__ void p0_prologue(Frame& F) {
    const int tid = F.tid, lane = F.lane;
    if (F.bx < 192) {
        LAS float* sv = (LAS float*)F.lds;
        LAS float* part = sv + 1024 * 12;
        for (int i = tid; i < 1024 * 9; i += NWAVES * 64) { const int r = i >> 10, k = i & 1023; const float v = (r < 8) ? F.in[I_C][r * 1024 + k] : F.in[I_CCTX][k]; sv[k * 12 + r] = silu_f(v); }
        __syncthreads();
        const int l = F.bx / 48, n0 = (F.bx % 48) * 128, kb = 128 * F.wave;
        const float* wp = F.in[I_ADAW] + ((size_t)l * 1024 + kb) * 6144 + n0 + 2 * lane;
        float acc0[9], acc1[9];
#pragma unroll
        for (int r = 0; r < 9; ++r) { acc0[r] = 0.f; acc1[r] = 0.f; }
#pragma unroll 1
        for (int k0 = 0; k0 < 128; k0 += 16) { float wx[16], wy[16];
#pragma unroll
            for (int u = 0; u < 16; ++u) { const GAS float* q = (const GAS float*)(wp + (size_t)(k0 + u) * 6144); wx[u] = q[0]; wy[u] = q[1]; }
#pragma unroll
            for (int u = 0; u < 16; ++u) { const LAS float* sk = sv + (kb + k0 + u) * 12;
                const f32x4 s0 = *(const LAS f32x4*)sk, s1 = *(const LAS f32x4*)(sk + 4); const float s8 = sk[8];
#pragma unroll
                for (int r = 0; r < 4; ++r) { acc0[r] += s0[r] * wx[u]; acc1[r] += s0[r] * wy[u]; acc0[4 + r] += s1[r] * wx[u]; acc1[4 + r] += s1[r] * wy[u]; }
                acc0[8] += s8 * wx[u]; acc1[8] += s8 * wy[u]; } }
#pragma unroll
        for (int r = 0; r < 9; ++r) { part[(F.wave * 9 + r) * 128 + 2 * lane] = acc0[r]; part[(F.wave * 9 + r) * 128 + 2 * lane + 1] = acc1[r]; }
        __syncthreads();
        for (int i = tid; i < 9 * 128; i += NWAVES * 64) { const int r = i >> 7, cix = i & 127; float t = F.in[I_ADAB][l * 6144 + n0 + cix];
#pragma unroll
            for (int w = 0; w < NWAVES; ++w) t += part[(w * 9 + r) * 128 + cix];
            ((float*)(F.ws + WS_MOD))[((size_t)l * 9 + r) * 6144 + n0 + cix] = t; }
        __syncthreads();
    }
    if (F.bx >= 192) {
        float* rt = (float*)(F.ws + WS_ROPE);
        for (int e = (F.bx - 192) * 512 + tid; e < 8192 * 32; e += 64 * 512) { const int pos = e >> 5, i = e & 31;
            const float inv = expf(-(float)(i & 15) * (1.0f / 16.0f) * 9.210340371976184f);
            const float ang = (float)((i < 16) ? (pos >> 6) : (pos & 63)) * inv; float sn, cs; sincosf(ang, &sn, &cs);
            rt[2 * e] = cs; rt[2 * e + 1] = sn; }
    }
    const int gw = F.vcu * NWAVES + F.wave, NGW = F.G * NWAVES;
    for (int task = gw; task < 2 * (8192 + 256); task += NGW) {
        const int j = task / 8448, tt = task % 8448; const bool lat = tt < 8192; const int t = lat ? tt : tt - 8192, L = lat ? 8192 : 256;
        float* dst = lat ? (float*)(F.ws + WS_A3L) + ((size_t)j * 8192 + t) * 64 : (float*)(F.ws + WS_A3C) + ((size_t)j * 256 + t) * 64;
        const float tl = (float)t / (float)(L - 1), w = 6.283185307179586f * (float)t / (float)L;
        float z = 0.f;
        if (lane == 0) z = tl;
        else if (lane <= 32) { const int mI = (lane - 1) & 15; const float band = 1e-4f + (float)mI * ((15.0f - 1e-4f) / 15.0f); z = (lane <= 16) ? cosf(band * w) : -sinf(band * w); }
        const float fr = F.in[I_FFREQ][j * 64 + lane];
        const float* w1 = F.in[I_FW1] + (size_t)j * 33 * 64; const float* w2 = F.in[I_FW2] + (size_t)j * 64 * 64; const float* w3 = F.in[I_FW3] + (size_t)j * 64 * 64;
        float a = F.in[I_FB1][j * 64 + lane];
        for (int i = 0; i < 33; ++i) a += __shfl(z, i) * w1[i * 64 + lane];
        a = sinf(fr * a);
        float a2 = F.in[I_FB2][j * 64 + lane];
        for (int k = 0; k < 64; ++k) a2 += __shfl(a, k) * w2[k * 64 + lane];
        a2 = sinf(fr * a2);
        float a3 = F.in[I_FB3][j * 64 + lane];
        for (int k = 0; k < 64; ++k) a3 += __shfl(a2, k) * w3[k * 64 + lane];
        if (lat) ((bf16*)(F.ws + WS_A3L))[(size_t)j * 8192 * 64 + ((((size_t)(t >> 5) * 4 + (lane >> 4)) * 64 + (t & 31) + 32 * ((lane >> 3) & 1)) << 3) + (lane & 7)] = (bf16)f2bf(sinf(fr * a3));
        else dst[lane] = sinf(fr * a3);
    }
    LAS float* scr = (LAS float*)(F.lds + RING_OFF + F.wave * 16384);
    constexpr int NI_GU = 128 * 1024, NI_DN = 128 * 512, NI_QKV = 2 * 768, NI_AO = 2 * 512, NI_HIN = 2 * 1536, NI_HO = 2 * 512;
    constexpr int NITEMS = NI_GU + NI_DN + NI_QKV + NI_AO + NI_HIN + NI_HO;
    for (int it = gw; it < NITEMS; it += NGW) {
        int r = it;
        if (r < NI_GU) { const int mat = r >> 10; tr_item<1>(F.in[I_WGU] + (size_t)mat * 1024 * 2048, 2048, (bf16*)(F.ws + WS_WGU) + (size_t)mat * 2048 * 1024, nullptr, scr, r & 1023, lane); continue; } r -= NI_GU;
        if (r < NI_DN) { const int mat = r >> 9; tr_item<0>(F.in[I_WDN] + (size_t)mat * 1024 * 1024, 1024, (bf16*)(F.ws + WS_WDN) + (size_t)mat * 1024 * 1024, nullptr, scr, r & 511, lane); continue; } r -= NI_DN;
        if (r < NI_QKV) { const int mat = r / 768; tr_item<2>(F.in[I_AWQKV] + (size_t)mat * 1024 * 1536, 1536, (bf16*)(F.ws + WS_WQK) + (size_t)mat * 1536 * 1024, nullptr, scr, r % 768, lane); continue; } r -= NI_QKV;
        if (r < NI_AO) { const int mat = r >> 9; tr_item<0>(F.in[I_AWO] + (size_t)mat * 1024 * 1024, 1024, (bf16*)(F.ws + WS_WAO) + (size_t)mat * 1024 * 1024, nullptr, scr, r & 511, lane); continue; } r -= NI_AO;
        if (r < NI_HIN) { const int mat = r / 1536; tr_item<0>(F.in[I_HWIN] + (size_t)mat * 1024 * 3072, 3072, (bf16*)(F.ws + WS_WHIN) + (size_t)mat * 3072 * 1024, nullptr, scr, r % 1536, lane); continue; } r -= NI_HIN;
        { const int mat = r >> 9; tr_item<0>(F.in[I_HWO] + (size_t)mat * 1024 * 1024, 1024, (bf16*)(F.ws + WS_WHO) + (size_t)mat * 1024 * 1024, nullptr, scr, r & 511, lane); }
    }
}

__device__ __forceinline__ void row8_unpack(const v4u w, f32x4& a, f32x4& b) { a = (f32x4){bflo(w.x), bfhi(w.x), bflo(w.y), bfhi(w.y)}; b = (f32x4){bflo(w.z), bfhi(w.z), bflo(w.w), bfhi(w.w)}; }
__device__ __forceinline__ v4u row8_pack(const f32x4 a, const f32x4 b) { v4u w; w.x = pk2(a.x, a.y); w.y = pk2(a.z, a.w); w.z = pk2(b.x, b.y); w.w = pk2(b.z, b.w); return w; }
#define ROW8_F32(ptr, jj, hf, lane) (((const f32x4*)(ptr))[128 * (jj) + 2 * (lane) + (hf)])
__device__ __forceinline__ void norm_mod_store(Frame& F, const f32x4 (&v)[4], const float* gain, const float* shift, const float* scale, bf16* orow) {
    float s2 = 0.f;
#pragma unroll
    for (int j = 0; j < 4; ++j) s2 += (v[j].x * v[j].x + v[j].y * v[j].y) + (v[j].z * v[j].z + v[j].w * v[j].w);
    const float rstd = 1.0f / sqrtf(wave_sum(s2) * (1.0f / D) + NORM_EPS);
#pragma unroll
    for (int jj = 0; jj < 2; ++jj) { f32x4 h[2];
#pragma unroll
        for (int hf = 0; hf < 2; ++hf) h[hf] = v[2 * jj + hf] * rstd * ROW8_F32(gain, jj, hf, F.lane) * (ROW8_F32(scale, jj, hf, F.lane) + 1.0f) + ROW8_F32(shift, jj, hf, F.lane);
        ((GAS v4u*)orow)[64 * jj + F.lane] = row8_pack(h[0], h[1]); }
}
__device__ __forceinline__ int mod_row(int row) { return row < TL ? (row >> 13) : 8; }
__device__ __forceinline__ int rows_of_layer(int l) { return l >= 2 ? TL : TT; }
__device__ __forceinline__ void norm0_phase(Frame& F) {
    const int gw = F.vcu * NWAVES + F.wave, NGW = F.G * NWAVES;
    const float* mod = (const float*)(F.ws + WS_MOD);
    for (int row = gw; row < TT; row += NGW) {
        const float* xr = row < TL ? F.in[I_X] + (size_t)row * D : F.in[I_CTX] + (size_t)(row - TL) * D;
        f32x4 v[4];
#pragma unroll
        for (int j = 0; j < 4; ++j) v[j] = ((const GAS f32x4*)xr)[128 * (j >> 1) + 2 * F.lane + (j & 1)];
        const float* mr = mod + (size_t)mod_row(row) * 6144;
        norm_mod_store(F, v, F.in[I_NMIX], mr, mr + 1024, (bf16*)(F.ws + WS_H) + (size_t)row * D);
    }
}

__device__ __forceinline__ void attn_phase(Frame& F, int j, int nunits) {
    const bf16* QK = (const bf16*)(F.ws + WS_QK); bf16* O = (bf16*)(F.ws + WS_O);
    const float* sinks = F.in[I_ASINK] + j * 16;
    LAS bf16* Ks0 = (LAS bf16*)(F.lds);
    const int w = F.wave, lane = F.lane, r = lane & 31, h = lane >> 5, tid = F.tid;
    float snk[4];
#pragma unroll
    for (int i = 0; i < 4; ++i) snk[i] = sinks[4 * i + (w >> 1)];
    for (int u = F.vcu; u < nunits; u += F.G) {
        int b, kvh, q0; const bool isctx = u >= 4096;
        if (!isctx) { b = u >> 9; kvh = (u >> 7) & 3; q0 = (u & 127) * 64; } else { const int u2 = u - 4096; b = u2 >> 4; kvh = (u2 >> 2) & 3; q0 = (u2 & 3) * 64; }
        const int head = kvh * 4 + (w >> 1), qrow = q0 + 32 * (w & 1) + r;
        const size_t tokq = isctx ? (size_t)TL + b * CTXL + qrow : (size_t)b * SEQ + qrow;
        const bf16* qp = QK + tokq * QKD + head * 64 + 8 * h;
        v4u bqv[4];
#pragma unroll
        for (int s = 0; s < 4; ++s) asm volatile("global_load_dwordx4 %0, %1, off" : "=&v"(bqv[s]) : "v"((const GAS v4u*)(qp + 16 * s)) : "memory");
        float m = (kvh == 0 ? snk[0] : kvh == 1 ? snk[1] : kvh == 2 ? snk[2] : snk[3]) * 1.4426950408889634f, l = 1.0f;
        f32x16 o0, o1;
#pragma unroll
        for (int i = 0; i < 16; ++i) { o0[i] = 0.f; o1[i] = 0.f; }
        const int jl0 = isctx ? 0 : (q0 >= 128 ? 0 : (128 - q0) >> 6), jl1 = isctx ? 0 : (q0 + 192 <= SEQ ? 5 : (SEQ + 128 - q0) >> 6), nl = jl1 - jl0, ntile = nl + 4;
        const int srow = tid >> 3, sch = tid & 7;
#define ATT_KEY0(i) ((i) < nl ? (size_t)b * SEQ + (q0 - 128 + 64 * (jl0 + (i))) : (size_t)TL + b * CTXL + 64 * ((i) - nl))
#define ATT_LOAD(kv, vv, i) do { const size_t kt_ = ATT_KEY0(i); const GAS v4u* pk_ = (const GAS v4u*)(QK + (kt_ + srow) * QKD + 1024 + kvh * 64 + sch * 8); const GAS v4u* pv_ = (const GAS v4u*)(QK + (kt_ + lane) * QKD + 1280 + kvh * 64 + w * 8); \
            asm volatile("global_load_dwordx4 %0, %2, off\n\tglobal_load_dwordx4 %1, %3, off" : "=&v"(kv), "=&v"(vv) : "v"(pk_), "v"(pv_) : "memory"); } while (0)
#define ATT_WAIT2() asm volatile("s_waitcnt vmcnt(2)" ::: "memory")
#define ATT_WRITE(kv, vv, bufi) do { LAS bf16* ks_ = Ks0 + (bufi) * 9216; LAS bf16* vs_ = ks_ + 4608; *(LAS v4u*)(ks_ + srow * 72 + sch * 8) = kv;     \
            LAS bf16* vd = vs_ + (w * 8) * 72 + lane; \
            vd[0] = (bf16)(vv.x & 0xffffu); vd[72] = (bf16)(vv.x >> 16); vd[144] = (bf16)(vv.y & 0xffffu); vd[216] = (bf16)(vv.y >> 16); \
            vd[288] = (bf16)(vv.z & 0xffffu); vd[360] = (bf16)(vv.z >> 16); vd[432] = (bf16)(vv.w & 0xffffu); vd[504] = (bf16)(vv.w >> 16); } while (0)
        v4u kvA, vvA, kvB, vvB;
        ATT_LOAD(kvA, vvA, 0);
        ATT_LOAD(kvB, vvB, 1);
        ATT_WAIT2();
        asm volatile("" : "+v"(bqv[0]), "+v"(bqv[1]), "+v"(bqv[2]), "+v"(bqv[3]));
        ATT_WRITE(kvA, vvA, 0);
        ATT_LOAD(kvA, vvA, 2);
        __syncthreads();
        auto tile_step = [&](const int it, v4u& kvN, v4u& vvN) __attribute__((always_inline)) {
            const int cur = it & 1;
            const bool local = it < nl; const int kp0 = q0 - 128 + 64 * (jl0 + it);
            const LAS bf16* Ks = Ks0 + cur * 9216; const LAS bf16* Vs = Ks + 4608;
            if (it + 1 < ntile) { ATT_WAIT2(); ATT_WRITE(kvN, vvN, cur ^ 1); }
            { const int i3 = it + 3 < ntile ? it + 3 : ntile - 1; ATT_LOAD(kvN, vvN, i3); }
            f32x16 st0, st1;
#pragma unroll
            for (int i = 0; i < 16; ++i) { st0[i] = 0.f; st1[i] = 0.f; }
#pragma unroll
            for (int s = 0; s < 4; ++s) {
                const bf16x8 a0 = *(const LAS bf16x8*)(Ks + r * 72 + 16 * s + 8 * h), a1 = *(const LAS bf16x8*)(Ks + (32 + r) * 72 + 16 * s + 8 * h);
                st0 = __builtin_amdgcn_mfma_f32_32x32x16_bf16(a0, __builtin_bit_cast(bf16x8, bqv[s]), st0, 0, 0, 0);
                st1 = __builtin_amdgcn_mfma_f32_32x32x16_bf16(a1, __builtin_bit_cast(bf16x8, bqv[s]), st1, 0, 0, 0);
            }
            const bool edge = local && (jl0 + it == 0 || jl0 + it == 4);
            if (edge) {
                const int dq = qrow - kp0 - 4 * h;
#pragma unroll
                for (int i = 0; i < 16; ++i) { const int d0 = dq - ((i & 3) + 8 * (i >> 2)), d1 = d0 - 32;
                    st0[i] = ((unsigned)(d0 + 128) > 256u) ? -1e30f : st0[i]; st1[i] = ((unsigned)(d1 + 128) > 256u) ? -1e30f : st1[i]; }
            }
            float mx = fmaxf(st0[0], st1[0]);
#pragma unroll
            for (int i = 1; i < 16; ++i) mx = __builtin_fmaxf(__builtin_fmaxf(mx, st0[i]), st1[i]);
            mx = fmaxf(mx, __shfl_xor(mx, 32));
            const float mn = fmaxf(m, mx), alpha = __builtin_amdgcn_exp2f(m - mn); m = mn;
#pragma unroll
            for (int i = 0; i < 16; ++i) { st0[i] = __builtin_amdgcn_exp2f(st0[i] - mn); st1[i] = __builtin_amdgcn_exp2f(st1[i] - mn); }
            f32x16 lsum;
#pragma unroll
            for (int i = 0; i < 16; ++i) lsum[i] = 0.f;
            if (!__all(alpha == 1.0f)) {
#pragma unroll
                for (int i = 0; i < 16; ++i) { o0[i] *= alpha; o1[i] *= alpha; } }
#pragma unroll
            for (int sp = 0; sp < 4; ++sp) {
                unsigned pw[4];
#pragma unroll
                for (int e = 0; e < 4; ++e) { const int i0 = 8 * (sp & 1) + 2 * e; pw[e] = (sp < 2) ? pg8::cvt_pk_bf16(st0[i0], st0[i0 + 1]) : pg8::cvt_pk_bf16(st1[i0], st1[i0 + 1]); }
                const bf16x8 pf = __builtin_bit_cast(bf16x8, (v4u){pw[0], pw[1], pw[2], pw[3]});
                lsum = __builtin_amdgcn_mfma_f32_32x32x16_bf16(__builtin_bit_cast(bf16x8, (v4u){0x3f803f80u, 0x3f803f80u, 0x3f803f80u, 0x3f803f80u}), pf, lsum, 0, 0, 0);
#pragma unroll
                for (int dt = 0; dt < 2; ++dt) {
                    const LAS bf16* vp = Vs + (32 * dt + r) * 72 + 16 * sp + 4 * h;
                    const v2u va = *(const LAS v2u*)vp, vb = *(const LAS v2u*)(vp + 8);
                    const bf16x8 vf = __builtin_bit_cast(bf16x8, (v4u){va.x, va.y, vb.x, vb.y});
                    if (dt == 0) o0 = __builtin_amdgcn_mfma_f32_32x32x16_bf16(vf, pf, o0, 0, 0, 0); else o1 = __builtin_amdgcn_mfma_f32_32x32x16_bf16(vf, pf, o1, 0, 0, 0);
                }
            }
            l = l * alpha + lsum[0];
            __syncthreads();
        };
#pragma unroll 1
        for (int it = 0;; it += 2) {
            tile_step(it, kvB, vvB);
            if (it + 1 >= ntile) break;
            tile_step(it + 1, kvA, vvA);
            if (it + 2 >= ntile) break;
        }
#undef ATT_KEY0
#undef ATT_WAIT2
#undef ATT_LOAD
#undef ATT_WRITE
        const float inv = 1.0f / l;
        bf16* op = O + tokq * D + head * 64 + 4 * h;
#pragma unroll
        for (int g = 0; g < 4; ++g) {
            v2u w0, w1; w0.x = pg8::cvt_pk_bf16(o0[4 * g] * inv, o0[4 * g + 1] * inv); w0.y = pg8::cvt_pk_bf16(o0[4 * g + 2] * inv, o0[4 * g + 3] * inv);
            w1.x = pg8::cvt_pk_bf16(o1[4 * g] * inv, o1[4 * g + 1] * inv); w1.y = pg8::cvt_pk_bf16(o1[4 * g + 2] * inv, o1[4 * g + 3] * inv);
            *(GAS v2u*)(op + 8 * g) = w0; *(GAS v2u*)(op + 32 + 8 * g) = w1;
        }
    }
}
__device__ __forceinline__ float sconv3(const bf16* p, int n, int L, float w0, float w1, float w2, float cb) {
    const float a = (n > 0) ? bf2f(p[n - 1]) : 0.f, b = bf2f(p[n]), c = (n < L - 1) ? bf2f(p[n + 1]) : 0.f;
    return cb + w0 * a + w1 * b + w2 * c;
}
struct HyRaw { v4u raw[4]; unsigned short lf[4], rt[4]; };
__device__ __forceinline__ void hy_stage_load(const bf16* p, HyRaw& R, int tid) {
#pragma unroll
    for (int ch = 0; ch < 2; ++ch)
#pragma unroll
        for (int b = 0; b < 2; ++b) {
            const int n0 = 8 * tid + 4096 * ch; const bf16* pb = p + (size_t)b * SEQ;
            R.raw[2 * ch + b] = *(const GAS v4u*)(pb + n0);
            R.lf[2 * ch + b] = n0 > 0 ? pb[n0 - 1] : (unsigned short)0; R.rt[2 * ch + b] = n0 + 8 < SEQ ? pb[n0 + 8] : (unsigned short)0;
        }
}
__device__ __forceinline__ void hy_stage_write(const HyRaw& R, float w0, float w1, float w2, float cb, LAS float* S, int tid) {
#pragma unroll
    for (int ch = 0; ch < 2; ++ch)
#pragma unroll
        for (int b = 0; b < 2; ++b) {
            const int n0 = 8 * tid + 4096 * ch; const v4u raw = R.raw[2 * ch + b];
            float x[10]; x[0] = bf2f(R.lf[2 * ch + b]); x[1] = bflo(raw.x); x[2] = bfhi(raw.x); x[3] = bflo(raw.y); x[4] = bfhi(raw.y); x[5] = bflo(raw.z); x[6] = bfhi(raw.z); x[7] = bflo(raw.w); x[8] = bfhi(raw.w); x[9] = bf2f(R.rt[2 * ch + b]);
            f32x4 lo, hi;
#pragma unroll
            for (int e = 0; e < 4; ++e) { lo[e] = cb + w0 * x[e] + w1 * x[e + 1] + w2 * x[e + 2]; hi[e] = cb + w0 * x[e + 4] + w1 * x[e + 5] + w2 * x[e + 6]; }
            *(LAS f32x4*)(S + b * 8192 + n0) = lo; *(LAS f32x4*)(S + b * 8192 + n0 + 4) = hi;
        }
}
__device__ __forceinline__ void hyena_phase(Frame& F, int j, bool with_ctx) {
    LAS cf2* X = (LAS cf2*)F.lds;
    LAS float* red = (LAS float*)(F.lds + USER_OFF + 1024);
    const int tid0 = F.tid;
    const bf16* Ut = (const bf16*)(F.ws + WS_UT); bf16* Zt = (bf16*)(F.ws + WS_ZT);
    const bf16* a3b = (const bf16*)(F.ws + WS_A3L) + (size_t)j * 8192 * 64; const float* a3c = (const float*)(F.ws + WS_A3C) + (size_t)j * 256 * 64;
    const float* wout = F.in[I_FWOUT] + (size_t)j * 64 * 4096; const float* convw = F.in[I_HCW] + (size_t)j * 3 * 3072; const float* convb = F.in[I_HCB] + (size_t)j * 3072;
    const float* biasd = F.in[I_HBD] + (size_t)j * 2 * 1024;
    LAS float* U4 = (LAS float*)(F.lds + USER_OFF + 2048);
    LAS float* nrm = (LAS float*)(F.lds + USER_OFF + 1536);
    LAS float* red8 = (LAS float*)(F.lds + USER_OFF + 1280);
#ifndef PROBE_HY_TAPS
#define PROBE_HY_TAPS 1
#endif
#pragma unroll 1
    for (int cc0 = 0; cc0 < 4; ++cc0) { const int c = F.vcu + 256 * cc0;
        if (cc0 == 0)
    {
        int tid = tid0; asm volatile("" : "+v"(tid));
        __syncthreads();
        for (int i = tid; i < 1024; i += NWAVES * 64) { const int cc = i >> 8, k = (i >> 2) & 63, q = i & 3; U4[i] = wout[(size_t)k * 4096 + q * 1024 + F.vcu + 256 * cc]; }
        __syncthreads();
        const int n = tid & 31, h = (tid >> 5) & 1, wv = tid >> 6, q = n & 3, cc = (n >> 2) & 3, sb = n >> 4, c = F.vcu + 256 * cc;
        bf16x8 bw[4];
#pragma unroll
        for (int f4 = 0; f4 < 4; ++f4) { unsigned pw[4];
#pragma unroll
            for (int e = 0; e < 4; ++e) { const int k0 = 16 * f4 + 8 * h + 2 * e; pw[e] = pk2(U4[cc * 256 + 4 * k0 + q], U4[cc * 256 + 4 * (k0 + 1) + q]); }
            bw[f4] = __builtin_bit_cast(bf16x8, (v4u){pw[0], pw[1], pw[2], pw[3]}); }
        const bf16x8 zero8 = __builtin_bit_cast(bf16x8, (v4u){0u, 0u, 0u, 0u});
        const float na = -(3.0701134573253945f + (15.350567286626973f - 3.0701134573253945f) * (float)c * (1.0f / 1023.0f)) * (1.0f / 8191.0f);
        const float r1 = expf(na), r2 = expf(2.0f * na), r3 = expf(3.0f * na);
        float sm = 0.f;
        float* tq = (float*)(F.ws + WS_TP) + (size_t)c * 2 * FFT_N + (size_t)(q & 1) * FFT_N + (q >> 1) * 8192;
#pragma unroll 1
        for (int i = 0; i < 16; ++i) {
            const int T0 = 64 * (wv + 8 * i);
            const bf16* ap = a3b + (size_t)T0 * 64 + 8 * (tid & 63);
            f32x16 acc;
#pragma unroll
            for (int e = 0; e < 16; ++e) acc[e] = 0.f;
#pragma unroll
            for (int s8 = 0; s8 < 2; ++s8)
#pragma unroll
                for (int f4 = 0; f4 < 4; ++f4)
                    acc = __builtin_amdgcn_mfma_f32_32x32x16_bf16(*(const GAS bf16x8*)(ap + (s8 * 4 + f4) * 512), sb == s8 ? bw[f4] : zero8, acc, 0, 0, 0);
#pragma unroll
            for (int g = 0; g < 4; ++g) { const int t = T0 + 32 * sb + 8 * g + 4 * h; const float d0 = expf(na * (float)t);
                f32x4 val = (f32x4){acc[4 * g] * d0, acc[4 * g + 1] * (d0 * r1), acc[4 * g + 2] * (d0 * r2), acc[4 * g + 3] * (d0 * r3)};
                sm += ((q >= 2 && t == 0) ? 0.f : fabsf(val.x)) + fabsf(val.y) + fabsf(val.z) + fabsf(val.w);
                *(GAS f32x4*)(tq + t) = val; }
        }
        sm += __shfl_xor(sm, 2); sm += __shfl_xor(sm, 16); sm += __shfl_xor(sm, 32);
        if ((tid & 50) == 0) red8[wv * 8 + 2 * cc + (q & 1)] = sm;
        __syncthreads();
        if (tid < 8) { float t8 = 0.f;
#pragma unroll
            for (int w = 0; w < NWAVES; ++w) t8 += red8[w * 8 + tid]; nrm[tid] = t8; }
        VM_WAIT();
        __syncthreads();
    }
        int tid = tid0; asm volatile("" : "+v"(tid));
        float* tp = (float*)(F.ws + WS_TP) + (size_t)c * 2 * FFT_N;
        float* Gc = (float*)(F.ws + WS_G) + (size_t)c * 2 * FFT_N * 2;
        __syncthreads();
        const float sum0 = nrm[2 * cc0], sum1 = nrm[2 * cc0 + 1];
        LAS float* U = U4 + cc0 * 256;
        const float absd = 3.0701134573253945f + (15.350567286626973f - 3.0701134573253945f) * (float)c * (1.0f / 1023.0f);
#pragma unroll 1
#ifndef PROBE_HY_SPEC
#define PROBE_HY_SPEC 2
#endif
        for (int o4 = 0; o4 < PROBE_HY_SPEC; ++o4) { const int o = o4 & 1;
            fft_fwd_first_taps(X, (const GAS float*)(tp + (size_t)o * FFT_N), 1.0f / (o == 0 ? sum0 : sum1), tid); __syncthreads();
            fft_fwd_double<1>(X, tid); __syncthreads();
            fft_fwd_double<3>(X, tid); __syncthreads();
            fft_mid_store(X, (GAS cf4*)(Gc + (size_t)o * FFT_N * 2), 1.0f / (float)FFT_N, biasd[o * 1024 + c], tid); __syncthreads();
        }
        VM_WAIT();
        __syncthreads();
        const float cwv0 = convw[2048 + c], cwv1 = convw[3072 + 2048 + c], cwv2 = convw[6144 + 2048 + c], cbv = convb[2048 + c];
        const float cwa0 = convw[c], cwa1 = convw[3072 + c], cwa2 = convw[6144 + c], cba = convb[c];
        const float cwb0 = convw[1024 + c], cwb1 = convw[3072 + 1024 + c], cwb2 = convw[6144 + 1024 + c], cbb = convb[1024 + c];
        const float d0 = biasd[c], d1 = biasd[1024 + c];
#ifndef PROBE_HY_PAIRS
#define PROBE_HY_PAIRS 4
#endif
        HyRaw rv, rg;
        hy_stage_load(Ut + (size_t)(2048 + c) * TT, rv, tid);
#pragma unroll 1
        for (int pr8 = 0; pr8 < PROBE_HY_PAIRS; ++pr8) { const int pr = pr8 & 3;
            const size_t tb0 = (size_t)(2 * pr) * SEQ;
            LAS float* S = (LAS float*)F.lds;
            float z0[16], z1[16];
            __syncthreads();
            hy_stage_write(rv, cwv0, cwv1, cwv2, cbv, S, tid); __syncthreads();
#pragma unroll
            for (int i = 0; i < 16; ++i) { z0[i] = S[tid + 512 * i]; z1[i] = S[8192 + tid + 512 * i]; }
#pragma unroll 1
            for (int o = 0; o < 2; ++o) {
                __syncthreads();
                fft_fwd_first(X, z0, z1, tid);
                hy_stage_load(Ut + (size_t)(o == 0 ? c : 1024 + c) * TT + tb0, rg, tid);
                if (o == 1) hy_stage_load(Ut + (size_t)(2048 + c) * TT + (size_t)(2 * ((pr8 + 1) & 3)) * SEQ, rv, tid);
                __syncthreads();
                fft_fwd_double<1>(X, tid); __syncthreads();
                fft_fwd_double<3>(X, tid); __syncthreads();
                fft_mid_mul(X, (const GAS cf4*)(Gc + (size_t)o * FFT_N * 2), tid); __syncthreads();
                fft_inv_double<3>(X, tid); __syncthreads();
                fft_inv_double<1>(X, tid); __syncthreads();
                fft_inv_last(X, z0, z1, tid); __syncthreads();
                hy_stage_write(rg, o == 0 ? cwa0 : cwb0, o == 0 ? cwa1 : cwb1, o == 0 ? cwa2 : cwb2, o == 0 ? cba : cbb, S, tid); __syncthreads();
#pragma unroll
                for (int i = 0; i < 16; ++i) { z0[i] *= S[tid + 512 * i]; z1[i] *= S[8192 + tid + 512 * i]; }
            }
            __syncthreads();
#pragma unroll
            for (int i = 0; i < 16; ++i) { S[tid + 512 * i] = z0[i]; S[8192 + tid + 512 * i] = z1[i]; }
            __syncthreads();
#pragma unroll
            for (int ch = 0; ch < 2; ++ch)
#pragma unroll
                for (int b = 0; b < 2; ++b) { const int n0 = 8 * tid + 4096 * ch; const f32x4 lo = *(const LAS f32x4*)(S + b * 8192 + n0), hi = *(const LAS f32x4*)(S + b * 8192 + n0 + 4);
                    v4u w; w.x = pk2(lo.x, lo.y); w.y = pk2(lo.z, lo.w); w.z = pk2(hi.x, hi.y); w.w = pk2(hi.z, hi.w);
                    *(GAS v4u*)(Zt + (size_t)c * TT + tb0 + (size_t)b * SEQ + n0) = w; }
        }
        if (!with_ctx) continue;
        asm volatile("" : "+v"(tid));
        __syncthreads();
        LAS float* tap0 = (LAS float*)F.lds; LAS float* tap1 = tap0 + 512; LAS float* vb = tap0 + 1024; LAS float* zb = tap0 + 1024 + 2048;
        {
            float f0 = 0.f, f1 = 0.f, b0 = 0.f, b1 = 0.f, s0 = 0.f, s1 = 0.f;
            if (tid < 256) { const int t = tid; const GAS f32x4* ar = (const GAS f32x4*)(a3c + (size_t)t * 64); f32x4 acc = (f32x4){0.f, 0.f, 0.f, 0.f};
#pragma unroll 4
                for (int k4 = 0; k4 < 16; ++k4) { const f32x4 a = ar[k4];
                    acc += a[0] * *(const LAS f32x4*)(U + 16 * k4) + a[1] * *(const LAS f32x4*)(U + 16 * k4 + 4) + a[2] * *(const LAS f32x4*)(U + 16 * k4 + 8) + a[3] * *(const LAS f32x4*)(U + 16 * k4 + 12); }
                const float dec = expf(-((float)t * (1.0f / 255.0f)) * absd);
                f0 = acc[0] * dec; f1 = acc[1] * dec; b0 = acc[2] * dec; b1 = acc[3] * dec;
                s0 = fabsf(f0) + (t > 0 ? fabsf(b0) : 0.f); s1 = fabsf(f1) + (t > 0 ? fabsf(b1) : 0.f); }
            block_sum2(F, red, s0, s1);
            if (tid < 256) { const float i0 = 1.0f / s0, i1 = 1.0f / s1; tap0[256 + tid] = f0 * i0; tap1[256 + tid] = f1 * i1; if (tid > 0) { tap0[256 - tid] = b0 * i0; tap1[256 - tid] = b1 * i1; } else { tap0[0] = 0.f; tap1[0] = 0.f; } }
        }
        const int cb_ = tid >> 6, n0 = (tid & 63) * 4;
        const size_t tcx = (size_t)TL + (size_t)cb_ * CTXL;
        float vloc[4], zloc[4];
        { const bf16* pv = Ut + (size_t)(2048 + c) * TT + tcx;
#pragma unroll
          for (int e = 0; e < 4; ++e) { vloc[e] = sconv3(pv, n0 + e, CTXL, cwv0, cwv1, cwv2, cbv); vb[cb_ * 256 + n0 + e] = vloc[e]; } }
        __syncthreads();
        { const bf16* pa = Ut + (size_t)c * TT + tcx; float acc[4] = {0.f, 0.f, 0.f, 0.f};
          for (int mI = 0; mI < 256; ++mI) { const float vv = vb[cb_ * 256 + mI];
#pragma unroll
              for (int e = 0; e < 4; ++e) acc[e] += tap0[256 + n0 + e - mI] * vv; }
#pragma unroll
          for (int e = 0; e < 4; ++e) { zloc[e] = sconv3(pa, n0 + e, CTXL, cwa0, cwa1, cwa2, cba) * (acc[e] + vloc[e] * d0); zb[cb_ * 256 + n0 + e] = zloc[e]; } }
        __syncthreads();
        { const bf16* pb = Ut + (size_t)(1024 + c) * TT + tcx; float acc[4] = {0.f, 0.f, 0.f, 0.f};
          for (int mI = 0; mI < 256; ++mI) { const float vv = zb[cb_ * 256 + mI];
#pragma unroll
              for (int e = 0; e < 4; ++e) acc[e] += tap1[256 + n0 + e - mI] * vv; }
#pragma unroll
          for (int e = 0; e < 4; ++e) { const float ov = sconv3(pb, n0 + e, CTXL, cwb0, cwb1, cwb2, cbb) * (acc[e] + zloc[e] * d1); Zt[(size_t)c * TT + tcx + n0 + e] = (bf16)f2bf(ov); } }
    }
}
__device__ __forceinline__ void transpose_phase(Frame& F, int ncols) {
    const bf16* Zt = (const bf16*)(F.ws + WS_ZT); bf16* Z = (bf16*)(F.ws + WS_O);
    LAS bf16* T = (LAS bf16*)(F.lds + F.wave * 16384);
    const int gw = F.vcu * NWAVES + F.wave, NGW = F.G * NWAVES, lane = F.lane;
    const int nitems = 16 * (ncols / 64);
    v4u tv[8];
    { const int it0 = gw < nitems ? gw : 0, ct = it0 & 15, tt = it0 >> 4;
#pragma unroll
      for (int i = 0; i < 8; ++i) { const int cr = (lane >> 3) + 8 * i, ch = lane & 7; tv[i] = *(const GAS v4u*)(Zt + (size_t)(ct * 64 + cr) * TT + (size_t)tt * 64 + ch * 8); } }
    for (int item = gw; item < nitems; item += NGW) {
        const int ct = item & 15, tt = item >> 4;
#pragma unroll
        for (int i = 0; i < 8; ++i) { const int cr = (lane >> 3) + 8 * i, ch = lane & 7; *(LAS v4u*)(T + cr * 72 + ch * 8) = tv[i]; }
        { const int itn = item + NGW < nitems ? item + NGW : item, ctn = itn & 15, ttn = itn >> 4;
#pragma unroll
          for (int i = 0; i < 8; ++i) { const int cr = (lane >> 3) + 8 * i, ch = lane & 7; tv[i] = *(const GAS v4u*)(Zt + (size_t)(ctn * 64 + cr) * TT + (size_t)ttn * 64 + ch * 8); } }
        LDS_WAIT(); asm volatile("" ::: "memory");
#pragma unroll
        for (int i = 0; i < 8; ++i) { const int tok = (lane >> 3) + 8 * i, cc = (lane & 7) * 8;
            unsigned short e[8];
#pragma unroll
            for (int q = 0; q < 8; ++q) e[q] = T[(cc + q) * 72 + tok];
            v4u o; o.x = e[0] | ((unsigned)e[1] << 16); o.y = e[2] | ((unsigned)e[3] << 16); o.z = e[4] | ((unsigned)e[5] << 16); o.w = e[6] | ((unsigned)e[7] << 16);
            *(GAS v4u*)(Z + (size_t)(tt * 64 + tok) * D + ct * 64 + cc) = o; }
        LDS_WAIT(); asm volatile("" ::: "memory");
    }
}

__device__ __forceinline__ void router_phase(Frame& F, int l) {
    const int nrows = rows_of_layer(l);
    constexpr int RR = 6;
    LAS bf16* Whi = (LAS bf16*)F.lds; LAS bf16* Wlo = Whi + 32 * 1024;
    LAS int* cnt = (LAS int*)(F.lds + USER_OFF); LAS int* base = cnt + 32; LAS int* rec = cnt + 64;
    const int tid = F.tid, lane = F.lane, wave = F.wave;
    const float* rw = F.in[I_RW] + (size_t)l * 1024 * 32;
    __syncthreads();
#pragma unroll 1
    for (int i0 = tid; i0 < 1024 * 32; i0 += 16 * NWAVES * 64) { float wv[16];
#pragma unroll
        for (int u = 0; u < 16; ++u) wv[u] = rw[i0 + u * NWAVES * 64];
#pragma unroll
        for (int u = 0; u < 16; ++u) { const int i = i0 + u * NWAVES * 64, k = i >> 5, e = i & 31; const float w = wv[u]; const unsigned hi = f2bf(w), lo = f2bf(w - bflo(hi));
            const int idx = e * 1024 + ((((k >> 3) ^ (e & 15)) << 3) | (k & 7)); Whi[idx] = (bf16)hi; Wlo[idx] = (bf16)lo; } }
    if (tid < 32) cnt[tid] = 0;
    __syncthreads();
    const float* mod = (const float*)(F.ws + WS_MOD) + (size_t)l * 9 * 6144;
    const float* gain = F.in[I_NFFN] + (size_t)l * D;
    const int gw = F.vcu * NWAVES + wave, NGW = F.G * NWAVES;
    bf16* H = (bf16*)(F.ws + WS_H);
    v4u rawn[RR][2];
#pragma unroll
    for (int r = 0; r < RR; ++r) { const int row = gw + r * NGW < nrows ? gw + r * NGW : gw;
        const GAS v4u* xr = (const GAS v4u*)((const bf16*)(F.ws + WS_XB) + (size_t)row * D) + lane; rawn[r][0] = xr[0]; rawn[r][1] = xr[64]; }
    for (int row0 = gw; row0 < nrows; row0 += RR * NGW) {
        f32x4 v[RR][4]; float s2[RR];
#pragma unroll
        for (int r = 0; r < RR; ++r) {
#pragma unroll
            for (int jj = 0; jj < 2; ++jj) row8_unpack(rawn[r][jj], v[r][2 * jj], v[r][2 * jj + 1]); }
        { const int nx0 = row0 + RR * NGW < nrows ? row0 + RR * NGW : row0;
#pragma unroll
          for (int r = 0; r < RR; ++r) { const int row = nx0 + r * NGW < nrows ? nx0 + r * NGW : nx0;
              const GAS v4u* xr = (const GAS v4u*)((const bf16*)(F.ws + WS_XB) + (size_t)row * D) + lane; rawn[r][0] = xr[0]; rawn[r][1] = xr[64]; } }
#pragma unroll
        for (int r = 0; r < RR; ++r) { s2[r] = 0.f;
#pragma unroll
            for (int jj = 0; jj < 4; ++jj) s2[r] += (v[r][jj].x * v[r][jj].x + v[r][jj].y * v[r][jj].y) + (v[r][jj].z * v[r][jj].z + v[r][jj].w * v[r][jj].w); }
#pragma unroll
        for (int o = 1; o < 64; o <<= 1) {
#pragma unroll
            for (int r = 0; r < RR; ++r) s2[r] += __shfl_xor(s2[r], o); }
#pragma unroll
        for (int r = 0; r < RR; ++r) { const int row = row0 + r * NGW < nrows ? row0 + r * NGW : row0;
            const float rstd = 1.0f / sqrtf(s2[r] * (1.0f / D) + NORM_EPS);
            const float* mr = mod + (size_t)mod_row(row) * 6144;
#pragma unroll
            for (int jj = 0; jj < 2; ++jj) { f32x4 hq[2];
#pragma unroll
                for (int hf = 0; hf < 2; ++hf) hq[hf] = v[r][2 * jj + hf] * rstd * ROW8_F32(gain, jj, hf, lane) * (ROW8_F32(mr + 4 * 1024, jj, hf, lane) + 1.0f) + ROW8_F32(mr + 3 * 1024, jj, hf, lane);
                ((GAS v4u*)(H + (size_t)row * D))[64 * jj + lane] = row8_pack(hq[0], hq[1]); } }
    }
    VM_WAIT();
    asm volatile("" ::: "memory");
    const int r32 = lane & 31, hh2 = lane >> 5;
    const float rb = F.in[I_RB][l * 32 + r32];
    const int nmine = (nrows - gw + NGW - 1) / NGW;
    for (int tile = 0; tile * 32 < nmine; ++tile) {
        const int irow = 32 * tile + r32; const size_t arow = (size_t)gw + (size_t)NGW * (irow < nmine ? irow : 0);
        const bf16* ap = H + arow * D + 8 * hh2;
        const LAS bf16* bh = Whi + r32 * 1024; const LAS bf16* bl = Wlo + r32 * 1024;
        f32x16 acc;
#pragma unroll
        for (int i = 0; i < 16; ++i) acc[i] = 0.f;
#pragma unroll 1
        for (int s0 = 0; s0 < 64; s0 += 32) {
            bf16x8 a[32];
#pragma unroll
            for (int u = 0; u < 32; ++u) a[u] = *(const GAS bf16x8*)(ap + 16 * (s0 + u));
            __builtin_amdgcn_sched_barrier(0);
#pragma unroll
            for (int u = 0; u < 32; ++u) {
                const int cb = ((2 * (s0 + u) + hh2) ^ (r32 & 15)) << 3;
                const bf16x8 b1 = *(const LAS bf16x8*)(bh + cb), b2 = *(const LAS bf16x8*)(bl + cb);
                acc = __builtin_amdgcn_mfma_f32_32x32x16_bf16(a[u], b1, acc, 0, 0, 0);
                acc = __builtin_amdgcn_mfma_f32_32x32x16_bf16(a[u], b2, acc, 0, 0, 0);
            }
            __builtin_amdgcn_sched_barrier(0);
        }
#pragma unroll 2
        for (int i = 0; i < 16; ++i) {
            if (32 * tile + (i & 3) + 8 * (i >> 2) >= nmine) continue;
            const float mine = acc[i] + rb; int rank = 0;
#pragma unroll 8
            for (int e2 = 0; e2 < 32; ++e2) { const float sv = __shfl(mine, (lane & 32) | e2); rank += (sv > mine || (sv == mine && e2 < r32)) ? 1 : 0; }
            const int rr = (i & 3) + 8 * (i >> 2);
#pragma unroll
            for (int hsel = 0; hsel < 2; ++hsel) {
                const int it = 32 * tile + rr + 4 * hsel;
                float tv[4]; int te[4];
#pragma unroll
                for (int k = 0; k < 4; ++k) { const unsigned long long mk = __ballot(rank == k) & (hsel ? 0xffffffff00000000ull : 0x00000000ffffffffull); const int src = __ffsll((long long)mk) - 1;
                    te[k] = src & 31; tv[k] = __builtin_bit_cast(float, __builtin_amdgcn_readlane(__builtin_bit_cast(int, mine), src)); }
                if (it < nmine) {
                    const size_t row = (size_t)gw + (size_t)NGW * it;
                    const float e1 = __expf(tv[1] - tv[0]), e2 = __expf(tv[2] - tv[0]), e3 = __expf(tv[3] - tv[0]), isum = 1.0f / (1.0f + e1 + e2 + e3);
                    if (lane == 0) *(GAS f32x4*)((float*)(F.ws + WS_GATE) + row * 4) = (f32x4){isum, e1 * isum, e2 * isum, e3 * isum};
                    if (lane < 4) { const int tel = lane == 0 ? te[0] : lane == 1 ? te[1] : lane == 2 ? te[2] : te[3];
                        const int rk = __hip_atomic_fetch_add(cnt + tel, 1, __ATOMIC_RELAXED, __HIP_MEMORY_SCOPE_WORKGROUP); rec[(wave * 64 + it) * 4 + lane] = tel | (rk << 8); }
                }
            }
        }
    }
    __syncthreads();
    if (tid < 32) base[tid] = (int)__hip_atomic_fetch_add((unsigned*)(F.ctl + CW_ECNT + l * 32 + tid), (unsigned)cnt[tid], RLX_AGENT);
    __syncthreads();
    for (int it = 0; it < nmine; ++it) {
        if (lane < 4) { const int rc = rec[(wave * 64 + it) * 4 + lane], e = rc & 255; ((int*)(F.ws + WS_POS))[((size_t)gw + (size_t)NGW * it) * 4 + lane] = e | ((base[e] + (rc >> 8)) << 8); }
    }
}
__device__ __forceinline__ void load_blkstart(Frame& F, int l, LAS int* blkstart) {
    __syncthreads();
    if (F.tid < 32) {
        const unsigned c = __hip_atomic_load((unsigned*)(F.ctl + CW_ECNT + l * 32 + F.tid), RLX_AGENT); const int nb = (int)((c + 255u) >> 8); int s = nb;
#pragma unroll
        for (int o = 1; o < 32; o <<= 1) { const int t = __shfl_up(s, o); if (F.tid >= o) s += t; }
        blkstart[F.tid] = s - nb; if (F.tid == 31) blkstart[32] = s; }
    __syncthreads();
    for (int rb = F.tid; rb < MAXBLK; rb += NWAVES * 64) { int e = 0;
#pragma unroll 1
        for (int q = 1; q < 32; ++q) e += (blkstart[q] <= rb) ? 1 : 0;
        blkstart[64 + rb] = e; }
    __syncthreads();
}
__device__ __forceinline__ void index_phase(Frame& F, int l) {
    const int nrows = rows_of_layer(l);
    LAS int* blkstart = (LAS int*)(F.lds + USER_OFF + 8192);
    load_blkstart(F, l, blkstart);
    const int* POS = (const int*)(F.ws + WS_POS); int* DEST = (int*)(F.ws + WS_DEST); int* RSRC = (int*)(F.ws + WS_RSRC);
    const int gt = F.vcu * (NWAVES * 64) + F.tid, NT = F.G * NWAVES * 64;
    for (int a = gt; a < nrows * 4; a += NT) { const int pk = POS[a], e = pk & 255, rk = pk >> 8, d = blkstart[e] * 256 + rk; DEST[a] = d; RSRC[d] = a >> 2; }
    if (F.bx < 32) { const int e = F.bx; const int cnt = (int)__hip_atomic_load((unsigned*)(F.ctl + CW_ECNT + l * 32 + e), RLX_AGENT), end = (blkstart[e + 1] - blkstart[e]) * 256;
        for (int p2 = cnt + F.tid; p2 < end; p2 += NWAVES * 64) RSRC[blkstart[e] * 256 + p2] = 0; }
}
__device__ __forceinline__ void combine_phase(Frame& F, int l, bool dry = false) {
    constexpr int RR = 3;
    const int gw = F.vcu * NWAVES + F.wave, NGW = F.G * NWAVES, lane = F.lane;
    const bf16* YS = (const bf16*)(F.ws + WS_YS); const int* POS = (const int*)(F.ws + WS_DEST); const float* GT = (const float*)(F.ws + WS_GATE);
    const float* mod = (const float*)(F.ws + WS_MOD);
    const int nrows = rows_of_layer(l);
    v4i psn[RR]; f32x4 gtn[RR];
#pragma unroll
    for (int r = 0; r < RR; ++r) { const int rw = gw + r * NGW < nrows ? gw + r * NGW : gw; psn[r] = *(const GAS v4i*)(POS + (size_t)rw * 4); gtn[r] = *(const GAS f32x4*)(GT + (size_t)rw * 4); }
    for (int row0 = gw; row0 < nrows; row0 += RR * NGW) {
        v4i ps[RR]; f32x4 gt[RR]; f32x4 v[RR][4]; int rows[RR];
#pragma unroll
        for (int r = 0; r < RR; ++r) { rows[r] = row0 + r * NGW < nrows ? row0 + r * NGW : row0; ps[r] = psn[r]; gt[r] = gtn[r]; }
        { const int nx0 = row0 + RR * NGW < nrows ? row0 + RR * NGW : row0;
#pragma unroll
          for (int r = 0; r < RR; ++r) { const int rw = nx0 + r * NGW < nrows ? nx0 + r * NGW : nx0; psn[r] = *(const GAS v4i*)(POS + (size_t)rw * 4); gtn[r] = *(const GAS f32x4*)(GT + (size_t)rw * 4); } }
#pragma unroll
        for (int r = 0; r < RR; ++r) { const int row = rows[r];
            const GAS v4u* xr = (const GAS v4u*)((const bf16*)(F.ws + WS_XB) + (size_t)row * D) + lane;
            const float* g2 = mod + ((size_t)l * 9 + mod_row(row)) * 6144 + 5 * 1024;
#pragma unroll
            for (int jj = 0; jj < 2; ++jj) {
                f32x4 y0 = (f32x4){0.f, 0.f, 0.f, 0.f}, y1 = y0;
#pragma unroll
                for (int k = 0; k < 4; ++k) { f32x4 a, b; row8_unpack(*(const GAS v4u*)(YS + (size_t)ps[r][k] * D + 512 * jj + 8 * lane), a, b); y0 += gt[r][k] * a; y1 += gt[r][k] * b; }
                f32x4 xa, xb2; row8_unpack(xr[64 * jj], xa, xb2);
                v[r][2 * jj] = xa + ROW8_F32(g2, jj, 0, lane) * y0; v[r][2 * jj + 1] = xb2 + ROW8_F32(g2, jj, 1, lane) * y1;
            } }
#pragma unroll
        for (int r = 0; r < RR; ++r) { const int row = rows[r];
            if (r > 0 && row0 + r * NGW >= nrows) continue;
            bf16* xw = (bf16*)(F.ws + (dry ? WS_ACT : WS_XB)) + (size_t)row * D; bf16* hw = (bf16*)(F.ws + (dry ? WS_ACT + 270 * MiB : WS_H)) + (size_t)row * D;
            if (l < DEPTH - 1) {
#pragma unroll
                for (int jj = 0; jj < 2; ++jj) ((GAS v4u*)xw)[64 * jj + lane] = row8_pack(v[r][2 * jj], v[r][2 * jj + 1]);
                const float* mr = mod + ((size_t)(l + 1) * 9 + mod_row(row)) * 6144;
                norm_mod_store(F, v[r], F.in[I_NMIX] + (size_t)(l + 1) * D, mr, mr + 1024, hw);
            } else {
                float s2 = 0.f;
#pragma unroll
                for (int jj = 0; jj < 4; ++jj) s2 += (v[r][jj].x * v[r][jj].x + v[r][jj].y * v[r][jj].y) + (v[r][jj].z * v[r][jj].z + v[r][jj].w * v[r][jj].w);
                const float rstd = 1.0f / sqrtf(wave_sum(s2) * (1.0f / D) + NORM_EPS);
#pragma unroll
                for (int q = 0; q < 4; ++q) ((GAS f32x4*)(dry ? (float*)(F.ws + WS_ACT) + (size_t)row * D : F.out + (size_t)row * D))[128 * (q >> 1) + 2 * lane + (q & 1)] = v[r][q] * rstd * ROW8_F32(F.in[I_FNORM], q >> 1, q & 1, lane);
            }
        }
    }
}
constexpr int N_PHASES = 1 + 10 * DEPTH;
#ifndef PG8_SP2
#define PG8_SP2 true
#endif
#ifndef PG8_ALIGN_EPI
#define PG8_ALIGN_EPI true
#endif
__host__ __device__ inline bool phase_exists(int ph) { if (ph == 0) return true; const int l = (ph - 1) / 10, k = (ph - 1) % 10; return !((k == 0 && l != 0) || (k == 3 && (l & 1) == 0)); }
struct Args { const float* in[N_IN]; float* out; unsigned char* ws; int ph_lo, ph_hi, use_bar, pad; };
__global__ void __launch_bounds__(NWAVES * 64, 2) fwd_kernel(Args args) {
    extern __shared__ __attribute__((aligned(16))) unsigned char lds[];
    Frame F;
    F.lds = (LAS unsigned char*)lds;
    F.MISC = (volatile LAS unsigned*)(F.lds + MISC_OFF);
    F.tid = threadIdx.x; F.lane = F.tid & 63; F.wave = __builtin_amdgcn_readfirstlane(F.tid >> 6);
    F.G = gridDim.x; { const int bx = blockIdx.x; F.vcu = (F.G % 8 == 0) ? (bx % 8) * (F.G / 8) + bx / 8 : bx; }
    const KAS Args* ap = (const KAS Args*)__builtin_amdgcn_kernarg_segment_ptr();
    F.in = ap->in; F.out = ap->out; F.ws = ap->ws;
    F.ctl = (gu32*)(F.ws + WS_CTL);
    const int use_bar = ap->use_bar;
    for (int u = F.tid; u < (USER_OFF - LDSCTL_OFF) / 4; u += NWAVES * 64) ((LAS unsigned*)(F.lds + LDSCTL_OFF))[u] = 0u;
    __syncthreads();
    XcdBarrier bar; bar.bar = (unsigned*)(F.ctl + CW_BAR); bar.x = 0; bar.st = nullptr;
    if (use_bar) bar = xcd_barrier_post((unsigned*)(F.ctl + CW_BAR), F.MISC + 8);
    const int hi = ap->ph_hi;
    LAS int* blkstart = (LAS int*)(F.lds + USER_OFF + 8192);
#ifndef PROBE_REP_MASK
#define PROBE_REP_MASK 0
#define PROBE_REP_KIND 2
#endif
    int rep_done = 0;
#pragma unroll 1
    for (int ph = ap->ph_lo; ph < hi; ++ph) {
        if (!phase_exists(ph)) continue;
        { int t_ = threadIdx.x; asm volatile("" : "+v"(t_)); F.tid = t_; F.lane = t_ & 63; F.wave = __builtin_amdgcn_readfirstlane(t_ >> 6);
          const KAS Args* a_ = ap; asm volatile("" : "+s"(a_)); F.in = a_->in;
          unsigned char* w_ = a_->ws; asm volatile("" : "+s"(w_)); F.ws = w_; float* o_ = a_->out; asm volatile("" : "+s"(o_)); F.out = o_;
          int v_ = F.vcu; asm volatile("" : "+s"(v_)); F.vcu = v_; int g_ = (int)gridDim.x; asm volatile("" : "+s"(g_)); F.G = g_; int b_ = (int)blockIdx.x; asm volatile("" : "+s"(b_)); F.bx = b_; }
        const int l = ph == 0 ? 0 : (ph - 1) / 10, k = ph == 0 ? -1 : (ph - 1) % 10, kind = l & 1, j = l >> 1;
        if (k == -1) {
#ifndef NO_P0
            p0_prologue(F);
#endif
        }
        else if (k == 0) norm0_phase(F);
        else if (k == 2) {
#ifndef NO_ATTN
            if (kind == 0) attn_phase(F, j, l == 0 ? 4096 + 128 : 4096);
#endif
#ifndef NO_HY
            if (kind == 1) hyena_phase(F, j, l == 1);
#endif
        }
#ifndef NO_TR
        else if (k == 3) transpose_phase(F, rows_of_layer(l));
#endif
#ifndef NO_ROUTER
        else if (k == 5) router_phase(F, l);
#endif
#ifndef NO_GATHER
        else if (k == 6) index_phase(F, l);
#endif
#ifndef NO_COMB
        else if (k == 9) combine_phase(F, l, ((PROBE_REP_MASK >> 10) & 1) != 0 && !rep_done);
#endif
        else if (k == 1 || k == 4 || k == 7 || k == 8) {
            pg8::Gemm g; pg8::AnyOrder S; pg8::EpiAny E;
            S.moe = 0; S.rb2e = blkstart + 64; S.nblk = 0; S.lg = 0; S.wbase = l * 32;
            E.bslot = (PG8_LAS float*)(F.lds + USER_OFF); E.ldc = TT; E.O = nullptr; E.f0 = nullptr; E.f1 = nullptr; E.p0 = nullptr; E.p1 = nullptr; E.p2 = nullptr; E.p3 = nullptr;
            if (k == 1 && kind == 0) {
                g = pg8::Gemm{(const bf16*)(F.ws + WS_H), (const bf16*)(F.ws + WS_WQK) + (size_t)j * QKD * 1024, TT, QKD, D}; S.so.init(TT, QKD, F.G, F.bx);
                E.mode = pg8::EPI_QK; E.O = (bf16*)(F.ws + WS_QK); E.p0 = F.in[I_ABQKV] + (size_t)j * 1536; E.p1 = (const float*)(F.ws + WS_ROPE);
            } else if (k == 1) {
                g = pg8::Gemm{(const bf16*)(F.ws + WS_WHIN) + (size_t)j * 3072 * 1024, (const bf16*)(F.ws + WS_H), 3072, rows_of_layer(l), D}; S.so.init(3072, rows_of_layer(l), F.G, F.bx);
                E.mode = pg8::EPI_T; E.O = (bf16*)(F.ws + WS_UT); E.p0 = F.in[I_HBIN] + (size_t)j * 3072;
            } else if (k == 4) {
                g = pg8::Gemm{(const bf16*)(F.ws + WS_O), kind == 0 ? (const bf16*)(F.ws + WS_WAO) + (size_t)j * 1024 * 1024 : (const bf16*)(F.ws + WS_WHO) + (size_t)j * 1024 * 1024, rows_of_layer(l), D, D};
                S.so.init(rows_of_layer(l), D, F.G, F.bx);
                E.mode = pg8::EPI_RES; E.p0 = l == 0 ? F.in[I_X] : nullptr; E.p1 = l == 0 ? F.in[I_CTX] : nullptr; E.O = (bf16*)(F.ws + WS_XB);
                E.p2 = kind == 0 ? F.in[I_ABO] + (size_t)j * 1024 : F.in[I_HBO] + (size_t)j * 1024; E.p3 = (const float*)(F.ws + WS_MOD) + (size_t)l * 9 * 6144 + 2 * 1024;
            } else {
                load_blkstart(F, l, blkstart);
                S.moe = 1; S.nblk = blkstart[32]; S.so.G = F.G; S.so.c = F.bx; S.so.nM = 0; S.so.nN = 0; S.so.nwg = 0;
                if (k == 7) { g = pg8::Gemm{(const bf16*)(F.ws + WS_H), (const bf16*)(F.ws + WS_WGU), MAXROWS, 2048, D, (const int*)(F.ws + WS_RSRC)}; S.lg = 3; E.mode = pg8::EPI_SWIGLU; E.O = (bf16*)(F.ws + WS_ACT); E.p0 = F.in[I_BGU] + (size_t)l * 32 * 2048; }
                else { g = pg8::Gemm{(const bf16*)(F.ws + WS_ACT), (const bf16*)(F.ws + WS_WDN), MAXROWS, 1024, D}; S.lg = 2; E.mode = pg8::EPI_DOWN; E.O = (bf16*)(F.ws + WS_YS); E.p0 = F.in[I_BDN] + (size_t)l * 32 * 1024; }
            }
#ifndef NO_G1
            pg8::gemm_phase<pg8::EpiAny, pg8::AnyOrder, PG8_ALIGN_EPI, PG8_SP2>(F.lds + RING_OFF, g, S, E);
#endif
        }
        if (use_bar && ph != N_PHASES - 1) xcd_barrier(bar);
#ifdef PROBE_DOUBLE_BAR
        if (use_bar && ph != N_PHASES - 1) xcd_barrier(bar);
#endif
        if (PROBE_REP_MASK != 0) { if (((PROBE_REP_MASK >> (k + 1)) & 1) && (PROBE_REP_KIND == 2 || kind == PROBE_REP_KIND) && !rep_done) { rep_done = 1; --ph;
                if (k == 5) { if (F.bx == 0 && F.tid < 32) __hip_atomic_store((unsigned*)(F.ctl + CW_ECNT + l * 32 + F.tid), 0u, RLX_AGENT); xcd_barrier(bar); }
            } else rep_done = 0; }
    }
}

extern "C" void kernel_launch(void* const* d_in, const int* in_sizes, int n_in, void* d_out, int out_size, void* d_ws, size_t ws_size, hipStream_t stream) {
    static int grid = 0;
    if (grid == 0) {
        if (n_in != N_IN || out_size != TL * D || ws_size < WS_END) { fprintf(stderr, "kernel_launch: unexpected shapes (n_in %d, out %d, ws %zu < %zu)\n", n_in, out_size, ws_size, (size_t)WS_END); grid = -1; return; }
        if (hipFuncSetAttribute((const void*)fwd_kernel, hipFuncAttributeMaxDynamicSharedMemorySize, LDS_BYTES) != hipSuccess) { fprintf(stderr, "kernel_launch: hipFuncSetAttribute failed\n"); grid = -1; return; }
        int per_cu = 0;
        if (hipOccupancyMaxActiveBlocksPerMultiprocessor(&per_cu, (const void*)fwd_kernel, NWAVES * 64, LDS_BYTES) != hipSuccess || per_cu < 1) fprintf(stderr, "kernel_launch: occupancy query says %d\n", per_cu);
        (void)hipGetLastError();
        grid = 256;
    }
    if (grid < 0) return;
    if (hipMemsetAsync((char*)d_ws + WS_CTL, 0, CTL_ZERO_BYTES, stream) != hipSuccess) return;
    Args a{};
    for (int i = 0; i < N_IN; ++i) a.in[i] = (const float*)d_in[i];
    a.out = (float*)d_out; a.ws = (unsigned char*)d_ws; a.pad = 0;
#if MK_ONE_LAUNCH
    a.ph_lo = 0; a.ph_hi = N_PHASES; a.use_bar = 1;
    hipLaunchKernelGGL(fwd_kernel, dim3(grid), dim3(NWAVES * 64), LDS_BYTES, stream, a);
#else
    for (int ph = 0; ph < N_PHASES; ++ph) {
        if (!phase_exists(ph)) continue;
        a.ph_lo = ph; a.ph_hi = ph + 1; a.use_bar = 0;
        hipLaunchKernelGGL(fwd_kernel, dim3(grid), dim3(NWAVES * 64), LDS_BYTES, stream, a);
    }
#endif
}
```

```cpp
#include <hip/hip_runtime.h>
#include <cstdio>
#include <cstdint>
#include <cmath>
#define MK_ONE_LAUNCH 1
namespace pg8 {
#define PG8_LAS __attribute__((address_space(3)))
typedef unsigned short bf16_t;
typedef short bf16x8 __attribute__((ext_vector_type(8)));
typedef float f32x4 __attribute__((ext_vector_type(4)));
typedef unsigned u32x4 __attribute__((ext_vector_type(4)));
constexpr int BM = 256, BK = 64, HALF = 128, HTB = HALF * BK * 2  , STAGE_BYTES = 8 * HTB, NXCD = 8, WGM = 8;

__host__ __device__ __forceinline__ int lds_byte(int r, int c) { const int st = (r >> 4) * 2 + (c >> 5), rr = r & 15, cc = c & 31, ob = rr * 64 + cc * 2; return st * 1024 + (ob ^ (((ob >> 9) & 1) << 5)); }
__host__ __device__ __forceinline__ void stage_rc(int b, int& R, int& C) { const int st = b / 1024, sb = b % 1024, swz = sb ^ (((sb >> 9) & 1) << 5); R = (st >> 1) * 16 + swz / 64; C = (st & 1) * 32 + (swz % 64) / 2; }
__host__ __device__ __forceinline__ int perm32(int rho) { const int n = rho >> 4, i = rho & 15; return 8 * (i >> 2) + 4 * n + (i & 3); }

struct Unit { int pm, pn, pb; };
struct Gemm { const bf16_t* A; const bf16_t* Bt; int M, N, K; const int* rows; };
struct StaticOrder {
    int nM, nN, nwg, G, c;
    __host__ __device__ void init(int M, int N, int G_, int c_) { nM = M / BM; nN = N / BM; nwg = nM * nN; G = G_; c = c_; }
    __host__ __device__ bool next(int i, Unit& u) const {
        const long L = (long)i * G + c; if (L >= nwg) return false;
        int wgid = (int)L; { const int q = nwg / NXCD, r = nwg % NXCD, xcd = wgid % NXCD, off = wgid / NXCD; wgid = (xcd < r ? xcd * (q + 1) : r * (q + 1) + (xcd - r) * q) + off; }
        const int nig = WGM * nN, gid = wgid / nig, fm = gid * WGM, gsz = (nM - fm) < WGM ? (nM - fm) : WGM;
        u.pm = fm + ((wgid % nig) % gsz); u.pn = (wgid % nig) / gsz; u.pb = u.pn; return true;
    }
    __device__ __forceinline__ void a_ready(const Unit&) const {}
    __device__ __forceinline__ void done(const Unit&) const {}
};
__device__ __forceinline__ unsigned cvt_pk_bf16(float lo, float hi) { unsigned r; asm volatile("v_cvt_pk_bf16_f32 %0, %1, %2" : "=v"(r) : "v"(lo), "v"(hi)); return r; }
typedef float f32x2 __attribute__((ext_vector_type(2)));
#define PG8_STR2(x) #x
#define PG8_STR(x) PG8_STR2(x)
template <class Epi, class Sched, bool ALIGN_EPI = false, bool SP2 = false>
__device__ __forceinline__ void gemm_phase(PG8_LAS unsigned char* lds, const Gemm g, const Sched& S, const Epi& E) {
    int tid_ = threadIdx.x; asm volatile("" : "+v"(tid_));
    const int tid = tid_, wid = __builtin_amdgcn_readfirstlane(tid >> 6), lane = tid & 63, wr = wid >> 2, wc = wid & 3, fr = lane & 15, fq = lane >> 4;
    const int K = g.K, nt = K / BK;
    unsigned roffA[4], voffB[2];
#pragma unroll
    for (int i = 0; i < 2; ++i) { int R, C; stage_rc(tid * 16 + i * 8192, R, C); const int Rb = Epi::PERM ? ((R & ~31) + perm32(R & 31)) : R;
        roffA[i] = (unsigned)(R * K + C) * 2u; roffA[2 + i] = (unsigned)((R + HALF) * K + C) * 2u; voffB[i] = (unsigned)(Rb * K + C) * 2u; }
    const size_t kstep = (size_t)(BK * 2);
    const size_t hstep = (size_t)HALF * K * 2;
    const size_t tstep = 2 * hstep;
    const unsigned ldsw = (unsigned)wid * 1024u;
    const int aoff = lds_byte(wr * 64 + fr, fq * 8), boff = lds_byte(wc * 32 + fr, fq * 8);
#define PG8_SA(b, h) (((b) * 2 + (h)) * HTB)
#define PG8_SB(b, h) ((4 + (b) * 2 + (h)) * HTB)
#define PG8_STAGE(bufoff, gbase, voff) do { _Pragma("unroll") for (int _i = 0; _i < 2; ++_i) \
        __builtin_amdgcn_global_load_lds((const unsigned*)((const char*)(gbase) + (voff)[_i]), (PG8_LAS unsigned*)(lds + (bufoff) + ldsw + _i * 8192), 16, 0, 0); } while (0)
#define PG8_STAGEA(bufoff, gbase, h) do { _Pragma("unroll") for (int _i = 0; _i < 2; ++_i) \
        __builtin_amdgcn_global_load_lds((const unsigned*)((const char*)(gbase) + roffA[2 * (h) + _i]), (PG8_LAS unsigned*)(lds + (bufoff) + ldsw + _i * 8192), 16, 0, 0); } while (0)
#define PG8_LDA(dst, b, h) do { _Pragma("unroll") for (int m = 0; m < 4; ++m) _Pragma("unroll") for (int k = 0; k < 2; ++k) dst[m][k] = *(const PG8_LAS bf16x8*)(lds + PG8_SA(b, h) + aoff + m * 2048 + k * 1024); } while (0)
#define PG8_LDB(dst, b, h) do { _Pragma("unroll") for (int n = 0; n < 2; ++n) _Pragma("unroll") for (int k = 0; k < 2; ++k) dst[n][k] = *(const PG8_LAS bf16x8*)(lds + PG8_SB(b, h) + boff + n * 2048 + k * 1024); } while (0)
#define PG8_MMA(ai, bj, At, Bt) do { __builtin_amdgcn_s_setprio(1); _Pragma("unroll") for (int m = 0; m < 4; ++m) _Pragma("unroll") for (int n = 0; n < 2; ++n) _Pragma("unroll") for (int k = 0; k < 2; ++k) \
        acc[ai][bj][m][n] = __builtin_amdgcn_mfma_f32_16x16x32_bf16(Bt[n][k], At[m][k], acc[ai][bj][m][n], 0, 0, 0); __builtin_amdgcn_s_setprio(0); } while (0)
#define PG8_WAIT_V(n) asm volatile("s_waitcnt vmcnt(" #n ")" ::: "memory")
#define PG8_WAIT_L(n) asm volatile("s_waitcnt lgkmcnt(" #n ")" ::: "memory")
#define PG8_BAR __builtin_amdgcn_s_barrier()
#define PG8_SCHED __builtin_amdgcn_sched_barrier(0)
    Unit cur, nxt; int ui = 0;
    if (!S.next(0, cur)) return;
    f32x4 acc[2][2][4][2];
#define PG8_ACC_INIT() do { if (E.mode >= 3) { const PG8_LAS float* bs_ = E.bslot + wid * 64 + 8 * fq; \
            const f32x4 b00_ = *(const PG8_LAS f32x4*)bs_, b01_ = *(const PG8_LAS f32x4*)(bs_ + 4), b10_ = *(const PG8_LAS f32x4*)(bs_ + 32), b11_ = *(const PG8_LAS f32x4*)(bs_ + 36); \
            _Pragma("unroll") for (int a = 0; a < 2; ++a) _Pragma("unroll") for (int m = 0; m < 4; ++m) { acc[a][0][m][0] = b00_; acc[a][0][m][1] = b01_; acc[a][1][m][0] = b10_; acc[a][1][m][1] = b11_; } \
        } else { _Pragma("unroll") for (int a = 0; a < 2; ++a) _Pragma("unroll") for (int b = 0; b < 2; ++b) _Pragma("unroll") for (int m = 0; m < 4; ++m) _Pragma("unroll") for (int n = 0; n < 2; ++n) acc[a][b][m][n] = (f32x4){0.f, 0.f, 0.f, 0.f}; } } while (0)
    if (E.mode >= 3) { __builtin_amdgcn_global_load_lds((const unsigned*)E.bias_src(cur, wc, lane), (PG8_LAS unsigned*)(E.bslot + wid * 64), 4, 0, 0); PG8_WAIT_V(0); }
    PG8_ACC_INIT();
    bf16x8 At[4][2], B0[2][2], B1[2][2];
    const __attribute__((address_space(1))) int* const rows = (const __attribute__((address_space(1))) int*)g.rows; const int r0g = (wid >> 1) * 16 + (lane >> 2); const unsigned cb2g = roffA[0] - (unsigned)(r0g * K) * 2u;
#define PG8_ROWS(dst, pm_) do { _Pragma("unroll") for (int _j = 0; _j < 4; ++_j) dst[_j] = (unsigned)rows[(size_t)(pm_) * BM + r0g + 64 * _j] * (unsigned)(K * 2) + cb2g; } while (0)
    if (rows) { unsigned t4[4]; PG8_ROWS(t4, cur.pm); roffA[0] = t4[0]; roffA[1] = t4[1]; roffA[2] = t4[2]; roffA[3] = t4[3]; }
    const char* cA = rows ? (const char*)g.A : (const char*)g.A + (size_t)cur.pm * tstep; const char* cB = (const char*)g.Bt + (size_t)cur.pb * tstep;
    S.a_ready(cur);
    if constexpr (SP2) {
        PG8_STAGE(PG8_SB(0, 0), cB, voffB); PG8_STAGE(PG8_SB(0, 1), cB + hstep, voffB); PG8_STAGEA(PG8_SA(0, 0), cA, 0); PG8_STAGEA(PG8_SA(0, 1), cA, 1);
        if (wr == 1) PG8_BAR;
        PG8_WAIT_V(2); PG8_BAR;
        PG8_STAGE(PG8_SB(1, 0), cB + kstep, voffB); PG8_STAGEA(PG8_SA(1, 0), cA + kstep, 0); PG8_STAGE(PG8_SB(1, 1), cB + hstep + kstep, voffB);
        PG8_WAIT_V(6); PG8_BAR;
    } else {
        PG8_STAGE(PG8_SB(0, 0), cB, voffB); PG8_STAGEA(PG8_SA(0, 0), cA, 0); PG8_STAGE(PG8_SB(0, 1), cB + hstep, voffB); PG8_STAGEA(PG8_SA(0, 1), cA, 1);
        if (wr == 1) PG8_BAR;
        PG8_WAIT_V(4); PG8_BAR;
        PG8_STAGE(PG8_SB(1, 0), cB + kstep, voffB); PG8_STAGEA(PG8_SA(1, 0), cA + kstep, 0); PG8_STAGE(PG8_SB(1, 1), cB + hstep + kstep, voffB);
        PG8_WAIT_V(6); PG8_BAR;
    }
    unsigned nr4[4] = {0u, 0u, 0u, 0u};
    for (;;) {
        const bool has_next = S.next(ui + 1, nxt);
        const char* nA = (has_next && !rows) ? (const char*)g.A + (size_t)nxt.pm * tstep : cA; const char* nB = has_next ? (const char*)g.Bt + (size_t)nxt.pb * tstep : cB;
#ifdef PG8_LOOP_ALIGN
        asm volatile(".p2align " PG8_STR(PG8_LOOP_ALIGN));
#endif
        for (int t = 0; t < nt; t += 2) {
            const bool last = (t == nt - 2);
            const char* a1 = cA + (size_t)(t + 1) * kstep;
            const char* a2 = last ? nA : cA + (size_t)(t + 2) * kstep; const char* b2 = last ? nB : cB + (size_t)(t + 2) * kstep;
            const char* a3 = a2 + kstep; const char* b3 = b2 + kstep;
            if (last && has_next) S.a_ready(nxt);
            const bool swap_rows = rows != nullptr && last && has_next;
            if (E.mode >= 3 && has_next && t == nt - 4)
                __builtin_amdgcn_global_load_lds((const unsigned*)E.bias_src(nxt, wc, lane), (PG8_LAS unsigned*)(E.bslot + wid * 64), 4, 0, 0);
            if (rows != nullptr && has_next && t == nt - 4) {
                const __attribute__((address_space(1))) int* rp = rows + (size_t)nxt.pm * BM + r0g;
                asm volatile("global_load_dword %0, %4, off\n\tglobal_load_dword %1, %4, off offset:256\n\tglobal_load_dword %2, %4, off offset:512\n\tglobal_load_dword %3, %4, off offset:768"
                             : "=&v"(nr4[0]), "=&v"(nr4[1]), "=&v"(nr4[2]), "=&v"(nr4[3]) : "v"(rp) : "memory"); }
            if constexpr (SP2) {
            PG8_LDB(B0, 0, 0); PG8_LDB(B1, 0, 1); PG8_SCHED; PG8_LDA(At, 0, 0); PG8_STAGEA(PG8_SA(1, 1), a1, 1);
            if (swap_rows) {
#pragma unroll
                for (int _j = 0; _j < 4; ++_j) roffA[_j] = nr4[_j] * (unsigned)(K * 2) + cb2g; }
            PG8_WAIT_V(8); PG8_WAIT_L(0); PG8_BAR; PG8_MMA(0, 0, At, B0); PG8_MMA(0, 1, At, B1); PG8_BAR; PG8_SCHED;
            PG8_LDA(At, 0, 1); PG8_STAGE(PG8_SB(0, 0), b2, voffB); PG8_STAGE(PG8_SB(0, 1), b2 + hstep, voffB); PG8_STAGEA(PG8_SA(0, 0), a2, 0);
            PG8_WAIT_V(8); PG8_WAIT_L(0); PG8_BAR; PG8_MMA(1, 0, At, B0); PG8_MMA(1, 1, At, B1); PG8_BAR; PG8_SCHED;
            PG8_LDB(B0, 1, 0); PG8_LDB(B1, 1, 1); PG8_SCHED; PG8_LDA(At, 1, 0); PG8_STAGEA(PG8_SA(0, 1), a2, 1);
            PG8_WAIT_V(8); PG8_WAIT_L(0); PG8_BAR; PG8_MMA(0, 0, At, B0); PG8_MMA(0, 1, At, B1); PG8_BAR; PG8_SCHED;
            PG8_LDA(At, 1, 1); PG8_STAGE(PG8_SB(1, 0), b3, voffB); PG8_STAGE(PG8_SB(1, 1), b3 + hstep, voffB); PG8_STAGEA(PG8_SA(1, 0), a3, 0);
            PG8_WAIT_V(8); PG8_WAIT_L(0); PG8_BAR; PG8_MMA(1, 0, At, B0); PG8_MMA(1, 1, At, B1); PG8_BAR; PG8_SCHED;
            } else {
            PG8_LDB(B0, 0, 0); PG8_SCHED; PG8_LDA(At, 0, 0); PG8_STAGEA(PG8_SA(1, 1), a1, 1);
            if (swap_rows) {
#pragma unroll
                for (int _j = 0; _j < 4; ++_j) roffA[_j] = nr4[_j] * (unsigned)(K * 2) + cb2g; }
            PG8_WAIT_L(8); PG8_BAR; PG8_WAIT_L(0); PG8_MMA(0, 0, At, B0); PG8_BAR; PG8_SCHED;
            PG8_LDB(B1, 0, 1); PG8_STAGE(PG8_SB(0, 0), b2, voffB);
            PG8_BAR; PG8_WAIT_L(0); PG8_MMA(0, 1, At, B1); PG8_BAR;
            PG8_LDA(At, 0, 1); PG8_STAGEA(PG8_SA(0, 0), a2, 0);
            PG8_BAR; PG8_WAIT_L(0); PG8_MMA(1, 0, At, B0); PG8_BAR; PG8_SCHED;
            PG8_STAGE(PG8_SB(0, 1), b2 + hstep, voffB);
            PG8_WAIT_V(6); PG8_BAR; PG8_MMA(1, 1, At, B1); PG8_BAR;
            PG8_LDB(B0, 1, 0); PG8_SCHED; PG8_LDA(At, 1, 0); PG8_STAGEA(PG8_SA(0, 1), a2, 1);
            PG8_WAIT_L(8); PG8_BAR; PG8_WAIT_L(0); PG8_MMA(0, 0, At, B0); PG8_BAR; PG8_SCHED;
            PG8_LDB(B1, 1, 1); PG8_STAGE(PG8_SB(1, 0), b3, voffB);
            PG8_BAR; PG8_WAIT_L(0); PG8_MMA(0, 1, At, B1); PG8_BAR;
            PG8_LDA(At, 1, 1); PG8_STAGEA(PG8_SA(1, 0), a3, 0);
            PG8_BAR; PG8_WAIT_L(0); PG8_MMA(1, 0, At, B0); PG8_BAR; PG8_SCHED;
            PG8_STAGE(PG8_SB(1, 1), b3 + hstep, voffB);
            PG8_WAIT_V(6); PG8_BAR; PG8_MMA(1, 1, At, B1); PG8_BAR;
            }
        }
        if constexpr (ALIGN_EPI) { if (wr == 0) PG8_BAR; }
        if constexpr (!Epi::AFTER_DRAIN) { E(acc, cur, wr, wc, fr, fq); S.done(cur); }
        if (!has_next) break;
        PG8_ACC_INIT();
        cur = nxt; cA = nA; cB = nB; ++ui;
        if constexpr (ALIGN_EPI) { if (wr == 1) PG8_BAR; }
    }
    PG8_WAIT_V(0);
    if constexpr (!ALIGN_EPI) { if (wr == 0) PG8_BAR; }
    PG8_BAR;
    if constexpr (Epi::AFTER_DRAIN) { E.fused(acc, cur, wr, wc, fr, fq, lds, wid, lane); S.done(cur); }
#undef PG8_ACC_INIT
#undef PG8_SA
#undef PG8_SB
#undef PG8_STAGE
#undef PG8_STAGEA
#undef PG8_ROWS
#undef PG8_LDA
#undef PG8_LDB
#undef PG8_MMA
#undef PG8_WAIT_V
#undef PG8_WAIT_L
#undef PG8_BAR
#undef PG8_SCHED
}
}
constexpr int NWAVES = 8;
constexpr int D = 1024, NBATCH = 8, SEQ = 8192, CTXL = 256, DEPTH = 4;
constexpr int TL = NBATCH * SEQ;
constexpr int TC = NBATCH * CTXL;
constexpr int TT = TL + TC;
constexpr int QKD = 1536, NE = 32;
constexpr int MAXBLK = 1088, MAXROWS = MAXBLK * 256;
constexpr float NORM_EPS = 1e-6f;
constexpr int N_IN = 35;
enum { I_X = 0, I_C, I_CTX, I_CCTX, I_ADAW, I_ADAB, I_NMIX, I_NFFN, I_AWQKV, I_ABQKV, I_AWO, I_ABO, I_ASINK, I_HWIN, I_HBIN, I_HCW, I_HCB,
       I_FW1, I_FB1, I_FW2, I_FB2, I_FW3, I_FB3, I_FFREQ, I_FWOUT, I_HBD, I_HWO, I_HBO, I_RW, I_RB, I_WGU, I_BGU, I_WDN, I_BDN, I_FNORM };

constexpr size_t MiB = 1u << 20;
constexpr size_t WS_CTL = 0, CTL_ZERO_BYTES = 1 * MiB;
constexpr size_t WS_MOD = 1 * MiB;
constexpr size_t WS_ROPE = 2 * MiB;
constexpr size_t WS_A3L = 4 * MiB;
constexpr size_t WS_A3C = 8 * MiB;
constexpr size_t WS_WQK = 9 * MiB;
constexpr size_t WS_WAO = 15 * MiB;
constexpr size_t WS_WHIN = 19 * MiB;
constexpr size_t WS_WHO = 31 * MiB;
constexpr size_t WS_WGU = 35 * MiB;
constexpr size_t WS_WDN = 547 * MiB;
constexpr size_t WS_XC = 803 * MiB;
constexpr size_t WS_H = 811 * MiB;
constexpr size_t WS_POS = 943 * MiB;
constexpr size_t WS_GATE = 945 * MiB;
constexpr size_t WS_DEST = 947 * MiB;
constexpr size_t WS_BIG = 949 * MiB;
constexpr size_t WS_QK = WS_BIG, WS_UT = WS_BIG, WS_YS = WS_BIG;
constexpr size_t WS_O = WS_BIG + 396 * MiB;
constexpr size_t WS_B2 = WS_BIG + 544 * MiB;
constexpr size_t WS_ZT = WS_B2, WS_G = WS_B2 + 132 * MiB, WS_TP = WS_B2 + 388 * MiB  , WS_ACT = WS_B2;
constexpr size_t WS_XB = WS_B2 + 544 * MiB;
constexpr size_t WS_RSRC = WS_XB + 132 * MiB;
constexpr size_t WS_END = WS_RSRC + 2 * MiB;
static_assert(WS_O + (size_t)TT * D * 2 <= WS_B2 && (size_t)MAXROWS * D * 2 <= 544 * MiB && (size_t)3072 * TT * 2 <= 396 * MiB, "ws map");
static_assert(WS_QK + (size_t)TT * QKD * 2 <= WS_O, "ws map 2");
constexpr int CW_BAR = 4096;
constexpr int CW_ECNT = 16384;

constexpr int RING_OFF = 0, RING_BYTES = 131072;
constexpr int LDSCTL_OFF = RING_BYTES, MISC_OFF = LDSCTL_OFF + 320, USER_OFF = RING_BYTES + 512;
constexpr int LDS_BYTES = 147456;

#define GAS __attribute__((address_space(1)))
#define LAS __attribute__((address_space(3)))
#define KAS __attribute__((address_space(4)))
typedef unsigned short bf16;
typedef unsigned v4u __attribute__((ext_vector_type(4)));
typedef unsigned v2u __attribute__((ext_vector_type(2)));
typedef int v4i __attribute__((ext_vector_type(4)));
typedef float f32x4 __attribute__((ext_vector_type(4)));
typedef float f32x16 __attribute__((ext_vector_type(16)));
typedef short bf16x8 __attribute__((ext_vector_type(8)));
typedef GAS unsigned gu32;
#define RLX_AGENT __ATOMIC_RELAXED, __HIP_MEMORY_SCOPE_AGENT
#define LDS_WAIT() asm volatile("s_waitcnt lgkmcnt(0)" ::: "memory")
#define VM_WAIT() asm volatile("s_waitcnt vmcnt(0)" ::: "memory")
__device__ __forceinline__ unsigned f2bf(float f) { unsigned u = __builtin_bit_cast(unsigned, f); return (u + 0x7fffu + ((u >> 16) & 1u)) >> 16; }
__device__ __forceinline__ unsigned pk2(float lo, float hi) { return f2bf(lo) | (f2bf(hi) << 16); }
__device__ __forceinline__ float bf2f(unsigned short b) { return __builtin_bit_cast(float, ((unsigned)b) << 16); }
__device__ __forceinline__ float bflo(unsigned w) { return __builtin_bit_cast(float, w << 16); }
__device__ __forceinline__ float bfhi(unsigned w) { return __builtin_bit_cast(float, w & 0xffff0000u); }
#define XB_TMO      128
#define XB_XCNT(j)  (256  + 64 * (j))
#define XB_XSUB(j)  (1280 + 64 * (j))
#define XB_XGEN(j)  (2304 + 64 * (j))
#define XB_TOP      3328
#define XB_TOPGEN   3392
#define XCD_BAR_WORDS 3456
#define XB_SPIN_CAP (1u << 21)

__device__ __forceinline__ unsigned xb_ld(unsigned* p)              { return __hip_atomic_load(p, __ATOMIC_RELAXED, __HIP_MEMORY_SCOPE_AGENT); }
__device__ __forceinline__ unsigned xb_add(unsigned* p, unsigned v) { return __hip_atomic_fetch_add(p, v, __ATOMIC_RELAXED, __HIP_MEMORY_SCOPE_AGENT); }
__device__ __forceinline__ unsigned xb_xcc_id() { return (unsigned)__builtin_amdgcn_s_getreg((3 << 11) | 20) & 0xFu; }
#define XB_SPIN(cond, bar) do { unsigned _sp = 0; while (cond) { __builtin_amdgcn_s_sleep(1); \
    if ((++_sp & 255u) == 0u) { if (xb_ld(&(bar)[XB_TMO])) break; if (_sp > XB_SPIN_CAP) { atomicAdd(&(bar)[XB_TMO], 1u); break; } } } } while (0)

struct XcdBarrier {
    unsigned* bar; unsigned x;
    volatile LAS unsigned* st;
};

__device__ __forceinline__ XcdBarrier xcd_barrier_post(unsigned* bar, volatile LAS unsigned* st) {
    XcdBarrier b; b.bar = bar; b.x = xb_xcc_id(); b.st = st;
    if (threadIdx.x == 0) (void)xb_add(&bar[XB_XCNT(b.x)], 1u);
    return b;
}
__device__ __forceinline__ void xcd_barrier_complete(unsigned* bar, unsigned x, unsigned& nloc, unsigned& nx) {
    const unsigned G = gridDim.x * gridDim.y * gridDim.z;
    unsigned sum, cnt, mine, sp = 0u;
    for (;;) {
        sum = 0u; cnt = 0u; mine = 0u;
#pragma unroll
        for (unsigned j = 0; j < 16; ++j) { const unsigned c = xb_ld(&bar[XB_XCNT(j)]); sum += c; cnt += (c > 0u) ? 1u : 0u; mine = (j == x) ? c : mine; }
        if (sum == G) break;
        __builtin_amdgcn_s_sleep(1);
        if ((++sp & 255u) == 0u) { if (xb_ld(&bar[XB_TMO])) break; if (sp > XB_SPIN_CAP) { atomicAdd(&bar[XB_TMO], 1u); break; } }
    }
    nloc = mine > 0u ? mine : 1u; nx = cnt > 0u ? cnt : 1u;
}

__device__ __forceinline__ void xcd_barrier(const XcdBarrier& b) {
    asm volatile("s_waitcnt vmcnt(0)" ::: "memory");
    __syncthreads();
    if (threadIdx.x == 0) {
        unsigned* bar = b.bar;
        __builtin_amdgcn_s_waitcnt(0);
        unsigned nloc = b.st[0], nx = b.st[1];
        if (nloc == 0u) { xcd_barrier_complete(bar, b.x, nloc, nx); b.st[0] = nloc; b.st[1] = nx; }
        const unsigned old = xb_add(&bar[XB_XSUB(b.x)], 1u);
        const unsigned gen = old / nloc;
        if (old + 1u == (gen + 1u) * nloc) {
            __builtin_amdgcn_fence(__ATOMIC_RELEASE, "agent");
            asm volatile("s_waitcnt vmcnt(0)" ::: "memory");
            const unsigned og = xb_add(&bar[XB_TOP], 1u);
            const unsigned tg = og / nx;
            if (og + 1u == (tg + 1u) * nx) xb_add(&bar[XB_TOPGEN], 1u);
            else XB_SPIN(xb_ld(&bar[XB_TOPGEN]) == tg, bar);
            __builtin_amdgcn_fence(__ATOMIC_ACQUIRE, "agent");
            xb_add(&bar[XB_XGEN(b.x)], 1u);
            asm volatile("s_waitcnt vmcnt(0)" ::: "memory");
        } else {
            XB_SPIN(xb_ld(&bar[XB_XGEN(b.x)]) == gen, bar);
            __builtin_amdgcn_fence(__ATOMIC_ACQUIRE, "agent");
            asm volatile("s_waitcnt vmcnt(0)" ::: "memory");
        }
    }
    __syncthreads();
}
#ifndef FFT_HOST_TEST
#define FFT_DEV __device__ __forceinline__
#define FFT_LAUNDER(t) asm volatile("" : "+v"(t))
#else
#define FFT_DEV inline
#define FFT_LAUNDER(t) (void)0
#endif
#ifndef FFT_HOST_TEST
#define FFT_FENCE() do { asm volatile("" ::: "memory"); __builtin_amdgcn_sched_barrier(0); } while (0)
#else
#define FFT_FENCE() (void)0
#endif
typedef float cf2 __attribute__((ext_vector_type(2)));
typedef float cf4 __attribute__((ext_vector_type(4)));
constexpr int FFT_N = 16384, FFT_THREADS = 512;
FFT_DEV void fft_cs(float frac, float& c, float& s) {
#ifndef FFT_HOST_TEST
    c = __builtin_amdgcn_cosf(frac); s = __builtin_amdgcn_sinf(frac);
#else
    c = (float)cos(6.283185307179586 * (double)frac); s = (float)sin(6.283185307179586 * (double)frac);
#endif
}
FFT_DEV cf2 cmulf(cf2 a, float c, float s) { cf2 r; r.x = a.x * c - a.y * s; r.y = a.x * s + a.y * c; return r; }
FFT_DEV int fft_swz(int e) { return e ^ (((e >> 5) & 7) << 1); }
FFT_DEV cf2 cmul2(cf2 a, cf2 b) { const cf2 axx = {a.x, a.x}, ayy = {a.y, a.y}, bs = {-b.y, b.x}; return ayy * bs + axx * b; }
FFT_DEV cf2 cmulc(cf2 a, cf2 b) { const cf2 axx = {a.x, a.x}, ayy = {a.y, a.y}, bs = {b.y, b.x}, bn = {b.x, -b.y}; return ayy * bs + axx * bn; }
FFT_DEV cf2 tw32(int j) {
    constexpr float C[9] = {1.0f, 0.98078528040323044913f, 0.92387953251128675613f, 0.83146961230254523708f, 0.70710678118654752440f, 0.55557023301960222474f, 0.38268343236508977173f, 0.19509032201612826785f, 0.0f};
    const int q = (j >> 3) & 3, r = j & 7; float c, sn;
    if (q == 0) { c = C[r]; sn = C[8 - r]; } else if (q == 1) { c = -C[8 - r]; sn = C[r]; } else if (q == 2) { c = -C[r]; sn = -C[8 - r]; } else { c = C[8 - r]; sn = -C[r]; }
    cf2 w; w.x = c; w.y = -sn; return w;
}
template <bool TW> FFT_DEV void bfly_fwd_w(cf2& a0, cf2& a1, cf2& a2, cf2& a3, cf2 w1, cf2 w2, cf2 w3) {
    const cf2 t0 = a0 + a2, t1 = a0 - a2, t2 = a1 + a3, t3 = a1 - a3;
    cf2 y0 = t0 + t2, y2 = t0 - t2, y1, y3;
    y1.x = t1.x + t3.y; y1.y = t1.y - t3.x;
    y3.x = t1.x - t3.y; y3.y = t1.y + t3.x;
    if (TW) { y1 = cmul2(y1, w1); y2 = cmul2(y2, w2); y3 = cmul2(y3, w3); }
    a0 = y0; a1 = y1; a2 = y2; a3 = y3;
}
template <bool TW> FFT_DEV void bfly_inv_w(cf2& a0, cf2& a1, cf2& a2, cf2& a3, cf2 w1, cf2 w2, cf2 w3) {
    if (TW) { a1 = cmulc(a1, w1); a2 = cmulc(a2, w2); a3 = cmulc(a3, w3); }
    const cf2 t0 = a0 + a2, t1 = a0 - a2, t2 = a1 + a3, t3 = a1 - a3;
    cf2 y0 = t0 + t2, y2 = t0 - t2, y1, y3;
    y1.x = t1.x - t3.y; y1.y = t1.y + t3.x;
    y3.x = t1.x + t3.y; y3.y = t1.y - t3.x;
    a0 = y0; a1 = y1; a2 = y2; a3 = y3;
}
FFT_DEV cf2 fft_w(float frac) { float c, sn; fft_cs(frac, c, sn); cf2 w; w.x = c; w.y = -sn; return w; }
template <bool TW> FFT_DEV void bfly_fwd(cf2& a0, cf2& a1, cf2& a2, cf2& a3, float f) {
    const cf2 t0 = a0 + a2, t1 = a0 - a2, t2 = a1 + a3, t3 = a1 - a3;
    cf2 y0 = t0 + t2, y2 = t0 - t2, y1, y3;
    y1.x = t1.x + t3.y; y1.y = t1.y - t3.x;
    y3.x = t1.x - t3.y; y3.y = t1.y + t3.x;
    if (TW) { float c1, s1, c2, s2, c3, s3; fft_cs(f, c1, s1); fft_cs(2.0f * f, c2, s2); fft_cs(3.0f * f, c3, s3);
        y1 = cmulf(y1, c1, -s1); y2 = cmulf(y2, c2, -s2); y3 = cmulf(y3, c3, -s3); }
    a0 = y0; a1 = y1; a2 = y2; a3 = y3;
}
template <bool TW> FFT_DEV void bfly_inv(cf2& a0, cf2& a1, cf2& a2, cf2& a3, float f) {
    if (TW) { float c1, s1, c2, s2, c3, s3; fft_cs(f, c1, s1); fft_cs(2.0f * f, c2, s2); fft_cs(3.0f * f, c3, s3);
        a1 = cmulf(a1, c1, s1); a2 = cmulf(a2, c2, s2); a3 = cmulf(a3, c3, s3); }
    const cf2 t0 = a0 + a2, t1 = a0 - a2, t2 = a1 + a3, t3 = a1 - a3;
    cf2 y0 = t0 + t2, y2 = t0 - t2, y1, y3;
    y1.x = t1.x - t3.y; y1.y = t1.y + t3.x;
    y3.x = t1.x + t3.y; y3.y = t1.y - t3.x;
    a0 = y0; a1 = y1; a2 = y2; a3 = y3;
}
template <class PT> FFT_DEV void fft_fwd_first(PT X, const float (&za)[16], const float (&zb)[16], int tid) {
    FFT_LAUNDER(tid);
    const cf2 wt1 = fft_w((float)tid * (1.0f / 16384.0f)), wt2 = cmul2(wt1, wt1), wt3 = cmul2(wt2, wt1);
#pragma unroll
    for (int q = 0; q < 8; ++q) {
        const int k = tid + FFT_THREADS * q;
        cf2 a0, a1, a2, a3; a0.x = za[q]; a0.y = zb[q]; a1.x = za[q + 8]; a1.y = zb[q + 8]; a2.x = 0.f; a2.y = 0.f; a3 = a2;
        bfly_fwd_w<true>(a0, a1, a2, a3, cmul2(wt1, tw32(q)), cmul2(wt2, tw32(2 * q)), cmul2(wt3, tw32(3 * q)));
        const int sk = fft_swz(k);
        X[sk] = a0; X[sk + 4096] = a1; X[sk + 8192] = a2; X[sk + 12288] = a3;
        FFT_FENCE();
    }
}
template <class PT, class SP> FFT_DEV void fft_fwd_first_full(PT X, SP src, float scale, int tid) {
    FFT_LAUNDER(tid);
    const cf2 wt1 = fft_w((float)tid * (1.0f / 16384.0f)), wt2 = cmul2(wt1, wt1), wt3 = cmul2(wt2, wt1);
#pragma unroll
    for (int q = 0; q < 8; ++q) {
        const int k = tid + FFT_THREADS * q;
        cf2 a0, a1, a2, a3; a0.x = src[k] * scale; a0.y = 0.f; a1.x = src[k + 4096] * scale; a1.y = 0.f; a2.x = src[k + 8192] * scale; a2.y = 0.f; a3.x = src[k + 12288] * scale; a3.y = 0.f;
        bfly_fwd_w<true>(a0, a1, a2, a3, cmul2(wt1, tw32(q)), cmul2(wt2, tw32(2 * q)), cmul2(wt3, tw32(3 * q)));
        const int sk = fft_swz(k);
        X[sk] = a0; X[sk + 4096] = a1; X[sk + 8192] = a2; X[sk + 12288] = a3;
        if (q & 1) FFT_FENCE();
    }
}
template <class PT, class SP> FFT_DEV void fft_fwd_first_taps(PT X, SP src, float scale, int tid) {
    FFT_LAUNDER(tid);
    const cf2 wt1 = fft_w((float)tid * (1.0f / 16384.0f)), wt2 = cmul2(wt1, wt1), wt3 = cmul2(wt2, wt1);
#pragma unroll
    for (int q = 0; q < 8; ++q) {
        const int k = tid + FFT_THREADS * q;
        cf2 a0, a1, a2, a3; a0.x = src[k] * scale; a0.y = 0.f; a1.x = src[k + 4096] * scale; a1.y = 0.f; a2.x = k == 0 ? 0.f : src[16384 - (k == 0 ? 1 : k)] * scale; a2.y = 0.f; a3.x = src[12288 - k] * scale; a3.y = 0.f;
        bfly_fwd_w<true>(a0, a1, a2, a3, cmul2(wt1, tw32(q)), cmul2(wt2, tw32(2 * q)), cmul2(wt3, tw32(3 * q)));
        const int sk = fft_swz(k);
        X[sk] = a0; X[sk + 4096] = a1; X[sk + 8192] = a2; X[sk + 12288] = a3;
        if (q & 1) FFT_FENCE();
    }
}
template <int S2> FFT_DEV int fft_dbl_idx(int base, int i) {
    if (S2 == 256) return fft_swz(base) + S2 * i;
    if (S2 == 16) return (base ^ ((i >> 1) << 1)) + S2 * i;
    return fft_swz(base + S2 * i);
}
template <int P, class PT> FFT_DEV void fft_fwd_double(PT X, int tid) {
    FFT_LAUNDER(tid);
    constexpr int LS2 = 2 * (5 - P), S2 = 1 << LS2, NCUR = 1 << (2 * (7 - P));
#pragma unroll 1
    for (int q = 0; q < 2; ++q) {
        const int g = tid + FFT_THREADS * q, blk = g >> LS2, k = g & (S2 - 1), base = blk * NCUR + k;
        cf2 s[16];
#pragma unroll
        for (int i = 0; i < 16; ++i) s[i] = X[fft_dbl_idx<S2>(base, i)];
        const cf2 w1 = fft_w((float)k * (1.0f / (float)NCUR)), w2 = cmul2(w1, w1), w3 = cmul2(w2, w1), v1 = cmul2(w2, w2), v2 = cmul2(v1, v1), v3 = cmul2(v2, v1);
#pragma unroll
        for (int i0 = 0; i0 < 4; ++i0) bfly_fwd_w<true>(s[i0], s[i0 + 4], s[i0 + 8], s[i0 + 12], cmul2(w1, tw32(2 * i0)), cmul2(w2, tw32(4 * i0)), cmul2(w3, tw32(6 * i0)));
#pragma unroll
        for (int m = 0; m < 4; ++m) bfly_fwd_w<true>(s[4 * m], s[4 * m + 1], s[4 * m + 2], s[4 * m + 3], v1, v2, v3);
#pragma unroll
        for (int i = 0; i < 16; ++i) X[fft_dbl_idx<S2>(base, i)] = s[i];
    }
}
template <int P, class PT> FFT_DEV void fft_inv_double(PT X, int tid) {
    FFT_LAUNDER(tid);
    constexpr int LS2 = 2 * (5 - P), S2 = 1 << LS2, NCUR = 1 << (2 * (7 - P));
#pragma unroll 1
    for (int q = 0; q < 2; ++q) {
        const int g = tid + FFT_THREADS * q, blk = g >> LS2, k = g & (S2 - 1), base = blk * NCUR + k;
        cf2 s[16];
#pragma unroll
        for (int i = 0; i < 16; ++i) s[i] = X[fft_dbl_idx<S2>(base, i)];
        const cf2 w1 = fft_w((float)k * (1.0f / (float)NCUR)), w2 = cmul2(w1, w1), w3 = cmul2(w2, w1), v1 = cmul2(w2, w2), v2 = cmul2(v1, v1), v3 = cmul2(v2, v1);
#pragma unroll
        for (int m = 0; m < 4; ++m) bfly_inv_w<true>(s[4 * m], s[4 * m + 1], s[4 * m + 2], s[4 * m + 3], v1, v2, v3);
#pragma unroll
        for (int i0 = 0; i0 < 4; ++i0) bfly_inv_w<true>(s[i0], s[i0 + 4], s[i0 + 8], s[i0 + 12], cmul2(w1, tw32(2 * i0)), cmul2(w2, tw32(4 * i0)), cmul2(w3, tw32(6 * i0)));
#pragma unroll
        for (int i = 0; i < 16; ++i) X[fft_dbl_idx<S2>(base, i)] = s[i];
    }
}
template <class PT> FFT_DEV void fft_load_group(PT X, int g, cf2 (&s)[16]) {
    const int m2 = ((g >> 1) & 7) << 1;
#pragma unroll
    for (int c = 0; c < 8; ++c) { const int e = 16 * g + ((2 * c) ^ m2); s[2 * c] = X[e]; s[2 * c + 1] = X[e + 1]; }
}
template <class PT> FFT_DEV void fft_store_group(PT X, int g, const cf2 (&s)[16]) {
    const int m2 = ((g >> 1) & 7) << 1;
#pragma unroll
    for (int c = 0; c < 8; ++c) { const int e = 16 * g + ((2 * c) ^ m2); X[e] = s[2 * c]; X[e + 1] = s[2 * c + 1]; }
}
FFT_DEV void fft_last2_fwd(cf2 (&s)[16]) {
#pragma unroll
    for (int i0 = 0; i0 < 4; ++i0) bfly_fwd_w<true>(s[i0], s[i0 + 4], s[i0 + 8], s[i0 + 12], tw32(2 * i0), tw32(4 * i0), tw32(6 * i0));
#pragma unroll
    for (int m = 0; m < 4; ++m) bfly_fwd_w<false>(s[4 * m], s[4 * m + 1], s[4 * m + 2], s[4 * m + 3], tw32(0), tw32(0), tw32(0));
}
FFT_DEV void fft_last2_inv(cf2 (&s)[16]) {
#pragma unroll
    for (int m = 0; m < 4; ++m) bfly_inv_w<false>(s[4 * m], s[4 * m + 1], s[4 * m + 2], s[4 * m + 3], tw32(0), tw32(0), tw32(0));
#pragma unroll
    for (int i0 = 0; i0 < 4; ++i0) bfly_inv_w<true>(s[i0], s[i0 + 4], s[i0 + 8], s[i0 + 12], tw32(2 * i0), tw32(4 * i0), tw32(6 * i0));
}
template <class PT, class GP> FFT_DEV void fft_mid_store(PT X, GP G, float scale, float add, int tid) {
    FFT_LAUNDER(tid);
#pragma unroll 1
    for (int q = 0; q < 2; ++q) { const int g = tid + FFT_THREADS * q; cf2 s[16]; fft_load_group(X, g, s); fft_last2_fwd(s);
#pragma unroll
        for (int c = 0; c < 8; ++c) { cf4 w; w.x = (s[2 * c].x + add) * scale; w.y = s[2 * c].y * scale; w.z = (s[2 * c + 1].x + add) * scale; w.w = s[2 * c + 1].y * scale; G[c * 1024 + g] = w; } }
}
template <class PT, class GP> FFT_DEV void fft_mid_mul(PT X, GP G, int tid) {
    FFT_LAUNDER(tid);
#pragma unroll 1
    for (int q = 0; q < 2; ++q) { const int g = tid + FFT_THREADS * q; cf2 s[16]; cf4 w[4];
#pragma unroll
        for (int c = 0; c < 4; ++c) w[c] = G[c * 1024 + g];
        fft_load_group(X, g, s); fft_last2_fwd(s);
#pragma unroll
        for (int h = 0; h < 2; ++h) {
#pragma unroll
            for (int c4 = 0; c4 < 4; ++c4) { const int c = 4 * h + c4; const cf4 wc = w[c4]; if (h == 0) w[c4] = G[(c + 4) * 1024 + g];
                cf2 a = s[2 * c], b = s[2 * c + 1], r; r.x = a.x * wc.x - a.y * wc.y; r.y = a.x * wc.y + a.y * wc.x; s[2 * c] = r;
                r.x = b.x * wc.z - b.y * wc.w; r.y = b.x * wc.w + b.y * wc.z; s[2 * c + 1] = r; } }
        fft_last2_inv(s); fft_store_group(X, g, s); }
}
template <class PT> FFT_DEV void fft_inv_last(PT X, float (&za)[16], float (&zb)[16], int tid) {
    FFT_LAUNDER(tid);
    const cf2 wt1 = fft_w((float)tid * (1.0f / 16384.0f)), wt2 = cmul2(wt1, wt1), wt3 = cmul2(wt2, wt1);
#pragma unroll
    for (int q = 0; q < 8; ++q) {
        const int k = tid + FFT_THREADS * q;
        const int sk = fft_swz(k);
        cf2 a0 = X[sk], a1 = X[sk + 4096], a2 = X[sk + 8192], a3 = X[sk + 12288];
        bfly_inv_w<true>(a0, a1, a2, a3, cmul2(wt1, tw32(q)), cmul2(wt2, tw32(2 * q)), cmul2(wt3, tw32(3 * q)));
        za[q] = a0.x; zb[q] = a0.y; za[q + 8] = a1.x; zb[q + 8] = a1.y;
        FFT_FENCE();
    }
}
template <int Q0, class PT> FFT_DEV void fft_inv_last_part(PT X, float (&za)[8], float (&zb)[8], int tid) {
    FFT_LAUNDER(tid);
    const cf2 wt1 = fft_w((float)tid * (1.0f / 16384.0f)), wt2 = cmul2(wt1, wt1), wt3 = cmul2(wt2, wt1);
#pragma unroll
    for (int q = Q0; q < Q0 + 4; ++q) {
        const int k = tid + FFT_THREADS * q;
        const int sk = fft_swz(k);
        cf2 a0 = X[sk], a1 = X[sk + 4096], a2 = X[sk + 8192], a3 = X[sk + 12288];
        bfly_inv_w<true>(a0, a1, a2, a3, cmul2(wt1, tw32(q)), cmul2(wt2, tw32(2 * q)), cmul2(wt3, tw32(3 * q)));
        za[q - Q0] = a0.x; zb[q - Q0] = a0.y; za[4 + q - Q0] = a1.x; zb[4 + q - Q0] = a1.y;
    }
}
namespace pg8 {
enum { EPI_QK = 0, EPI_T = 1, EPI_RES = 2, EPI_SWIGLU = 3, EPI_DOWN = 4 };
struct EpiAny {
    static constexpr bool PERM = true, AFTER_DRAIN = false;
    int mode, ldc;
    bf16_t* O;
    float* f0; float* f1;
    const float* p0; const float* p1; const float* p2; const float* p3;
    PG8_LAS float* bslot;
    __device__ __forceinline__ void epi_qk(const f32x4 (&acc)[2][2][4][2], const Unit& u, int wr, int wc, int fr, int fq) const {
        const int row0 = u.pm * BM + wr * 64 + fr;
        const bool latent = u.pm < 256;
#pragma unroll
        for (int bj = 0; bj < 2; ++bj) {
            const int cs = u.pn * BM + bj * HALF + wc * 32 + 8 * fq;
            const int hb = cs & ~63, jj = (cs & 63) >> 3;
            const bool isv = u.pn >= 5;
            const f32x4 b0 = *(const f32x4*)(p0 + (isv ? cs : hb + 4 * jj)), b1 = *(const f32x4*)(p0 + (isv ? cs + 4 : hb + 32 + 4 * jj));
#pragma unroll
            for (int ai = 0; ai < 2; ++ai)
#pragma unroll
                for (int m = 0; m < 4; ++m) {
                    const int row = row0 + ai * HALF + m * 16;
                    f32x4 x1 = acc[ai][bj][m][0] + b0, x2 = acc[ai][bj][m][1] + b1;
                    if (latent && !isv) {
                        const float* rp = p1 + ((size_t)(row & 8191) * 32 + 4 * jj) * 2;
                        const f32x4 cs0 = *(const f32x4*)rp, cs1 = *(const f32x4*)(rp + 4);
                        const f32x4 c = (f32x4){cs0[0], cs0[2], cs1[0], cs1[2]}, s = (f32x4){cs0[1], cs0[3], cs1[1], cs1[3]};
                        const f32x4 o1 = x1 * c - x2 * s, o2 = x1 * s + x2 * c; x1 = o1; x2 = o2;
                    }
                    if (u.pn < 4) { x1 *= 0.18033688011112042f; x2 *= 0.18033688011112042f; }
                    u32x4 w; w.x = cvt_pk_bf16(x1[0], x1[1]); w.y = cvt_pk_bf16(x1[2], x1[3]); w.z = cvt_pk_bf16(x2[0], x2[1]); w.w = cvt_pk_bf16(x2[2], x2[3]);
                    *(u32x4*)(O + (size_t)row * 1536 + cs) = w;
                }
        }
    }
    __device__ __forceinline__ void epi_t(const f32x4 (&acc)[2][2][4][2], const Unit& u, int wr, int wc, int fr, int fq) const {
        const int row0 = u.pm * BM + wr * 64 + fr, col0 = u.pn * BM + wc * 32 + 8 * fq;
        float bvs[8];
#pragma unroll
        for (int q = 0; q < 8; ++q) bvs[q] = p0[row0 + (q >> 2) * HALF + (q & 3) * 16];
#pragma unroll
        for (int ai = 0; ai < 2; ++ai)
#pragma unroll
            for (int m = 0; m < 4; ++m) { const int row = row0 + ai * HALF + m * 16; const float bv = bvs[ai * 4 + m]; bf16_t* rowp = O + (size_t)row * ldc + col0;
#pragma unroll
                for (int bj = 0; bj < 2; ++bj) { const f32x4 v0 = acc[ai][bj][m][0] + bv, v1 = acc[ai][bj][m][1] + bv;
                    u32x4 w; w.x = cvt_pk_bf16(v0[0], v0[1]); w.y = cvt_pk_bf16(v0[2], v0[3]); w.z = cvt_pk_bf16(v1[0], v1[1]); w.w = cvt_pk_bf16(v1[2], v1[3]);
                    *(u32x4*)(rowp + bj * HALF) = w; } }
    }
    __device__ __forceinline__ void epi_res(const f32x4 (&acc)[2][2][4][2], const Unit& u, int wr, int wc, int fr, int fq) const {
        const bool latent = u.pm < 256;
        const int row0 = u.pm * BM + wr * 64 + fr, col0 = u.pn * BM + wc * 32 + 8 * fq;
        const float* gp = p3 + (size_t)(latent ? (u.pm >> 5) : 8) * 6144 + col0; const float* bp = p2 + col0;
        const float* srcf = p0 ? (latent ? p0 : p1 - (size_t)TL * 1024) : nullptr;
#pragma unroll
        for (int bj = 0; bj < 2; ++bj) { const f32x4 b0 = *(const f32x4*)(bp + bj * HALF), b1 = *(const f32x4*)(bp + bj * HALF + 4), g0 = *(const f32x4*)(gp + bj * HALF), g1 = *(const f32x4*)(gp + bj * HALF + 4);
#pragma unroll
            for (int ai = 0; ai < 2; ++ai)
#pragma unroll
                for (int m = 0; m < 4; ++m) { const size_t off = (size_t)(row0 + ai * HALF + m * 16) * 1024 + col0 + bj * HALF;
                    f32x4 x0, x1;
                    if (srcf) { x0 = *(const f32x4*)(srcf + off); x1 = *(const f32x4*)(srcf + off + 4); }
                    else { const u32x4 r = *(const u32x4*)(O + off); x0 = (f32x4){__builtin_bit_cast(float, r.x << 16), __builtin_bit_cast(float, r.x & 0xffff0000u), __builtin_bit_cast(float, r.y << 16), __builtin_bit_cast(float, r.y & 0xffff0000u)};
                        x1 = (f32x4){__builtin_bit_cast(float, r.z << 16), __builtin_bit_cast(float, r.z & 0xffff0000u), __builtin_bit_cast(float, r.w << 16), __builtin_bit_cast(float, r.w & 0xffff0000u)}; }
                    const f32x4 v0 = x0 + g0 * (acc[ai][bj][m][0] + b0), v1 = x1 + g1 * (acc[ai][bj][m][1] + b1);
                    u32x4 w; w.x = cvt_pk_bf16(v0[0], v0[1]); w.y = cvt_pk_bf16(v0[2], v0[3]); w.z = cvt_pk_bf16(v1[0], v1[1]); w.w = cvt_pk_bf16(v1[2], v1[3]);
                    *(u32x4*)(O + off) = w; } }
    }
    __device__ __forceinline__ const float* bias_src(const Unit& u, int wc, int lane) const {
        if (mode == EPI_SWIGLU) return p0 + (size_t)((u.pb >> 3) & 31) * 2048 + (lane >> 5) * 1024 + u.pn * HALF + wc * 32 + (lane & 31);
        return p0 + (size_t)((u.pb >> 2) & 31) * 1024 + u.pn * BM + (lane >> 5) * HALF + wc * 32 + (lane & 31);
    }
    __device__ __forceinline__ void epi_swiglu(const f32x4 (&acc)[2][2][4][2], const Unit& u, int wr, int wc, int fr, int fq) const {
        const int e = (u.pb >> 3) & 31;
        const int row0 = u.pm * BM + wr * 64 + fr, col0 = u.pn * HALF + wc * 32 + 8 * fq;
        (void)e;
#pragma unroll
        for (int ai = 0; ai < 2; ++ai)
#pragma unroll
            for (int m = 0; m < 4; ++m) {
                f32x4 a[2];
#pragma unroll
                for (int n = 0; n < 2; ++n) {
                    f32x4 g = acc[ai][0][m][n], up = acc[ai][1][m][n];
#pragma unroll
                    for (int t = 0; t < 4; ++t) { const float gg = fminf(g[t], 7.0f), uu = fminf(fmaxf(up[t], -7.0f), 7.0f);
                        const float sg = __builtin_amdgcn_rcpf(1.0f + __builtin_amdgcn_exp2f(-2.4554669595930157f * gg)); a[n][t] = gg * sg * (uu + 1.0f); }
                }
                u32x4 w; w.x = cvt_pk_bf16(a[0][0], a[0][1]); w.y = cvt_pk_bf16(a[0][2], a[0][3]); w.z = cvt_pk_bf16(a[1][0], a[1][1]); w.w = cvt_pk_bf16(a[1][2], a[1][3]);
                *(u32x4*)(O + (size_t)(row0 + ai * HALF + m * 16) * 1024 + col0) = w;
            }
    }
    __device__ __forceinline__ void epi_down(const f32x4 (&acc)[2][2][4][2], const Unit& u, int wr, int wc, int fr, int fq) const {
        const int e = (u.pb >> 2) & 31;
        const int row0 = u.pm * BM + wr * 64 + fr, col0 = u.pn * BM + wc * 32 + 8 * fq;
        (void)e;
#pragma unroll
        for (int bj = 0; bj < 2; ++bj) {
#pragma unroll
            for (int ai = 0; ai < 2; ++ai)
#pragma unroll
                for (int m = 0; m < 4; ++m) { const f32x4 v0 = acc[ai][bj][m][0], v1 = acc[ai][bj][m][1];
                    u32x4 w; w.x = cvt_pk_bf16(v0[0], v0[1]); w.y = cvt_pk_bf16(v0[2], v0[3]); w.z = cvt_pk_bf16(v1[0], v1[1]); w.w = cvt_pk_bf16(v1[2], v1[3]);
                    *(u32x4*)(O + (size_t)(row0 + ai * HALF + m * 16) * 1024 + col0 + bj * HALF) = w; } }
    }
    __device__ __forceinline__ void operator()(const f32x4 (&acc)[2][2][4][2], const Unit& u, int wr, int wc, int fr, int fq) const {
        if (mode == EPI_QK) epi_qk(acc, u, wr, wc, fr, fq);
        else if (mode == EPI_T) epi_t(acc, u, wr, wc, fr, fq);
        else if (mode == EPI_RES) epi_res(acc, u, wr, wc, fr, fq);
        else if (mode == EPI_SWIGLU) epi_swiglu(acc, u, wr, wc, fr, fq);
        else epi_down(acc, u, wr, wc, fr, fq);
    }
};
struct AnyOrder {
    int moe; StaticOrder so;
    const PG8_LAS int* rb2e; int nblk, lg, wbase;
    __device__ __forceinline__ bool next(int i, Unit& u) const {
        if (!moe) return so.next(i, u);
        const int x = so.c & 7, j = so.c >> 3, per = (so.G >> 3) >> lg;
        const int rb = (i * 8 + x) * per + (j >> lg); if (rb >= nblk) return false;
        const int e = rb2e[rb];
        u.pm = rb; u.pn = j & ((1 << lg) - 1); u.pb = ((wbase + e) << lg) + u.pn; return true;
    }
    __device__ __forceinline__ void a_ready(const Unit&) const {}
    __device__ __forceinline__ void done(const Unit&) const {}
};
}
struct Frame {
    LAS unsigned char* lds;
    volatile LAS unsigned* MISC;
    gu32* ctl;
    int tid, lane, wave;
    int vcu, G, bx;
    const float* const KAS* in;
    float* out; unsigned char* ws;
};
__device__ __forceinline__ float wave_sum(float v) {
#pragma unroll
    for (int o = 1; o < 64; o <<= 1) v += __shfl_xor(v, o);
    return v;
}
__device__ __forceinline__ void block_sum2(Frame& F, LAS float* red, float& a, float& b) {
    a = wave_sum(a); b = wave_sum(b);
    __syncthreads();
    if (F.lane == 0) { red[F.wave * 2] = a; red[F.wave * 2 + 1] = b; }
    __syncthreads();
    float sa = 0.f, sb = 0.f;
#pragma unroll
    for (int w = 0; w < NWAVES; ++w) { sa += red[2 * w]; sb += red[2 * w + 1]; }
    a = sa; b = sb;
}

template <int MODE>
__device__ __forceinline__ void tr_item(const float* W, int N, bf16* WT, bf16* WT2, LAS float* scr, int item, int lane) {
    const int nblk = N / 32, kb = item / nblk, nb = item % nblk, k0 = 64 * kb, n0 = 32 * nb;
#pragma unroll 8
    for (int i = 0; i < 32; ++i) { const int kk = 2 * i + (lane >> 5); scr[kk * 33 + (lane & 31)] = W[(size_t)(k0 + kk) * N + n0 + (lane & 31)]; }
    LDS_WAIT(); asm volatile("" ::: "memory");
    const int c = lane & 7;
#pragma unroll
    for (int j = 0; j < 4; ++j) { const int n = (lane >> 3) + 8 * j; const LAS float* s = scr + (8 * c) * 33 + n;
        const int ns = n0 + n; int d = ns; bf16* dst = WT;
        if (MODE == 1) { const int n2 = ns & 1023; d = 256 * (n2 >> 7) + (n2 & 127) + (ns >= 1024 ? 128 : 0); }
        if (MODE == 2) { if (ns < 1280) { const int hb = ns & ~63, dd = ns & 63, d2 = dd & 31; d = hb + 8 * (d2 >> 2) + (d2 & 3) + (dd >= 32 ? 4 : 0); } }
        v4u o; o.x = pk2(s[0 * 33], s[1 * 33]); o.y = pk2(s[2 * 33], s[3 * 33]); o.z = pk2(s[4 * 33], s[5 * 33]); o.w = pk2(s[6 * 33], s[7 * 33]);
        *(GAS v4u*)(dst + (size_t)d * 1024 + k0 + 8 * c) = o; }
    LDS_WAIT(); asm volatile("" ::: "memory");
}
__device__ __forceinline__ float silu_f(float v) { return v / (1.0f + expf(-v)); }
__device__ __forceinline__ void p0_prologue(Frame& F) {
    const int tid = F.tid, lane = F.lane;
    if (F.bx < 192) {
        LAS float* sv = (LAS float*)F.lds;
        LAS float* part = sv + 1024 * 12;
        for (int i = tid; i < 1024 * 9; i += NWAVES * 64) { const int r = i >> 10, k = i & 1023; const float v = (r < 8) ? F.in[I_C][r * 1024 + k] : F.in[I_CCTX][k]; sv[k * 12 + r] = silu_f(v); }
        __syncthreads();
        const int l = F.bx / 48, n0 = (F.bx % 48) * 128, kb = 128 * F.wave;
        const float* wp = F.in[I_ADAW] + ((size_t)l * 1024 + kb) * 6144 + n0 + 2 * lane;
        float acc0[9], acc1[9];
#pragma unroll
        for (int r = 0; r < 9; ++r) { acc0[r] = 0.f; acc1[r] = 0.f; }
#pragma unroll 1
        for (int k0 = 0; k0 < 128; k0 += 16) { float wx[16], wy[16];
#pragma unroll
            for (int u = 0; u < 16; ++u) { const GAS float* q = (const GAS float*)(wp + (size_t)(k0 + u) * 6144); wx[u] = q[0]; wy[u] = q[1]; }
#pragma unroll
            for (int u = 0; u < 16; ++u) { const LAS float* sk = sv + (kb + k0 + u) * 12;
                const f32x4 s0 = *(const LAS f32x4*)sk, s1 = *(const LAS f32x4*)(sk + 4); const float s8 = sk[8];
#pragma unroll
                for (int r = 0; r < 4; ++r) { acc0[r] += s0[r] * wx[u]; acc1[r] += s0[r] * wy[u]; acc0[4 + r] += s1[r] * wx[u]; acc1[4 + r] += s1[r] * wy[u]; }
                acc0[8] += s8 * wx[u]; acc1[8] += s8 * wy[u]; } }
#pragma unroll
        for (int r = 0; r < 9; ++r) { part[(F.wave * 9 + r) * 128 + 2 * lane] = acc0[r]; part[(F.wave * 9 + r) * 128 + 2 * lane + 1] = acc1[r]; }
        __syncthreads();
        for (int i = tid; i < 9 * 128; i += NWAVES * 64) { const int r = i >> 7, cix = i & 127; float t = F.in[I_ADAB][l * 6144 + n0 + cix];
#pragma unroll
            for (int w = 0; w < NWAVES; ++w) t += part[(w * 9 + r) * 128 + cix];
            ((float*)(F.ws + WS_MOD))[((size_t)l * 9 + r) * 6144 + n0 + cix] = t; }
        __syncthreads();
    }
    if (F.bx >= 192) {
        float* rt = (float*)(F.ws + WS_ROPE);
        for (int e = (F.bx - 192) * 512 + tid; e < 8192 * 32; e += 64 * 512) { const int pos = e >> 5, i = e & 31;
            const float inv = expf(-(float)(i & 15) * (1.0f / 16.0f) * 9.210340371976184f);
            const float ang = (float)((i < 16) ? (pos >> 6) : (pos & 63)) * inv; float sn, cs; sincosf(ang, &sn, &cs);
            rt[2 * e] = cs; rt[2 * e + 1] = sn; }
    }
    const int gw = F.vcu * NWAVES + F.wave, NGW = F.G * NWAVES;
    for (int task = gw; task < 2 * (8192 + 256); task += NGW) {
        const int j = task / 8448, tt = task % 8448; const bool lat = tt < 8192; const int t = lat ? tt : tt - 8192, L = lat ? 8192 : 256;
        float* dst = lat ? (float*)(F.ws + WS_A3L) + ((size_t)j * 8192 + t) * 64 : (float*)(F.ws + WS_A3C) + ((size_t)j * 256 + t) * 64;
        const float tl = (float)t / (float)(L - 1), w = 6.283185307179586f * (float)t / (float)L;
        float z = 0.f;
        if (lane == 0) z = tl;
        else if (lane <= 32) { const int mI = (lane - 1) & 15; const float band = 1e-4f + (float)mI * ((15.0f - 1e-4f) / 15.0f); z = (lane <= 16) ? cosf(band * w) : -sinf(band * w); }
        const float fr = F.in[I_FFREQ][j * 64 + lane];
        const float* w1 = F.in[I_FW1] + (size_t)j * 33 * 64; const float* w2 = F.in[I_FW2] + (size_t)j * 64 * 64; const float* w3 = F.in[I_FW3] + (size_t)j * 64 * 64;
        float a = F.in[I_FB1][j * 64 + lane];
        for (int i = 0; i < 33; ++i) a += __shfl(z, i) * w1[i * 64 + lane];
        a = sinf(fr * a);
        float a2 = F.in[I_FB2][j * 64 + lane];
        for (int k = 0; k < 64; ++k) a2 += __shfl(a, k) * w2[k * 64 + lane];
        a2 = sinf(fr * a2);
        float a3 = F.in[I_FB3][j * 64 + lane];
        for (int k = 0; k < 64; ++k) a3 += __shfl(a2, k) * w3[k * 64 + lane];
        if (lat) ((bf16*)(F.ws + WS_A3L))[(size_t)j * 8192 * 64 + ((((size_t)(t >> 5) * 4 + (lane >> 4)) * 64 + (t & 31) + 32 * ((lane >> 3) & 1)) << 3) + (lane & 7)] = (bf16)f2bf(sinf(fr * a3));
        else dst[lane] = sinf(fr * a3);
    }
    LAS float* scr = (LAS float*)(F.lds + RING_OFF + F.wave * 16384);
    constexpr int NI_GU = 128 * 1024, NI_DN = 128 * 512, NI_QKV = 2 * 768, NI_AO = 2 * 512, NI_HIN = 2 * 1536, NI_HO = 2 * 512;
    constexpr int NITEMS = NI_GU + NI_DN + NI_QKV + NI_AO + NI_HIN + NI_HO;
    for (int it = gw; it < NITEMS; it += NGW) {
        int r = it;
        if (r < NI_GU) { const int mat = r >> 10; tr_item<1>(F.in[I_WGU] + (size_t)mat * 1024 * 2048, 2048, (bf16*)(F.ws + WS_WGU) + (size_t)mat * 2048 * 1024, nullptr, scr, r & 1023, lane); continue; } r -= NI_GU;
        if (r < NI_DN) { const int mat = r >> 9; tr_item<0>(F.in[I_WDN] + (size_t)mat * 1024 * 1024, 1024, (bf16*)(F.ws + WS_WDN) + (size_t)mat * 1024 * 1024, nullptr, scr, r & 511, lane); continue; } r -= NI_DN;
        if (r < NI_QKV) { const int mat = r / 768; tr_item<2>(F.in[I_AWQKV] + (size_t)mat * 1024 * 1536, 1536, (bf16*)(F.ws + WS_WQK) + (size_t)mat * 1536 * 1024, nullptr, scr, r % 768, lane); continue; } r -= NI_QKV;
        if (r < NI_AO) { const int mat = r >> 9; tr_item<0>(F.in[I_AWO] + (size_t)mat * 1024 * 1024, 1024, (bf16*)(F.ws + WS_WAO) + (size_t)mat * 1024 * 1024, nullptr, scr, r & 511, lane); continue; } r -= NI_AO;
        if (r < NI_HIN) { const int mat = r / 1536; tr_item<0>(F.in[I_HWIN] + (size_t)mat * 1024 * 3072, 3072, (bf16*)(F.ws + WS_WHIN) + (size_t)mat * 3072 * 1024, nullptr, scr, r % 1536, lane); continue; } r -= NI_HIN;
        { const int mat = r >> 9; tr_item<0>(F.in[I_HWO] + (size_t)mat * 1024 * 1024, 1024, (bf16*)(F.ws + WS_WHO) + (size_t)mat * 1024 * 1024, nullptr, scr, r & 511, lane); }
    }
}

__device__ __forceinline__ void row8_unpack(const v4u w, f32x4& a, f32x4& b) { a = (f32x4){bflo(w.x), bfhi(w.x), bflo(w.y), bfhi(w.y)}; b = (f32x4){bflo(w.z), bfhi(w.z), bflo(w.w), bfhi(w.w)}; }
__device__ __forceinline__ v4u row8_pack(const f32x4 a, const f32x4 b) { v4u w; w.x = pk2(a.x, a.y); w.y = pk2(a.z, a.w); w.z = pk2(b.x, b.y); w.w = pk2(b.z, b.w); return w; }
#define ROW8_F32(ptr, jj, hf, lane) (((const f32x4*)(ptr))[128 * (jj) + 2 * (lane) + (hf)])
__device__ __forceinline__ void norm_mod_store(Frame& F, const f32x4 (&v)[4], const float* gain, const float* shift, const float* scale, bf16* orow) {
    float s2 = 0.f;
#pragma unroll
    for (int j = 0; j < 4; ++j) s2 += (v[j].x * v[j].x + v[j].y * v[j].y) + (v[j].z * v[j].z + v[j].w * v[j].w);
    const float rstd = 1.0f / sqrtf(wave_sum(s2) * (1.0f / D) + NORM_EPS);
#pragma unroll
    for (int jj = 0; jj < 2; ++jj) { f32x4 h[2];
#pragma unroll
        for (int hf = 0; hf < 2; ++hf) h[hf] = v[2 * jj + hf] * rstd * ROW8_F32(gain, jj, hf, F.lane) * (ROW8_F32(scale, jj, hf, F.lane) + 1.0f) + ROW8_F32(shift, jj, hf, F.lane);
        ((GAS v4u*)orow)[64 * jj + F.lane] = row8_pack(h[0], h[1]); }
}
__device__ __forceinline__ int mod_row(int row) { return row < TL ? (row >> 13) : 8; }
__device__ __forceinline__ int rows_of_layer(int l) { return l >= 2 ? TL : TT; }
__device__ __forceinline__ void norm0_phase(Frame& F) {
    const int gw = F.vcu * NWAVES + F.wave, NGW = F.G * NWAVES;
    const float* mod = (const float*)(F.ws + WS_MOD);
    for (int row = gw; row < TT; row += NGW) {
        const float* xr = row < TL ? F.in[I_X] + (size_t)row * D : F.in[I_CTX] + (size_t)(row - TL) * D;
        f32x4 v[4];
#pragma unroll
        for (int j = 0; j < 4; ++j) v[j] = ((const GAS f32x4*)xr)[128 * (j >> 1) + 2 * F.lane + (j & 1)];
        const float* mr = mod + (size_t)mod_row(row) * 6144;
        norm_mod_store(F, v, F.in[I_NMIX], mr, mr + 1024, (bf16*)(F.ws + WS_H) + (size_t)row * D);
    }
}

__device__ __forceinline__ void attn_phase(Frame& F, int j, int nunits) {
    const bf16* QK = (const bf16*)(F.ws + WS_QK); bf16* O = (bf16*)(F.ws + WS_O);
    const float* sinks = F.in[I_ASINK] + j * 16;
    LAS bf16* Ks0 = (LAS bf16*)(F.lds);
    const int w = F.wave, lane = F.lane, r = lane & 31, h = lane >> 5, tid = F.tid;
    float snk[4];
#pragma unroll
    for (int i = 0; i < 4; ++i) snk[i] = sinks[4 * i + (w >> 1)];
    for (int u = F.vcu; u < nunits; u += F.G) {
        int b, kvh, q0; const bool isctx = u >= 4096;
        if (!isctx) { b = u >> 9; kvh = (u >> 7) & 3; q0 = (u & 127) * 64; } else { const int u2 = u - 4096; b = u2 >> 4; kvh = (u2 >> 2) & 3; q0 = (u2 & 3) * 64; }
        const int head = kvh * 4 + (w >> 1), qrow = q0 + 32 * (w & 1) + r;
        const size_t tokq = isctx ? (size_t)TL + b * CTXL + qrow : (size_t)b * SEQ + qrow;
        const bf16* qp = QK + tokq * QKD + head * 64 + 8 * h;
        v4u bqv[4];
#pragma unroll
        for (int s = 0; s < 4; ++s) asm volatile("global_load_dwordx4 %0, %1, off" : "=&v"(bqv[s]) : "v"((const GAS v4u*)(qp + 16 * s)) : "memory");
        float m = (kvh == 0 ? snk[0] : kvh == 1 ? snk[1] : kvh == 2 ? snk[2] : snk[3]) * 1.4426950408889634f, l = 1.0f;
        f32x16 o0, o1;
#pragma unroll
        for (int i = 0; i < 16; ++i) { o0[i] = 0.f; o1[i] = 0.f; }
        const int jl0 = isctx ? 0 : (q0 >= 128 ? 0 : (128 - q0) >> 6), jl1 = isctx ? 0 : (q0 + 192 <= SEQ ? 5 : (SEQ + 128 - q0) >> 6), nl = jl1 - jl0, ntile = nl + 4;
        const int srow = tid >> 3, sch = tid & 7;
#define ATT_KEY0(i) ((i) < nl ? (size_t)b * SEQ + (q0 - 128 + 64 * (jl0 + (i))) : (size_t)TL + b * CTXL + 64 * ((i) - nl))
#define ATT_LOAD(kv, vv, i) do { const size_t kt_ = ATT_KEY0(i); const GAS v4u* pk_ = (const GAS v4u*)(QK + (kt_ + srow) * QKD + 1024 + kvh * 64 + sch * 8); const GAS v4u* pv_ = (const GAS v4u*)(QK + (kt_ + lane) * QKD + 1280 + kvh * 64 + w * 8); \
            asm volatile("global_load_dwordx4 %0, %2, off\n\tglobal_load_dwordx4 %1, %3, off" : "=&v"(kv), "=&v"(vv) : "v"(pk_), "v"(pv_) : "memory"); } while (0)
#define ATT_WAIT2() asm volatile("s_waitcnt vmcnt(2)" ::: "memory")
#define ATT_WRITE(kv, vv, bufi) do { LAS bf16* ks_ = Ks0 + (bufi) * 9216; LAS bf16* vs_ = ks_ + 4608; *(LAS v4u*)(ks_ + srow * 72 + sch * 8) = kv;     \
            LAS bf16* vd = vs_ + (w * 8) * 72 + lane; \
            vd[0] = (bf16)(vv.x & 0xffffu); vd[72] = (bf16)(vv.x >> 16); vd[144] = (bf16)(vv.y & 0xffffu); vd[216] = (bf16)(vv.y >> 16); \
            vd[288] = (bf16)(vv.z & 0xffffu); vd[360] = (bf16)(vv.z >> 16); vd[432] = (bf16)(vv.w & 0xffffu); vd[504] = (bf16)(vv.w >> 16); } while (0)
        v4u kvA, vvA, kvB, vvB;
        unsigned qtouch = 0u;
        ATT_LOAD(kvA, vvA, 0);
        ATT_LOAD(kvB, vvB, 1);
        ATT_WAIT2();
        asm volatile("" : "+v"(bqv[0]), "+v"(bqv[1]), "+v"(bqv[2]), "+v"(bqv[3]));
        ATT_WRITE(kvA, vvA, 0);
        ATT_LOAD(kvA, vvA, 2);
        __syncthreads();
        auto tile_step = [&](const int it, v4u& kvN, v4u& vvN) __attribute__((always_inline)) {
            const int cur = it & 1;
            const bool local = it < nl; const int kp0 = q0 - 128 + 64 * (jl0 + it);
            const LAS bf16* Ks = Ks0 + cur * 9216; const LAS bf16* Vs = Ks + 4608;
            if (it + 1 < ntile) { ATT_WAIT2(); ATT_WRITE(kvN, vvN, cur ^ 1); }
            { const int i3 = it + 3 < ntile ? it + 3 : ntile - 1; ATT_LOAD(kvN, vvN, i3); }
            if (it + 2 == ntile) {
                const int un = u + F.G < nunits ? u + F.G : u; int bn, kn, qn; const bool cn = un >= 4096;
                if (!cn) { bn = un >> 9; kn = (un >> 7) & 3; qn = (un & 127) * 64; } else { const int u2 = un - 4096; bn = u2 >> 4; kn = (u2 >> 2) & 3; qn = (u2 & 3) * 64; }
                const int ln = (w * 64 + lane) & 255; const size_t tn = (cn ? (size_t)TL + bn * CTXL + qn : (size_t)bn * SEQ + qn) + (ln >> 2);
                asm volatile("global_load_dword %0, %1, off" : "=&v"(qtouch) : "v"((const GAS unsigned*)(QK + tn * QKD + kn * 256 + (ln & 3) * 64)) : "memory"); }
            f32x16 st0, st1;
#pragma unroll
            for (int i = 0; i < 16; ++i) { st0[i] = 0.f; st1[i] = 0.f; }
#pragma unroll
            for (int s = 0; s < 4; ++s) {
                const bf16x8 a0 = *(const LAS bf16x8*)(Ks + r * 72 + 16 * s + 8 * h), a1 = *(const LAS bf16x8*)(Ks + (32 + r) * 72 + 16 * s + 8 * h);
                st0 = __builtin_amdgcn_mfma_f32_32x32x16_bf16(a0, __builtin_bit_cast(bf16x8, bqv[s]), st0, 0, 0, 0);
                st1 = __builtin_amdgcn_mfma_f32_32x32x16_bf16(a1, __builtin_bit_cast(bf16x8, bqv[s]), st1, 0, 0, 0);
            }
            const bool edge = local && (jl0 + it == 0 || jl0 + it == 4);
            if (edge) {
                const int dq = qrow - kp0 - 4 * h;
#pragma unroll
                for (int i = 0; i < 16; ++i) { const int d0 = dq - ((i & 3) + 8 * (i >> 2)), d1 = d0 - 32;
                    st0[i] = ((unsigned)(d0 + 128) > 256u) ? -1e30f : st0[i]; st1[i] = ((unsigned)(d1 + 128) > 256u) ? -1e30f : st1[i]; }
            }
            float mx = fmaxf(st0[0], st1[0]);
#pragma unroll
            for (int i = 1; i < 16; ++i) mx = __builtin_fmaxf(__builtin_fmaxf(mx, st0[i]), st1[i]);
            mx = fmaxf(mx, __shfl_xor(mx, 32));
            const float mn = fmaxf(m, mx), alpha = __builtin_amdgcn_exp2f(m - mn); m = mn;
#pragma unroll
            for (int i = 0; i < 16; ++i) { st0[i] = __builtin_amdgcn_exp2f(st0[i] - mn); st1[i] = __builtin_amdgcn_exp2f(st1[i] - mn); }
            f32x16 lsum;
#pragma unroll
            for (int i = 0; i < 16; ++i) lsum[i] = 0.f;
            if (!__all(alpha == 1.0f)) {
#pragma unroll
                for (int i = 0; i < 16; ++i) { o0[i] *= alpha; o1[i] *= alpha; } }
#pragma unroll
            for (int sp = 0; sp < 4; ++sp) {
                unsigned pw[4];
#pragma unroll
                for (int e = 0; e < 4; ++e) { const int i0 = 8 * (sp & 1) + 2 * e; pw[e] = (sp < 2) ? pg8::cvt_pk_bf16(st0[i0], st0[i0 + 1]) : pg8::cvt_pk_bf16(st1[i0], st1[i0 + 1]); }
                const bf16x8 pf = __builtin_bit_cast(bf16x8, (v4u){pw[0], pw[1], pw[2], pw[3]});
                lsum = __builtin_amdgcn_mfma_f32_32x32x16_bf16(__builtin_bit_cast(bf16x8, (v4u){0x3f803f80u, 0x3f803f80u, 0x3f803f80u, 0x3f803f80u}), pf, lsum, 0, 0, 0);
#pragma unroll
                for (int dt = 0; dt < 2; ++dt) {
                    const LAS bf16* vp = Vs + (32 * dt + r) * 72 + 16 * sp + 4 * h;
                    const v2u va = *(const LAS v2u*)vp, vb = *(const LAS v2u*)(vp + 8);
                    const bf16x8 vf = __builtin_bit_cast(bf16x8, (v4u){va.x, va.y, vb.x, vb.y});
                    if (dt == 0) o0 = __builtin_amdgcn_mfma_f32_32x32x16_bf16(vf, pf, o0, 0, 0, 0); else o1 = __builtin_amdgcn_mfma_f32_32x32x16_bf16(vf, pf, o1, 0, 0, 0);
                }
            }
            l = l * alpha + lsum[0];
            __syncthreads();
        };
#pragma unroll 1
        for (int it = 0;; it += 2) {
            tile_step(it, kvB, vvB);
            if (it + 1 >= ntile) break;
            tile_step(it + 1, kvA, vvA);
            if (it + 2 >= ntile) break;
        }
        asm volatile("s_waitcnt vmcnt(0)" ::: "memory");
        asm volatile("" :: "v"(qtouch));
#undef ATT_KEY0
#undef ATT_WAIT2
#undef ATT_LOAD
#undef ATT_WRITE
        const float inv = 1.0f / l;
        bf16* op = O + tokq * D + head * 64 + 4 * h;
#pragma unroll
        for (int g = 0; g < 4; ++g) {
            v2u w0, w1; w0.x = pg8::cvt_pk_bf16(o0[4 * g] * inv, o0[4 * g + 1] * inv); w0.y = pg8::cvt_pk_bf16(o0[4 * g + 2] * inv, o0[4 * g + 3] * inv);
            w1.x = pg8::cvt_pk_bf16(o1[4 * g] * inv, o1[4 * g + 1] * inv); w1.y = pg8::cvt_pk_bf16(o1[4 * g + 2] * inv, o1[4 * g + 3] * inv);
            *(GAS v2u*)(op + 8 * g) = w0; *(GAS v2u*)(op + 32 + 8 * g) = w1;
        }
    }
}
__device__ __forceinline__ float sconv3(const bf16* p, int n, int L, float w0, float w1, float w2, float cb) {
    const float a = (n > 0) ? bf2f(p[n - 1]) : 0.f, b = bf2f(p[n]), c = (n < L - 1) ? bf2f(p[n + 1]) : 0.f;
    return cb + w0 * a + w1 * b + w2 * c;
}
struct HyRaw { v4u raw[4]; unsigned short lf[4], rt[4]; };
__device__ __forceinline__ void hy_stage_load(const bf16* p, HyRaw& R, int tid) {
#pragma unroll
    for (int ch = 0; ch < 2; ++ch)
#pragma unroll
        for (int b = 0; b < 2; ++b) {
            const int n0 = 8 * tid + 4096 * ch; const bf16* pb = p + (size_t)b * SEQ;
            R.raw[2 * ch + b] = *(const GAS v4u*)(pb + n0);
            R.lf[2 * ch + b] = n0 > 0 ? pb[n0 - 1] : (unsigned short)0; R.rt[2 * ch + b] = n0 + 8 < SEQ ? pb[n0 + 8] : (unsigned short)0;
        }
}
__device__ __forceinline__ void hy_stage_write(const HyRaw& R, float w0, float w1, float w2, float cb, LAS float* S, int tid) {
#pragma unroll
    for (int ch = 0; ch < 2; ++ch)
#pragma unroll
        for (int b = 0; b < 2; ++b) {
            const int n0 = 8 * tid + 4096 * ch; const v4u raw = R.raw[2 * ch + b];
            float x[10]; x[0] = bf2f(R.lf[2 * ch + b]); x[1] = bflo(raw.x); x[2] = bfhi(raw.x); x[3] = bflo(raw.y); x[4] = bfhi(raw.y); x[5] = bflo(raw.z); x[6] = bfhi(raw.z); x[7] = bflo(raw.w); x[8] = bfhi(raw.w); x[9] = bf2f(R.rt[2 * ch + b]);
            f32x4 lo, hi;
#pragma unroll
            for (int e = 0; e < 4; ++e) { lo[e] = cb + w0 * x[e] + w1 * x[e + 1] + w2 * x[e + 2]; hi[e] = cb + w0 * x[e + 4] + w1 * x[e + 5] + w2 * x[e + 6]; }
            *(LAS f32x4*)(S + b * 8192 + n0) = lo; *(LAS f32x4*)(S + b * 8192 + n0 + 4) = hi;
        }
}
__device__ __forceinline__ void hyena_phase(Frame& F, int j, bool with_ctx) {
    LAS cf2* X = (LAS cf2*)F.lds;
    LAS float* red = (LAS float*)(F.lds + USER_OFF + 1024);
    const int tid0 = F.tid;
    const bf16* Ut = (const bf16*)(F.ws + WS_UT); bf16* Zt = (bf16*)(F.ws + WS_ZT);
    const bf16* a3b = (const bf16*)(F.ws + WS_A3L) + (size_t)j * 8192 * 64; const float* a3c = (const float*)(F.ws + WS_A3C) + (size_t)j * 256 * 64;
    const float* wout = F.in[I_FWOUT] + (size_t)j * 64 * 4096; const float* convw = F.in[I_HCW] + (size_t)j * 3 * 3072; const float* convb = F.in[I_HCB] + (size_t)j * 3072;
    const float* biasd = F.in[I_HBD] + (size_t)j * 2 * 1024;
    LAS float* U4 = (LAS float*)(F.lds + USER_OFF + 2048);
    LAS float* nrm = (LAS float*)(F.lds + USER_OFF + 1536);
    LAS float* red8 = (LAS float*)(F.lds + USER_OFF + 1280);
#ifndef PROBE_HY_TAPS
#define PROBE_HY_TAPS 1
#endif
#pragma unroll 1
    for (int cc0 = 0; cc0 < 4; ++cc0) { const int c = F.vcu + 256 * cc0;
        if (cc0 == 0)
    {
        int tid = tid0; asm volatile("" : "+v"(tid));
        __syncthreads();
        for (int i = tid; i < 1024; i += NWAVES * 64) { const int cc = i >> 8, k = (i >> 2) & 63, q = i & 3; U4[i] = wout[(size_t)k * 4096 + q * 1024 + F.vcu + 256 * cc]; }
        __syncthreads();
        const int n = tid & 31, h = (tid >> 5) & 1, wv = tid >> 6, q = n & 3, cc = (n >> 2) & 3, sb = n >> 4, c = F.vcu + 256 * cc;
        bf16x8 bw[4];
#pragma unroll
        for (int f4 = 0; f4 < 4; ++f4) { unsigned pw[4];
#pragma unroll
            for (int e = 0; e < 4; ++e) { const int k0 = 16 * f4 + 8 * h + 2 * e; pw[e] = pk2(U4[cc * 256 + 4 * k0 + q], U4[cc * 256 + 4 * (k0 + 1) + q]); }
            bw[f4] = __builtin_bit_cast(bf16x8, (v4u){pw[0], pw[1], pw[2], pw[3]}); }
        const bf16x8 zero8 = __builtin_bit_cast(bf16x8, (v4u){0u, 0u, 0u, 0u});
        const float na = -(3.0701134573253945f + (15.350567286626973f - 3.0701134573253945f) * (float)c * (1.0f / 1023.0f)) * (1.0f / 8191.0f);
        const float r1 = expf(na), r2 = expf(2.0f * na), r3 = expf(3.0f * na);
        float sm = 0.f;
        float* tq = (float*)(F.ws + WS_TP) + (size_t)c * 2 * FFT_N + (size_t)(q & 1) * FFT_N + (q >> 1) * 8192;
#pragma unroll 1
        for (int i = 0; i < 16; ++i) {
            const int T0 = 64 * (wv + 8 * i);
            const bf16* ap = a3b + (size_t)T0 * 64 + 8 * (tid & 63);
            f32x16 acc;
#pragma unroll
            for (int e = 0; e < 16; ++e) acc[e] = 0.f;
#pragma unroll
            for (int s8 = 0; s8 < 2; ++s8)
#pragma unroll
                for (int f4 = 0; f4 < 4; ++f4)
                    acc = __builtin_amdgcn_mfma_f32_32x32x16_bf16(*(const GAS bf16x8*)(ap + (s8 * 4 + f4) * 512), sb == s8 ? bw[f4] : zero8, acc, 0, 0, 0);
#pragma unroll
            for (int g = 0; g < 4; ++g) { const int t = T0 + 32 * sb + 8 * g + 4 * h; const float d0 = expf(na * (float)t);
                f32x4 val = (f32x4){acc[4 * g] * d0, acc[4 * g + 1] * (d0 * r1), acc[4 * g + 2] * (d0 * r2), acc[4 * g + 3] * (d0 * r3)};
                sm += ((q >= 2 && t == 0) ? 0.f : fabsf(val.x)) + fabsf(val.y) + fabsf(val.z) + fabsf(val.w);
                *(GAS f32x4*)(tq + t) = val; }
        }
        sm += __shfl_xor(sm, 2); sm += __shfl_xor(sm, 16); sm += __shfl_xor(sm, 32);
        if ((tid & 50) == 0) red8[wv * 8 + 2 * cc + (q & 1)] = sm;
        __syncthreads();
        if (tid < 8) { float t8 = 0.f;
#pragma unroll
            for (int w = 0; w < NWAVES; ++w) t8 += red8[w * 8 + tid]; nrm[tid] = t8; }
        VM_WAIT();
        __syncthreads();
    }
        int tid = tid0; asm volatile("" : "+v"(tid));
        float* tp = (float*)(F.ws + WS_TP) + (size_t)c * 2 * FFT_N;
        float* Gc = (float*)(F.ws + WS_G) + (size_t)c * 2 * FFT_N * 2;
        __syncthreads();
        const float sum0 = nrm[2 * cc0], sum1 = nrm[2 * cc0 + 1];
        LAS float* U = U4 + cc0 * 256;
        const float absd = 3.0701134573253945f + (15.350567286626973f - 3.0701134573253945f) * (float)c * (1.0f / 1023.0f);
#pragma unroll 1
#ifndef PROBE_HY_SPEC
#define PROBE_HY_SPEC 2
#endif
        for (int o4 = 0; o4 < PROBE_HY_SPEC; ++o4) { const int o = o4 & 1;
            fft_fwd_first_taps(X, (const GAS float*)(tp + (size_t)o * FFT_N), 1.0f / (o == 0 ? sum0 : sum1), tid); __syncthreads();
            fft_fwd_double<1>(X, tid); __syncthreads();
            fft_fwd_double<3>(X, tid); __syncthreads();
            fft_mid_store(X, (GAS cf4*)(Gc + (size_t)o * FFT_N * 2), 1.0f / (float)FFT_N, biasd[o * 1024 + c], tid); __syncthreads();
        }
        VM_WAIT();
        __syncthreads();
        const float cwv0 = convw[2048 + c], cwv1 = convw[3072 + 2048 + c], cwv2 = convw[6144 + 2048 + c], cbv = convb[2048 + c];
        const float cwa0 = convw[c], cwa1 = convw[3072 + c], cwa2 = convw[6144 + c], cba = convb[c];
        const float cwb0 = convw[1024 + c], cwb1 = convw[3072 + 1024 + c], cwb2 = convw[6144 + 1024 + c], cbb = convb[1024 + c];
        const float d0 = biasd[c], d1 = biasd[1024 + c];
#ifndef PROBE_HY_PAIRS
#define PROBE_HY_PAIRS 4
#endif
        HyRaw rv, rg;
        hy_stage_load(Ut + (size_t)(2048 + c) * TT, rv, tid);
#pragma unroll 1
        for (int pr8 = 0; pr8 < PROBE_HY_PAIRS; ++pr8) { const int pr = pr8 & 3;
            const size_t tb0 = (size_t)(2 * pr) * SEQ;
            LAS float* S = (LAS float*)F.lds;
            float z0[16], z1[16];
            __syncthreads();
            hy_stage_write(rv, cwv0, cwv1, cwv2, cbv, S, tid); __syncthreads();
#pragma unroll
            for (int i = 0; i < 16; ++i) { z0[i] = S[tid + 512 * i]; z1[i] = S[8192 + tid + 512 * i]; }
#pragma unroll 1
            for (int o = 0; o < 2; ++o) {
                __syncthreads();
                fft_fwd_first(X, z0, z1, tid);
                hy_stage_load(Ut + (size_t)(o == 0 ? c : 1024 + c) * TT + tb0, rg, tid);
                if (o == 1) hy_stage_load(Ut + (size_t)(2048 + c) * TT + (size_t)(2 * ((pr8 + 1) & 3)) * SEQ, rv, tid);
                __syncthreads();
                fft_fwd_double<1>(X, tid); __syncthreads();
                fft_fwd_double<3>(X, tid); __syncthreads();
                fft_mid_mul(X, (const GAS cf4*)(Gc + (size_t)o * FFT_N * 2), tid); __syncthreads();
                fft_inv_double<3>(X, tid); __syncthreads();
                fft_inv_double<1>(X, tid); __syncthreads();
                fft_inv_last(X, z0, z1, tid); __syncthreads();
                hy_stage_write(rg, o == 0 ? cwa0 : cwb0, o == 0 ? cwa1 : cwb1, o == 0 ? cwa2 : cwb2, o == 0 ? cba : cbb, S, tid); __syncthreads();
#pragma unroll
                for (int i = 0; i < 16; ++i) { z0[i] *= S[tid + 512 * i]; z1[i] *= S[8192 + tid + 512 * i]; }
            }
            __syncthreads();
#pragma unroll
            for (int i = 0; i < 16; ++i) { S[tid + 512 * i] = z0[i]; S[8192 + tid + 512 * i] = z1[i]; }
            __syncthreads();
#pragma unroll
            for (int ch = 0; ch < 2; ++ch)
#pragma unroll
                for (int b = 0; b < 2; ++b) { const int n0 = 8 * tid + 4096 * ch; const f32x4 lo = *(const LAS f32x4*)(S + b * 8192 + n0), hi = *(const LAS f32x4*)(S + b * 8192 + n0 + 4);
                    v4u w; w.x = pk2(lo.x, lo.y); w.y = pk2(lo.z, lo.w); w.z = pk2(hi.x, hi.y); w.w = pk2(hi.z, hi.w);
                    *(GAS v4u*)(Zt + (size_t)c * TT + tb0 + (size_t)b * SEQ + n0) = w; }
        }
        if (!with_ctx) continue;
        asm volatile("" : "+v"(tid));
        __syncthreads();
        LAS float* tap0 = (LAS float*)F.lds; LAS float* tap1 = tap0 + 512; LAS float* vb = tap0 + 1024; LAS float* zb = tap0 + 1024 + 2048;
        {
            float f0 = 0.f, f1 = 0.f, b0 = 0.f, b1 = 0.f, s0 = 0.f, s1 = 0.f;
            if (tid < 256) { const int t = tid; const GAS f32x4* ar = (const GAS f32x4*)(a3c + (size_t)t * 64); f32x4 acc = (f32x4){0.f, 0.f, 0.f, 0.f};
#pragma unroll 4
                for (int k4 = 0; k4 < 16; ++k4) { const f32x4 a = ar[k4];
                    acc += a[0] * *(const LAS f32x4*)(U + 16 * k4) + a[1] * *(const LAS f32x4*)(U + 16 * k4 + 4) + a[2] * *(const LAS f32x4*)(U + 16 * k4 + 8) + a[3] * *(const LAS f32x4*)(U + 16 * k4 + 12); }
                const float dec = expf(-((float)t * (1.0f / 255.0f)) * absd);
                f0 = acc[0] * dec; f1 = acc[1] * dec; b0 = acc[2] * dec; b1 = acc[3] * dec;
                s0 = fabsf(f0) + (t > 0 ? fabsf(b0) : 0.f); s1 = fabsf(f1) + (t > 0 ? fabsf(b1) : 0.f); }
            block_sum2(F, red, s0, s1);
            if (tid < 256) { const float i0 = 1.0f / s0, i1 = 1.0f / s1; tap0[256 + tid] = f0 * i0; tap1[256 + tid] = f1 * i1; if (tid > 0) { tap0[256 - tid] = b0 * i0; tap1[256 - tid] = b1 * i1; } else { tap0[0] = 0.f; tap1[0] = 0.f; } }
        }
        const int cb_ = tid >> 6, n0 = (tid & 63) * 4;
        const size_t tcx = (size_t)TL + (size_t)cb_ * CTXL;
        float vloc[4], zloc[4];
        { const bf16* pv = Ut + (size_t)(2048 + c) * TT + tcx;
#pragma unroll
          for (int e = 0; e < 4; ++e) { vloc[e] = sconv3(pv, n0 + e, CTXL, cwv0, cwv1, cwv2, cbv); vb[cb_ * 256 + n0 + e] = vloc[e]; } }
        __syncthreads();
        { const bf16* pa = Ut + (size_t)c * TT + tcx; float acc[4] = {0.f, 0.f, 0.f, 0.f};
          for (int mI = 0; mI < 256; ++mI) { const float vv = vb[cb_ * 256 + mI];
#pragma unroll
              for (int e = 0; e < 4; ++e) acc[e] += tap0[256 + n0 + e - mI] * vv; }
#pragma unroll
          for (int e = 0; e < 4; ++e) { zloc[e] = sconv3(pa, n0 + e, CTXL, cwa0, cwa1, cwa2, cba) * (acc[e] + vloc[e] * d0); zb[cb_ * 256 + n0 + e] = zloc[e]; } }
        __syncthreads();
        { const bf16* pb = Ut + (size_t)(1024 + c) * TT + tcx; float acc[4] = {0.f, 0.f, 0.f, 0.f};
          for (int mI = 0; mI < 256; ++mI) { const float vv = zb[cb_ * 256 + mI];
#pragma unroll
              for (int e = 0; e < 4; ++e) acc[e] += tap1[256 + n0 + e - mI] * vv; }
#pragma unroll
          for (int e = 0; e < 4; ++e) { const float ov = sconv3(pb, n0 + e, CTXL, cwb0, cwb1, cwb2, cbb) * (acc[e] + zloc[e] * d1); Zt[(size_t)c * TT + tcx + n0 + e] = (bf16)f2bf(ov); } }
    }
}
__device__ __forceinline__ void transpose_phase(Frame& F, int ncols) {
    const bf16* Zt = (const bf16*)(F.ws + WS_ZT); bf16* Z = (bf16*)(F.ws + WS_O);
    LAS bf16* T = (LAS bf16*)(F.lds + F.wave * 16384);
    const int gw = F.vcu * NWAVES + F.wave, NGW = F.G * NWAVES, lane = F.lane;
    const int nitems = 16 * (ncols / 64);
    v4u tv[8];
    { const int it0 = gw < nitems ? gw : 0, ct = it0 & 15, tt = it0 >> 4;
#pragma unroll
      for (int i = 0; i < 8; ++i) { const int cr = (lane >> 3) + 8 * i, ch = lane & 7; tv[i] = *(const GAS v4u*)(Zt + (size_t)(ct * 64 + cr) * TT + (size_t)tt * 64 + ch * 8); } }
    for (int item = gw; item < nitems; item += NGW) {
        const int ct = item & 15, tt = item >> 4;
#pragma unroll
        for (int i = 0; i < 8; ++i) { const int cr = (lane >> 3) + 8 * i, ch = lane & 7; *(LAS v4u*)(T + cr * 72 + ch * 8) = tv[i]; }
        { const int itn = item + NGW < nitems ? item + NGW : item, ctn = itn & 15, ttn = itn >> 4;
#pragma unroll
          for (int i = 0; i < 8; ++i) { const int cr = (lane >> 3) + 8 * i, ch = lane & 7; tv[i] = *(const GAS v4u*)(Zt + (size_t)(ctn * 64 + cr) * TT + (size_t)ttn * 64 + ch * 8); } }
        LDS_WAIT(); asm volatile("" ::: "memory");
#pragma unroll
        for (int i = 0; i < 8; ++i) { const int tok = (lane >> 3) + 8 * i, cc = (lane & 7) * 8;
            unsigned short e[8];
#pragma unroll
            for (int q = 0; q < 8; ++q) e[q] = T[(cc + q) * 72 + tok];
            v4u o; o.x = e[0] | ((unsigned)e[1] << 16); o.y = e[2] | ((unsigned)e[3] << 16); o.z = e[4] | ((unsigned)e[5] << 16); o.w = e[6] | ((unsigned)e[7] << 16);
            *(GAS v4u*)(Z + (size_t)(tt * 64 + tok) * D + ct * 64 + cc) = o; }
        LDS_WAIT(); asm volatile("" ::: "memory");
    }
}

__device__ __forceinline__ void router_phase(Frame& F, int l) {
    const int nrows = rows_of_layer(l);
    constexpr int RR = 6;
    LAS bf16* Whi = (LAS bf16*)F.lds; LAS bf16* Wlo = Whi + 32 * 1024;
    LAS int* cnt = (LAS int*)(F.lds + USER_OFF); LAS int* base = cnt + 32; LAS int* rec = cnt + 64;
    const int tid = F.tid, lane = F.lane, wave = F.wave;
    const float* rw = F.in[I_RW] + (size_t)l * 1024 * 32;
    __syncthreads();
#pragma unroll 1
    for (int i0 = tid; i0 < 1024 * 32; i0 += 16 * NWAVES * 64) { float wv[16];
#pragma unroll
        for (int u = 0; u < 16; ++u) wv[u] = rw[i0 + u * NWAVES * 64];
#pragma unroll
        for (int u = 0; u < 16; ++u) { const int i = i0 + u * NWAVES * 64, k = i >> 5, e = i & 31; const float w = wv[u]; const unsigned hi = f2bf(w), lo = f2bf(w - bflo(hi));
            const int idx = e * 1024 + ((((k >> 3) ^ (e & 15)) << 3) | (k & 7)); Whi[idx] = (bf16)hi; Wlo[idx] = (bf16)lo; } }
    if (tid < 32) cnt[tid] = 0;
    __syncthreads();
    const float* mod = (const float*)(F.ws + WS_MOD) + (size_t)l * 9 * 6144;
    const float* gain = F.in[I_NFFN] + (size_t)l * D;
    const int gw = F.vcu * NWAVES + wave, NGW = F.G * NWAVES;
    bf16* H = (bf16*)(F.ws + WS_H);
    v4u rawn[RR][2];
#pragma unroll
    for (int r = 0; r < RR; ++r) { const int row = gw + r * NGW < nrows ? gw + r * NGW : gw;
        const GAS v4u* xr = (const GAS v4u*)((const bf16*)(F.ws + WS_XB) + (size_t)row * D) + lane; rawn[r][0] = xr[0]; rawn[r][1] = xr[64]; }
    for (int row0 = gw; row0 < nrows; row0 += RR * NGW) {
        f32x4 v[RR][4]; float s2[RR];
#pragma unroll
        for (int r = 0; r < RR; ++r) {
#pragma unroll
            for (int jj = 0; jj < 2; ++jj) row8_unpack(rawn[r][jj], v[r][2 * jj], v[r][2 * jj + 1]); }
        { const int nx0 = row0 + RR * NGW < nrows ? row0 + RR * NGW : row0;
#pragma unroll
          for (int r = 0; r < RR; ++r) { const int row = nx0 + r * NGW < nrows ? nx0 + r * NGW : nx0;
              const GAS v4u* xr = (const GAS v4u*)((const bf16*)(F.ws + WS_XB) + (size_t)row * D) + lane; rawn[r][0] = xr[0]; rawn[r][1] = xr[64]; } }
#pragma unroll
        for (int r = 0; r < RR; ++r) { s2[r] = 0.f;
#pragma unroll
            for (int jj = 0; jj < 4; ++jj) s2[r] += (v[r][jj].x * v[r][jj].x + v[r][jj].y * v[r][jj].y) + (v[r][jj].z * v[r][jj].z + v[r][jj].w * v[r][jj].w); }
#pragma unroll
        for (int o = 1; o < 64; o <<= 1) {
#pragma unroll
            for (int r = 0; r < RR; ++r) s2[r] += __shfl_xor(s2[r], o); }
#pragma unroll
        for (int r = 0; r < RR; ++r) { const int row = row0 + r * NGW < nrows ? row0 + r * NGW : row0;
            const float rstd = 1.0f / sqrtf(s2[r] * (1.0f / D) + NORM_EPS);
            const float* mr = mod + (size_t)mod_row(row) * 6144;
#pragma unroll
            for (int jj = 0; jj < 2; ++jj) { f32x4 hq[2];
#pragma unroll
                for (int hf = 0; hf < 2; ++hf) hq[hf] = v[r][2 * jj + hf] * rstd * ROW8_F32(gain, jj, hf, lane) * (ROW8_F32(mr + 4 * 1024, jj, hf, lane) + 1.0f) + ROW8_F32(mr + 3 * 1024, jj, hf, lane);
                ((GAS v4u*)(H + (size_t)row * D))[64 * jj + lane] = row8_pack(hq[0], hq[1]); } }
    }
    VM_WAIT();
    asm volatile("" ::: "memory");
    const int r32 = lane & 31, hh2 = lane >> 5;
    const float rb = F.in[I_RB][l * 32 + r32];
    const int nmine = (nrows - gw + NGW - 1) / NGW;
    for (int tile = 0; tile * 32 < nmine; ++tile) {
        const int irow = 32 * tile + r32; const size_t arow = (size_t)gw + (size_t)NGW * (irow < nmine ? irow : 0);
        const bf16* ap = H + arow * D + 8 * hh2;
        const LAS bf16* bh = Whi + r32 * 1024; const LAS bf16* bl = Wlo + r32 * 1024;
        f32x16 acc;
#pragma unroll
        for (int i = 0; i < 16; ++i) acc[i] = 0.f;
#pragma unroll 1
        for (int s0 = 0; s0 < 64; s0 += 32) {
            bf16x8 a[32];
#pragma unroll
            for (int u = 0; u < 32; ++u) a[u] = *(const GAS bf16x8*)(ap + 16 * (s0 + u));
            __builtin_amdgcn_sched_barrier(0);
#pragma unroll
            for (int u = 0; u < 32; ++u) {
                const int cb = ((2 * (s0 + u) + hh2) ^ (r32 & 15)) << 3;
                const bf16x8 b1 = *(const LAS bf16x8*)(bh + cb), b2 = *(const LAS bf16x8*)(bl + cb);
                acc = __builtin_amdgcn_mfma_f32_32x32x16_bf16(a[u], b1, acc, 0, 0, 0);
                acc = __builtin_amdgcn_mfma_f32_32x32x16_bf16(a[u], b2, acc, 0, 0, 0);
            }
            __builtin_amdgcn_sched_barrier(0);
        }
#pragma unroll 2
        for (int i = 0; i < 16; ++i) {
            if (32 * tile + (i & 3) + 8 * (i >> 2) >= nmine) continue;
            const float mine = acc[i] + rb; int rank = 0;
#pragma unroll 8
            for (int e2 = 0; e2 < 32; ++e2) { const float sv = __shfl(mine, (lane & 32) | e2); rank += (sv > mine || (sv == mine && e2 < r32)) ? 1 : 0; }
            const int rr = (i & 3) + 8 * (i >> 2);
#pragma unroll
            for (int hsel = 0; hsel < 2; ++hsel) {
                const int it = 32 * tile + rr + 4 * hsel;
                float tv[4]; int te[4];
#pragma unroll
                for (int k = 0; k < 4; ++k) { const unsigned long long mk = __ballot(rank == k) & (hsel ? 0xffffffff00000000ull : 0x00000000ffffffffull); const int src = __ffsll((long long)mk) - 1;
                    te[k] = src & 31; tv[k] = __builtin_bit_cast(float, __builtin_amdgcn_readlane(__builtin_bit_cast(int, mine), src)); }
                if (it < nmine) {
                    const size_t row = (size_t)gw + (size_t)NGW * it;
                    const float e1 = __expf(tv[1] - tv[0]), e2 = __expf(tv[2] - tv[0]), e3 = __expf(tv[3] - tv[0]), isum = 1.0f / (1.0f + e1 + e2 + e3);
                    if (lane == 0) *(GAS f32x4*)((float*)(F.ws + WS_GATE) + row * 4) = (f32x4){isum, e1 * isum, e2 * isum, e3 * isum};
                    if (lane < 4) { const int tel = lane == 0 ? te[0] : lane == 1 ? te[1] : lane == 2 ? te[2] : te[3];
                        const int rk = __hip_atomic_fetch_add(cnt + tel, 1, __ATOMIC_RELAXED, __HIP_MEMORY_SCOPE_WORKGROUP); rec[(wave * 64 + it) * 4 + lane] = tel | (rk << 8); }
                }
            }
        }
    }
    __syncthreads();
    if (tid < 32) base[tid] = (int)__hip_atomic_fetch_add((unsigned*)(F.ctl + CW_ECNT + l * 32 + tid), (unsigned)cnt[tid], RLX_AGENT);
    __syncthreads();
    for (int it = 0; it < nmine; ++it) {
        if (lane < 4) { const int rc = rec[(wave * 64 + it) * 4 + lane], e = rc & 255; ((int*)(F.ws + WS_POS))[((size_t)gw + (size_t)NGW * it) * 4 + lane] = e | ((base[e] + (rc >> 8)) << 8); }
    }
}
__device__ __forceinline__ void load_blkstart(Frame& F, int l, LAS int* blkstart) {
    __syncthreads();
    if (F.tid < 32) {
        const unsigned c = __hip_atomic_load((unsigned*)(F.ctl + CW_ECNT + l * 32 + F.tid), RLX_AGENT); const int nb = (int)((c + 255u) >> 8); int s = nb;
#pragma unroll
        for (int o = 1; o < 32; o <<= 1) { const int t = __shfl_up(s, o); if (F.tid >= o) s += t; }
        blkstart[F.tid] = s - nb; if (F.tid == 31) blkstart[32] = s; }
    __syncthreads();
    for (int rb = F.tid; rb < MAXBLK; rb += NWAVES * 64) { int e = 0;
#pragma unroll 1
        for (int q = 1; q < 32; ++q) e += (blkstart[q] <= rb) ? 1 : 0;
        blkstart[64 + rb] = e; }
    __syncthreads();
}
__device__ __forceinline__ void index_phase(Frame& F, int l) {
    const int nrows = rows_of_layer(l);
    LAS int* blkstart = (LAS int*)(F.lds + USER_OFF + 8192);
    load_blkstart(F, l, blkstart);
    const int* POS = (const int*)(F.ws + WS_POS); int* DEST = (int*)(F.ws + WS_DEST); int* RSRC = (int*)(F.ws + WS_RSRC);
    const int gt = F.vcu * (NWAVES * 64) + F.tid, NT = F.G * NWAVES * 64;
    for (int a = gt; a < nrows * 4; a += NT) { const int pk = POS[a], e = pk & 255, rk = pk >> 8, d = blkstart[e] * 256 + rk; DEST[a] = d; RSRC[d] = a >> 2; }
    if (F.bx < 32) { const int e = F.bx; const int cnt = (int)__hip_atomic_load((unsigned*)(F.ctl + CW_ECNT + l * 32 + e), RLX_AGENT), end = (blkstart[e + 1] - blkstart[e]) * 256;
        for (int p2 = cnt + F.tid; p2 < end; p2 += NWAVES * 64) RSRC[blkstart[e] * 256 + p2] = 0; }
}
__device__ __forceinline__ void combine_phase(Frame& F, int l, bool dry = false) {
    constexpr int RR = 3;
    const int gw = F.vcu * NWAVES + F.wave, NGW = F.G * NWAVES, lane = F.lane;
    const bf16* YS = (const bf16*)(F.ws + WS_YS); const int* POS = (const int*)(F.ws + WS_DEST); const float* GT = (const float*)(F.ws + WS_GATE);
    const float* mod = (const float*)(F.ws + WS_MOD);
    const int nrows = rows_of_layer(l);
    v4i psn[RR]; f32x4 gtn[RR];
#pragma unroll
    for (int r = 0; r < RR; ++r) { const int rw = gw + r * NGW < nrows ? gw + r * NGW : gw; psn[r] = *(const GAS v4i*)(POS + (size_t)rw * 4); gtn[r] = *(const GAS f32x4*)(GT + (size_t)rw * 4); }
    for (int row0 = gw; row0 < nrows; row0 += RR * NGW) {
        v4i ps[RR]; f32x4 gt[RR]; f32x4 v[RR][4]; int rows[RR];
#pragma unroll
        for (int r = 0; r < RR; ++r) { rows[r] = row0 + r * NGW < nrows ? row0 + r * NGW : row0; ps[r] = psn[r]; gt[r] = gtn[r]; }
        { const int nx0 = row0 + RR * NGW < nrows ? row0 + RR * NGW : row0;
#pragma unroll
          for (int r = 0; r < RR; ++r) { const int rw = nx0 + r * NGW < nrows ? nx0 + r * NGW : nx0; psn[r] = *(const GAS v4i*)(POS + (size_t)rw * 4); gtn[r] = *(const GAS f32x4*)(GT + (size_t)rw * 4); } }
#pragma unroll
        for (int r = 0; r < RR; ++r) { const int row = rows[r];
            const GAS v4u* xr = (const GAS v4u*)((const bf16*)(F.ws + WS_XB) + (size_t)row * D) + lane;
            const float* g2 = mod + ((size_t)l * 9 + mod_row(row)) * 6144 + 5 * 1024;
#pragma unroll
            for (int jj = 0; jj < 2; ++jj) {
                f32x4 y0 = (f32x4){0.f, 0.f, 0.f, 0.f}, y1 = y0;
#pragma unroll
                for (int k = 0; k < 4; ++k) { f32x4 a, b; row8_unpack(*(const GAS v4u*)(YS + (size_t)ps[r][k] * D + 512 * jj + 8 * lane), a, b); y0 += gt[r][k] * a; y1 += gt[r][k] * b; }
                f32x4 xa, xb2; row8_unpack(xr[64 * jj], xa, xb2);
                v[r][2 * jj] = xa + ROW8_F32(g2, jj, 0, lane) * y0; v[r][2 * jj + 1] = xb2 + ROW8_F32(g2, jj, 1, lane) * y1;
            } }
#pragma unroll
        for (int r = 0; r < RR; ++r) { const int row = rows[r];
            if (r > 0 && row0 + r * NGW >= nrows) continue;
            bf16* xw = (bf16*)(F.ws + (dry ? WS_ACT : WS_XB)) + (size_t)row * D; bf16* hw = (bf16*)(F.ws + (dry ? WS_ACT + 270 * MiB : WS_H)) + (size_t)row * D;
            if (l < DEPTH - 1) {
#pragma unroll
                for (int jj = 0; jj < 2; ++jj) ((GAS v4u*)xw)[64 * jj + lane] = row8_pack(v[r][2 * jj], v[r][2 * jj + 1]);
                const float* mr = mod + ((size_t)(l + 1) * 9 + mod_row(row)) * 6144;
                norm_mod_store(F, v[r], F.in[I_NMIX] + (size_t)(l + 1) * D, mr, mr + 1024, hw);
            } else {
                float s2 = 0.f;
#pragma unroll
                for (int jj = 0; jj < 4; ++jj) s2 += (v[r][jj].x * v[r][jj].x + v[r][jj].y * v[r][jj].y) + (v[r][jj].z * v[r][jj].z + v[r][jj].w * v[r][jj].w);
                const float rstd = 1.0f / sqrtf(wave_sum(s2) * (1.0f / D) + NORM_EPS);
#pragma unroll
                for (int q = 0; q < 4; ++q) ((GAS f32x4*)(dry ? (float*)(F.ws + WS_ACT) + (size_t)row * D : F.out + (size_t)row * D))[128 * (q >> 1) + 2 * lane + (q & 1)] = v[r][q] * rstd * ROW8_F32(F.in[I_FNORM], q >> 1, q & 1, lane);
            }
        }
    }
}
constexpr int N_PHASES = 1 + 10 * DEPTH;
#ifndef PG8_SP2
#define PG8_SP2 true
#endif
#ifndef PG8_ALIGN_EPI
#define PG8_ALIGN_EPI true
#endif
__host__ __device__ inline bool phase_exists(int ph) { if (ph == 0) return true; const int l = (ph - 1) / 10, k = (ph - 1) % 10; return !((k == 0 && l != 0) || (k == 3 && (l & 1) == 0)); }
struct Args { const float* in[N_IN]; float* out; unsigned char* ws; int ph_lo, ph_hi, use_bar, pad; };
__global__ void __launch_bounds__(NWAVES * 64, 2) fwd_kernel(Args args) {
    extern __shared__ __attribute__((aligned(16))) unsigned char lds[];
    Frame F;
    F.lds = (LAS unsigned char*)lds;
    F.MISC = (volatile LAS unsigned*)(F.lds + MISC_OFF);
    F.tid = threadIdx.x; F.lane = F.tid & 63; F.wave = __builtin_amdgcn_readfirstlane(F.tid >> 6);
    F.G = gridDim.x; { const int bx = blockIdx.x; F.vcu = (F.G % 8 == 0) ? (bx % 8) * (F.G / 8) + bx / 8 : bx; }
    const KAS Args* ap = (const KAS Args*)__builtin_amdgcn_kernarg_segment_ptr();
    F.in = ap->in; F.out = ap->out; F.ws = ap->ws;
    F.ctl = (gu32*)(F.ws + WS_CTL);
    const int use_bar = ap->use_bar;
    for (int u = F.tid; u < (USER_OFF - LDSCTL_OFF) / 4; u += NWAVES * 64) ((LAS unsigned*)(F.lds + LDSCTL_OFF))[u] = 0u;
    __syncthreads();
    XcdBarrier bar; bar.bar = (unsigned*)(F.ctl + CW_BAR); bar.x = 0; bar.st = nullptr;
    if (use_bar) bar = xcd_barrier_post((unsigned*)(F.ctl + CW_BAR), F.MISC + 8);
    const int hi = ap->ph_hi;
    LAS int* blkstart = (LAS int*)(F.lds + USER_OFF + 8192);
#ifndef PROBE_REP_MASK
#define PROBE_REP_MASK 0
#define PROBE_REP_KIND 2
#endif
    int rep_done = 0;
#pragma unroll 1
    for (int ph = ap->ph_lo; ph < hi; ++ph) {
        if (!phase_exists(ph)) continue;
        { int t_ = threadIdx.x; asm volatile("" : "+v"(t_)); F.tid = t_; F.lane = t_ & 63; F.wave = __builtin_amdgcn_readfirstlane(t_ >> 6);
          const KAS Args* a_ = ap; asm volatile("" : "+s"(a_)); F.in = a_->in;
          unsigned char* w_ = a_->ws; asm volatile("" : "+s"(w_)); F.ws = w_; float* o_ = a_->out; asm volatile("" : "+s"(o_)); F.out = o_;
          int v_ = F.vcu; asm volatile("" : "+s"(v_)); F.vcu = v_; int g_ = (int)gridDim.x; asm volatile("" : "+s"(g_)); F.G = g_; int b_ = (int)blockIdx.x; asm volatile("" : "+s"(b_)); F.bx = b_; }
        const int l = ph == 0 ? 0 : (ph - 1) / 10, k = ph == 0 ? -1 : (ph - 1) % 10, kind = l & 1, j = l >> 1;
        if (k == -1) {
#ifndef NO_P0
            p0_prologue(F);
#endif
        }
        else if (k == 0) norm0_phase(F);
        else if (k == 2) {
#ifndef NO_ATTN
            if (kind == 0) attn_phase(F, j, l == 0 ? 4096 + 128 : 4096);
#endif
#ifndef NO_HY
            if (kind == 1) hyena_phase(F, j, l == 1);
#endif
        }
#ifndef NO_TR
        else if (k == 3) transpose_phase(F, rows_of_layer(l));
#endif
#ifndef NO_ROUTER
        else if (k == 5) router_phase(F, l);
#endif
#ifndef NO_GATHER
        else if (k == 6) index_phase(F, l);
#endif
#ifndef NO_COMB
        else if (k == 9) combine_phase(F, l, ((PROBE_REP_MASK >> 10) & 1) != 0 && !rep_done);
#endif
        else if (k == 1 || k == 4 || k == 7 || k == 8) {
            pg8::Gemm g; pg8::AnyOrder S; pg8::EpiAny E;
            S.moe = 0; S.rb2e = blkstart + 64; S.nblk = 0; S.lg = 0; S.wbase = l * 32;
            E.bslot = (PG8_LAS float*)(F.lds + USER_OFF); E.ldc = TT; E.O = nullptr; E.f0 = nullptr; E.f1 = nullptr; E.p0 = nullptr; E.p1 = nullptr; E.p2 = nullptr; E.p3 = nullptr;
            if (k == 1 && kind == 0) {
                g = pg8::Gemm{(const bf16*)(F.ws + WS_H), (const bf16*)(F.ws + WS_WQK) + (size_t)j * QKD * 1024, TT, QKD, D}; S.so.init(TT, QKD, F.G, F.bx);
                E.mode = pg8::EPI_QK; E.O = (bf16*)(F.ws + WS_QK); E.p0 = F.in[I_ABQKV] + (size_t)j * 1536; E.p1 = (const float*)(F.ws + WS_ROPE);
            } else if (k == 1) {
                g = pg8::Gemm{(const bf16*)(F.ws + WS_WHIN) + (size_t)j * 3072 * 1024, (const bf16*)(F.ws + WS_H), 3072, rows_of_layer(l), D}; S.so.init(3072, rows_of_layer(l), F.G, F.bx);
                E.mode = pg8::EPI_T; E.O = (bf16*)(F.ws + WS_UT); E.p0 = F.in[I_HBIN] + (size_t)j * 3072;
            } else if (k == 4) {
                g = pg8::Gemm{(const bf16*)(F.ws + WS_O), kind == 0 ? (const bf16*)(F.ws + WS_WAO) + (size_t)j * 1024 * 1024 : (const bf16*)(F.ws + WS_WHO) + (size_t)j * 1024 * 1024, rows_of_layer(l), D, D};
                S.so.init(rows_of_layer(l), D, F.G, F.bx);
                E.mode = pg8::EPI_RES; E.p0 = l == 0 ? F.in[I_X] : nullptr; E.p1 = l == 0 ? F.in[I_CTX] : nullptr; E.O = (bf16*)(F.ws + WS_XB);
                E.p2 = kind == 0 ? F.in[I_ABO] + (size_t)j * 1024 : F.in[I_HBO] + (size_t)j * 1024; E.p3 = (const float*)(F.ws + WS_MOD) + (size_t)l * 9 * 6144 + 2 * 1024;
            } else {
                load_blkstart(F, l, blkstart);
                S.moe = 1; S.nblk = blkstart[32]; S.so.G = F.G; S.so.c = F.bx; S.so.nM = 0; S.so.nN = 0; S.so.nwg = 0;
                if (k == 7) { g = pg8::Gemm{(const bf16*)(F.ws + WS_H), (const bf16*)(F.ws + WS_WGU), MAXROWS, 2048, D, (const int*)(F.ws + WS_RSRC)}; S.lg = 3; E.mode = pg8::EPI_SWIGLU; E.O = (bf16*)(F.ws + WS_ACT); E.p0 = F.in[I_BGU] + (size_t)l * 32 * 2048; }
                else { g = pg8::Gemm{(const bf16*)(F.ws + WS_ACT), (const bf16*)(F.ws + WS_WDN), MAXROWS, 1024, D}; S.lg = 2; E.mode = pg8::EPI_DOWN; E.O = (bf16*)(F.ws + WS_YS); E.p0 = F.in[I_BDN] + (size_t)l * 32 * 1024; }
            }
#ifndef NO_G1
            pg8::gemm_phase<pg8::EpiAny, pg8::AnyOrder, PG8_ALIGN_EPI, PG8_SP2>(F.lds + RING_OFF, g, S, E);
#endif
        }
        if (use_bar && ph != N_PHASES - 1) xcd_barrier(bar);
#ifdef PROBE_DOUBLE_BAR
        if (use_bar && ph != N_PHASES - 1) xcd_barrier(bar);
#endif
        if (PROBE_REP_MASK != 0) { if (((PROBE_REP_MASK >> (k + 1)) & 1) && (PROBE_REP_KIND == 2 || kind == PROBE_REP_KIND) && !rep_done) { rep_done = 1; --ph;
                if (k == 5) { if (F.bx == 0 && F.tid < 32) __hip_atomic_store((unsigned*)(F.ctl + CW_ECNT + l * 32 + F.tid), 0u, RLX_AGENT); xcd_barrier(bar); }
            } else rep_done = 0; }
    }
}

extern "C" void kernel_launch(void* const* d_in, const int* in_sizes, int n_in, void* d_out, int out_size, void* d_ws, size_t ws_size, hipStream_t stream) {
    static int grid = 0;
    if (grid == 0) {
        if (n_in != N_IN || out_size != TL * D || ws_size < WS_END) { fprintf(stderr, "kernel_launch: unexpected shapes (n_in %d, out %d, ws %zu < %zu)\n", n_in, out_size, ws_size, (size_t)WS_END); grid = -1; return; }
        if (hipFuncSetAttribute((const void*)fwd_kernel, hipFuncAttributeMaxDynamicSharedMemorySize, LDS_BYTES) != hipSuccess) { fprintf(stderr, "kernel_launch: hipFuncSetAttribute failed\n"); grid = -1; return; }
        int per_cu = 0;
        if (hipOccupancyMaxActiveBlocksPerMultiprocessor(&per_cu, (const void*)fwd_kernel, NWAVES * 64, LDS_BYTES) != hipSuccess || per_cu < 1) fprintf(stderr, "kernel_launch: occupancy query says %d\n", per_cu);
        (void)hipGetLastError();
        grid = 256;
    }
    if (grid < 0) return;
    if (hipMemsetAsync((char*)d_ws + WS_CTL, 0, CTL_ZERO_BYTES, stream) != hipSuccess) return;
    Args a{};
    for (int i = 0; i < N_IN; ++i) a.in[i] = (const float*)d_in[i];
    a.out = (float*)d_out; a.ws = (unsigned char*)d_ws; a.pad = 0;
#if MK_ONE_LAUNCH
    a.ph_lo = 0; a.ph_hi = N_PHASES; a.use_bar = 1;
    hipLaunchKernelGGL(fwd_kernel, dim3(grid), dim3(NWAVES * 64), LDS_BYTES, stream, a);
#else
    for (int ph = 0; ph < N_PHASES; ++ph) {
        if (!phase_exists(ph)) continue;
        a.ph_lo = ph; a.ph_hi = ph + 1; a.use_bar = 0;
        hipLaunchKernelGGL(fwd_kernel, dim3(grid), dim3(NWAVES * 64), LDS_BYTES, stream, a);
    }
#endif
}
```

```cpp
#include <hip/hip_runtime.h>
#include <cstdio>
#include <cstdint>
#include <cmath>
#define MK_ONE_LAUNCH 1
namespace pg8 {
#define PG8_LAS __attribute__((address_space(3)))
typedef unsigned short bf16_t;
typedef short bf16x8 __attribute__((ext_vector_type(8)));
typedef float f32x4 __attribute__((ext_vector_type(4)));
typedef unsigned u32x4 __attribute__((ext_vector_type(4)));
constexpr int BM = 256, BK = 64, HALF = 128, HTB = HALF * BK * 2  , STAGE_BYTES = 8 * HTB, NXCD = 8, WGM = 8;

__host__ __device__ __forceinline__ int lds_byte(int r, int c) { const int st = (r >> 4) * 2 + (c >> 5), rr = r & 15, cc = c & 31, ob = rr * 64 + cc * 2; return st * 1024 + (ob ^ (((ob >> 9) & 1) << 5)); }
__host__ __device__ __forceinline__ void stage_rc(int b, int& R, int& C) { const int st = b / 1024, sb = b % 1024, swz = sb ^ (((sb >> 9) & 1) << 5); R = (st >> 1) * 16 + swz / 64; C = (st & 1) * 32 + (swz % 64) / 2; }
__host__ __device__ __forceinline__ int perm32(int rho) { const int n = rho >> 4, i = rho & 15; return 8 * (i >> 2) + 4 * n + (i & 3); }

struct Unit { int pm, pn, pb; };
struct Gemm { const bf16_t* A; const bf16_t* Bt; int M, N, K; const int* rows; };
struct StaticOrder {
    int nM, nN, nwg, G, c;
    __host__ __device__ void init(int M, int N, int G_, int c_) { nM = M / BM; nN = N / BM; nwg = nM * nN; G = G_; c = c_; }
    __host__ __device__ bool next(int i, Unit& u) const {
        const long L = (long)i * G + c; if (L >= nwg) return false;
        int wgid = (int)L; { const int q = nwg / NXCD, r = nwg % NXCD, xcd = wgid % NXCD, off = wgid / NXCD; wgid = (xcd < r ? xcd * (q + 1) : r * (q + 1) + (xcd - r) * q) + off; }
        const int nig = WGM * nN, gid = wgid / nig, fm = gid * WGM, gsz = (nM - fm) < WGM ? (nM - fm) : WGM;
        u.pm = fm + ((wgid % nig) % gsz); u.pn = (wgid % nig) / gsz; u.pb = u.pn; return true;
    }
    __device__ __forceinline__ void a_ready(const Unit&) const {}
    __device__ __forceinline__ void done(const Unit&) const {}
};
__device__ __forceinline__ unsigned cvt_pk_bf16(float lo, float hi) { unsigned r; asm volatile("v_cvt_pk_bf16_f32 %0, %1, %2" : "=v"(r) : "v"(lo), "v"(hi)); return r; }
typedef float f32x2 __attribute__((ext_vector_type(2)));
#define PG8_STR2(x) #x
#define PG8_STR(x) PG8_STR2(x)
template <class Epi, class Sched, bool ALIGN_EPI = false, bool SP2 = false>
__device__ __forceinline__ void gemm_phase(PG8_LAS unsigned char* lds, const Gemm g, const Sched& S, const Epi& E) {
    int tid_ = threadIdx.x; asm volatile("" : "+v"(tid_));
    const int tid = tid_, wid = __builtin_amdgcn_readfirstlane(tid >> 6), lane = tid & 63, wr = wid >> 2, wc = wid & 3, fr = lane & 15, fq = lane >> 4;
    const int K = g.K, nt = K / BK;
    unsigned roffA[4], voffB[2];
#pragma unroll
    for (int i = 0; i < 2; ++i) { int R, C; stage_rc(tid * 16 + i * 8192, R, C); const int Rb = Epi::PERM ? ((R & ~31) + perm32(R & 31)) : R;
        roffA[i] = (unsigned)(R * K + C) * 2u; roffA[2 + i] = (unsigned)((R + HALF) * K + C) * 2u; voffB[i] = (unsigned)(Rb * K + C) * 2u; }
    const size_t kstep = (size_t)(BK * 2);
    const size_t hstep = (size_t)HALF * K * 2;
    const size_t tstep = 2 * hstep;
    const unsigned ldsw = (unsigned)wid * 1024u;
    const int aoff = lds_byte(wr * 64 + fr, fq * 8), boff = lds_byte(wc * 32 + fr, fq * 8);
#define PG8_SA(b, h) (((b) * 2 + (h)) * HTB)
#define PG8_SB(b, h) ((4 + (b) * 2 + (h)) * HTB)
#define PG8_STAGE(bufoff, gbase, voff) do { _Pragma("unroll") for (int _i = 0; _i < 2; ++_i) \
        __builtin_amdgcn_global_load_lds((const unsigned*)((const char*)(gbase) + (voff)[_i]), (PG8_LAS unsigned*)(lds + (bufoff) + ldsw + _i * 8192), 16, 0, 0); } while (0)
#define PG8_STAGEA(bufoff, gbase, h) do { _Pragma("unroll") for (int _i = 0; _i < 2; ++_i) \
        __builtin_amdgcn_global_load_lds((const unsigned*)((const char*)(gbase) + roffA[2 * (h) + _i]), (PG8_LAS unsigned*)(lds + (bufoff) + ldsw + _i * 8192), 16, 0, 0); } while (0)
#define PG8_LDA(dst, b, h) do { _Pragma("unroll") for (int m = 0; m < 4; ++m) _Pragma("unroll") for (int k = 0; k < 2; ++k) dst[m][k] = *(const PG8_LAS bf16x8*)(lds + PG8_SA(b, h) + aoff + m * 2048 + k * 1024); } while (0)
#define PG8_LDB(dst, b, h) do { _Pragma("unroll") for (int n = 0; n < 2; ++n) _Pragma("unroll") for (int k = 0; k < 2; ++k) dst[n][k] = *(const PG8_LAS bf16x8*)(lds + PG8_SB(b, h) + boff + n * 2048 + k * 1024); } while (0)
#define PG8_MMA(ai, bj, At, Bt) do { __builtin_amdgcn_s_setprio(1); _Pragma("unroll") for (int m = 0; m < 4; ++m) _Pragma("unroll") for (int n = 0; n < 2; ++n) _Pragma("unroll") for (int k = 0; k < 2; ++k) \
        acc[ai][bj][m][n] = __builtin_amdgcn_mfma_f32_16x16x32_bf16(Bt[n][k], At[m][k], acc[ai][bj][m][n], 0, 0, 0); __builtin_amdgcn_s_setprio(0); } while (0)
#define PG8_WAIT_V(n) asm volatile("s_waitcnt vmcnt(" #n ")" ::: "memory")
#define PG8_WAIT_L(n) asm volatile("s_waitcnt lgkmcnt(" #n ")" ::: "memory")
#define PG8_BAR __builtin_amdgcn_s_barrier()
#define PG8_SCHED __builtin_amdgcn_sched_barrier(0)
    Unit cur, nxt; int ui = 0;
    if (!S.next(0, cur)) return;
    f32x4 acc[2][2][4][2];
#define PG8_ACC_INIT() do { if (E.mode >= 3) { const PG8_LAS float* bs_ = E.bslot + wid * 64 + 8 * fq; \
            const f32x4 b00_ = *(const PG8_LAS f32x4*)bs_, b01_ = *(const PG8_LAS f32x4*)(bs_ + 4), b10_ = *(const PG8_LAS f32x4*)(bs_ + 32), b11_ = *(const PG8_LAS f32x4*)(bs_ + 36); \
            _Pragma("unroll") for (int a = 0; a < 2; ++a) _Pragma("unroll") for (int m = 0; m < 4; ++m) { acc[a][0][m][0] = b00_; acc[a][0][m][1] = b01_; acc[a][1][m][0] = b10_; acc[a][1][m][1] = b11_; } \
        } else { _Pragma("unroll") for (int a = 0; a < 2; ++a) _Pragma("unroll") for (int b = 0; b < 2; ++b) _Pragma("unroll") for (int m = 0; m < 4; ++m) _Pragma("unroll") for (int n = 0; n < 2; ++n) acc[a][b][m][n] = (f32x4){0.f, 0.f, 0.f, 0.f}; } } while (0)
    if (E.mode >= 3) { __builtin_amdgcn_global_load_lds((const unsigned*)E.bias_src(cur, wc, lane), (PG8_LAS unsigned*)(E.bslot + wid * 64), 4, 0, 0); PG8_WAIT_V(0); }
    PG8_ACC_INIT();
    bf16x8 At[4][2], B0[2][2], B1[2][2];
    const __attribute__((address_space(1))) int* const rows = (const __attribute__((address_space(1))) int*)g.rows; const int r0g = (wid >> 1) * 16 + (lane >> 2); const unsigned cb2g = roffA[0] - (unsigned)(r0g * K) * 2u;
#define PG8_ROWS(dst, pm_) do { _Pragma("unroll") for (int _j = 0; _j < 4; ++_j) dst[_j] = (unsigned)rows[(size_t)(pm_) * BM + r0g + 64 * _j] * (unsigned)(K * 2) + cb2g; } while (0)
    if (rows) { unsigned t4[4]; PG8_ROWS(t4, cur.pm); roffA[0] = t4[0]; roffA[1] = t4[1]; roffA[2] = t4[2]; roffA[3] = t4[3]; }
    const char* cA = rows ? (const char*)g.A : (const char*)g.A + (size_t)cur.pm * tstep; const char* cB = (const char*)g.Bt + (size_t)cur.pb * tstep;
    S.a_ready(cur);
    if constexpr (SP2) {
        PG8_STAGE(PG8_SB(0, 0), cB, voffB); PG8_STAGE(PG8_SB(0, 1), cB + hstep, voffB); PG8_STAGEA(PG8_SA(0, 0), cA, 0); PG8_STAGEA(PG8_SA(0, 1), cA, 1);
        if (wr == 1) PG8_BAR;
        PG8_WAIT_V(2); PG8_BAR;
        PG8_STAGE(PG8_SB(1, 0), cB + kstep, voffB); PG8_STAGEA(PG8_SA(1, 0), cA + kstep, 0); PG8_STAGE(PG8_SB(1, 1), cB + hstep + kstep, voffB);
        PG8_WAIT_V(6); PG8_BAR;
    } else {
        PG8_STAGE(PG8_SB(0, 0), cB, voffB); PG8_STAGEA(PG8_SA(0, 0), cA, 0); PG8_STAGE(PG8_SB(0, 1), cB + hstep, voffB); PG8_STAGEA(PG8_SA(0, 1), cA, 1);
        if (wr == 1) PG8_BAR;
        PG8_WAIT_V(4); PG8_BAR;
        PG8_STAGE(PG8_SB(1, 0), cB + kstep, voffB); PG8_STAGEA(PG8_SA(1, 0), cA + kstep, 0); PG8_STAGE(PG8_SB(1, 1), cB + hstep + kstep, voffB);
        PG8_WAIT_V(6); PG8_BAR;
    }
    unsigned nr4[4] = {0u, 0u, 0u, 0u};
    for (;;) {
        const bool has_next = S.next(ui + 1, nxt);
        const char* nA = (has_next && !rows) ? (const char*)g.A + (size_t)nxt.pm * tstep : cA; const char* nB = has_next ? (const char*)g.Bt + (size_t)nxt.pb * tstep : cB;
#ifdef PG8_LOOP_ALIGN
        asm volatile(".p2align " PG8_STR(PG8_LOOP_ALIGN));
#endif
        for (int t = 0; t < nt; t += 2) {
            const bool last = (t == nt - 2);
            const char* a1 = cA + (size_t)(t + 1) * kstep;
            const char* a2 = last ? nA : cA + (size_t)(t + 2) * kstep; const char* b2 = last ? nB : cB + (size_t)(t + 2) * kstep;
            const char* a3 = a2 + kstep; const char* b3 = b2 + kstep;
            if (last && has_next) S.a_ready(nxt);
            const bool swap_rows = rows != nullptr && last && has_next;
            if (E.mode >= 3 && has_next && t == nt - 4)
                __builtin_amdgcn_global_load_lds((const unsigned*)E.bias_src(nxt, wc, lane), (PG8_LAS unsigned*)(E.bslot + wid * 64), 4, 0, 0);
            if (rows != nullptr && has_next && t == nt - 4) {
                const __attribute__((address_space(1))) int* rp = rows + (size_t)nxt.pm * BM + r0g;
                asm volatile("global_load_dword %0, %4, off\n\tglobal_load_dword %1, %4, off offset:256\n\tglobal_load_dword %2, %4, off offset:512\n\tglobal_load_dword %3, %4, off offset:768"
                             : "=&v"(nr4[0]), "=&v"(nr4[1]), "=&v"(nr4[2]), "=&v"(nr4[3]) : "v"(rp) : "memory"); }
            if constexpr (SP2) {
            PG8_LDB(B0, 0, 0); PG8_LDB(B1, 0, 1); PG8_SCHED; PG8_LDA(At, 0, 0); PG8_STAGEA(PG8_SA(1, 1), a1, 1);
            if (swap_rows) {
#pragma unroll
                for (int _j = 0; _j < 4; ++_j) roffA[_j] = nr4[_j] * (unsigned)(K * 2) + cb2g; }
            PG8_WAIT_V(8); PG8_WAIT_L(0); PG8_BAR; PG8_MMA(0, 0, At, B0); PG8_MMA(0, 1, At, B1); PG8_BAR; PG8_SCHED;
            PG8_LDA(At, 0, 1); PG8_STAGE(PG8_SB(0, 0), b2, voffB); PG8_STAGE(PG8_SB(0, 1), b2 + hstep, voffB); PG8_STAGEA(PG8_SA(0, 0), a2, 0);
            PG8_WAIT_V(8); PG8_WAIT_L(0); PG8_BAR; PG8_MMA(1, 0, At, B0); PG8_MMA(1, 1, At, B1); PG8_BAR; PG8_SCHED;
            PG8_LDB(B0, 1, 0); PG8_LDB(B1, 1, 1); PG8_SCHED; PG8_LDA(At, 1, 0); PG8_STAGEA(PG8_SA(0, 1), a2, 1);
            PG8_WAIT_V(8); PG8_WAIT_L(0); PG8_BAR; PG8_MMA(0, 0, At, B0); PG8_MMA(0, 1, At, B1); PG8_BAR; PG8_SCHED;
            PG8_LDA(At, 1, 1); PG8_STAGE(PG8_SB(1, 0), b3, voffB); PG8_STAGE(PG8_SB(1, 1), b3 + hstep, voffB); PG8_STAGEA(PG8_SA(1, 0), a3, 0);
            PG8_WAIT_V(8); PG8_WAIT_L(0); PG8_BAR; PG8_MMA(1, 0, At, B0); PG8_MMA(1, 1, At, B1); PG8_BAR; PG8_SCHED;
            } else {
            PG8_LDB(B0, 0, 0); PG8_SCHED; PG8_LDA(At, 0, 0); PG8_STAGEA(PG8_SA(1, 1), a1, 1);
            if (swap_rows) {
#pragma unroll
                for (int _j = 0; _j < 4; ++_j) roffA[_j] = nr4[_j] * (unsigned)(K * 2) + cb2g; }
            PG8_WAIT_L(8); PG8_BAR; PG8_WAIT_L(0); PG8_MMA(0, 0, At, B0); PG8_BAR; PG8_SCHED;
            PG8_LDB(B1, 0, 1); PG8_STAGE(PG8_SB(0, 0), b2, voffB);
            PG8_BAR; PG8_WAIT_L(0); PG8_MMA(0, 1, At, B1); PG8_BAR;
            PG8_LDA(At, 0, 1); PG8_STAGEA(PG8_SA(0, 0), a2, 0);
            PG8_BAR; PG8_WAIT_L(0); PG8_MMA(1, 0, At, B0); PG8_BAR; PG8_SCHED;
            PG8_STAGE(PG8_SB(0, 1), b2 + hstep, voffB);
            PG8_WAIT_V(6); PG8_BAR; PG8_MMA(1, 1, At, B1); PG8_BAR;
            PG8_LDB(B0, 1, 0); PG8_SCHED; PG8_LDA(At, 1, 0); PG8_STAGEA(PG8_SA(0, 1), a2, 1);
            PG8_WAIT_L(8); PG8_BAR; PG8_WAIT_L(0); PG8_MMA(0, 0, At, B0); PG8_BAR; PG8_SCHED;
            PG8_LDB(B1, 1, 1); PG8_STAGE(PG8_SB(1, 0), b3, voffB);
            PG8_BAR; PG8_WAIT_L(0); PG8_MMA(0, 1, At, B1); PG8_BAR;
            PG8_LDA(At, 1, 1); PG8_STAGEA(PG8_SA(1, 0), a3, 0);
            PG8_BAR; PG8_WAIT_L(0); PG8_MMA(1, 0, At, B0); PG8_BAR; PG8_SCHED;
            PG8_STAGE(PG8_SB(1, 1), b3 + hstep, voffB);
            PG8_WAIT_V(6); PG8_BAR; PG8_MMA(1, 1, At, B1); PG8_BAR;
            }
        }
        if constexpr (ALIGN_EPI) { if (wr == 0) PG8_BAR; }
        if constexpr (!Epi::AFTER_DRAIN) { E(acc, cur, wr, wc, fr, fq); S.done(cur); }
        if (!has_next) break;
        PG8_ACC_INIT();
        cur = nxt; cA = nA; cB = nB; ++ui;
        if constexpr (ALIGN_EPI) { if (wr == 1) PG8_BAR; }
    }
    PG8_WAIT_V(0);
    if constexpr (!ALIGN_EPI) { if (wr == 0) PG8_BAR; }
    PG8_BAR;
    if constexpr (Epi::AFTER_DRAIN) { E.fused(acc, cur, wr, wc, fr, fq, lds, wid, lane); S.done(cur); }
#undef PG8_ACC_INIT
#undef PG8_SA
#undef PG8_SB
#undef PG8_STAGE
#undef PG8_STAGEA
#undef PG8_ROWS
#undef PG8_LDA
#undef PG8_LDB
#undef PG8_MMA
#undef PG8_WAIT_V
#undef PG8_WAIT_L
#undef PG8_BAR
#undef PG8_SCHED
}
}
constexpr int NWAVES = 8;
constexpr int D = 1024, NBATCH = 8, SEQ = 8192, CTXL = 256, DEPTH = 4;
constexpr int TL = NBATCH * SEQ;
constexpr int TC = NBATCH * CTXL;
constexpr int TT = TL + TC;
constexpr int QKD = 1536, NE = 32;
constexpr int MAXBLK = 1088, MAXROWS = MAXBLK * 256;
constexpr float NORM_EPS = 1e-6f;
constexpr int N_IN = 35;
enum { I_X = 0, I_C, I_CTX, I_CCTX, I_ADAW, I_ADAB, I_NMIX, I_NFFN, I_AWQKV, I_ABQKV, I_AWO, I_ABO, I_ASINK, I_HWIN, I_HBIN, I_HCW, I_HCB,
       I_FW1, I_FB1, I_FW2, I_FB2, I_FW3, I_FB3, I_FFREQ, I_FWOUT, I_HBD, I_HWO, I_HBO, I_RW, I_RB, I_WGU, I_BGU, I_WDN, I_BDN, I_FNORM };

constexpr size_t MiB = 1u << 20;
constexpr size_t WS_CTL = 0, CTL_ZERO_BYTES = 1 * MiB;
constexpr size_t WS_MOD = 1 * MiB;
constexpr size_t WS_ROPE = 2 * MiB;
constexpr size_t WS_A3L = 4 * MiB;
constexpr size_t WS_A3C = 8 * MiB;
constexpr size_t WS_WQK = 9 * MiB;
constexpr size_t WS_WAO = 15 * MiB;
constexpr size_t WS_WHIN = 19 * MiB;
constexpr size_t WS_WHO = 31 * MiB;
constexpr size_t WS_WGU = 35 * MiB;
constexpr size_t WS_WDN = 547 * MiB;
constexpr size_t WS_XC = 803 * MiB;
constexpr size_t WS_H = 811 * MiB;
constexpr size_t WS_POS = 943 * MiB;
constexpr size_t WS_GATE = 945 * MiB;
constexpr size_t WS_DEST = 947 * MiB;
constexpr size_t WS_BIG = 949 * MiB;
constexpr size_t WS_QK = WS_BIG, WS_UT = WS_BIG, WS_YS = WS_BIG;
constexpr size_t WS_O = WS_BIG + 396 * MiB;
constexpr size_t WS_B2 = WS_BIG + 544 * MiB;
constexpr size_t WS_ZT = WS_B2, WS_G = WS_B2 + 132 * MiB, WS_TP = WS_B2 + 388 * MiB  , WS_ACT = WS_B2;
constexpr size_t WS_XB = WS_B2 + 544 * MiB;
constexpr size_t WS_RSRC = WS_XB + 132 * MiB;
constexpr size_t WS_END = WS_RSRC + 2 * MiB;
static_assert(WS_O + (size_t)TT * D * 2 <= WS_B2 && (size_t)MAXROWS * D * 2 <= 544 * MiB && (size_t)3072 * TT * 2 <= 396 * MiB, "ws map");
static_assert(WS_QK + (size_t)TT * QKD * 2 <= WS_O, "ws map 2");
constexpr int CW_BAR = 4096;
constexpr int CW_ECNT = 16384;

constexpr int RING_OFF = 0, RING_BYTES = 131072;
constexpr int LDSCTL_OFF = RING_BYTES, MISC_OFF = LDSCTL_OFF + 320, USER_OFF = RING_BYTES + 512;
constexpr int LDS_BYTES = 147456;

#define GAS __attribute__((address_space(1)))
#define LAS __attribute__((address_space(3)))
#define KAS __attribute__((address_space(4)))
typedef unsigned short bf16;
typedef unsigned v4u __attribute__((ext_vector_type(4)));
typedef unsigned v2u __attribute__((ext_vector_type(2)));
typedef int v4i __attribute__((ext_vector_type(4)));
typedef float f32x4 __attribute__((ext_vector_type(4)));
typedef float f32x16 __attribute__((ext_vector_type(16)));
typedef short bf16x8 __attribute__((ext_vector_type(8)));
typedef GAS unsigned gu32;
#define RLX_AGENT __ATOMIC_RELAXED, __HIP_MEMORY_SCOPE_AGENT
#define LDS_WAIT() asm volatile("s_waitcnt lgkmcnt(0)" ::: "memory")
#define VM_WAIT() asm volatile("s_waitcnt vmcnt(0)" ::: "memory")
__device__ __forceinline__ unsigned f2bf(float f) { unsigned u = __builtin_bit_cast(unsigned, f); return (u + 0x7fffu + ((u >> 16) & 1u)) >> 16; }
__device__ __forceinline__ unsigned pk2(float lo, float hi) { return f2bf(lo) | (f2bf(hi) << 16); }
__device__ __forceinline__ float bf2f(unsigned short b) { return __builtin_bit_cast(float, ((unsigned)b) << 16); }
__device__ __forceinline__ float bflo(unsigned w) { return __builtin_bit_cast(float, w << 16); }
__device__ __forceinline__ float bfhi(unsigned w) { return __builtin_bit_cast(float, w & 0xffff0000u); }
#define XB_TMO      128
#define XB_XCNT(j)  (256  + 64 * (j))
#define XB_XSUB(j)  (1280 + 64 * (j))
#define XB_XGEN(j)  (2304 + 64 * (j))
#define XB_TOP      3328
#define XB_TOPGEN   3392
#define XCD_BAR_WORDS 3456
#define XB_SPIN_CAP (1u << 21)

__device__ __forceinline__ unsigned xb_ld(unsigned* p)              { return __hip_atomic_load(p, __ATOMIC_RELAXED, __HIP_MEMORY_SCOPE_AGENT); }
__device__ __forceinline__ unsigned xb_add(unsigned* p, unsigned v) { return __hip_atomic_fetch_add(p, v, __ATOMIC_RELAXED, __HIP_MEMORY_SCOPE_AGENT); }
__device__ __forceinline__ unsigned xb_xcc_id() { return (unsigned)__builtin_amdgcn_s_getreg((3 << 11) | 20) & 0xFu; }
#define XB_SPIN(cond, bar) do { unsigned _sp = 0; while (cond) { __builtin_amdgcn_s_sleep(1); \
    if ((++_sp & 255u) == 0u) { if (xb_ld(&(bar)[XB_TMO])) break; if (_sp > XB_SPIN_CAP) { atomicAdd(&(bar)[XB_TMO], 1u); break; } } } } while (0)

struct XcdBarrier {
    unsigned* bar; unsigned x;
    volatile LAS unsigned* st;
};

__device__ __forceinline__ XcdBarrier xcd_barrier_post(unsigned* bar, volatile LAS unsigned* st) {
    XcdBarrier b; b.bar = bar; b.x = xb_xcc_id(); b.st = st;
    if (threadIdx.x == 0) (void)xb_add(&bar[XB_XCNT(b.x)], 1u);
    return b;
}
__device__ __forceinline__ void xcd_barrier_complete(unsigned* bar, unsigned x, unsigned& nloc, unsigned& nx) {
    const unsigned G = gridDim.x * gridDim.y * gridDim.z;
    unsigned sum, cnt, mine, sp = 0u;
    for (;;) {
        sum = 0u; cnt = 0u; mine = 0u;
#pragma unroll
        for (unsigned j = 0; j < 16; ++j) { const unsigned c = xb_ld(&bar[XB_XCNT(j)]); sum += c; cnt += (c > 0u) ? 1u : 0u; mine = (j == x) ? c : mine; }
        if (sum == G) break;
        __builtin_amdgcn_s_sleep(1);
        if ((++sp & 255u) == 0u) { if (xb_ld(&bar[XB_TMO])) break; if (sp > XB_SPIN_CAP) { atomicAdd(&bar[XB_TMO], 1u); break; } }
    }
    nloc = mine > 0u ? mine : 1u; nx = cnt > 0u ? cnt : 1u;
}

__device__ __forceinline__ void xcd_barrier(const XcdBarrier& b) {
    asm volatile("s_waitcnt vmcnt(0)" ::: "memory");
    __syncthreads();
    if (threadIdx.x == 0) {
        unsigned* bar = b.bar;
        __builtin_amdgcn_s_waitcnt(0);
        unsigned nloc = b.st[0], nx = b.st[1];
        if (nloc == 0u) { xcd_barrier_complete(bar, b.x, nloc, nx); b.st[0] = nloc; b.st[1] = nx; }
        const unsigned old = xb_add(&bar[XB_XSUB(b.x)], 1u);
        const unsigned gen = old / nloc;
        if (old + 1u == (gen + 1u) * nloc) {
            __builtin_amdgcn_fence(__ATOMIC_RELEASE, "agent");
            asm volatile("s_waitcnt vmcnt(0)" ::: "memory");
            const unsigned og = xb_add(&bar[XB_TOP], 1u);
            const unsigned tg = og / nx;
            if (og + 1u == (tg + 1u) * nx) xb_add(&bar[XB_TOPGEN], 1u);
            else XB_SPIN(xb_ld(&bar[XB_TOPGEN]) == tg, bar);
            __builtin_amdgcn_fence(__ATOMIC_ACQUIRE, "agent");
            xb_add(&bar[XB_XGEN(b.x)], 1u);
            asm volatile("s_waitcnt vmcnt(0)" ::: "memory");
        } else {
            XB_SPIN(xb_ld(&bar[XB_XGEN(b.x)]) == gen, bar);
            __builtin_amdgcn_fence(__ATOMIC_ACQUIRE, "agent");
            asm volatile("s_waitcnt vmcnt(0)" ::: "memory");
        }
    }
    __syncthreads();
}
#ifndef FFT_HOST_TEST
#define FFT_DEV __device__ __forceinline__
#define FFT_LAUNDER(t) asm volatile("" : "+v"(t))
#else
#define FFT_DEV inline
#define FFT_LAUNDER(t) (void)0
#endif
#ifndef FFT_HOST_TEST
#define FFT_FENCE() do { asm volatile("" ::: "memory"); __builtin_amdgcn_sched_barrier(0); } while (0)
#else
#define FFT_FENCE() (void)0
#endif
typedef float cf2 __attribute__((ext_vector_type(2)));
typedef float cf4 __attribute__((ext_vector_type(4)));
constexpr int FFT_N = 16384, FFT_THREADS = 512;
FFT_DEV void fft_cs(float frac, float& c, float& s) {
#ifndef FFT_HOST_TEST
    c = __builtin_amdgcn_cosf(frac); s = __builtin_amdgcn_sinf(frac);
#else
    c = (float)cos(6.283185307179586 * (double)frac); s = (float)sin(6.283185307179586 * (double)frac);
#endif
}
FFT_DEV cf2 cmulf(cf2 a, float c, float s) { cf2 r; r.x = a.x * c - a.y * s; r.y = a.x * s + a.y * c; return r; }
FFT_DEV int fft_swz(int e) { return e ^ (((e >> 5) & 7) << 1); }
FFT_DEV cf2 cmul2(cf2 a, cf2 b) { const cf2 axx = {a.x, a.x}, ayy = {a.y, a.y}, bs = {-b.y, b.x}; return ayy * bs + axx * b; }
FFT_DEV cf2 cmulc(cf2 a, cf2 b) { const cf2 axx = {a.x, a.x}, ayy = {a.y, a.y}, bs = {b.y, b.x}, bn = {b.x, -b.y}; return ayy * bs + axx * bn; }
FFT_DEV cf2 tw32(int j) {
    constexpr float C[9] = {1.0f, 0.98078528040323044913f, 0.92387953251128675613f, 0.83146961230254523708f, 0.70710678118654752440f, 0.55557023301960222474f, 0.38268343236508977173f, 0.19509032201612826785f, 0.0f};
    const int q = (j >> 3) & 3, r = j & 7; float c, sn;
    if (q == 0) { c = C[r]; sn = C[8 - r]; } else if (q == 1) { c = -C[8 - r]; sn = C[r]; } else if (q == 2) { c = -C[r]; sn = -C[8 - r]; } else { c = C[8 - r]; sn = -C[r]; }
    cf2 w; w.x = c; w.y = -sn; return w;
}
template <bool TW> FFT_DEV void bfly_fwd_w(cf2& a0, cf2& a1, cf2& a2, cf2& a3, cf2 w1, cf2 w2, cf2 w3) {
    const cf2 t0 = a0 + a2, t1 = a0 - a2, t2 = a1 + a3, t3 = a1 - a3;
    cf2 y0 = t0 + t2, y2 = t0 - t2, y1, y3;
    y1.x = t1.x + t3.y; y1.y = t1.y - t3.x;
    y3.x = t1.x - t3.y; y3.y = t1.y + t3.x;
    if (TW) { y1 = cmul2(y1, w1); y2 = cmul2(y2, w2); y3 = cmul2(y3, w3); }
    a0 = y0; a1 = y1; a2 = y2; a3 = y3;
}
template <bool TW> FFT_DEV void bfly_inv_w(cf2& a0, cf2& a1, cf2& a2, cf2& a3, cf2 w1, cf2 w2, cf2 w3) {
    if (TW) { a1 = cmulc(a1, w1); a2 = cmulc(a2, w2); a3 = cmulc(a3, w3); }
    const cf2 t0 = a0 + a2, t1 = a0 - a2, t2 = a1 + a3, t3 = a1 - a3;
    cf2 y0 = t0 + t2, y2 = t0 - t2, y1, y3;
    y1.x = t1.x - t3.y; y1.y = t1.y + t3.x;
    y3.x = t1.x + t3.y; y3.y = t1.y - t3.x;
    a0 = y0; a1 = y1; a2 = y2; a3 = y3;
}
FFT_DEV cf2 fft_w(float frac) { float c, sn; fft_cs(frac, c, sn); cf2 w; w.x = c; w.y = -sn; return w; }
template <bool TW> FFT_DEV void bfly_fwd(cf2& a0, cf2& a1, cf2& a2, cf2& a3, float f) {
    const cf2 t0 = a0 + a2, t1 = a0 - a2, t2 = a1 + a3, t3 = a1 - a3;
    cf2 y0 = t0 + t2, y2 = t0 - t2, y1, y3;
    y1.x = t1.x + t3.y; y1.y = t1.y - t3.x;
    y3.x = t1.x - t3.y; y3.y = t1.y + t3.x;
    if (TW) { float c1, s1, c2, s2, c3, s3; fft_cs(f, c1, s1); fft_cs(2.0f * f, c2, s2); fft_cs(3.0f * f, c3, s3);
        y1 = cmulf(y1, c1, -s1); y2 = cmulf(y2, c2, -s2); y3 = cmulf(y3, c3, -s3); }
    a0 = y0; a1 = y1; a2 = y2; a3 = y3;
}
template <bool TW> FFT_DEV void bfly_inv(cf2& a0, cf2& a1, cf2& a2, cf2& a3, float f) {
    if (TW) { float c1, s1, c2, s2, c3, s3; fft_cs(f, c1, s1); fft_cs(2.0f * f, c2, s2); fft_cs(3.0f * f, c3, s3);
        a1 = cmulf(a1, c1, s1); a2 = cmulf(a2, c2, s2); a3 = cmulf(a3, c3, s3); }
    const cf2 t0 = a0 + a2, t1 = a0 - a2, t2 = a1 + a3, t3 = a1 - a3;
    cf2 y0 = t0 + t2, y2 = t0 - t2, y1, y3;
    y1.x = t1.x - t3.y; y1.y = t1.y + t3.x;
    y3.x = t1.x + t3.y; y3.y = t1.y - t3.x;
    a0 = y0; a1 = y1; a2 = y2; a3 = y3;
}
template <class PT> FFT_DEV void fft_fwd_first(PT X, const float (&za)[16], const float (&zb)[16], int tid) {
    FFT_LAUNDER(tid);
    const cf2 wt1 = fft_w((float)tid * (1.0f / 16384.0f)), wt2 = cmul2(wt1, wt1), wt3 = cmul2(wt2, wt1);
#pragma unroll
    for (int q = 0; q < 8; ++q) {
        const int k = tid + FFT_THREADS * q;
        cf2 a0, a1, a2, a3; a0.x = za[q]; a0.y = zb[q]; a1.x = za[q + 8]; a1.y = zb[q + 8]; a2.x = 0.f; a2.y = 0.f; a3 = a2;
        bfly_fwd_w<true>(a0, a1, a2, a3, cmul2(wt1, tw32(q)), cmul2(wt2, tw32(2 * q)), cmul2(wt3, tw32(3 * q)));
        const int sk = fft_swz(k);
        X[sk] = a0; X[sk + 4096] = a1; X[sk + 8192] = a2; X[sk + 12288] = a3;
        FFT_FENCE();
    }
}
template <class PT, class SP> FFT_DEV void fft_fwd_first_full(PT X, SP src, float scale, int tid) {
    FFT_LAUNDER(tid);
    const cf2 wt1 = fft_w((float)tid * (1.0f / 16384.0f)), wt2 = cmul2(wt1, wt1), wt3 = cmul2(wt2, wt1);
#pragma unroll
    for (int q = 0; q < 8; ++q) {
        const int k = tid + FFT_THREADS * q;
        cf2 a0, a1, a2, a3; a0.x = src[k] * scale; a0.y = 0.f; a1.x = src[k + 4096] * scale; a1.y = 0.f; a2.x = src[k + 8192] * scale; a2.y = 0.f; a3.x = src[k + 12288] * scale; a3.y = 0.f;
        bfly_fwd_w<true>(a0, a1, a2, a3, cmul2(wt1, tw32(q)), cmul2(wt2, tw32(2 * q)), cmul2(wt3, tw32(3 * q)));
        const int sk = fft_swz(k);
        X[sk] = a0; X[sk + 4096] = a1; X[sk + 8192] = a2; X[sk + 12288] = a3;
        if (q & 1) FFT_FENCE();
    }
}
template <class PT, class SP> FFT_DEV void fft_fwd_first_taps(PT X, SP src, float scale, int tid) {
    FFT_LAUNDER(tid);
    const cf2 wt1 = fft_w((float)tid * (1.0f / 16384.0f)), wt2 = cmul2(wt1, wt1), wt3 = cmul2(wt2, wt1);
#pragma unroll
    for (int q = 0; q < 8; ++q) {
        const int k = tid + FFT_THREADS * q;
        cf2 a0, a1, a2, a3; a0.x = src[k] * scale; a0.y = 0.f; a1.x = src[k + 4096] * scale; a1.y = 0.f; a2.x = k == 0 ? 0.f : src[16384 - (k == 0 ? 1 : k)] * scale; a2.y = 0.f; a3.x = src[12288 - k] * scale; a3.y = 0.f;
        bfly_fwd_w<true>(a0, a1, a2, a3, cmul2(wt1, tw32(q)), cmul2(wt2, tw32(2 * q)), cmul2(wt3, tw32(3 * q)));
        const int sk = fft_swz(k);
        X[sk] = a0; X[sk + 4096] = a1; X[sk + 8192] = a2; X[sk + 12288] = a3;
        if (q & 1) FFT_FENCE();
    }
}
template <int S2> FFT_DEV int fft_dbl_idx(int base, int i) {
    if (S2 == 256) return fft_swz(base) + S2 * i;
    if (S2 == 16) return (base ^ ((i >> 1) << 1)) + S2 * i;
    return fft_swz(base + S2 * i);
}
template <int P, class PT> FFT_DEV void fft_fwd_double(PT X, int tid) {
    FFT_LAUNDER(tid);
    constexpr int LS2 = 2 * (5 - P), S2 = 1 << LS2, NCUR = 1 << (2 * (7 - P));
#pragma unroll 1
    for (int q = 0; q < 2; ++q) {
        const int g = tid + FFT_THREADS * q, blk = g >> LS2, k = g & (S2 - 1), base = blk * NCUR + k;
        cf2 s[16];
#pragma unroll
        for (int i = 0; i < 16; ++i) s[i] = X[fft_dbl_idx<S2>(base, i)];
        const cf2 w1 = fft_w((float)k * (1.0f / (float)NCUR)), w2 = cmul2(w1, w1), w3 = cmul2(w2, w1), v1 = cmul2(w2, w2), v2 = cmul2(v1, v1), v3 = cmul2(v2, v1);
#pragma unroll
        for (int i0 = 0; i0 < 4; ++i0) bfly_fwd_w<true>(s[i0], s[i0 + 4], s[i0 + 8], s[i0 + 12], cmul2(w1, tw32(2 * i0)), cmul2(w2, tw32(4 * i0)), cmul2(w3, tw32(6 * i0)));
#pragma unroll
        for (int m = 0; m < 4; ++m) bfly_fwd_w<true>(s[4 * m], s[4 * m + 1], s[4 * m + 2], s[4 * m + 3], v1, v2, v3);
#pragma unroll
        for (int i = 0; i < 16; ++i) X[fft_dbl_idx<S2>(base, i)] = s[i];
    }
}
template <int P, class PT> FFT_DEV void fft_inv_double(PT X, int tid) {
    FFT_LAUNDER(tid);
    constexpr int LS2 = 2 * (5 - P), S2 = 1 << LS2, NCUR = 1 << (2 * (7 - P));
#pragma unroll 1
    for (int q = 0; q < 2; ++q) {
        const int g = tid + FFT_THREADS * q, blk = g >> LS2, k = g & (S2 - 1), base = blk * NCUR + k;
        cf2 s[16];
#pragma unroll
        for (int i = 0; i < 16; ++i) s[i] = X[fft_dbl_idx<S2>(base, i)];
        const cf2 w1 = fft_w((float)k * (1.0f / (float)NCUR)), w2 = cmul2(w1, w1), w3 = cmul2(w2, w1), v1 = cmul2(w2, w2), v2 = cmul2(v1, v1), v3 = cmul2(v2, v1);
#pragma unroll
        for (int m = 0; m < 4; ++m) bfly_inv_w<true>(s[4 * m], s[4 * m + 1], s[4 * m + 2], s[4 * m + 3], v1, v2, v3);
#pragma unroll
        for (int i0 = 0; i0 < 4; ++i0) bfly_inv_w<true>(s[i0], s[i0 + 4], s[i0 + 8], s[i0 + 12], cmul2(w1, tw32(2 * i0)), cmul2(w2, tw32(4 * i0)), cmul2(w3, tw32(6 * i0)));
#pragma unroll
        for (int i = 0; i < 16; ++i) X[fft_dbl_idx<S2>(base, i)] = s[i];
    }
}
template <class PT> FFT_DEV void fft_load_group(PT X, int g, cf2 (&s)[16]) {
    const int m2 = ((g >> 1) & 7) << 1;
#pragma unroll
    for (int c = 0; c < 8; ++c) { const int e = 16 * g + ((2 * c) ^ m2); s[2 * c] = X[e]; s[2 * c + 1] = X[e + 1]; }
}
template <class PT> FFT_DEV void fft_store_group(PT X, int g, const cf2 (&s)[16]) {
    const int m2 = ((g >> 1) & 7) << 1;
#pragma unroll
    for (int c = 0; c < 8; ++c) { const int e = 16 * g + ((2 * c) ^ m2); X[e] = s[2 * c]; X[e + 1] = s[2 * c + 1]; }
}
FFT_DEV void fft_last2_fwd(cf2 (&s)[16]) {
#pragma unroll
    for (int i0 = 0; i0 < 4; ++i0) bfly_fwd_w<true>(s[i0], s[i0 + 4], s[i0 + 8], s[i0 + 12], tw32(2 * i0), tw32(4 * i0), tw32(6 * i0));
#pragma unroll
    for (int m = 0; m < 4; ++m) bfly_fwd_w<false>(s[4 * m], s[4 * m + 1], s[4 * m + 2], s[4 * m + 3], tw32(0), tw32(0), tw32(0));
}
FFT_DEV void fft_last2_inv(cf2 (&s)[16]) {
#pragma unroll
    for (int m = 0; m < 4; ++m) bfly_inv_w<false>(s[4 * m], s[4 * m + 1], s[4 * m + 2], s[4 * m + 3], tw32(0), tw32(0), tw32(0));
#pragma unroll
    for (int i0 = 0; i0 < 4; ++i0) bfly_inv_w<true>(s[i0], s[i0 + 4], s[i0 + 8], s[i0 + 12], tw32(2 * i0), tw32(4 * i0), tw32(6 * i0));
}
template <class PT, class GP> FFT_DEV void fft_mid_store(PT X, GP G, float scale, float add, int tid) {
    FFT_LAUNDER(tid);
#pragma unroll 1
    for (int q = 0; q < 2; ++q) { const int g = tid + FFT_THREADS * q; cf2 s[16]; fft_load_group(X, g, s); fft_last2_fwd(s);
#pragma unroll
        for (int c = 0; c < 8; ++c) { cf4 w; w.x = (s[2 * c].x + add) * scale; w.y = s[2 * c].y * scale; w.z = (s[2 * c + 1].x + add) * scale; w.w = s[2 * c + 1].y * scale; G[c * 1024 + g] = w; } }
}
template <class PT, class GP> FFT_DEV void fft_mid_mul(PT X, GP G, int tid) {
    FFT_LAUNDER(tid);
#pragma unroll 1
    for (int q = 0; q < 2; ++q) { const int g = tid + FFT_THREADS * q; cf2 s[16]; cf4 w[4];
#pragma unroll
        for (int c = 0; c < 4; ++c) w[c] = G[c * 1024 + g];
        fft_load_group(X, g, s); fft_last2_fwd(s);
#pragma unroll
        for (int h = 0; h < 2; ++h) {
#pragma unroll
            for (int c4 = 0; c4 < 4; ++c4) { const int c = 4 * h + c4; const cf4 wc = w[c4]; if (h == 0) w[c4] = G[(c + 4) * 1024 + g];
                cf2 a = s[2 * c], b = s[2 * c + 1], r; r.x = a.x * wc.x - a.y * wc.y; r.y = a.x * wc.y + a.y * wc.x; s[2 * c] = r;
                r.x = b.x * wc.z - b.y * wc.w; r.y = b.x * wc.w + b.y * wc.z; s[2 * c + 1] = r; } }
        fft_last2_inv(s); fft_store_group(X, g, s); }
}
template <class PT> FFT_DEV void fft_inv_last(PT X, float (&za)[16], float (&zb)[16], int tid) {
    FFT_LAUNDER(tid);
    const cf2 wt1 = fft_w((float)tid * (1.0f / 16384.0f)), wt2 = cmul2(wt1, wt1), wt3 = cmul2(wt2, wt1);
#pragma unroll
    for (int q = 0; q < 8; ++q) {
        const int k = tid + FFT_THREADS * q;
        const int sk = fft_swz(k);
        cf2 a0 = X[sk], a1 = X[sk + 4096], a2 = X[sk + 8192], a3 = X[sk + 12288];
        bfly_inv_w<true>(a0, a1, a2, a3, cmul2(wt1, tw32(q)), cmul2(wt2, tw32(2 * q)), cmul2(wt3, tw32(3 * q)));
        za[q] = a0.x; zb[q] = a0.y; za[q + 8] = a1.x; zb[q + 8] = a1.y;
        FFT_FENCE();
    }
}
template <int Q0, class PT> FFT_DEV void fft_inv_last_part(PT X, float (&za)[8], float (&zb)[8], int tid) {
    FFT_LAUNDER(tid);
    const cf2 wt1 = fft_w((float)tid * (1.0f / 16384.0f)), wt2 = cmul2(wt1, wt1), wt3 = cmul2(wt2, wt1);
#pragma unroll
    for (int q = Q0; q < Q0 + 4; ++q) {
        const int k = tid + FFT_THREADS * q;
        const int sk = fft_swz(k);
        cf2 a0 = X[sk], a1 = X[sk + 4096], a2 = X[sk + 8192], a3 = X[sk + 12288];
        bfly_inv_w<true>(a0, a1, a2, a3, cmul2(wt1, tw32(q)), cmul2(wt2, tw32(2 * q)), cmul2(wt3, tw32(3 * q)));
        za[q - Q0] = a0.x; zb[q - Q0] = a0.y; za[4 + q - Q0] = a1.x; zb[4 + q - Q0] = a1.y;
    }
}
namespace pg8 {
enum { EPI_QK = 0, EPI_T = 1, EPI_RES = 2, EPI_SWIGLU = 3, EPI_DOWN = 4 };
struct EpiAny {
    static constexpr bool PERM = true, AFTER_DRAIN = false;
    int mode, ldc;
    bf16_t* O;
    float* f0; float* f1;
    const float* p0; const float* p1; const float* p2; const float* p3;
    PG8_LAS float* bslot;
    __device__ __forceinline__ void epi_qk(const f32x4 (&acc)[2][2][4][2], const Unit& u, int wr, int wc, int fr, int fq) const {
        const int row0 = u.pm * BM + wr * 64 + fr;
        const bool latent = u.pm < 256;
#pragma unroll
        for (int bj = 0; bj < 2; ++bj) {
            const int cs = u.pn * BM + bj * HALF + wc * 32 + 8 * fq;
            const int hb = cs & ~63, jj = (cs & 63) >> 3;
            const bool isv = u.pn >= 5;
            const f32x4 b0 = *(const f32x4*)(p0 + (isv ? cs : hb + 4 * jj)), b1 = *(const f32x4*)(p0 + (isv ? cs + 4 : hb + 32 + 4 * jj));
#pragma unroll
            for (int ai = 0; ai < 2; ++ai)
#pragma unroll
                for (int m = 0; m < 4; ++m) {
                    const int row = row0 + ai * HALF + m * 16;
                    f32x4 x1 = acc[ai][bj][m][0] + b0, x2 = acc[ai][bj][m][1] + b1;
                    if (latent && !isv) {
                        const float* rp = p1 + ((size_t)(row & 8191) * 32 + 4 * jj) * 2;
                        const f32x4 cs0 = *(const f32x4*)rp, cs1 = *(const f32x4*)(rp + 4);
                        const f32x4 c = (f32x4){cs0[0], cs0[2], cs1[0], cs1[2]}, s = (f32x4){cs0[1], cs0[3], cs1[1], cs1[3]};
                        const f32x4 o1 = x1 * c - x2 * s, o2 = x1 * s + x2 * c; x1 = o1; x2 = o2;
                    }
                    if (u.pn < 4) { x1 *= 0.18033688011112042f; x2 *= 0.18033688011112042f; }
                    u32x4 w; w.x = cvt_pk_bf16(x1[0], x1[1]); w.y = cvt_pk_bf16(x1[2], x1[3]); w.z = cvt_pk_bf16(x2[0], x2[1]); w.w = cvt_pk_bf16(x2[2], x2[3]);
                    *(u32x4*)(O + (size_t)row * 1536 + cs) = w;
                }
        }
    }
    __device__ __forceinline__ void epi_t(const f32x4 (&acc)[2][2][4][2], const Unit& u, int wr, int wc, int fr, int fq) const {
        const int row0 = u.pm * BM + wr * 64 + fr, col0 = u.pn * BM + wc * 32 + 8 * fq;
        float bvs[8];
#pragma unroll
        for (int q = 0; q < 8; ++q) bvs[q] = p0[row0 + (q >> 2) * HALF + (q & 3) * 16];
#pragma unroll
        for (int ai = 0; ai < 2; ++ai)
#pragma unroll
            for (int m = 0; m < 4; ++m) { const int row = row0 + ai * HALF + m * 16; const float bv = bvs[ai * 4 + m]; bf16_t* rowp = O + (size_t)row * ldc + col0;
#pragma unroll
                for (int bj = 0; bj < 2; ++bj) { const f32x4 v0 = acc[ai][bj][m][0] + bv, v1 = acc[ai][bj][m][1] + bv;
                    u32x4 w; w.x = cvt_pk_bf16(v0[0], v0[1]); w.y = cvt_pk_bf16(v0[2], v0[3]); w.z = cvt_pk_bf16(v1[0], v1[1]); w.w = cvt_pk_bf16(v1[2], v1[3]);
                    *(u32x4*)(rowp + bj * HALF) = w; } }
    }
    __device__ __forceinline__ void epi_res(const f32x4 (&acc)[2][2][4][2], const Unit& u, int wr, int wc, int fr, int fq) const {
        const bool latent = u.pm < 256;
        const int row0 = u.pm * BM + wr * 64 + fr, col0 = u.pn * BM + wc * 32 + 8 * fq;
        const float* gp = p3 + (size_t)(latent ? (u.pm >> 5) : 8) * 6144 + col0; const float* bp = p2 + col0;
        const float* srcf = p0 ? (latent ? p0 : p1 - (size_t)TL * 1024) : nullptr;
#pragma unroll
        for (int bj = 0; bj < 2; ++bj) { const f32x4 b0 = *(const f32x4*)(bp + bj * HALF), b1 = *(const f32x4*)(bp + bj * HALF + 4), g0 = *(const f32x4*)(gp + bj * HALF), g1 = *(const f32x4*)(gp + bj * HALF + 4);
#pragma unroll
            for (int ai = 0; ai < 2; ++ai)
#pragma unroll
                for (int m = 0; m < 4; ++m) { const size_t off = (size_t)(row0 + ai * HALF + m * 16) * 1024 + col0 + bj * HALF;
                    f32x4 x0, x1;
                    if (srcf) { x0 = *(const f32x4*)(srcf + off); x1 = *(const f32x4*)(srcf + off + 4); }
                    else { const u32x4 r = *(const u32x4*)(O + off); x0 = (f32x4){__builtin_bit_cast(float, r.x << 16), __builtin_bit_cast(float, r.x & 0xffff0000u), __builtin_bit_cast(float, r.y << 16), __builtin_bit_cast(float, r.y & 0xffff0000u)};
                        x1 = (f32x4){__builtin_bit_cast(float, r.z << 16), __builtin_bit_cast(float, r.z & 0xffff0000u), __builtin_bit_cast(float, r.w << 16), __builtin_bit_cast(float, r.w & 0xffff0000u)}; }
                    const f32x4 v0 = x0 + g0 * (acc[ai][bj][m][0] + b0), v1 = x1 + g1 * (acc[ai][bj][m][1] + b1);
                    u32x4 w; w.x = cvt_pk_bf16(v0[0], v0[1]); w.y = cvt_pk_bf16(v0[2], v0[3]); w.z = cvt_pk_bf16(v1[0], v1[1]); w.w = cvt_pk_bf16(v1[2], v1[3]);
                    *(u32x4*)(O + off) = w; } }
    }
    __device__ __forceinline__ const float* bias_src(const Unit& u, int wc, int lane) const {
        if (mode == EPI_SWIGLU) return p0 + (size_t)((u.pb >> 3) & 31) * 2048 + (lane >> 5) * 1024 + u.pn * HALF + wc * 32 + (lane & 31);
        return p0 + (size_t)((u.pb >> 2) & 31) * 1024 + u.pn * BM + (lane >> 5) * HALF + wc * 32 + (lane & 31);
    }
    __device__ __forceinline__ void epi_swiglu(const f32x4 (&acc)[2][2][4][2], const Unit& u, int wr, int wc, int fr, int fq) const {
        const int e = (u.pb >> 3) & 31;
        const int row0 = u.pm * BM + wr * 64 + fr, col0 = u.pn * HALF + wc * 32 + 8 * fq;
        (void)e;
#pragma unroll
        for (int ai = 0; ai < 2; ++ai)
#pragma unroll
            for (int m = 0; m < 4; ++m) {
                f32x4 a[2];
#pragma unroll
                for (int n = 0; n < 2; ++n) {
                    f32x4 g = acc[ai][0][m][n], up = acc[ai][1][m][n];
#pragma unroll
                    for (int t = 0; t < 4; ++t) { const float gg = fminf(g[t], 7.0f), uu = fminf(fmaxf(up[t], -7.0f), 7.0f);
                        const float sg = __builtin_amdgcn_rcpf(1.0f + __builtin_amdgcn_exp2f(-2.4554669595930157f * gg)); a[n][t] = gg * sg * (uu + 1.0f); }
                }
                u32x4 w; w.x = cvt_pk_bf16(a[0][0], a[0][1]); w.y = cvt_pk_bf16(a[0][2], a[0][3]); w.z = cvt_pk_bf16(a[1][0], a[1][1]); w.w = cvt_pk_bf16(a[1][2], a[1][3]);
                *(u32x4*)(O + (size_t)(row0 + ai * HALF + m * 16) * 1024 + col0) = w;
            }
    }
    __device__ __forceinline__ void epi_down(const f32x4 (&acc)[2][2][4][2], const Unit& u, int wr, int wc, int fr, int fq) const {
        const int e = (u.pb >> 2) & 31;
        const int row0 = u.pm * BM + wr * 64 + fr, col0 = u.pn * BM + wc * 32 + 8 * fq;
        (void)e;
#pragma unroll
        for (int bj = 0; bj < 2; ++bj) {
#pragma unroll
            for (int ai = 0; ai < 2; ++ai)
#pragma unroll
                for (int m = 0; m < 4; ++m) { const f32x4 v0 = acc[ai][bj][m][0], v1 = acc[ai][bj][m][1];
                    u32x4 w; w.x = cvt_pk_bf16(v0[0], v0[1]); w.y = cvt_pk_bf16(v0[2], v0[3]); w.z = cvt_pk_bf16(v1[0], v1[1]); w.w = cvt_pk_bf16(v1[2], v1[3]);
                    *(u32x4*)(O + (size_t)(row0 + ai * HALF + m * 16) * 1024 + col0 + bj * HALF) = w; } }
    }
    __device__ __forceinline__ void operator()(const f32x4 (&acc)[2][2][4][2], const Unit& u, int wr, int wc, int fr, int fq) const {
        if (mode == EPI_QK) epi_qk(acc, u, wr, wc, fr, fq);
        else if (mode == EPI_T) epi_t(acc, u, wr, wc, fr, fq);
        else if (mode == EPI_RES) epi_res(acc, u, wr, wc, fr, fq);
        else if (mode == EPI_SWIGLU) epi_swiglu(acc, u, wr, wc, fr, fq);
        else epi_down(acc, u, wr, wc, fr, fq);
    }
};
struct AnyOrder {
    int moe; StaticOrder so;
    const PG8_LAS int* rb2e; int nblk, lg, wbase;
    __device__ __forceinline__ bool next(int i, Unit& u) const {
        if (!moe) return so.next(i, u);
        const int x = so.c & 7, j = so.c >> 3, per = (so.G >> 3) >> lg;
        const int rb = (i * 8 + x) * per + (j >> lg); if (rb >= nblk) return false;
        const int e = rb2e[rb];
        u.pm = rb; u.pn = j & ((1 << lg) - 1); u.pb = ((wbase + e) << lg) + u.pn; return true;
    }
    __device__ __forceinline__ void a_ready(const Unit&) const {}
    __device__ __forceinline__ void done(const Unit&) const {}
};
}
struct Frame {
    LAS unsigned char* lds;
    volatile LAS unsigned* MISC;
    gu32* ctl;
    int tid, lane, wave;
    int vcu, G, bx;
    const float* const KAS* in;
    float* out; unsigned char* ws;
};
__device__ __forceinline__ float wave_sum(float v) {
#pragma unroll
    for (int o = 1; o < 64; o <<= 1) v += __shfl_xor(v, o);
    return v;
}
__device__ __forceinline__ void block_sum2(Frame& F, LAS float* red, float& a, float& b) {
    a = wave_sum(a); b = wave_sum(b);
    __syncthreads();
    if (F.lane == 0) { red[F.wave * 2] = a; red[F.wave * 2 + 1] = b; }
    __syncthreads();
    float sa = 0.f, sb = 0.f;
#pragma unroll
    for (int w = 0; w < NWAVES; ++w) { sa += red[2 * w]; sb += red[2 * w + 1]; }
    a = sa; b = sb;
}

template <int MODE>
__device__ __forceinline__ void tr_item(const float* W, int N, bf16* WT, bf16* WT2, LAS float* scr, int item, int lane) {
    const int nblk = N / 32, kb = item / nblk, nb = item % nblk, k0 = 64 * kb, n0 = 32 * nb;
#pragma unroll 8
    for (int i = 0; i < 32; ++i) { const int kk = 2 * i + (lane >> 5); scr[kk * 33 + (lane & 31)] = W[(size_t)(k0 + kk) * N + n0 + (lane & 31)]; }
    LDS_WAIT(); asm volatile("" ::: "memory");
    const int c = lane & 7;
#pragma unroll
    for (int j = 0; j < 4; ++j) { const int n = (lane >> 3) + 8 * j; const LAS float* s = scr + (8 * c) * 33 + n;
        const int ns = n0 + n; int d = ns; bf16* dst = WT;
        if (MODE == 1) { const int n2 = ns & 1023; d = 256 * (n2 >> 7) + (n2 & 127) + (ns >= 1024 ? 128 : 0); }
        if (MODE == 2) { if (ns < 1280) { const int hb = ns & ~63, dd = ns & 63, d2 = dd & 31; d = hb + 8 * (d2 >> 2) + (d2 & 3) + (dd >= 32 ? 4 : 0); } }
        v4u o; o.x = pk2(s[0 * 33], s[1 * 33]); o.y = pk2(s[2 * 33], s[3 * 33]); o.z = pk2(s[4 * 33], s[5 * 33]); o.w = pk2(s[6 * 33], s[7 * 33]);
        *(GAS v4u*)(dst + (size_t)d * 1024 + k0 + 8 * c) = o; }
    LDS_WAIT(); asm volatile("" ::: "memory");
}
__device__ __forceinline__ float silu_f(float v) { return v / (1.0f + expf(-v)); }
__device__ __forceinline__ void p0_prologue(Frame& F) {
    const int tid = F.tid, lane = F.lane;
    if (F.bx < 192) {
        LAS float* sv = (LAS float*)F.lds;
        LAS float* part = sv + 1024 * 12;
        for (int i = tid; i < 1024 * 9; i += NWAVES * 64) { const int r = i >> 10, k = i & 1023; const float v = (r < 8) ? F.in[I_C][r * 1024 + k] : F.in[I_CCTX][k]; sv[k * 12 + r] = silu_f(v); }
        __syncthreads();
        const int l = F.bx / 48, n0 = (F.bx % 48) * 128, kb = 128 * F.wave;
        const float* wp = F.in[I_ADAW] + ((size_t)l * 1024 + kb) * 6144 + n0 + 2 * lane;
        float acc0[9], acc1[9];
#pragma unroll
        for (int r = 0; r < 9; ++r) { acc0[r] = 0.f; acc1[r] = 0.f; }
#pragma unroll 1
        for (int k0 = 0; k0 < 128; k0 += 16) { float wx[16], wy[16];
#pragma unroll
            for (int u = 0; u < 16; ++u) { const GAS float* q = (const GAS float*)(wp + (size_t)(k0 + u) * 6144); wx[u] = q[0]; wy[u] = q[1]; }
#pragma unroll
            for (int u = 0; u < 16; ++u) { const LAS float* sk = sv + (kb + k0 + u) * 12;
                const f32x4 s0 = *(const LAS f32x4*)sk, s1 = *(const LAS f32x4*)(sk + 4); const float s8 = sk[8];
#pragma unroll
                for (int r = 0; r < 4; ++r) { acc0[r] += s0[r] * wx[u]; acc1[r] += s0[r] * wy[u]; acc0[4 + r] += s1[r] * wx[u]; acc1[4 + r] += s1[r] * wy[u]; }
                acc0[8] += s8 * wx[u]; acc1[8] += s8 * wy[u]; } }
#pragma unroll
        for (int r = 0; r < 9; ++r) { part[(F.wave * 9 + r) * 128 + 2 * lane] = acc0[r]; part[(F.wave * 9 + r) * 128 + 2 * lane + 1] = acc1[r]; }
        __syncthreads();
        for (int i = tid; i < 9 * 128; i += NWAVES * 64) { const int r = i >> 7, cix = i & 127; float t = F.in[I_ADAB][l * 6144 + n0 + cix];
#pragma unroll
            for (int w = 0; w < NWAVES; ++w) t += part[(w * 9 + r) * 128 + cix];
            ((float*)(F.ws + WS_MOD))[((size_t)l * 9 + r) * 6144 + n0 + cix] = t; }
        __syncthreads();
    }
    if (F.bx >= 192) {
        float* rt = (float*)(F.ws + WS_ROPE);
        for (int e = (F.bx - 192) * 512 + tid; e < 8192 * 32; e += 64 * 512) { const int pos = e >> 5, i = e & 31;
            const float inv = expf(-(float)(i & 15) * (1.0f / 16.0f) * 9.210340371976184f);
            const float ang = (float)((i < 16) ? (pos >> 6) : (pos & 63)) * inv; float sn, cs; sincosf(ang, &sn, &cs);
            rt[2 * e] = cs; rt[2 * e + 1] = sn; }
    }
    const int gw = F.vcu * NWAVES + F.wave, NGW = F.G * NWAVES;
    for (int task = gw; task < 2 * (8192 + 256); task += NGW) {
        const int j = task / 8448, tt = task % 8448; const bool lat = tt < 8192; const int t = lat ? tt : tt - 8192, L = lat ? 8192 : 256;
        float* dst = lat ? (float*)(F.ws + WS_A3L) + ((size_t)j * 8192 + t) * 64 : (float*)(F.ws + WS_A3C) + ((size_t)j * 256 + t) * 64;
        const float tl = (float)t / (float)(L - 1), w = 6.283185307179586f * (float)t / (float)L;
        float z = 0.f;
        if (lane == 0) z = tl;
        else if (lane <= 32) { const int mI = (lane - 1) & 15; const float band = 1e-4f + (float)mI * ((15.0f - 1e-4f) / 15.0f); z = (lane <= 16) ? cosf(band * w) : -sinf(band * w); }
        const float fr = F.in[I_FFREQ][j * 64 + lane];
        const float* w1 = F.in[I_FW1] + (size_t)j * 33 * 64; const float* w2 = F.in[I_FW2] + (size_t)j * 64 * 64; const float* w3 = F.in[I_FW3] + (size_t)j * 64 * 64;
        float a = F.in[I_FB1][j * 64 + lane];
        for (int i = 0; i < 33; ++i) a += __shfl(z, i) * w1[i * 64 + lane];
        a = sinf(fr * a);
        float a2 = F.in[I_FB2][j * 64 + lane];
        for (int k = 0; k < 64; ++k) a2 += __shfl(a, k) * w2[k * 64 + lane];
        a2 = sinf(fr * a2);
        float a3 = F.in[I_FB3][j * 64 + lane];
        for (int k = 0; k < 64; ++k) a3 += __shfl(a2, k) * w3[k * 64 + lane];
        if (lat) ((bf16*)(F.ws + WS_A3L))[(size_t)j * 8192 * 64 + ((((size_t)(t >> 5) * 4 + (lane >> 4)) * 64 + (t & 31) + 32 * ((lane >> 3) & 1)) << 3) + (lane & 7)] = (bf16)f2bf(sinf(fr * a3));
        else dst[lane] = sinf(fr * a3);
    }
    LAS float* scr = (LAS float*)(F.lds + RING_OFF + F.wave * 16384);
    constexpr int NI_GU = 128 * 1024, NI_DN = 128 * 512, NI_QKV = 2 * 768, NI_AO = 2 * 512, NI_HIN = 2 * 1536, NI_HO = 2 * 512;
    constexpr int NITEMS = NI_GU + NI_DN + NI_QKV + NI_AO + NI_HIN + NI_HO;
    for (int it = gw; it < NITEMS; it += NGW) {
        int r = it;
        if (r < NI_GU) { const int mat = r >> 10; tr_item<1>(F.in[I_WGU] + (size_t)mat * 1024 * 2048, 2048, (bf16*)(F.ws + WS_WGU) + (size_t)mat * 2048 * 1024, nullptr, scr, r & 1023, lane); continue; } r -= NI_GU;
        if (r < NI_DN) { const int mat = r >> 9; tr_item<0>(F.in[I_WDN] + (size_t)mat * 1024 * 1024, 1024, (bf16*)(F.ws + WS_WDN) + (size_t)mat * 1024 * 1024, nullptr, scr, r & 511, lane); continue; } r -= NI_DN;
        if (r < NI_QKV) { const int mat = r / 768; tr_item<2>(F.in[I_AWQKV] + (size_t)mat * 1024 * 1536, 1536, (bf16*)(F.ws + WS_WQK) + (size_t)mat * 1536 * 1024, nullptr, scr, r % 768, lane); continue; } r -= NI_QKV;
        if (r < NI_AO) { const int mat = r >> 9; tr_item<0>(F.in[I_AWO] + (size_t)mat * 1024 * 1024, 1024, (bf16*)(F.ws + WS_WAO) + (size_t)mat * 1024 * 1024, nullptr, scr, r & 511, lane); continue; } r -= NI_AO;
        if (r < NI_HIN) { const int mat = r / 1536; tr_item<0>(F.in[I_HWIN] + (size_t)mat * 1024 * 3072, 3072, (bf16*)(F.ws + WS_WHIN) + (size_t)mat * 3072 * 1024, nullptr, scr, r % 1536, lane); continue; } r -= NI_HIN;
        { const int mat = r >> 9; tr_item<0>(F.in[I_HWO] + (size_t)mat * 1024 * 1024, 1024, (bf16*)(F.ws + WS_WHO) + (size_t)mat * 1024 * 1024, nullptr, scr, r & 511, lane); }
    }
}

__device__ __forceinline__ void row8_unpack(const v4u w, f32x4& a, f32x4& b) { a = (f32x4){bflo(w.x), bfhi(w.x), bflo(w.y), bfhi(w.y)}; b = (f32x4){bflo(w.z), bfhi(w.z), bflo(w.w), bfhi(w.w)}; }
__device__ __forceinline__ v4u row8_pack(const f32x4 a, const f32x4 b) { v4u w; w.x = pk2(a.x, a.y); w.y = pk2(a.z, a.w); w.z = pk2(b.x, b.y); w.w = pk2(b.z, b.w); return w; }
#define ROW8_F32(ptr, jj, hf, lane) (((const f32x4*)(ptr))[128 * (jj) + 2 * (lane) + (hf)])
__device__ __forceinline__ void norm_mod_store(Frame& F, const f32x4 (&v)[4], const float* gain, const float* shift, const float* scale, bf16* orow) {
    float s2 = 0.f;
#pragma unroll
    for (int j = 0; j < 4; ++j) s2 += (v[j].x * v[j].x + v[j].y * v[j].y) + (v[j].z * v[j].z + v[j].w * v[j].w);
    const float rstd = 1.0f / sqrtf(wave_sum(s2) * (1.0f / D) + NORM_EPS);
#pragma unroll
    for (int jj = 0; jj < 2; ++jj) { f32x4 h[2];
#pragma unroll
        for (int hf = 0; hf < 2; ++hf) h[hf] = v[2 * jj + hf] * rstd * ROW8_F32(gain, jj, hf, F.lane) * (ROW8_F32(scale, jj, hf, F.lane) + 1.0f) + ROW8_F32(shift, jj, hf, F.lane);
        ((GAS v4u*)orow)[64 * jj + F.lane] = row8_pack(h[0], h[1]); }
}
__device__ __forceinline__ int mod_row(int row) { return row < TL ? (row >> 13) : 8; }
__device__ __forceinline__ int rows_of_layer(int l) { return l >= 2 ? TL : TT; }
__device__ __forceinline__ void norm0_phase(Frame& F) {
    const int gw = F.vcu * NWAVES + F.wave, NGW = F.G * NWAVES;
    const float* mod = (const float*)(F.ws + WS_MOD);
    for (int row = gw; row < TT; row += NGW) {
        const float* xr = row < TL ? F.in[I_X] + (size_t)row * D : F.in[I_CTX] + (size_t)(row - TL) * D;
        f32x4 v[4];
#pragma unroll
        for (int j = 0; j < 4; ++j) v[j] = ((const GAS f32x4*)xr)[128 * (j >> 1) + 2 * F.lane + (j & 1)];
        const float* mr = mod + (size_t)mod_row(row) * 6144;
        norm_mod_store(F, v, F.in[I_NMIX], mr, mr + 1024, (bf16*)(F.ws + WS_H) + (size_t)row * D);
    }
}

__device__ __forceinline__ void attn_phase(Frame& F, int j, int nunits) {
    const bf16* QK = (const bf16*)(F.ws + WS_QK); bf16* O = (bf16*)(F.ws + WS_O);
    const float* sinks = F.in[I_ASINK] + j * 16;
    LAS bf16* Ks0 = (LAS bf16*)(F.lds);
    const int w = F.wave, lane = F.lane, r = lane & 31, h = lane >> 5, tid = F.tid;
    float snk[4];
#pragma unroll
    for (int i = 0; i < 4; ++i) snk[i] = sinks[4 * i + (w >> 1)];
    for (int u = F.vcu; u < nunits; u += F.G) {
        int b, kvh, q0; const bool isctx = u >= 4096;
        if (!isctx) { b = u >> 9; kvh = (u >> 7) & 3; q0 = (u & 127) * 64; } else { const int u2 = u - 4096; b = u2 >> 4; kvh = (u2 >> 2) & 3; q0 = (u2 & 3) * 64; }
        const int head = kvh * 4 + (w >> 1), qrow = q0 + 32 * (w & 1) + r;
        const size_t tokq = isctx ? (size_t)TL + b * CTXL + qrow : (size_t)b * SEQ + qrow;
        const bf16* qp = QK + tokq * QKD + head * 64 + 8 * h;
        v4u bqv[4];
#pragma unroll
        for (int s = 0; s < 4; ++s) asm volatile("global_load_dwordx4 %0, %1, off" : "=&v"(bqv[s]) : "v"((const GAS v4u*)(qp + 16 * s)) : "memory");
        float m = (kvh == 0 ? snk[0] : kvh == 1 ? snk[1] : kvh == 2 ? snk[2] : snk[3]) * 1.4426950408889634f, l = 1.0f;
        f32x16 o0, o1;
#pragma unroll
        for (int i = 0; i < 16; ++i) { o0[i] = 0.f; o1[i] = 0.f; }
        const int jl0 = isctx ? 0 : (q0 >= 128 ? 0 : (128 - q0) >> 6), jl1 = isctx ? 0 : (q0 + 192 <= SEQ ? 5 : (SEQ + 128 - q0) >> 6), nl = jl1 - jl0, ntile = nl + 4;
        const int srow = tid >> 3, sch = tid & 7;
#define ATT_KEY0(i) ((i) < nl ? (size_t)b * SEQ + (q0 - 128 + 64 * (jl0 + (i))) : (size_t)TL + b * CTXL + 64 * ((i) - nl))
#define ATT_LOAD(kv, vv, i) do { const size_t kt_ = ATT_KEY0(i); const GAS v4u* pk_ = (const GAS v4u*)(QK + (kt_ + srow) * QKD + 1024 + kvh * 64 + sch * 8); const GAS v4u* pv_ = (const GAS v4u*)(QK + (kt_ + lane) * QKD + 1280 + kvh * 64 + w * 8); \
            asm volatile("global_load_dwordx4 %0, %2, off\n\tglobal_load_dwordx4 %1, %3, off" : "=&v"(kv), "=&v"(vv) : "v"(pk_), "v"(pv_) : "memory"); } while (0)
#define ATT_WAIT2() asm volatile("s_waitcnt vmcnt(2)" ::: "memory")
#define ATT_WRITE(kv, vv, bufi) do { LAS bf16* ks_ = Ks0 + (bufi) * 9216; LAS bf16* vs_ = ks_ + 4608; *(LAS v4u*)(ks_ + srow * 72 + sch * 8) = kv;     \
            LAS bf16* vd = vs_ + (w * 8) * 72 + lane; \
            vd[0] = (bf16)(vv.x & 0xffffu); vd[72] = (bf16)(vv.x >> 16); vd[144] = (bf16)(vv.y & 0xffffu); vd[216] = (bf16)(vv.y >> 16); \
            vd[288] = (bf16)(vv.z & 0xffffu); vd[360] = (bf16)(vv.z >> 16); vd[432] = (bf16)(vv.w & 0xffffu); vd[504] = (bf16)(vv.w >> 16); } while (0)
        v4u kvA, vvA, kvB, vvB;
        unsigned qtouch = 0u;
        ATT_LOAD(kvA, vvA, 0);
        ATT_LOAD(kvB, vvB, 1);
        ATT_WAIT2();
        asm volatile("" : "+v"(bqv[0]), "+v"(bqv[1]), "+v"(bqv[2]), "+v"(bqv[3]));
        ATT_WRITE(kvA, vvA, 0);
        ATT_LOAD(kvA, vvA, 2);
        __syncthreads();
        auto tile_step = [&](const int it, v4u& kvN, v4u& vvN) __attribute__((always_inline)) {
            const int cur = it & 1;
            const bool local = it < nl; const int kp0 = q0 - 128 + 64 * (jl0 + it);
            const LAS bf16* Ks = Ks0 + cur * 9216; const LAS bf16* Vs = Ks + 4608;
            if (it + 1 < ntile) { ATT_WAIT2(); ATT_WRITE(kvN, vvN, cur ^ 1); }
            { const int i3 = it + 3 < ntile ? it + 3 : ntile - 1; ATT_LOAD(kvN, vvN, i3); }
            if (it + 2 == ntile) {
                const int un = u + F.G < nunits ? u + F.G : u; int bn, kn, qn; const bool cn = un >= 4096;
                if (!cn) { bn = un >> 9; kn = (un >> 7) & 3; qn = (un & 127) * 64; } else { const int u2 = un - 4096; bn = u2 >> 4; kn = (u2 >> 2) & 3; qn = (u2 & 3) * 64; }
                const int ln = (w * 64 + lane) & 255; const size_t tn = (cn ? (size_t)TL + bn * CTXL + qn : (size_t)bn * SEQ + qn) + (ln >> 2);
                asm volatile("global_load_dword %0, %1, off" : "=&v"(qtouch) : "v"((const GAS unsigned*)(QK + tn * QKD + kn * 256 + (ln & 3) * 64)) : "memory"); }
            f32x16 st0, st1;
#pragma unroll
            for (int i = 0; i < 16; ++i) { st0[i] = 0.f; st1[i] = 0.f; }
#pragma unroll
            for (int s = 0; s < 4; ++s) {
                const bf16x8 a0 = *(const LAS bf16x8*)(Ks + r * 72 + 16 * s + 8 * h), a1 = *(const LAS bf16x8*)(Ks + (32 + r) * 72 + 16 * s + 8 * h);
                st0 = __builtin_amdgcn_mfma_f32_32x32x16_bf16(a0, __builtin_bit_cast(bf16x8, bqv[s]), st0, 0, 0, 0);
                st1 = __builtin_amdgcn_mfma_f32_32x32x16_bf16(a1, __builtin_bit_cast(bf16x8, bqv[s]), st1, 0, 0, 0);
            }
            const bool edge = local && (jl0 + it == 0 || jl0 + it == 4);
            if (edge) {
                const int dq = qrow - kp0 - 4 * h;
#pragma unroll
                for (int i = 0; i < 16; ++i) { const int d0 = dq - ((i & 3) + 8 * (i >> 2)), d1 = d0 - 32;
                    st0[i] = ((unsigned)(d0 + 128) > 256u) ? -1e30f : st0[i]; st1[i] = ((unsigned)(d1 + 128) > 256u) ? -1e30f : st1[i]; }
            }
            float mx = fmaxf(st0[0], st1[0]);
#pragma unroll
            for (int i = 1; i < 16; ++i) mx = __builtin_fmaxf(__builtin_fmaxf(mx, st0[i]), st1[i]);
            mx = fmaxf(mx, __shfl_xor(mx, 32));
            const float mn = fmaxf(m, mx), alpha = __builtin_amdgcn_exp2f(m - mn); m = mn;
#pragma unroll
            for (int i = 0; i < 16; ++i) { st0[i] = __builtin_amdgcn_exp2f(st0[i] - mn); st1[i] = __builtin_amdgcn_exp2f(st1[i] - mn); }
            f32x16 lsum;
#pragma unroll
            for (int i = 0; i < 16; ++i) lsum[i] = 0.f;
            if (!__all(alpha == 1.0f)) {
#pragma unroll
                for (int i = 0; i < 16; ++i) { o0[i] *= alpha; o1[i] *= alpha; } }
#pragma unroll
            for (int sp = 0; sp < 4; ++sp) {
                unsigned pw[4];
#pragma unroll
                for (int e = 0; e < 4; ++e) { const int i0 = 8 * (sp & 1) + 2 * e; pw[e] = (sp < 2) ? pg8::cvt_pk_bf16(st0[i0], st0[i0 + 1]) : pg8::cvt_pk_bf16(st1[i0], st1[i0 + 1]); }
                const bf16x8 pf = __builtin_bit_cast(bf16x8, (v4u){pw[0], pw[1], pw[2], pw[3]});
                lsum = __builtin_amdgcn_mfma_f32_32x32x16_bf16(__builtin_bit_cast(bf16x8, (v4u){0x3f803f80u, 0x3f803f80u, 0x3f803f80u, 0x3f803f80u}), pf, lsum, 0, 0, 0);
#pragma unroll
                for (int dt = 0; dt < 2; ++dt) {
                    const LAS bf16* vp = Vs + (32 * dt + r) * 72 + 16 * sp + 4 * h;
                    const v2u va = *(const LAS v2u*)vp, vb = *(const LAS v2u*)(vp + 8);
                    const bf16x8 vf = __builtin_bit_cast(bf16x8, (v4u){va.x, va.y, vb.x, vb.y});
                    if (dt == 0) o0 = __builtin_amdgcn_mfma_f32_32x32x16_bf16(vf, pf, o0, 0, 0, 0); else o1 = __builtin_amdgcn_mfma_f32_32x32x16_bf16(vf, pf, o1, 0, 0, 0);
                }
            }
            l = l * alpha + lsum[0];
            __syncthreads();
        };
#pragma unroll 1
        for (int it = 0;; it += 2) {
            tile_step(it, kvB, vvB);
            if (it + 1 >= ntile) break;
            tile_step(it + 1, kvA, vvA);
            if (it + 2 >= ntile) break;
        }
        asm volatile("s_waitcnt vmcnt(0)" ::: "memory");
        asm volatile("" :: "v"(qtouch));
#undef ATT_KEY0
#undef ATT_WAIT2
#undef ATT_LOAD
#undef ATT_WRITE
        const float inv = 1.0f / l;
        bf16* op = O + tokq * D + head * 64 + 4 * h;
#pragma unroll
        for (int g = 0; g < 4; ++g) {
            v2u w0, w1; w0.x = pg8::cvt_pk_bf16(o0[4 * g] * inv, o0[4 * g + 1] * inv); w0.y = pg8::cvt_pk_bf16(o0[4 * g + 2] * inv, o0[4 * g + 3] * inv);
            w1.x = pg8::cvt_pk_bf16(o1[4 * g] * inv, o1[4 * g + 1] * inv); w1.y = pg8::cvt_pk_bf16(o1[4 * g + 2] * inv, o1[4 * g + 3] * inv);
            *(GAS v2u*)(op + 8 * g) = w0; *(GAS v2u*)(op + 32 + 8 * g) = w1;
        }
    }
}
__device__ __forceinline__ float sconv3(const bf16* p, int n, int L, float w0, float w1, float w2, float cb) {
    const float a = (n > 0) ? bf2f(p[n - 1]) : 0.f, b = bf2f(p[n]), c = (n < L - 1) ? bf2f(p[n + 1]) : 0.f;
    return cb + w0 * a + w1 * b + w2 * c;
}
struct HyRaw { v4u raw[4]; unsigned short lf[4], rt[4]; };
__device__ __forceinline__ void hy_stage_load(const bf16* p, HyRaw& R, int tid) {
#pragma unroll
    for (int ch = 0; ch < 2; ++ch)
#pragma unroll
        for (int b = 0; b < 2; ++b) {
            const int n0 = 8 * tid + 4096 * ch; const bf16* pb = p + (size_t)b * SEQ;
            R.raw[2 * ch + b] = *(const GAS v4u*)(pb + n0);
            R.lf[2 * ch + b] = n0 > 0 ? pb[n0 - 1] : (unsigned short)0; R.rt[2 * ch + b] = n0 + 8 < SEQ ? pb[n0 + 8] : (unsigned short)0;
        }
}
__device__ __forceinline__ void hy_stage_write(const HyRaw& R, float w0, float w1, float w2, float cb, LAS float* S, int tid) {
#pragma unroll
    for (int ch = 0; ch < 2; ++ch)
#pragma unroll
        for (int b = 0; b < 2; ++b) {
            const int n0 = 8 * tid + 4096 * ch; const v4u raw = R.raw[2 * ch + b];
            float x[10]; x[0] = bf2f(R.lf[2 * ch + b]); x[1] = bflo(raw.x); x[2] = bfhi(raw.x); x[3] = bflo(raw.y); x[4] = bfhi(raw.y); x[5] = bflo(raw.z); x[6] = bfhi(raw.z); x[7] = bflo(raw.w); x[8] = bfhi(raw.w); x[9] = bf2f(R.rt[2 * ch + b]);
            f32x4 lo, hi;
#pragma unroll
            for (int e = 0; e < 4; ++e) { lo[e] = cb + w0 * x[e] + w1 * x[e + 1] + w2 * x[e + 2]; hi[e] = cb + w0 * x[e + 4] + w1 * x[e + 5] + w2 * x[e + 6]; }
            *(LAS f32x4*)(S + b * 8192 + n0) = lo; *(LAS f32x4*)(S + b * 8192 + n0 + 4) = hi;
        }
}
__device__ __forceinline__ void hyena_phase(Frame& F, int j, bool with_ctx) {
    LAS cf2* X = (LAS cf2*)F.lds;
    LAS float* red = (LAS float*)(F.lds + USER_OFF + 1024);
    const int tid0 = F.tid;
    const bf16* Ut = (const bf16*)(F.ws + WS_UT); bf16* Zt = (bf16*)(F.ws + WS_ZT);
    const bf16* a3b = (const bf16*)(F.ws + WS_A3L) + (size_t)j * 8192 * 64; const float* a3c = (const float*)(F.ws + WS_A3C) + (size_t)j * 256 * 64;
    const float* wout = F.in[I_FWOUT] + (size_t)j * 64 * 4096; const float* convw = F.in[I_HCW] + (size_t)j * 3 * 3072; const float* convb = F.in[I_HCB] + (size_t)j * 3072;
    const float* biasd = F.in[I_HBD] + (size_t)j * 2 * 1024;
    LAS float* U4 = (LAS float*)(F.lds + USER_OFF + 2048);
    LAS float* nrm = (LAS float*)(F.lds + USER_OFF + 1536);
    LAS float* red8 = (LAS float*)(F.lds + USER_OFF + 1280);
#ifndef PROBE_HY_TAPS
#define PROBE_HY_TAPS 1
#endif
#pragma unroll 1
    for (int cc0 = 0; cc0 < 4; ++cc0) { const int c = F.vcu + 256 * cc0;
        if (cc0 == 0)
    {
        int tid = tid0; asm volatile("" : "+v"(tid));
        __syncthreads();
        for (int i = tid; i < 1024; i += NWAVES * 64) { const int cc = i >> 8, k = (i >> 2) & 63, q = i & 3; U4[i] = wout[(size_t)k * 4096 + q * 1024 + F.vcu + 256 * cc]; }
        __syncthreads();
        const int n = tid & 31, h = (tid >> 5) & 1, wv = tid >> 6, q = n & 3, cc = (n >> 2) & 3, sb = n >> 4, c = F.vcu + 256 * cc;
        bf16x8 bw[4];
#pragma unroll
        for (int f4 = 0; f4 < 4; ++f4) { unsigned pw[4];
#pragma unroll
            for (int e = 0; e < 4; ++e) { const int k0 = 16 * f4 + 8 * h + 2 * e; pw[e] = pk2(U4[cc * 256 + 4 * k0 + q], U4[cc * 256 + 4 * (k0 + 1) + q]); }
            bw[f4] = __builtin_bit_cast(bf16x8, (v4u){pw[0], pw[1], pw[2], pw[3]}); }
        const bf16x8 zero8 = __builtin_bit_cast(bf16x8, (v4u){0u, 0u, 0u, 0u});
        const float na = -(3.0701134573253945f + (15.350567286626973f - 3.0701134573253945f) * (float)c * (1.0f / 1023.0f)) * (1.0f / 8191.0f);
        const float r1 = expf(na), r2 = expf(2.0f * na), r3 = expf(3.0f * na);
        float sm = 0.f;
        float* tq = (float*)(F.ws + WS_TP) + (size_t)c * 2 * FFT_N + (size_t)(q & 1) * FFT_N + (q >> 1) * 8192;
#pragma unroll 1
        for (int i = 0; i < 16; ++i) {
            const int T0 = 64 * (wv + 8 * i);
            const bf16* ap = a3b + (size_t)T0 * 64 + 8 * (tid & 63);
            f32x16 acc;
#pragma unroll
            for (int e = 0; e < 16; ++e) acc[e] = 0.f;
#pragma unroll
            for (int s8 = 0; s8 < 2; ++s8)
#pragma unroll
                for (int f4 = 0; f4 < 4; ++f4)
                    acc = __builtin_amdgcn_mfma_f32_32x32x16_bf16(*(const GAS bf16x8*)(ap + (s8 * 4 + f4) * 512), sb == s8 ? bw[f4] : zero8, acc, 0, 0, 0);
#pragma unroll
            for (int g = 0; g < 4; ++g) { const int t = T0 + 32 * sb + 8 * g + 4 * h; const float d0 = expf(na * (float)t);
                f32x4 val = (f32x4){acc[4 * g] * d0, acc[4 * g + 1] * (d0 * r1), acc[4 * g + 2] * (d0 * r2), acc[4 * g + 3] * (d0 * r3)};
                sm += ((q >= 2 && t == 0) ? 0.f : fabsf(val.x)) + fabsf(val.y) + fabsf(val.z) + fabsf(val.w);
                *(GAS f32x4*)(tq + t) = val; }
        }
        sm += __shfl_xor(sm, 2); sm += __shfl_xor(sm, 16); sm += __shfl_xor(sm, 32);
        if ((tid & 50) == 0) red8[wv * 8 + 2 * cc + (q & 1)] = sm;
        __syncthreads();
        if (tid < 8) { float t8 = 0.f;
#pragma unroll
            for (int w = 0; w < NWAVES; ++w) t8 += red8[w * 8 + tid]; nrm[tid] = t8; }
        VM_WAIT();
        __syncthreads();
    }
        int tid = tid0; asm volatile("" : "+v"(tid));
        float* tp = (float*)(F.ws + WS_TP) + (size_t)c * 2 * FFT_N;
        float* Gc = (float*)(F.ws + WS_G) + (size_t)c * 2 * FFT_N * 2;
        __syncthreads();
        const float sum0 = nrm[2 * cc0], sum1 = nrm[2 * cc0 + 1];
        LAS float* U = U4 + cc0 * 256;
        const float absd = 3.0701134573253945f + (15.350567286626973f - 3.0701134573253945f) * (float)c * (1.0f / 1023.0f);
#pragma unroll 1
#ifndef PROBE_HY_SPEC
#define PROBE_HY_SPEC 2
#endif
        for (int o4 = 0; o4 < PROBE_HY_SPEC; ++o4) { const int o = o4 & 1;
            fft_fwd_first_taps(X, (const GAS float*)(tp + (size_t)o * FFT_N), 1.0f / (o == 0 ? sum0 : sum1), tid); __syncthreads();
            fft_fwd_double<1>(X, tid); __syncthreads();
            fft_fwd_double<3>(X, tid); __syncthreads();
            fft_mid_store(X, (GAS cf4*)(Gc + (size_t)o * FFT_N * 2), 1.0f / (float)FFT_N, biasd[o * 1024 + c], tid); __syncthreads();
        }
        VM_WAIT();
        __syncthreads();
        const float cwv0 = convw[2048 + c], cwv1 = convw[3072 + 2048 + c], cwv2 = convw[6144 + 2048 + c], cbv = convb[2048 + c];
        const float cwa0 = convw[c], cwa1 = convw[3072 + c], cwa2 = convw[6144 + c], cba = convb[c];
        const float cwb0 = convw[1024 + c], cwb1 = convw[3072 + 1024 + c], cwb2 = convw[6144 + 1024 + c], cbb = convb[1024 + c];
        const float d0 = biasd[c], d1 = biasd[1024 + c];
#ifndef PROBE_HY_PAIRS
#define PROBE_HY_PAIRS 4
#endif
        HyRaw rv, rg;
        hy_stage_load(Ut + (size_t)(2048 + c) * TT, rv, tid);
#pragma unroll 1
        for (int pr8 = 0; pr8 < PROBE_HY_PAIRS; ++pr8) { const int pr = pr8 & 3;
            const size_t tb0 = (size_t)(2 * pr) * SEQ;
            LAS float* S = (LAS float*)F.lds;
            float z0[16], z1[16];
            __syncthreads();
            hy_stage_write(rv, cwv0, cwv1, cwv2, cbv, S, tid); __syncthreads();
#pragma unroll
            for (int i = 0; i < 16; ++i) { z0[i] = S[tid + 512 * i]; z1[i] = S[8192 + tid + 512 * i]; }
#pragma unroll 1
            for (int o = 0; o < 2; ++o) {
                __syncthreads();
                fft_fwd_first(X, z0, z1, tid);
                hy_stage_load(Ut + (size_t)(o == 0 ? c : 1024 + c) * TT + tb0, rg, tid);
                if (o == 1) hy_stage_load(Ut + (size_t)(2048 + c) * TT + (size_t)(2 * ((pr8 + 1) & 3)) * SEQ, rv, tid);
                __syncthreads();
                fft_fwd_double<1>(X, tid); __syncthreads();
                fft_fwd_double<3>(X, tid); __syncthreads();
                fft_mid_mul(X, (const GAS cf4*)(Gc + (size_t)o * FFT_N * 2), tid); __syncthreads();
                fft_inv_double<3>(X, tid); __syncthreads();
                fft_inv_double<1>(X, tid); __syncthreads();
                fft_inv_last(X, z0, z1, tid); __syncthreads();
                hy_stage_write(rg, o == 0 ? cwa0 : cwb0, o == 0 ? cwa1 : cwb1, o == 0 ? cwa2 : cwb2, o == 0 ? cba : cbb, S, tid); __syncthreads();
#pragma unroll
                for (int i = 0; i < 16; ++i) { z0[i] *= S[tid + 512 * i]; z1[i] *= S[8192 + tid + 512 * i]; }
            }
            __syncthreads();
#pragma unroll
            for (int i = 0; i < 16; ++i) { S[tid + 512 * i] = z0[i]; S[8192 + tid + 512 * i] = z1[i]; }
            __syncthreads();
#pragma unroll
            for (int ch = 0; ch < 2; ++ch)
#pragma unroll
                for (int b = 0; b < 2; ++b) { const int n0 = 8 * tid + 4096 * ch; const f32x4 lo = *(const LAS f32x4*)(S + b * 8192 + n0), hi = *(const LAS f32x4*)(S + b * 8192 + n0 + 4);
                    v4u w; w.x = pk2(lo.x, lo.y); w.y = pk2(lo.z, lo.w); w.z = pk2(hi.x, hi.y); w.w = pk2(hi.z, hi.w);
                    *(GAS v4u*)(Zt + (size_t)c * TT + tb0 + (size_t)b * SEQ + n0) = w; }
        }
        if (!with_ctx) continue;
        asm volatile("" : "+v"(tid));
        __syncthreads();
        LAS float* tap0 = (LAS float*)F.lds; LAS float* tap1 = tap0 + 512; LAS float* vb = tap0 + 1024; LAS float* zb = tap0 + 1024 + 2048;
        {
            float f0 = 0.f, f1 = 0.f, b0 = 0.f, b1 = 0.f, s0 = 0.f, s1 = 0.f;
            if (tid < 256) { const int t = tid; const GAS f32x4* ar = (const GAS f32x4*)(a3c + (size_t)t * 64); f32x4 acc = (f32x4){0.f, 0.f, 0.f, 0.f};
#pragma unroll 4
                for (int k4 = 0; k4 < 16; ++k4) { const f32x4 a = ar[k4];
                    acc += a[0] * *(const LAS f32x4*)(U + 16 * k4) + a[1] * *(const LAS f32x4*)(U + 16 * k4 + 4) + a[2] * *(const LAS f32x4*)(U + 16 * k4 + 8) + a[3] * *(const LAS f32x4*)(U + 16 * k4 + 12); }
                const float dec = expf(-((float)t * (1.0f / 255.0f)) * absd);
                f0 = acc[0] * dec; f1 = acc[1] * dec; b0 = acc[2] * dec; b1 = acc[3] * dec;
                s0 = fabsf(f0) + (t > 0 ? fabsf(b0) : 0.f); s1 = fabsf(f1) + (t > 0 ? fabsf(b1) : 0.f); }
            block_sum2(F, red, s0, s1);
            if (tid < 256) { const float i0 = 1.0f / s0, i1 = 1.0f / s1; tap0[256 + tid] = f0 * i0; tap1[256 + tid] = f1 * i1; if (tid > 0) { tap0[256 - tid] = b0 * i0; tap1[256 - tid] = b1 * i1; } else { tap0[0] = 0.f; tap1[0] = 0.f; } }
        }
        const int cb_ = tid >> 6, n0 = (tid & 63) * 4;
        const size_t tcx = (size_t)TL + (size_t)cb_ * CTXL;
        float vloc[4], zloc[4];
        { const bf16* pv = Ut + (size_t)(2048 + c) * TT + tcx;
#pragma unroll
          for (int e = 0; e < 4; ++e) { vloc[e] = sconv3(pv, n0 + e, CTXL, cwv0, cwv1, cwv2, cbv); vb[cb_ * 256 + n0 + e] = vloc[e]; } }
        __syncthreads();
        { const bf16* pa = Ut + (size_t)c * TT + tcx; float acc[4] = {0.f, 0.f, 0.f, 0.f};
          for (int mI = 0; mI < 256; ++mI) { const float vv = vb[cb_ * 256 + mI];
#pragma unroll
              for (int e = 0; e < 4; ++e) acc[e] += tap0[256 + n0 + e - mI] * vv; }
#pragma unroll
          for (int e = 0; e < 4; ++e) { zloc[e] = sconv3(pa, n0 + e, CTXL, cwa0, cwa1, cwa2, cba) * (acc[e] + vloc[e] * d0); zb[cb_ * 256 + n0 + e] = zloc[e]; } }
        __syncthreads();
        { const bf16* pb = Ut + (size_t)(1024 + c) * TT + tcx; float acc[4] = {0.f, 0.f, 0.f, 0.f};
          for (int mI = 0; mI < 256; ++mI) { const float vv = zb[cb_ * 256 + mI];
#pragma unroll
              for (int e = 0; e < 4; ++e) acc[e] += tap1[256 + n0 + e - mI] * vv; }
#pragma unroll
          for (int e = 0; e < 4; ++e) { const float ov = sconv3(pb, n0 + e, CTXL, cwb0, cwb1, cwb2, cbb) * (acc[e] + zloc[e] * d1); Zt[(size_t)c * TT + tcx + n0 + e] = (bf16)f2bf(ov); } }
    }
}
__device__ __forceinline__ void transpose_phase(Frame& F, int ncols) {
    const bf16* Zt = (const bf16*)(F.ws + WS_ZT); bf16* Z = (bf16*)(F.ws + WS_O);
    LAS bf16* T = (LAS bf16*)(F.lds + F.wave * 16384);
    const int gw = F.vcu * NWAVES + F.wave, NGW = F.G * NWAVES, lane = F.lane;
    const int nitems = 16 * (ncols / 64);
    v4u tv[8];
    { const int it0 = gw < nitems ? gw : 0, ct = it0 & 15, tt = it0 >> 4;
#pragma unroll
      for (int i = 0; i < 8; ++i) { const int cr = (lane >> 3) + 8 * i, ch = lane & 7; tv[i] = *(const GAS v4u*)(Zt + (size_t)(ct * 64 + cr) * TT + (size_t)tt * 64 + ch * 8); } }
    for (int item = gw; item < nitems; item += NGW) {
        const int ct = item & 15, tt = item >> 4;
#pragma unroll
        for (int i = 0; i < 8; ++i) { const int cr = (lane >> 3) + 8 * i, ch = lane & 7; *(LAS v4u*)(T + cr * 72 + ch * 8) = tv[i]; }
        { const int itn = item + NGW < nitems ? item + NGW : item, ctn = itn & 15, ttn = itn >> 4;
#pragma unroll
          for (int i = 0; i < 8; ++i) { const int cr = (lane >> 3) + 8 * i, ch = lane & 7; tv[i] = *(const GAS v4u*)(Zt + (size_t)(ctn * 64 + cr) * TT + (size_t)ttn * 64 + ch * 8); } }
        LDS_WAIT(); asm volatile("" ::: "memory");
#pragma unroll
        for (int i = 0; i < 8; ++i) { const int tok = (lane >> 3) + 8 * i, cc = (lane & 7) * 8;
            unsigned short e[8];
#pragma unroll
            for (int q = 0; q < 8; ++q) e[q] = T[(cc + q) * 72 + tok];
            v4u o; o.x = e[0] | ((unsigned)e[1] << 16); o.y = e[2] | ((unsigned)e[3] << 16); o.z = e[4] | ((unsigned)e[5] << 16); o.w = e[6] | ((unsigned)e[7] << 16);
            *(GAS v4u*)(Z + (size_t)(tt * 64 + tok) * D + ct * 64 + cc) = o; }
        LDS_WAIT(); asm volatile("" ::: "memory");
    }
}

__device__ __forceinline__ void router_phase(Frame& F, int l) {
    const int nrows = rows_of_layer(l);
    constexpr int RR = 6;
    LAS bf16* Whi = (LAS bf16*)F.lds; LAS bf16* Wlo = Whi + 32 * 1024;
    LAS int* cnt = (LAS int*)(F.lds + USER_OFF); LAS int* base = cnt + 32; LAS int* rec = cnt + 64;
    const int tid = F.tid, lane = F.lane, wave = F.wave;
    const float* rw = F.in[I_RW] + (size_t)l * 1024 * 32;
    __syncthreads();
#pragma unroll 1
    for (int i0 = tid; i0 < 1024 * 32; i0 += 16 * NWAVES * 64) { float wv[16];
#pragma unroll
        for (int u = 0; u < 16; ++u) wv[u] = rw[i0 + u * NWAVES * 64];
#pragma unroll
        for (int u = 0; u < 16; ++u) { const int i = i0 + u * NWAVES * 64, k = i >> 5, e = i & 31; const float w = wv[u]; const unsigned hi = f2bf(w), lo = f2bf(w - bflo(hi));
            const int idx = e * 1024 + ((((k >> 3) ^ (e & 15)) << 3) | (k & 7)); Whi[idx] = (bf16)hi; Wlo[idx] = (bf16)lo; } }
    if (tid < 32) cnt[tid] = 0;
    __syncthreads();
    const float* mod = (const float*)(F.ws + WS_MOD) + (size_t)l * 9 * 6144;
    const float* gain = F.in[I_NFFN] + (size_t)l * D;
    const int gw = F.vcu * NWAVES + wave, NGW = F.G * NWAVES;
    bf16* H = (bf16*)(F.ws + WS_H);
    v4u rawn[RR][2];
#pragma unroll
    for (int r = 0; r < RR; ++r) { const int row = gw + r * NGW < nrows ? gw + r * NGW : gw;
        const GAS v4u* xr = (const GAS v4u*)((const bf16*)(F.ws + WS_XB) + (size_t)row * D) + lane; rawn[r][0] = xr[0]; rawn[r][1] = xr[64]; }
    for (int row0 = gw; row0 < nrows; row0 += RR * NGW) {
        f32x4 v[RR][4]; float s2[RR];
#pragma unroll
        for (int r = 0; r < RR; ++r) {
#pragma unroll
            for (int jj = 0; jj < 2; ++jj) row8_unpack(rawn[r][jj], v[r][2 * jj], v[r][2 * jj + 1]); }
        { const int nx0 = row0 + RR * NGW < nrows ? row0 + RR * NGW : row0;
#pragma unroll
          for (int r = 0; r < RR; ++r) { const int row = nx0 + r * NGW < nrows ? nx0 + r * NGW : nx0;
              const GAS v4u* xr = (const GAS v4u*)((const bf16*)(F.ws + WS_XB) + (size_t)row * D) + lane; rawn[r][0] = xr[0]; rawn[r][1] = xr[64]; } }
#pragma unroll
        for (int r = 0; r < RR; ++r) { s2[r] = 0.f;
#pragma unroll
            for (int jj = 0; jj < 4; ++jj) s2[r] += (v[r][jj].x * v[r][jj].x + v[r][jj].y * v[r][jj].y) + (v[r][jj].z * v[r][jj].z + v[r][jj].w * v[r][jj].w); }
#pragma unroll
        for (int o = 1; o < 64; o <<= 1) {
#pragma unroll
            for (int r = 0; r < RR; ++r) s2[r] += __shfl_xor(s2[r], o); }
#pragma unroll
        for (int r = 0; r < RR; ++r) { const int row = row0 + r * NGW < nrows ? row0 + r * NGW : row0;
            const float rstd = 1.0f / sqrtf(s2[r] * (1.0f / D) + NORM_EPS);
            const float* mr = mod + (size_t)mod_row(row) * 6144;
#pragma unroll
            for (int jj = 0; jj < 2; ++jj) { f32x4 hq[2];
#pragma unroll
                for (int hf = 0; hf < 2; ++hf) hq[hf] = v[r][2 * jj + hf] * rstd * ROW8_F32(gain, jj, hf, lane) * (ROW8_F32(mr + 4 * 1024, jj, hf, lane) + 1.0f) + ROW8_F32(mr + 3 * 1024, jj, hf, lane);
                ((GAS v4u*)(H + (size_t)row * D))[64 * jj + lane] = row8_pack(hq[0], hq[1]); } }
    }
    VM_WAIT();
    asm volatile("" ::: "memory");
    const int r32 = lane & 31, hh2 = lane >> 5;
    const float rb = F.in[I_RB][l * 32 + r32];
    const int nmine = (nrows - gw + NGW - 1) / NGW;
    for (int tile = 0; tile * 32 < nmine; ++tile) {
        const int irow = 32 * tile + r32; const size_t arow = (size_t)gw + (size_t)NGW * (irow < nmine ? irow : 0);
        const bf16* ap = H + arow * D + 8 * hh2;
        const LAS bf16* bh = Whi + r32 * 1024; const LAS bf16* bl = Wlo + r32 * 1024;
        f32x16 acc;
#pragma unroll
        for (int i = 0; i < 16; ++i) acc[i] = 0.f;
#pragma unroll 1
        for (int s0 = 0; s0 < 64; s0 += 32) {
            bf16x8 a[32];
#pragma unroll
            for (int u = 0; u < 32; ++u) a[u] = *(const GAS bf16x8*)(ap + 16 * (s0 + u));
            __builtin_amdgcn_sched_barrier(0);
#pragma unroll
            for (int u = 0; u < 32; ++u) {
                const int cb = ((2 * (s0 + u) + hh2) ^ (r32 & 15)) << 3;
                const bf16x8 b1 = *(const LAS bf16x8*)(bh + cb), b2 = *(const LAS bf16x8*)(bl + cb);
                acc = __builtin_amdgcn_mfma_f32_32x32x16_bf16(a[u], b1, acc, 0, 0, 0);
                acc = __builtin_amdgcn_mfma_f32_32x32x16_bf16(a[u], b2, acc, 0, 0, 0);
            }
            __builtin_amdgcn_sched_barrier(0);
        }
#pragma unroll 2
        for (int i = 0; i < 16; ++i) {
            if (32 * tile + (i & 3) + 8 * (i >> 2) >= nmine) continue;
            const float mine = acc[i] + rb; int rank = 0;
#pragma unroll 8
            for (int e2 = 0; e2 < 32; ++e2) { const float sv = __shfl(mine, (lane & 32) | e2); rank += (sv > mine || (sv == mine && e2 < r32)) ? 1 : 0; }
            const int rr = (i & 3) + 8 * (i >> 2);
#pragma unroll
            for (int hsel = 0; hsel < 2; ++hsel) {
                const int it = 32 * tile + rr + 4 * hsel;
                float tv[4]; int te[4];
#pragma unroll
                for (int k = 0; k < 4; ++k) { const unsigned long long mk = __ballot(rank == k) & (hsel ? 0xffffffff00000000ull : 0x00000000ffffffffull); const int src = __ffsll((long long)mk) - 1;
                    te[k] = src & 31; tv[k] = __builtin_bit_cast(float, __builtin_amdgcn_readlane(__builtin_bit_cast(int, mine), src)); }
                if (it < nmine) {
                    const size_t row = (size_t)gw + (size_t)NGW * it;
                    const float e1 = __expf(tv[1] - tv[0]), e2 = __expf(tv[2] - tv[0]), e3 = __expf(tv[3] - tv[0]), isum = 1.0f / (1.0f + e1 + e2 + e3);
                    if (lane == 0) *(GAS f32x4*)((float*)(F.ws + WS_GATE) + row * 4) = (f32x4){isum, e1 * isum, e2 * isum, e3 * isum};
                    if (lane < 4) { const int tel = lane == 0 ? te[0] : lane == 1 ? te[1] : lane == 2 ? te[2] : te[3];
                        const int rk = __hip_atomic_fetch_add(cnt + tel, 1, __ATOMIC_RELAXED, __HIP_MEMORY_SCOPE_WORKGROUP); rec[(wave * 64 + it) * 4 + lane] = tel | (rk << 8); }
                }
            }
        }
    }
    __syncthreads();
    if (tid < 32) base[tid] = (int)__hip_atomic_fetch_add((unsigned*)(F.ctl + CW_ECNT + l * 32 + tid), (unsigned)cnt[tid], RLX_AGENT);
    __syncthreads();
    for (int it = 0; it < nmine; ++it) {
        if (lane < 4) { const int rc = rec[(wave * 64 + it) * 4 + lane], e = rc & 255; ((int*)(F.ws + WS_POS))[((size_t)gw + (size_t)NGW * it) * 4 + lane] = e | ((base[e] + (rc >> 8)) << 8); }
    }
}
__device__ __forceinline__ void load_blkstart(Frame& F, int l, LAS int* blkstart) {
    __syncthreads();
    if (F.tid < 32) {
        const unsigned c = __hip_atomic_load((unsigned*)(F.ctl + CW_ECNT + l * 32 + F.tid), RLX_AGENT); const int nb = (int)((c + 255u) >> 8); int s = nb;
#pragma unroll
        for (int o = 1; o < 32; o <<= 1) { const int t = __shfl_up(s, o); if (F.tid >= o) s += t; }
        blkstart[F.tid] = s - nb; if (F.tid == 31) blkstart[32] = s; }
    __syncthreads();
    for (int rb = F.tid; rb < MAXBLK; rb += NWAVES * 64) { int e = 0;
#pragma unroll 1
        for (int q = 1; q < 32; ++q) e += (blkstart[q] <= rb) ? 1 : 0;
        blkstart[64 + rb] = e; }
    __syncthreads();
}
__device__ __forceinline__ void index_phase(Frame& F, int l) {
    const int nrows = rows_of_layer(l);
    LAS int* blkstart = (LAS int*)(F.lds + USER_OFF + 8192);
    load_blkstart(F, l, blkstart);
    const int* POS = (const int*)(F.ws + WS_POS); int* DEST = (int*)(F.ws + WS_DEST); int* RSRC = (int*)(F.ws + WS_RSRC);
    const int gt = F.vcu * (NWAVES * 64) + F.tid, NT = F.G * NWAVES * 64;
    for (int a = gt; a < nrows * 4; a += NT) { const int pk = POS[a], e = pk & 255, rk = pk >> 8, d = blkstart[e] * 256 + rk; DEST[a] = d; RSRC[d] = a >> 2; }
    if (F.bx < 32) { const int e = F.bx; const int cnt = (int)__hip_atomic_load((unsigned*)(F.ctl + CW_ECNT + l * 32 + e), RLX_AGENT), end = (blkstart[e + 1] - blkstart[e]) * 256;
        for (int p2 = cnt + F.tid; p2 < end; p2 += NWAVES * 64) RSRC[blkstart[e] * 256 + p2] = 0; }
}
__device__ __forceinline__ void combine_phase(Frame& F, int l, bool dry = false) {
    constexpr int RR = 3;
    const int gw = F.vcu * NWAVES + F.wave, NGW = F.G * NWAVES, lane = F.lane;
    const bf16* YS = (const bf16*)(F.ws + WS_YS); const int* POS = (const int*)(F.ws + WS_DEST); const float* GT = (const float*)(F.ws + WS_GATE);
    const float* mod = (const float*)(F.ws + WS_MOD);
    const int nrows = rows_of_layer(l);
    v4i psn[RR]; f32x4 gtn[RR];
#pragma unroll
    for (int r = 0; r < RR; ++r) { const int rw = gw + r * NGW < nrows ? gw + r * NGW : gw; psn[r] = *(const GAS v4i*)(POS + (size_t)rw * 4); gtn[r] = *(const GAS f32x4*)(GT + (size_t)rw * 4); }
    for (int row0 = gw; row0 < nrows; row0 += RR * NGW) {
        v4i ps[RR]; f32x4 gt[RR]; f32x4 v[RR][4]; int rows[RR];
#pragma unroll
        for (int r = 0; r < RR; ++r) { rows[r] = row0 + r * NGW < nrows ? row0 + r * NGW : row0; ps[r] = psn[r]; gt[r] = gtn[r]; }
        { const int nx0 = row0 + RR * NGW < nrows ? row0 + RR * NGW : row0;
#pragma unroll
          for (int r = 0; r < RR; ++r) { const int rw = nx0 + r * NGW < nrows ? nx0 + r * NGW : nx0; psn[r] = *(const GAS v4i*)(POS + (size_t)rw * 4); gtn[r] = *(const GAS f32x4*)(GT + (size_t)rw * 4); } }
#pragma unroll
        for (int r = 0; r < RR; ++r) { const int row = rows[r];
            const GAS v4u* xr = (const GAS v4u*)((const bf16*)(F.ws + WS_XB) + (size_t)row * D) + lane;
            const float* g2 = mod + ((size_t)l * 9 + mod_row(row)) * 6144 + 5 * 1024;
#pragma unroll
            for (int jj = 0; jj < 2; ++jj) {
                f32x4 y0 = (f32x4){0.f, 0.f, 0.f, 0.f}, y1 = y0;
#pragma unroll
                for (int k = 0; k < 4; ++k) { f32x4 a, b; row8_unpack(*(const GAS v4u*)(YS + (size_t)ps[r][k] * D + 512 * jj + 8 * lane), a, b); y0 += gt[r][k] * a; y1 += gt[r][k] * b; }
                f32x4 xa, xb2; row8_unpack(xr[64 * jj], xa, xb2);
                v[r][2 * jj] = xa + ROW8_F32(g2, jj, 0, lane) * y0; v[r][2 * jj + 1] = xb2 + ROW8_F32(g2, jj, 1, lane) * y1;
            } }
#pragma unroll
        for (int r = 0; r < RR; ++r) { const int row = rows[r];
            if (r > 0 && row0 + r * NGW >= nrows) continue;
            bf16* xw = (bf16*)(F.ws + (dry ? WS_ACT : WS_XB)) + (size_t)row * D; bf16* hw = (bf16*)(F.ws + (dry ? WS_ACT + 270 * MiB : WS_H)) + (size_t)row * D;
            if (l < DEPTH - 1) {
#pragma unroll
                for (int jj = 0; jj < 2; ++jj) ((GAS v4u*)xw)[64 * jj + lane] = row8_pack(v[r][2 * jj], v[r][2 * jj + 1]);
                const float* mr = mod + ((size_t)(l + 1) * 9 + mod_row(row)) * 6144;
                norm_mod_store(F, v[r], F.in[I_NMIX] + (size_t)(l + 1) * D, mr, mr + 1024, hw);
            } else {
                float s2 = 0.f;
#pragma unroll
                for (int jj = 0; jj < 4; ++jj) s2 += (v[r][jj].x * v[r][jj].x + v[r][jj].y * v[r][jj].y) + (v[r][jj].z * v[r][jj].z + v[r][jj].w * v[r][jj].w);
                const float rstd = 1.0f / sqrtf(wave_sum(s2) * (1.0f / D) + NORM_EPS);
#pragma unroll
                for (int q = 0; q < 4; ++q) ((GAS f32x4*)(dry ? (float*)(F.ws + WS_ACT) + (size_t)row * D : F.out + (size_t)row * D))[128 * (q >> 1) + 2 * lane + (q & 1)] = v[r][q] * rstd * ROW8_F32(F.in[I_FNORM], q >> 1, q & 1, lane);
            }
        }
    }
}
constexpr int N_PHASES = 1 + 10 * DEPTH;
#ifndef PG8_SP2
#define PG8_SP2 true
#endif
#ifndef PG8_ALIGN_EPI
#define PG8_ALIGN_EPI true
#endif
__host__ __device__ inline bool phase_exists(int ph) { if (ph == 0) return true; const int l = (ph - 1) / 10, k = (ph - 1) % 10; return !((k == 0 && l != 0) || (k == 3 && (l & 1) == 0)); }
struct Args { const float* in[N_IN]; float* out; unsigned char* ws; int ph_lo, ph_hi, use_bar, pad; };
__global__ void __launch_bounds__(NWAVES * 64, 2) fwd_kernel(Args args) {
    extern __shared__ __attribute__((aligned(16))) unsigned char lds[];
    Frame F;
    F.lds = (LAS unsigned char*)lds;
    F.MISC = (volatile LAS unsigned*)(F.lds + MISC_OFF);
    F.tid = threadIdx.x; F.lane = F.tid & 63; F.wave = __builtin_amdgcn_readfirstlane(F.tid >> 6);
    F.G = gridDim.x; { const int bx = blockIdx.x; F.vcu = (F.G % 8 == 0) ? (bx % 8) * (F.G / 8) + bx / 8 : bx; }
    const KAS Args* ap = (const KAS Args*)__builtin_amdgcn_kernarg_segment_ptr();
    F.in = ap->in; F.out = ap->out; F.ws = ap->ws;
    F.ctl = (gu32*)(F.ws + WS_CTL);
    const int use_bar = ap->use_bar;
    for (int u = F.tid; u < (USER_OFF - LDSCTL_OFF) / 4; u += NWAVES * 64) ((LAS unsigned*)(F.lds + LDSCTL_OFF))[u] = 0u;
    __syncthreads();
    XcdBarrier bar; bar.bar = (unsigned*)(F.ctl + CW_BAR); bar.x = 0; bar.st = nullptr;
    if (use_bar) bar = xcd_barrier_post((unsigned*)(F.ctl + CW_BAR), F.MISC + 8);
    const int hi = ap->ph_hi;
    LAS int* blkstart = (LAS int*)(F.lds + USER_OFF + 8192);
#ifndef PROBE_REP_MASK
#define PROBE_REP_MASK 0
#define PROBE_REP_KIND 2
#endif
    int rep_done = 0;
#pragma unroll 1
    for (int ph = ap->ph_lo; ph < hi; ++ph) {
        if (!phase_exists(ph)) continue;
        { int t_ = threadIdx.x; asm volatile("" : "+v"(t_)); F.tid = t_; F.lane = t_ & 63; F.wave = __builtin_amdgcn_readfirstlane(t_ >> 6);
          const KAS Args* a_ = ap; asm volatile("" : "+s"(a_)); F.in = a_->in;
          unsigned char* w_ = a_->ws; asm volatile("" : "+s"(w_)); F.ws = w_; float* o_ = a_->out; asm volatile("" : "+s"(o_)); F.out = o_;
          int v_ = F.vcu; asm volatile("" : "+s"(v_)); F.vcu = v_; int g_ = (int)gridDim.x; asm volatile("" : "+s"(g_)); F.G = g_; int b_ = (int)blockIdx.x; asm volatile("" : "+s"(b_)); F.bx = b_; }
        const int l = ph == 0 ? 0 : (ph - 1) / 10, k = ph == 0 ? -1 : (ph - 1) % 10, kind = l & 1, j = l >> 1;
        if (k == -1) {
#ifndef NO_P0
            p0_prologue(F);
#endif
        }
        else if (k == 0) norm0_phase(F);
        else if (k == 2) {
#ifndef NO_ATTN
            if (kind == 0) attn_phase(F, j, l == 0 ? 4096 + 128 : 4096);
#endif
#ifndef NO_HY
            if (kind == 1) hyena_phase(F, j, l == 1);
#endif
        }
#ifndef NO_TR
        else if (k == 3) transpose_phase(F, rows_of_layer(l));
#endif
#ifndef NO_ROUTER
        else if (k == 5) router_phase(F, l);
#endif
#ifndef NO_GATHER
        else if (k == 6) index_phase(F, l);
#endif
#ifndef NO_COMB
        else if (k == 9) combine_phase(F, l, ((PROBE_REP_MASK >> 10) & 1) != 0 && !rep_done);
#endif
        else if (k == 1 || k == 4 || k == 7 || k == 8) {
            pg8::Gemm g; pg8::AnyOrder S; pg8::EpiAny E;
            S.moe = 0; S.rb2e = blkstart + 64; S.nblk = 0; S.lg = 0; S.wbase = l * 32;
            E.bslot = (PG8_LAS float*)(F.lds + USER_OFF); E.ldc = TT; E.O = nullptr; E.f0 = nullptr; E.f1 = nullptr; E.p0 = nullptr; E.p1 = nullptr; E.p2 = nullptr; E.p3 = nullptr;
            if (k == 1 && kind == 0) {
                g = pg8::Gemm{(const bf16*)(F.ws + WS_H), (const bf16*)(F.ws + WS_WQK) + (size_t)j * QKD * 1024, TT, QKD, D}; S.so.init(TT, QKD, F.G, F.bx);
                E.mode = pg8::EPI_QK; E.O = (bf16*)(F.ws + WS_QK); E.p0 = F.in[I_ABQKV] + (size_t)j * 1536; E.p1 = (const float*)(F.ws + WS_ROPE);
            } else if (k == 1) {
                g = pg8::Gemm{(const bf16*)(F.ws + WS_WHIN) + (size_t)j * 3072 * 1024, (const bf16*)(F.ws + WS_H), 3072, rows_of_layer(l), D}; S.so.init(3072, rows_of_layer(l), F.G, F.bx);
                E.mode = pg8::EPI_T; E.O = (bf16*)(F.ws + WS_UT); E.p0 = F.in[I_HBIN] + (size_t)j * 3072;
            } else if (k == 4) {
                g = pg8::Gemm{(const bf16*)(F.ws + WS_O), kind == 0 ? (const bf16*)(F.ws + WS_WAO) + (size_t)j * 1024 * 1024 : (const bf16*)(F.ws + WS_WHO) + (size_t)j * 1024 * 1024, rows_of_layer(l), D, D};
                S.so.init(rows_of_layer(l), D, F.G, F.bx);
                E.mode = pg8::EPI_RES; E.p0 = l == 0 ? F.in[I_X] : nullptr; E.p1 = l == 0 ? F.in[I_CTX] : nullptr; E.O = (bf16*)(F.ws + WS_XB);
                E.p2 = kind == 0 ? F.in[I_ABO] + (size_t)j * 1024 : F.in[I_HBO] + (size_t)j * 1024; E.p3 = (const float*)(F.ws + WS_MOD) + (size_t)l * 9 * 6144 + 2 * 1024;
            } else {
                if (!use_bar) load_blkstart(F, l, blkstart);
                S.moe = 1; S.nblk = blkstart[32]; S.so.G = F.G; S.so.c = F.bx; S.so.nM = 0; S.so.nN = 0; S.so.nwg = 0;
                if (k == 7) { g = pg8::Gemm{(const bf16*)(F.ws + WS_H), (const bf16*)(F.ws + WS_WGU), MAXROWS, 2048, D, (const int*)(F.ws + WS_RSRC)}; S.lg = 3; E.mode = pg8::EPI_SWIGLU; E.O = (bf16*)(F.ws + WS_ACT); E.p0 = F.in[I_BGU] + (size_t)l * 32 * 2048; }
                else { g = pg8::Gemm{(const bf16*)(F.ws + WS_ACT), (const bf16*)(F.ws + WS_WDN), MAXROWS, 1024, D}; S.lg = 2; E.mode = pg8::EPI_DOWN; E.O = (bf16*)(F.ws + WS_YS); E.p0 = F.in[I_BDN] + (size_t)l * 32 * 1024; }
            }
#ifndef NO_G1
            pg8::gemm_phase<pg8::EpiAny, pg8::AnyOrder, PG8_ALIGN_EPI, PG8_SP2>(F.lds + RING_OFF, g, S, E);
#endif
        }
        if (use_bar && ph != N_PHASES - 1) xcd_barrier(bar);
#ifdef PROBE_DOUBLE_BAR
        if (use_bar && ph != N_PHASES - 1) xcd_barrier(bar);
#endif
        if (PROBE_REP_MASK != 0) { if (((PROBE_REP_MASK >> (k + 1)) & 1) && (PROBE_REP_KIND == 2 || kind == PROBE_REP_KIND) && !rep_done) { rep_done = 1; --ph;
                if (k == 5) { if (F.bx == 0 && F.tid < 32) __hip_atomic_store((unsigned*)(F.ctl + CW_ECNT + l * 32 + F.tid), 0u, RLX_AGENT); xcd_barrier(bar); }
            } else rep_done = 0; }
    }
}

extern "C" void kernel_launch(void* const* d_in, const int* in_sizes, int n_in, void* d_out, int out_size, void* d_ws, size_t ws_size, hipStream_t stream) {
    static int grid = 0;
    if (grid == 0) {
        if (n_in != N_IN || out_size != TL * D || ws_size < WS_END) { fprintf(stderr, "kernel_launch: unexpected shapes (n_in %d, out %d, ws %zu < %zu)\n", n_in, out_size, ws_size, (size_t)WS_END); grid = -1; return; }
        if (hipFuncSetAttribute((const void*)fwd_kernel, hipFuncAttributeMaxDynamicSharedMemorySize, LDS_BYTES) != hipSuccess) { fprintf(stderr, "kernel_launch: hipFuncSetAttribute failed\n"); grid = -1; return; }
        int per_cu = 0;
        if (hipOccupancyMaxActiveBlocksPerMultiprocessor(&per_cu, (const void*)fwd_kernel, NWAVES * 64, LDS_BYTES) != hipSuccess || per_cu < 1) fprintf(stderr, "kernel_launch: occupancy query says %d\n", per_cu);
        (void)hipGetLastError();
        grid = 256;
    }
    if (grid < 0) return;
    if (hipMemsetAsync((char*)d_ws + WS_CTL, 0, CTL_ZERO_BYTES, stream) != hipSuccess) return;
    Args a{};
    for (int i = 0; i < N_IN; ++i) a.in[i] = (const float*)d_in[i];
    a.out = (float*)d_out; a.ws = (unsigned char*)d_ws; a.pad = 0;
#if MK_ONE_LAUNCH
    a.ph_lo = 0; a.ph_hi = N_PHASES; a.use_bar = 1;
    hipLaunchKernelGGL(fwd_kernel, dim3(grid), dim3(NWAVES * 64), LDS_BYTES, stream, a);
#else
    for (int ph = 0; ph < N_PHASES; ++ph) {
        if (!phase_exists(ph)) continue;
        a.ph_lo = ph; a.ph_hi = ph + 1; a.use_bar = 0;
        hipLaunchKernelGGL(fwd_kernel, dim3(grid), dim3(NWAVES * 64), LDS_BYTES, stream, a);
    }
#endif
}
```
